# Optimizing an MI355X kernel written in HIP

```python
import jax, jax.numpy as jnp
from jax import lax
import numpy as np


D_MODEL = 2048
BATCH = 1
SEQ = 16384
DEPTH = 2

EPS = 1e-6
RET_HEADS = 4
RET_DK = D_MODEL // 8
RET_DV = D_MODEL // 8
RET_CHUNK = 128
ROPE_BASE = 10000.0
GMLP_GROUPS = 4
GMLP_DIM = D_MODEL // 8
GMLP_CHUNK = 128
RET_QK_WIDTH = RET_HEADS * RET_DK
RET_V_WIDTH = RET_HEADS * RET_DV
GMLP_WIDTH = GMLP_GROUPS * GMLP_DIM
AB_IN_WIDTH = 2 * RET_QK_WIDTH + 2 * RET_V_WIDTH + 2 * GMLP_WIDTH
AB_MIX_WIDTH = RET_V_WIDTH + GMLP_WIDTH
AB_SPLITS = [RET_QK_WIDTH, 2 * RET_QK_WIDTH, 2 * RET_QK_WIDTH + RET_V_WIDTH,
             2 * RET_QK_WIDTH + 2 * RET_V_WIDTH, 2 * RET_QK_WIDTH + 2 * RET_V_WIDTH + GMLP_WIDTH]
HGRN_DK = 128
HGRN_DV = 128
HGRN_HEADS = D_MODEL // HGRN_DK
HGRN_WIDTH = HGRN_HEADS * HGRN_DK
HGRN_IN_WIDTH = 4 * HGRN_WIDTH
HGRN_CHUNK = 32
N_GROUPS = 4
EXPERTS_PER_GROUP = 8
N_EXPERTS = N_GROUPS * EXPERTS_PER_GROUP
TOP_K = 2
EXPERT_FF = D_MODEL // 2
MOE_BLOCK = 128

kernel_name = 'hybrid_retention_gmlp_hgrn2_hmoe'


def _rmsnorm(x, g):
    xf = x.astype(jnp.float32)
    y = xf * lax.rsqrt(jnp.mean(xf * xf, axis=-1, keepdims=True) + EPS)
    return (y * g.astype(jnp.float32)).astype(x.dtype)


def _head_norm(x, gain, center):
    if center:
        x = x - jnp.mean(x, axis=-1, keepdims=True)
    y = x * lax.rsqrt(jnp.mean(x * x, axis=-1, keepdims=True) + EPS)
    return y.reshape(x.shape[0], x.shape[1], -1) * gain.astype(jnp.float32)


def _to_chunks(x, c):
    b, s, h, d = x.shape
    return x.reshape(b, s // c, c, h, d).transpose(1, 0, 3, 2, 4)


def _from_chunks(y):
    n, b, h, c, d = y.shape
    return y.transpose(1, 0, 3, 2, 4).reshape(b, n * c, h, d)


def _rope(x):
    s, d = x.shape[1], x.shape[-1]
    inv = ROPE_BASE ** (-jnp.arange(0, d, 2, dtype=jnp.float32) / d)
    ang = jnp.arange(s, dtype=jnp.float32)[:, None] * inv[None, :]
    cos = jnp.cos(ang)[None, :, None, :]
    sin = jnp.sin(ang)[None, :, None, :]
    x1, x2 = x[..., : d // 2], x[..., d // 2:]
    return jnp.concatenate([x1 * cos - x2 * sin, x2 * cos + x1 * sin], axis=-1)


def _retention(q, k, v, gate, gain):
    f32 = jnp.float32
    b, s, _ = q.shape
    q = _rope(q.astype(f32).reshape(b, s, RET_HEADS, RET_DK))
    k = _rope(k.astype(f32).reshape(b, s, RET_HEADS, RET_DK)) * (RET_DK ** -0.5)
    v = v.astype(f32).reshape(b, s, RET_HEADS, RET_DV)
    log_gamma = jnp.log(1.0 - jnp.exp2(-5.0 - jnp.arange(RET_HEADS, dtype=f32)))
    idx = jnp.arange(RET_CHUNK, dtype=f32)
    diff = idx[:, None] - idx[None, :]
    d_intra = jnp.where(diff >= 0, jnp.exp(jnp.maximum(diff, 0.0) * log_gamma[:, None, None]), 0.0)
    q_decay = jnp.exp((idx + 1.0)[None, :] * log_gamma[:, None])[..., None]
    k_decay = jnp.exp((RET_CHUNK - 1.0 - idx)[None, :] * log_gamma[:, None])[..., None]
    chunk_decay = jnp.exp(RET_CHUNK * log_gamma)[:, None, None]

    def step(state, xs):
        qc, kc, vc = xs
        scores = jnp.einsum('bhik,bhjk->bhij', qc, kc) * d_intra
        out = (jnp.einsum('bhij,bhjv->bhiv', scores, vc)
               + jnp.einsum('bhik,bhkv->bhiv', qc * q_decay, state))
        state = chunk_decay * state + jnp.einsum('bhjk,bhjv->bhkv', kc * k_decay, vc)
        return state, out

    init = jnp.zeros((b, RET_HEADS, RET_DK, RET_DV), f32)
    _, o = lax.scan(step, init, (_to_chunks(q, RET_CHUNK), _to_chunks(k, RET_CHUNK), _to_chunks(v, RET_CHUNK)))
    o = _head_norm(_from_chunks(o), gain, center=True)
    return (jax.nn.silu(gate.astype(f32)) * o).astype(gate.dtype)


def _chunked_gmlp(u, v, gain, w_s, b_s):
    f32 = jnp.float32
    b, s, _ = u.shape
    n = s // GMLP_CHUNK
    u = jax.nn.gelu(u.astype(f32))
    v = jax.nn.gelu(v.astype(f32)).reshape(b, n, GMLP_CHUNK, GMLP_GROUPS, GMLP_DIM)
    v = v - jnp.mean(v, axis=-1, keepdims=True)
    v = v * lax.rsqrt(jnp.mean(v * v, axis=-1, keepdims=True) + EPS) * gain.astype(f32).reshape(GMLP_GROUPS, GMLP_DIM)
    causal = jnp.tril(jnp.ones((GMLP_CHUNK, GMLP_CHUNK), f32))
    mixed = (jnp.einsum('gts,bnsgc->bntgc', w_s.astype(f32) * causal, v)
             + b_s.astype(f32).T[:, :, None])
    return (u * mixed.reshape(b, s, GMLP_WIDTH)).astype(u.dtype)


def _hgrn2(zq, zf, zi, zg, lb, gain):
    f32 = jnp.float32
    b, s, _ = zq.shape
    lb = lb.astype(f32)
    zf = zf.astype(f32)
    q = jax.nn.silu(zq.astype(f32)).reshape(b, s, HGRN_HEADS, HGRN_DK)
    f = lb + (1.0 - lb) * jax.nn.sigmoid(zf)
    k = ((1.0 - lb) * jax.nn.sigmoid(-zf)).reshape(b, s, HGRN_HEADS, HGRN_DK)
    log_f = jnp.log(f).reshape(b, s, HGRN_HEADS, HGRN_DK)
    v = zi.astype(f32).reshape(b, s, HGRN_HEADS, HGRN_DV)
    causal = jnp.tril(jnp.ones((HGRN_CHUNK, HGRN_CHUNK), f32))

    def step(state, xs):
        qc, kc, vc, lfc = xs
        cum = jnp.cumsum(lfc, axis=-2)
        q_dec = qc * jnp.exp(cum)
        scores = jnp.einsum('bhik,bhjk->bhij', q_dec, kc * jnp.exp(-cum)) * causal
        out = (jnp.einsum('bhij,bhjv->bhiv', scores, vc)
               + jnp.einsum('bhik,bhkv->bhiv', q_dec, state))
        last = cum[:, :, -1:, :]
        state = (jnp.exp(last)[:, :, 0, :, None] * state
                 + jnp.einsum('bhjk,bhjv->bhkv', kc * jnp.exp(last - cum), vc))
        return state, out

    init = jnp.zeros((b, HGRN_HEADS, HGRN_DK, HGRN_DV), f32)
    _, o = lax.scan(step, init, (_to_chunks(q, HGRN_CHUNK), _to_chunks(k, HGRN_CHUNK),
                                 _to_chunks(v, HGRN_CHUNK), _to_chunks(log_f, HGRN_CHUNK)))
    o = _head_norm(_from_chunks(o), gain, center=False)
    return (o * jax.nn.silu(zg.astype(f32))).astype(zg.dtype)


def _hier_moe(h, w_rg, b_rg, w_re, b_re, w_gate, w_up, w_down):
    f32 = jnp.float32
    b, s, d = h.shape
    t = b * s
    m = t * TOP_K
    xt = h.reshape(t, d)
    p_group = jax.nn.softmax(jnp.einsum('td,dg->tg', xt, w_rg).astype(f32) + b_rg.astype(f32), axis=-1)
    p_sel, g_sel = lax.top_k(p_group, 1)
    logits_e = (jnp.einsum('td,de->te', xt, w_re).astype(f32) + b_re.astype(f32)).reshape(t, N_GROUPS, EXPERTS_PER_GROUP)
    logits_in = jnp.take_along_axis(logits_e, g_sel[:, :, None], axis=1)[:, 0]
    top_logit, e_sel = lax.top_k(logits_in, TOP_K)
    gates = (p_sel * jax.nn.softmax(top_logit, axis=-1)).reshape(m)
    expert_id = (g_sel * EXPERTS_PER_GROUP + e_sel).reshape(m).astype(jnp.int32)
    token_id = jnp.repeat(jnp.arange(t, dtype=jnp.int32), TOP_K)

    order = jnp.argsort(expert_id)
    sorted_e = expert_id[order]
    counts = jnp.zeros((N_EXPERTS,), jnp.int32).at[expert_id].add(1)
    starts = jnp.cumsum(counts) - counts
    padded = (counts + MOE_BLOCK - 1) // MOE_BLOCK * MOE_BLOCK
    padded_ends = jnp.cumsum(padded)
    padded_starts = padded_ends - padded
    dest = padded_starts[sorted_e] + jnp.arange(m, dtype=jnp.int32) - starts[sorted_e]
    n_blocks = -(-(m + N_EXPERTS * (MOE_BLOCK - 1)) // MOE_BLOCK)
    buf_tok = jnp.zeros((n_blocks * MOE_BLOCK,), jnp.int32).at[dest].set(token_id[order])
    buf_gate = jnp.zeros((n_blocks * MOE_BLOCK,), f32).at[dest].set(gates[order])
    block_start = jnp.arange(n_blocks, dtype=jnp.int32) * MOE_BLOCK
    block_expert = jnp.minimum(jnp.searchsorted(padded_ends, block_start, side='right'), N_EXPERTS - 1)

    def run_block(args):
        tok, e = args
        xb = xt[tok]
        hid = jax.nn.silu(xb @ w_gate[e]) * (xb @ w_up[e])
        return hid @ w_down[e]

    out = lax.map(run_block, (buf_tok.reshape(n_blocks, MOE_BLOCK), block_expert))
    y = jnp.zeros((t, d), f32).at[buf_tok].add(out.reshape(-1, d).astype(f32) * buf_gate[:, None])
    return y.astype(h.dtype).reshape(b, s, d)


def setup_inputs(seed: int = 0) -> dict:
    key = jax.random.key(seed)
    ks = jax.random.split(key, 21)
    f32 = jnp.float32
    n_even = (DEPTH + 1) // 2
    n_odd = DEPTH // 2

    def nrm(k, shape, scale):
        return jax.random.normal(k, shape, f32) * scale

    def gain(k, shape):
        return 1.0 + 0.05 * jax.random.normal(k, shape, f32)

    return {
        'x': nrm(ks[0], (BATCH, SEQ, D_MODEL), 1.0),
        'attn_norm': gain(ks[1], (DEPTH, D_MODEL)),
        'ffn_norm': gain(ks[2], (DEPTH, D_MODEL)),
        'final_norm': gain(ks[3], (D_MODEL,)),
        'w_in_ab': nrm(ks[4], (n_even, D_MODEL, AB_IN_WIDTH), D_MODEL ** -0.5),
        'ret_norm': gain(ks[5], (n_even, RET_V_WIDTH)),
        'gmlp_norm': gain(ks[6], (n_even, GMLP_WIDTH)),
        'gmlp_ws': nrm(ks[7], (n_even, GMLP_GROUPS, GMLP_CHUNK, GMLP_CHUNK), GMLP_CHUNK ** -0.5),
        'gmlp_bs': 1.0 + nrm(ks[8], (n_even, GMLP_GROUPS, GMLP_CHUNK), 0.1),
        'w_out_ab': nrm(ks[9], (n_even, AB_MIX_WIDTH, D_MODEL), AB_MIX_WIDTH ** -0.5),
        'w_in_c': nrm(ks[10], (n_odd, D_MODEL, HGRN_IN_WIDTH), D_MODEL ** -0.5),
        'lb_params': nrm(ks[11], (DEPTH, HGRN_WIDTH), 0.1),
        'hgrn_norm': gain(ks[12], (n_odd, HGRN_WIDTH)),
        'w_out_c': nrm(ks[13], (n_odd, HGRN_WIDTH, D_MODEL), HGRN_WIDTH ** -0.5),
        'router_w_group': nrm(ks[14], (DEPTH, D_MODEL, N_GROUPS), D_MODEL ** -0.5),
        'router_b_group': nrm(ks[15], (DEPTH, N_GROUPS), 0.01),
        'router_w_expert': nrm(ks[16], (DEPTH, D_MODEL, N_EXPERTS), D_MODEL ** -0.5),
        'router_b_expert': nrm(ks[17], (DEPTH, N_EXPERTS), 0.01),
        'w_gate': nrm(ks[18], (DEPTH, N_EXPERTS, D_MODEL, EXPERT_FF), D_MODEL ** -0.5),
        'w_up': nrm(ks[19], (DEPTH, N_EXPERTS, D_MODEL, EXPERT_FF), D_MODEL ** -0.5),
        'w_down': nrm(ks[20], (DEPTH, N_EXPERTS, EXPERT_FF, D_MODEL), EXPERT_FF ** -0.5),
    }


def reference(x, attn_norm, ffn_norm, final_norm, w_in_ab, ret_norm, gmlp_norm, gmlp_ws, gmlp_bs,
              w_out_ab, w_in_c, lb_params, hgrn_norm, w_out_c, router_w_group, router_b_group,
              router_w_expert, router_b_expert, w_gate, w_up, w_down):
    lb_soft = jax.nn.softmax(lb_params.astype(jnp.float32), axis=0)
    lower_bounds = jnp.cumsum(lb_soft, axis=0) - lb_soft[0]
    for layer in range(DEPTH):
        i = layer // 2
        h = _rmsnorm(x, attn_norm[layer])
        if layer % 2 == 0:
            proj = jnp.einsum('bsd,de->bse', h, w_in_ab[i])
            q, k, v, g, u, vs = jnp.split(proj, AB_SPLITS, axis=-1)
            mixed = jnp.concatenate([_retention(q, k, v, g, ret_norm[i]),
                                     _chunked_gmlp(u, vs, gmlp_norm[i], gmlp_ws[i], gmlp_bs[i])], axis=-1)
            x = x + jnp.einsum('bse,ed->bsd', mixed, w_out_ab[i])
        else:
            proj = jnp.einsum('bsd,de->bse', h, w_in_c[i])
            zq, zf, zi, zg = jnp.split(proj, 4, axis=-1)
            mixed = _hgrn2(zq, zf, zi, zg, lower_bounds[layer], hgrn_norm[i])
            x = x + jnp.einsum('bse,ed->bsd', mixed, w_out_c[i])
        h = _rmsnorm(x, ffn_norm[layer])
        x = x + _hier_moe(h, router_w_group[layer], router_b_group[layer], router_w_expert[layer],
                          router_b_expert[layer], w_gate[layer], w_up[layer], w_down[layer])
    return _rmsnorm(x, final_norm)
```

```cpp
#include <hip/hip_runtime.h>
#include <stdint.h>

#define T_ 16384
#define D_ 2048
#define NEXP 32
#define FF_ 1024
#define CAP_ 32768

__device__ __forceinline__ float wave_sum(float v) {
#pragma unroll
    for (int o = 32; o > 0; o >>= 1) v += __shfl_xor(v, o);
    return v;
}
__device__ __forceinline__ float silu_f(float x) { return x / (1.f + __expf(-x)); }
__device__ __forceinline__ float sigmoid_f(float x) { return 1.f / (1.f + __expf(-x)); }
__device__ __forceinline__ float gelu_tanh_f(float x) {
    const float c = 0.7978845608028654f;
    float u = c * (x + 0.044715f * x * x * x);
    return 0.5f * x * (1.f + tanhf(u));
}

__global__ void __launch_bounds__(256) k_rmsnorm(const float* __restrict__ x, const float* __restrict__ g, float* __restrict__ out) {
    const int row = blockIdx.x * 4 + (threadIdx.x >> 6), lane = threadIdx.x & 63;
    const float4* xr = (const float4*)(x + (size_t)row * D_);
    float4 v[8]; float ss = 0.f;
#pragma unroll
    for (int i = 0; i < 8; ++i) { v[i] = xr[lane + 64 * i]; ss += v[i].x * v[i].x + v[i].y * v[i].y + v[i].z * v[i].z + v[i].w * v[i].w; }
    ss = wave_sum(ss);
    const float r = rsqrtf(ss * (1.f / D_) + 1e-6f);
    float4* orow = (float4*)(out + (size_t)row * D_);
#pragma unroll
    for (int i = 0; i < 8; ++i) { const float4 gg = ((const float4*)g)[lane + 64 * i]; float4 o; o.x = v[i].x * r * gg.x; o.y = v[i].y * r * gg.y; o.z = v[i].z * r * gg.z; o.w = v[i].w * r * gg.w; orow[lane + 64 * i] = o; }
}

struct GemmArgs {
    const float* A; int lda;
    const float* B; int ldb;
    float* C; int ldc;
    int M, N, K;
    const int* cnt; const int* aidx; const int* cidx;
    int ashift; int accumulate;
    long long strideB; int strideIdx; int pad;
};
__global__ void __launch_bounds__(256) k_gemm_naive(GemmArgs g) {
    const int z = blockIdx.z;
    const float* B = g.B + (size_t)z * (size_t)g.strideB;
    const int M = g.cnt ? g.cnt[z] : g.M;
    const int* aidx = g.aidx ? g.aidx + (size_t)z * g.strideIdx : nullptr;
    const int* cidx = g.cidx ? g.cidx + (size_t)z * g.strideIdx : nullptr;
    const int m0 = blockIdx.y * 64, n0 = blockIdx.x * 64;
    if (m0 >= M) return;
    __shared__ float As[16][65];
    __shared__ float Bs[16][64];
    const int tx = threadIdx.x & 15, ty = threadIdx.x >> 4;
    float acc[4][4];
#pragma unroll
    for (int i = 0; i < 4; ++i)
#pragma unroll
        for (int j = 0; j < 4; ++j) acc[i][j] = 0.f;
    const int ar = threadIdx.x >> 2, ak = (threadIdx.x & 3) * 4;
    const int arow_g = m0 + ar; const bool avalid = arow_g < M;
    size_t arow = 0;
    if (avalid) arow = aidx ? (size_t)(aidx[arow_g] >> g.ashift) : (size_t)arow_g;
    const float* Ap = g.A + arow * (size_t)g.lda + ak;
    const int bk = threadIdx.x >> 4, bn = (threadIdx.x & 15) * 4;
    const float* Bp = B + (size_t)bk * g.ldb + n0 + bn;
    for (int k0 = 0; k0 < g.K; k0 += 16) {
        float4 av = make_float4(0.f, 0.f, 0.f, 0.f);
        if (avalid) av = *(const float4*)(Ap + k0);
        const float4 bv = *(const float4*)(Bp + (size_t)k0 * g.ldb);
        As[ak + 0][ar] = av.x; As[ak + 1][ar] = av.y; As[ak + 2][ar] = av.z; As[ak + 3][ar] = av.w;
        *(float4*)&Bs[bk][bn] = bv;
        __syncthreads();
#pragma unroll
        for (int kk = 0; kk < 16; ++kk) {
            float a0 = As[kk][ty * 4 + 0], a1 = As[kk][ty * 4 + 1], a2 = As[kk][ty * 4 + 2], a3 = As[kk][ty * 4 + 3];
            const float4 b = *(const float4*)&Bs[kk][tx * 4];
            acc[0][0] += a0 * b.x; acc[0][1] += a0 * b.y; acc[0][2] += a0 * b.z; acc[0][3] += a0 * b.w;
            acc[1][0] += a1 * b.x; acc[1][1] += a1 * b.y; acc[1][2] += a1 * b.z; acc[1][3] += a1 * b.w;
            acc[2][0] += a2 * b.x; acc[2][1] += a2 * b.y; acc[2][2] += a2 * b.z; acc[2][3] += a2 * b.w;
            acc[3][0] += a3 * b.x; acc[3][1] += a3 * b.y; acc[3][2] += a3 * b.z; acc[3][3] += a3 * b.w;
        }
        __syncthreads();
    }
#pragma unroll
    for (int i = 0; i < 4; ++i) {
        const int r = m0 + ty * 4 + i;
        if (r < M) {
            const size_t cr = cidx ? (size_t)cidx[r] : (size_t)r;
            float4* cp = (float4*)(g.C + cr * (size_t)g.ldc + n0 + tx * 4);
            float4 o = make_float4(acc[i][0], acc[i][1], acc[i][2], acc[i][3]);
            if (g.accumulate) { const float4 c = *cp; o.x += c.x; o.y += c.y; o.z += c.z; o.w += c.w; }
            *cp = o;
        }
    }
}

__global__ void __launch_bounds__(256) k_rope(float* __restrict__ proj) {
    const size_t gid = (size_t)blockIdx.x * 256 + threadIdx.x;
    const int j = (int)(gid & 127); const int hh = (int)((gid >> 7) & 7); const int t = (int)(gid >> 10);
    const double inv = pow(10000.0, -(double)(2 * j) / 256.0);
    const double ang = (double)t * inv;
    const float c = (float)cos(ang), s = (float)sin(ang);
    float* p = proj + (size_t)t * 6144 + hh * 256 + j;
    const float a = p[0], b = p[128];
    const float sc = hh >= 4 ? 0.0625f : 1.f;
    p[0] = (a * c - b * s) * sc; p[128] = (b * c + a * s) * sc;
}

__global__ void __launch_bounds__(256) k_ret_rec(const float* __restrict__ proj, float* __restrict__ oret) {
    const int h = blockIdx.x >> 4, d0 = (blockIdx.x & 15) * 16;
    const int tid = threadIdx.x, kg = tid >> 4, j = tid & 15;
    const float gamma = 1.f - exp2f(-5.f - (float)h);
    float S[16];
#pragma unroll
    for (int i = 0; i < 16; ++i) S[i] = 0.f;
    __shared__ float qs[16][256], ks[16][256], vs[16][16], red[16][4][16];
    for (int t0 = 0; t0 < T_; t0 += 16) {
        __syncthreads();
        for (int i = tid; i < 16 * 256; i += 256) { const int tt = i >> 8, c = i & 255; const float* pr = proj + (size_t)(t0 + tt) * 6144;
            qs[tt][c] = pr[h * 256 + c]; ks[tt][c] = pr[1024 + h * 256 + c]; }
        for (int i = tid; i < 16 * 16; i += 256) { const int tt = i >> 4, c = i & 15; vs[tt][c] = proj[(size_t)(t0 + tt) * 6144 + 2048 + h * 256 + d0 + c]; }
        __syncthreads();
        for (int tt = 0; tt < 16; ++tt) {
            const float v = vs[tt][j]; float o = 0.f;
#pragma unroll
            for (int i = 0; i < 16; ++i) { S[i] = gamma * S[i] + ks[tt][kg * 16 + i] * v; o += qs[tt][kg * 16 + i] * S[i]; }
            o += __shfl_xor(o, 16); o += __shfl_xor(o, 32);
            if ((tid & 63) < 16) red[tt][tid >> 6][j] = o;
        }
        __syncthreads();
        for (int i = tid; i < 16 * 16; i += 256) { const int tt = i >> 4, c = i & 15;
            oret[(size_t)(t0 + tt) * 1024 + h * 256 + d0 + c] = red[tt][0][c] + red[tt][1][c] + red[tt][2][c] + red[tt][3][c]; }
    }
}
__global__ void __launch_bounds__(256) k_ret_post(const float* __restrict__ oret, const float* __restrict__ proj, const float* __restrict__ gain, float* __restrict__ mix) {
    const int w = blockIdx.x * 4 + (threadIdx.x >> 6), lane = threadIdx.x & 63;
    const int t = w >> 2, h = w & 3;
    const float4 v = *(const float4*)(oret + (size_t)t * 1024 + h * 256 + lane * 4);
    const float mean = wave_sum(v.x + v.y + v.z + v.w) * (1.f / 256.f);
    const float a = v.x - mean, b = v.y - mean, c = v.z - mean, d = v.w - mean;
    const float var = wave_sum(a * a + b * b + c * c + d * d) * (1.f / 256.f);
    const float r = rsqrtf(var + 1e-6f);
    const float4 gn = *(const float4*)(gain + h * 256 + lane * 4);
    const float4 gt = *(const float4*)(proj + (size_t)t * 6144 + 3072 + h * 256 + lane * 4);
    float4 o; o.x = silu_f(gt.x) * a * r * gn.x; o.y = silu_f(gt.y) * b * r * gn.y; o.z = silu_f(gt.z) * c * r * gn.z; o.w = silu_f(gt.w) * d * r * gn.w;
    *(float4*)(mix + (size_t)t * D_ + h * 256 + lane * 4) = o;
}

__global__ void __launch_bounds__(256) k_gmlp_norm(float* __restrict__ proj, const float* __restrict__ gain) {
    const int w = blockIdx.x * 4 + (threadIdx.x >> 6), lane = threadIdx.x & 63;
    const int t = w >> 2, g = w & 3;
    float* pv = proj + (size_t)t * 6144 + 5120 + g * 256 + lane * 4;
    float4 v = *(float4*)pv;
    v.x = gelu_tanh_f(v.x); v.y = gelu_tanh_f(v.y); v.z = gelu_tanh_f(v.z); v.w = gelu_tanh_f(v.w);
    const float mean = wave_sum(v.x + v.y + v.z + v.w) * (1.f / 256.f);
    const float a = v.x - mean, b = v.y - mean, c = v.z - mean, d = v.w - mean;
    const float var = wave_sum(a * a + b * b + c * c + d * d) * (1.f / 256.f);
    const float r = rsqrtf(var + 1e-6f);
    const float4 gn = *(const float4*)(gain + g * 256 + lane * 4);
    float4 o; o.x = a * r * gn.x; o.y = b * r * gn.y; o.z = c * r * gn.z; o.w = d * r * gn.w;
    *(float4*)pv = o;
    float* pu = proj + (size_t)t * 6144 + 4096 + g * 256 + lane * 4;
    float4 u = *(float4*)pu;
    u.x = gelu_tanh_f(u.x); u.y = gelu_tanh_f(u.y); u.z = gelu_tanh_f(u.z); u.w = gelu_tanh_f(u.w);
    *(float4*)pu = u;
}
__global__ void __launch_bounds__(256) k_gmlp_mix(const float* __restrict__ proj, const float* __restrict__ ws, const float* __restrict__ bs, float* __restrict__ mix) {
    const int n = blockIdx.x >> 2, g = blockIdx.x & 3, c = threadIdx.x;
    const float* W = ws + (size_t)g * 128 * 128;
    for (int tb = 0; tb < 128; tb += 16) {
        float acc[16];
#pragma unroll
        for (int i = 0; i < 16; ++i) acc[i] = 0.f;
        for (int s = 0; s < tb + 16; ++s) {
            const float v = proj[(size_t)(n * 128 + s) * 6144 + 5120 + g * 256 + c];
#pragma unroll
            for (int i = 0; i < 16; ++i) { const float w = (s <= tb + i) ? W[(tb + i) * 128 + s] : 0.f; acc[i] += w * v; }
        }
#pragma unroll
        for (int i = 0; i < 16; ++i) { const int t = n * 128 + tb + i;
            const float u = proj[(size_t)t * 6144 + 4096 + g * 256 + c];
            mix[(size_t)t * D_ + 1024 + g * 256 + c] = u * (acc[i] + bs[g * 128 + tb + i]); }
    }
}

__global__ void __launch_bounds__(256) k_hgrn_prep(float* __restrict__ proj, const float* __restrict__ lbp) {
    const size_t gid = (size_t)blockIdx.x * 256 + threadIdx.x;
    const int c = (int)(gid & 2047); const size_t t = gid >> 11;
    const float lb = 1.f / (1.f + __expf(lbp[c] - lbp[2048 + c]));
    float* p = proj + t * 8192 + c;
    p[0] = silu_f(p[0]);
    p[2048] = lb + (1.f - lb) * sigmoid_f(p[2048]);
    p[6144] = silu_f(p[6144]);
}
__global__ void __launch_bounds__(256) k_hgrn_rec(const float* __restrict__ proj, float* __restrict__ o) {
    const int h = blockIdx.x >> 3, d0 = (blockIdx.x & 7) * 16;
    const int tid = threadIdx.x, kg = tid >> 4, j = tid & 15;
    float S[8];
#pragma unroll
    for (int i = 0; i < 8; ++i) S[i] = 0.f;
    __shared__ float qs[32][128], fs[32][128], vs[32][16], red[32][4][16];
    for (int t0 = 0; t0 < T_; t0 += 32) {
        __syncthreads();
        for (int i = tid; i < 32 * 128; i += 256) { const int tt = i >> 7, c = i & 127; const float* pr = proj + (size_t)(t0 + tt) * 8192 + h * 128 + c;
            qs[tt][c] = pr[0]; fs[tt][c] = pr[2048]; }
        for (int i = tid; i < 32 * 16; i += 256) { const int tt = i >> 4, c = i & 15; vs[tt][c] = proj[(size_t)(t0 + tt) * 8192 + 4096 + h * 128 + d0 + c]; }
        __syncthreads();
        for (int tt = 0; tt < 32; ++tt) {
            const float v = vs[tt][j]; float acc = 0.f;
#pragma unroll
            for (int i = 0; i < 8; ++i) { const float f = fs[tt][kg * 8 + i]; S[i] = f * S[i] + (1.f - f) * v; acc += qs[tt][kg * 8 + i] * S[i]; }
            acc += __shfl_xor(acc, 16); acc += __shfl_xor(acc, 32);
            if ((tid & 63) < 16) red[tt][tid >> 6][j] = acc;
        }
        __syncthreads();
        for (int i = tid; i < 32 * 16; i += 256) { const int tt = i >> 4, c = i & 15;
            o[(size_t)(t0 + tt) * D_ + h * 128 + d0 + c] = red[tt][0][c] + red[tt][1][c] + red[tt][2][c] + red[tt][3][c]; }
    }
}
__global__ void __launch_bounds__(256) k_hgrn_post(const float* __restrict__ o, const float* __restrict__ proj, const float* __restrict__ gain, float* __restrict__ mix) {
    const int w = blockIdx.x * 4 + (threadIdx.x >> 6), lane = threadIdx.x & 63;
    const int t = w >> 4, h = w & 15;
    const float2 v = *(const float2*)(o + (size_t)t * D_ + h * 128 + lane * 2);
    const float var = wave_sum(v.x * v.x + v.y * v.y) * (1.f / 128.f);
    const float r = rsqrtf(var + 1e-6f);
    const float2 gn = *(const float2*)(gain + h * 128 + lane * 2);
    const float2 gt = *(const float2*)(proj + (size_t)t * 8192 + 6144 + h * 128 + lane * 2);
    float2 out; out.x = v.x * r * gn.x * gt.x; out.y = v.y * r * gn.y * gt.y;
    *(float2*)(mix + (size_t)t * D_ + h * 128 + lane * 2) = out;
}

__global__ void __launch_bounds__(256) k_router(const float* __restrict__ h, const float* __restrict__ wg, const float* __restrict__ bg,
                                                const float* __restrict__ we, const float* __restrict__ be,
                                                int* __restrict__ cnt, int* __restrict__ list, float* __restrict__ gate) {
    const int t = blockIdx.x * 4 + (threadIdx.x >> 6), lane = threadIdx.x & 63;
    const float* hr = h + (size_t)t * D_;
    float lg[4], le[32];
#pragma unroll
    for (int i = 0; i < 4; ++i) lg[i] = 0.f;
#pragma unroll
    for (int i = 0; i < 32; ++i) le[i] = 0.f;
    for (int k = lane; k < D_; k += 64) {
        const float x = hr[k];
        const float4 g4 = *(const float4*)(wg + (size_t)k * 4);
        lg[0] += x * g4.x; lg[1] += x * g4.y; lg[2] += x * g4.z; lg[3] += x * g4.w;
        const float4* e4 = (const float4*)(we + (size_t)k * 32);
#pragma unroll
        for (int i = 0; i < 8; ++i) { const float4 e = e4[i]; le[4 * i] += x * e.x; le[4 * i + 1] += x * e.y; le[4 * i + 2] += x * e.z; le[4 * i + 3] += x * e.w; }
    }
#pragma unroll
    for (int i = 0; i < 4; ++i) lg[i] = wave_sum(lg[i]) + bg[i];
#pragma unroll
    for (int i = 0; i < 32; ++i) le[i] = wave_sum(le[i]) + be[i];
    int gs = 0; float gm = lg[0];
#pragma unroll
    for (int i = 1; i < 4; ++i) if (lg[i] > gm) { gm = lg[i]; gs = i; }
    float den = 0.f;
#pragma unroll
    for (int i = 0; i < 4; ++i) den += __expf(lg[i] - gm);
    const float psel = 1.f / den;
    float l8[8];
#pragma unroll
    for (int i = 0; i < 8; ++i) l8[i] = gs == 0 ? le[i] : gs == 1 ? le[8 + i] : gs == 2 ? le[16 + i] : le[24 + i];
    int e1 = 0; float m1 = l8[0];
#pragma unroll
    for (int i = 1; i < 8; ++i) if (l8[i] > m1) { m1 = l8[i]; e1 = i; }
    int e2 = -1; float m2 = -3.0e38f;
#pragma unroll
    for (int i = 0; i < 8; ++i) if (i != e1 && l8[i] > m2) { m2 = l8[i]; e2 = i; }
    const float z = __expf(m2 - m1);
    const float g1 = psel / (1.f + z), g2 = psel * z / (1.f + z);
    if (lane == 0) {
        const int ex1 = gs * 8 + e1, ex2 = gs * 8 + e2;
        const int p1 = atomicAdd(&cnt[ex1], 1); list[(size_t)ex1 * CAP_ + p1] = t * 2;
        const int p2 = atomicAdd(&cnt[ex2], 1); list[(size_t)ex2 * CAP_ + p2] = t * 2 + 1;
        gate[t * 2] = g1; gate[t * 2 + 1] = g2;
    }
}
__global__ void __launch_bounds__(256) k_silu_mul(float* __restrict__ G, const float* __restrict__ U) {
    const size_t i = ((size_t)blockIdx.x * 256 + threadIdx.x) * 4;
    float4 g = *(float4*)(G + i); const float4 u = *(const float4*)(U + i);
    g.x = silu_f(g.x) * u.x; g.y = silu_f(g.y) * u.y; g.z = silu_f(g.z) * u.z; g.w = silu_f(g.w) * u.w;
    *(float4*)(G + i) = g;
}
__global__ void __launch_bounds__(256) k_combine(float* __restrict__ x, const float* __restrict__ O, const float* __restrict__ gate) {
    const size_t i = ((size_t)blockIdx.x * 256 + threadIdx.x) * 4;
    const size_t t = i >> 11; const int c = (int)(i & 2047);
    float4 xv = *(float4*)(x + i);
    const float4 a = *(const float4*)(O + (t * 2) * D_ + c), b = *(const float4*)(O + (t * 2 + 1) * D_ + c);
    const float g1 = gate[t * 2], g2 = gate[t * 2 + 1];
    xv.x += g1 * a.x + g2 * b.x; xv.y += g1 * a.y + g2 * b.y; xv.z += g1 * a.z + g2 * b.z; xv.w += g1 * a.w + g2 * b.w;
    *(float4*)(x + i) = xv;
}

static void gemm(hipStream_t st, const float* A, int lda, const float* B, int ldb, float* C, int ldc, int M, int N, int K, int accumulate,
                 int batch = 1, const int* cnt = nullptr, const int* aidx = nullptr, int ashift = 0, const int* cidx = nullptr, long long strideB = 0, int strideIdx = 0) {
    GemmArgs g{};
    g.A = A; g.lda = lda; g.B = B; g.ldb = ldb; g.C = C; g.ldc = ldc; g.M = M; g.N = N; g.K = K;
    g.cnt = cnt; g.aidx = aidx; g.cidx = cidx; g.ashift = ashift; g.accumulate = accumulate; g.strideB = strideB; g.strideIdx = strideIdx; g.pad = 0;
    dim3 grid(N / 64, (M + 63) / 64, batch);
    hipLaunchKernelGGL(k_gemm_naive, grid, dim3(256), 0, st, g);
}

static void moe_layer(hipStream_t st, int layer, float* xbuf, float* h, float* Gb, float* Ub, float* Ob, int* cnt, int* list, float* gate,
                      const float* ffn_norm, const float* wrg, const float* brg, const float* wre, const float* bre,
                      const float* wgate, const float* wup, const float* wdown) {
    hipLaunchKernelGGL(k_rmsnorm, dim3(T_ / 4), dim3(256), 0, st, xbuf, ffn_norm + layer * D_, h);
    hipLaunchKernelGGL(k_router, dim3(T_ / 4), dim3(256), 0, st, h, wrg + (size_t)layer * D_ * 4, brg + layer * 4, wre + (size_t)layer * D_ * 32, bre + layer * 32,
                       cnt + layer * NEXP, list, gate);
    const size_t lw = (size_t)layer * NEXP * D_ * FF_;
    gemm(st, h, D_, wgate + lw, FF_, Gb, FF_, T_, FF_, D_, 0, NEXP, cnt + layer * NEXP, list, 1, list, (long long)D_ * FF_, CAP_);
    gemm(st, h, D_, wup + lw, FF_, Ub, FF_, T_, FF_, D_, 0, NEXP, cnt + layer * NEXP, list, 1, list, (long long)D_ * FF_, CAP_);
    hipLaunchKernelGGL(k_silu_mul, dim3((size_t)T_ * 2 * FF_ / 1024), dim3(256), 0, st, Gb, Ub);
    gemm(st, Gb, FF_, wdown + lw, D_, Ob, D_, T_, D_, FF_, 0, NEXP, cnt + layer * NEXP, list, 0, list, (long long)FF_ * D_, CAP_);
    hipLaunchKernelGGL(k_combine, dim3((size_t)T_ * D_ / 1024), dim3(256), 0, st, xbuf, Ob, gate);
}

extern "C" void kernel_launch(void* const* d_in, const int* in_sizes, int n_in, void* d_out, int out_size, void* d_ws, size_t ws_size, hipStream_t stream) {
    const float* x = (const float*)d_in[0];
    const float* attn_norm = (const float*)d_in[1];
    const float* ffn_norm = (const float*)d_in[2];
    const float* final_norm = (const float*)d_in[3];
    const float* w_in_ab = (const float*)d_in[4];
    const float* ret_norm = (const float*)d_in[5];
    const float* gmlp_norm = (const float*)d_in[6];
    const float* gmlp_ws = (const float*)d_in[7];
    const float* gmlp_bs = (const float*)d_in[8];
    const float* w_out_ab = (const float*)d_in[9];
    const float* w_in_c = (const float*)d_in[10];
    const float* lb_params = (const float*)d_in[11];
    const float* hgrn_norm = (const float*)d_in[12];
    const float* w_out_c = (const float*)d_in[13];
    const float* wrg = (const float*)d_in[14];
    const float* brg = (const float*)d_in[15];
    const float* wre = (const float*)d_in[16];
    const float* bre = (const float*)d_in[17];
    const float* wgate = (const float*)d_in[18];
    const float* wup = (const float*)d_in[19];
    const float* wdown = (const float*)d_in[20];
    float* out = (float*)d_out;

    char* ws = (char*)d_ws; size_t off = 0;
    auto take = [&](size_t bytes) { char* p = ws + off; off += (bytes + 255) & ~(size_t)255; return p; };
    int* cnt = (int*)take(256);
    float* xbuf = (float*)take((size_t)T_ * D_ * 4);
    float* h = (float*)take((size_t)T_ * D_ * 4);
    float* mix = (float*)take((size_t)T_ * D_ * 4);
    float* gate = (float*)take((size_t)T_ * 2 * 4);
    int* list = (int*)take((size_t)NEXP * CAP_ * 4);
    char* big = take((size_t)T_ * 8192 * 4);
    float* proj = (float*)big;
    float* oret = (float*)take((size_t)T_ * 2048 * 4);
    float* Gb = (float*)big; float* Ub = Gb + (size_t)T_ * 2 * FF_; float* Ob = Ub + (size_t)T_ * 2 * FF_;

    hipMemsetAsync(cnt, 0, 256, stream);
    hipLaunchKernelGGL(k_rmsnorm, dim3(T_ / 4), dim3(256), 0, stream, x, attn_norm, h);
    gemm(stream, h, D_, w_in_ab, 6144, proj, 6144, T_, 6144, D_, 0);
    hipLaunchKernelGGL(k_rope, dim3(T_ * 8 * 128 / 256), dim3(256), 0, stream, proj);
    hipLaunchKernelGGL(k_ret_rec, dim3(64), dim3(256), 0, stream, (const float*)proj, oret);
    hipLaunchKernelGGL(k_ret_post, dim3(T_ * 4 / 4), dim3(256), 0, stream, (const float*)oret, (const float*)proj, ret_norm, mix);
    hipLaunchKernelGGL(k_gmlp_norm, dim3(T_ * 4 / 4), dim3(256), 0, stream, proj, gmlp_norm);
    hipLaunchKernelGGL(k_gmlp_mix, dim3(128 * 4), dim3(256), 0, stream, (const float*)proj, gmlp_ws, gmlp_bs, mix);
    hipMemcpyAsync(xbuf, x, (size_t)T_ * D_ * 4, hipMemcpyDeviceToDevice, stream);
    gemm(stream, mix, D_, w_out_ab, D_, xbuf, D_, T_, D_, D_, 1);
    moe_layer(stream, 0, xbuf, h, Gb, Ub, Ob, cnt, list, gate, ffn_norm, wrg, brg, wre, bre, wgate, wup, wdown);
    hipLaunchKernelGGL(k_rmsnorm, dim3(T_ / 4), dim3(256), 0, stream, (const float*)xbuf, attn_norm + D_, h);
    gemm(stream, h, D_, w_in_c, 8192, proj, 8192, T_, 8192, D_, 0);
    hipLaunchKernelGGL(k_hgrn_prep, dim3((size_t)T_ * 2048 / 256), dim3(256), 0, stream, proj, lb_params);
    hipLaunchKernelGGL(k_hgrn_rec, dim3(128), dim3(256), 0, stream, (const float*)proj, oret  );
    hipLaunchKernelGGL(k_hgrn_post, dim3(T_ * 16 / 4), dim3(256), 0, stream, (const float*)oret, (const float*)proj, hgrn_norm, mix);
    gemm(stream, mix, D_, w_out_c, D_, xbuf, D_, T_, D_, D_, 1);
    moe_layer(stream, 1, xbuf, h, Gb, Ub, Ob, cnt, list, gate, ffn_norm, wrg, brg, wre, bre, wgate, wup, wdown);
    hipLaunchKernelGGL(k_rmsnorm, dim3(T_ / 4), dim3(256), 0, stream, (const float*)xbuf, final_norm, out);
}
```

```cpp
#include <hip/hip_runtime.h>
#include <stdint.h>
#define T_ 16384
#define D_ 2048
__device__ __forceinline__ float wave_sum(float v) {
#pragma unroll
    for (int o = 32; o > 0; o >>= 1) v += __shfl_xor(v, o);
    return v;
}
#define GRID_BAR() do { } while (0)
typedef unsigned short bf16_t;
typedef short bf16x8 __attribute__((ext_vector_type(8)));
typedef float f32x4 __attribute__((ext_vector_type(4)));
typedef unsigned u32x4 __attribute__((ext_vector_type(4)));
typedef unsigned u32x2 __attribute__((ext_vector_type(2)));
#define LAS __attribute__((address_space(3)))
#define NTHR 512

__device__ __forceinline__ unsigned cvt_pk_bf16(float lo, float hi) { unsigned r; asm volatile("v_cvt_pk_bf16_f32 %0, %1, %2" : "=v"(r) : "v"(lo), "v"(hi)); return r; }
__device__ __forceinline__ float bf2f(bf16_t b) { return __uint_as_float(((unsigned)b) << 16); }
__device__ __forceinline__ float bflo(unsigned w) { return __uint_as_float(w << 16); }
__device__ __forceinline__ float bfhi(unsigned w) { return __uint_as_float(w & 0xffff0000u); }

__device__ __forceinline__ int lds_byte(int r, int c) { const int st = (r >> 4) * 2 + (c >> 5), ob = (r & 15) * 64 + (c & 31) * 2; return st * 1024 + (ob ^ (((ob >> 9) & 1) << 5)); }
__device__ __forceinline__ void stage_rc(int b, int& R, int& C) { const int st = b >> 10, sb = b & 1023, swz = sb ^ (((sb >> 9) & 1) << 5); R = (st >> 1) * 16 + swz / 64; C = (st & 1) * 32 + (swz % 64) / 2; }

#define WAIT_V0() asm volatile("s_waitcnt vmcnt(0)" ::: "memory")
__device__ __forceinline__ int opaque_tid(int wave_s) { int t = wave_s * 64 + (int)__builtin_amdgcn_mbcnt_hi(~0u, __builtin_amdgcn_mbcnt_lo(~0u, 0u)); asm volatile("" : "+v"(t)); return t; }

template <int MF> __device__ __forceinline__ int arow_of(int wr, int m, int fr) { if (MF == 8) return (m >> 2) * 128 + wr * 64 + (m & 3) * 16 + fr; return wr * (MF * 16) + m * 16 + fr; }
template <int NF> __device__ __forceinline__ int bcol_of(int wc, int n, int fq, int j) {
    if (NF == 4) return (n >> 1) * 128 + wc * 32 + 8 * fq + 4 * (n & 1) + j;
    if (NF == 2) return wc * 32 + 8 * fq + 4 * n + j;
    return wc * 16 + 4 * fq + j; }
template <int MF> __device__ __forceinline__ int aslot_to_row(int s) { const int wr = s / (MF * 16), m = (s >> 4) % MF, fr = s & 15; return arow_of<MF>(wr, m, fr); }
template <int NF> __device__ __forceinline__ int bslot_to_col(int s) { const int wc = s / (NF * 16), n = (s >> 4) % NF, i = s & 15; return bcol_of<NF>(wc, n, i >> 2, i & 3); }

template <int MF, int NF> struct Core {
    static constexpr int BM = 32 * MF, BN = 64 * NF;
    static constexpr int GA = BM / 64, GB = BN / 64;
    static constexpr int TA = BM * 128, TB = BN * 128;
    static __device__ __forceinline__ void apiece(int tid, int i, int& row, int& c) { int R, C; stage_rc((tid >> 6) * 1024 + i * 8192 + (tid & 63) * 16, R, C); row = aslot_to_row<MF>(R); c = C; }
    static __device__ __forceinline__ void bpiece(int tid, int i, int& col, int& c) { int R, C; stage_rc((tid >> 6) * 1024 + i * 8192 + (tid & 63) * 16, R, C); col = bslot_to_col<NF>(R); c = C; }
    static __device__ __forceinline__ void zero(f32x4 (&acc)[MF][NF]) {
#pragma unroll
        for (int m = 0; m < MF; ++m)
#pragma unroll
            for (int n = 0; n < NF; ++n) acc[m][n] = (f32x4){0.f, 0.f, 0.f, 0.f}; }
    static __device__ __forceinline__ void compute(LAS unsigned char* la, LAS unsigned char* lb, f32x4 (&acc)[MF][NF], int wr, int wc, int fr, int fq) {
        const int ao = lds_byte(wr * MF * 16 + fr, fq * 8), bo = lds_byte(wc * NF * 16 + fr, fq * 8);
#pragma unroll
        for (int ks = 0; ks < 2; ++ks) {
            bf16x8 At[MF], Bf[NF];
#pragma unroll
            for (int m = 0; m < MF; ++m) At[m] = *(const LAS bf16x8*)(la + ao + m * 2048 + ks * 1024);
#pragma unroll
            for (int n = 0; n < NF; ++n) Bf[n] = *(const LAS bf16x8*)(lb + bo + n * 2048 + ks * 1024);
#pragma unroll
            for (int m = 0; m < MF; ++m)
#pragma unroll
                for (int n = 0; n < NF; ++n) acc[m][n] = __builtin_amdgcn_mfma_f32_16x16x32_bf16(Bf[n], At[m], acc[m][n], 0, 0, 0);
            __builtin_amdgcn_sched_barrier(0);
        }
    }
    static __device__ __forceinline__ void stage_a(LAS unsigned char* dst, const char* base, const unsigned (&off)[GA], unsigned kbyte, int wid) {
#pragma unroll
        for (int i = 0; i < GA; ++i) __builtin_amdgcn_global_load_lds((const unsigned*)(base + off[i] + kbyte), (LAS unsigned*)(dst + wid * 1024 + i * 8192), 16, 0, 0); }
    static __device__ __forceinline__ void stage_b(LAS unsigned char* dst, const char* base, const unsigned (&off)[GB], unsigned kbyte, int wid) {
#pragma unroll
        for (int i = 0; i < GB; ++i) __builtin_amdgcn_global_load_lds((const unsigned*)(base + off[i] + kbyte), (LAS unsigned*)(dst + wid * 1024 + i * 8192), 16, 0, 0); }
    static __device__ __forceinline__ void loop_gg(LAS unsigned char* lds, const char* Ab, const unsigned (&aoff)[GA], const char* Bb, const unsigned (&boff)[GB], int nt,
                                                   f32x4 (&acc)[MF][NF], int wid, int wr, int wc, int fr, int fq) {
        constexpr int STG = TA + TB;
        stage_a(lds, Ab, aoff, 0, wid); stage_b(lds + TA, Bb, boff, 0, wid);
        WAIT_V0(); __syncthreads();
        for (int t = 0; t < nt; ++t) {
            const int cur = t & 1;
            if (t + 1 < nt) { stage_a(lds + (cur ^ 1) * STG, Ab, aoff, (unsigned)(t + 1) * 128u, wid); stage_b(lds + (cur ^ 1) * STG + TA, Bb, boff, (unsigned)(t + 1) * 128u, wid); }
            compute(lds + cur * STG, lds + cur * STG + TA, acc, wr, wc, fr, fq);
            WAIT_V0(); __syncthreads();
        }
    }
    static __device__ __forceinline__ void loop_lg(LAS unsigned char* la, LAS unsigned char* lb, const char* Bb, const unsigned (&boff)[GB], int nt,
                                                   f32x4 (&acc)[MF][NF], int wid, int wr, int wc, int fr, int fq) {
        stage_b(lb, Bb, boff, 0, wid);
        WAIT_V0(); __syncthreads();
        for (int t = 0; t < nt; ++t) {
            const int cur = t & 1;
            if (t + 1 < nt) stage_b(lb + (cur ^ 1) * TB, Bb, boff, (unsigned)(t + 1) * 128u, wid);
            compute(la + t * TA, lb + cur * TB, acc, wr, wc, fr, fq);
            WAIT_V0(); __syncthreads();
        }
    }
    static __device__ __forceinline__ void loop_gl(LAS unsigned char* la, const char* Ab, const unsigned (&aoff)[GA], LAS unsigned char* lb, int nt,
                                                   f32x4 (&acc)[MF][NF], int wid, int wr, int wc, int fr, int fq) {
        stage_a(la, Ab, aoff, 0, wid);
        WAIT_V0(); __syncthreads();
        for (int t = 0; t < nt; ++t) {
            const int cur = t & 1;
            if (t + 1 < nt) stage_a(la + (cur ^ 1) * TA, Ab, aoff, (unsigned)(t + 1) * 128u, wid);
            compute(la + cur * TA, lb + t * TB, acc, wr, wc, fr, fq);
            WAIT_V0(); __syncthreads();
        }
    }
};
__device__ __forceinline__ bool unit_of(long L, int nM, int nN, int& pm, int& pn) {
    const int nwg = nM * nN; if (L >= nwg) return false;
    int wgid = (int)L; { const int q = nwg / 8, r = nwg % 8, xcd = wgid % 8, off = wgid / 8; wgid = (xcd < r ? xcd * (q + 1) : r * (q + 1) + (xcd - r) * q) + off; }
    const int nig = 8 * nN, gid = wgid / nig, fm = gid * 8, gsz = (nM - fm) < 8 ? (nM - fm) : 8;
    pm = fm + ((wgid % nig) % gsz); pn = (wgid % nig) / gsz; return true;
}

template <class Epi>
__device__ __forceinline__ void gemm_phase(LAS unsigned char* lds, const bf16_t* A, const bf16_t* Bt, int nM, int nN, int K, const Epi& E, int wave_s) {
    typedef Core<8, 4> C;
    const int tid = opaque_tid(wave_s), wid = __builtin_amdgcn_readfirstlane(tid >> 6), lane = tid & 63, wr = wid >> 2, wc = wid & 3, fr = lane & 15, fq = lane >> 4;
    unsigned aoff[4], boff[4];
#pragma unroll
    for (int i = 0; i < 4; ++i) { int r, c; C::apiece(tid, i, r, c); aoff[i] = (unsigned)(r * K + c) * 2u; C::bpiece(tid, i, r, c); boff[i] = (unsigned)(r * K + c) * 2u; }
    for (int it = 0;; ++it) {
        int pm, pn; if (!unit_of((long)it * gridDim.x + blockIdx.x, nM, nN, pm, pn)) break;
        const bool sw = E.swapped(pn);
        const char* act = (const char*)(A + (size_t)pm * 256 * K); const char* wt = (const char*)(Bt + (size_t)E.brow0(pn) * K);
        f32x4 acc[8][4]; C::zero(acc);
        C::loop_gg(lds, sw ? wt : act, aoff, sw ? act : wt, boff, K / 64, acc, wid, wr, wc, fr, fq);
        E(acc, pm, pn, wr, wc, fr, fq);
    }
}

struct EpiPlainF32 {
    float* Cout; int ldc;
    __device__ __forceinline__ bool swapped(int) const { return false; }
    __device__ __forceinline__ int brow0(int pn) const { return pn * 256; }
    __device__ __forceinline__ void operator()(const f32x4 (&acc)[8][4], int pm, int pn, int wr, int wc, int fr, int fq) const {
#pragma unroll
        for (int m = 0; m < 8; ++m) { float* rp = Cout + (size_t)(pm * 256 + arow_of<8>(wr, m, fr)) * ldc + pn * 256;
#pragma unroll
            for (int n = 0; n < 4; ++n) *(f32x4*)(rp + bcol_of<4>(wc, n, fq, 0)) = acc[m][n]; }
    }
};

struct ConvJob { const float* W; bf16_t* dst; int K, N, batch, rows_per_batch, grp, grp_stride, add, pad; };
__device__ __forceinline__ void conv_phase(LAS unsigned char* lds, const ConvJob& J, int wg, int nwg, int wave_s) {
    const int tid = opaque_tid(wave_s), n = tid & 63, kg = tid >> 6;
    const int tk = J.K / 128, tn = J.N / 64, per = tk * tn, total = per * J.batch;
    for (int u = wg; u < total; u += nwg) {
        const int b = u / per, r = u % per, kt = r / tn, nt = r % tn;
        const float* src = J.W + ((size_t)b * J.K + (size_t)kt * 128) * J.N + nt * 64 + n;
#pragma unroll
        for (int p = 0; p < 2; ++p) {
            const int g = p * 8 + kg; float v[8];
#pragma unroll
            for (int j = 0; j < 8; ++j) v[j] = src[(size_t)(g * 8 + j) * J.N];
            u32x4 w; w.x = cvt_pk_bf16(v[0], v[1]); w.y = cvt_pk_bf16(v[2], v[3]); w.z = cvt_pk_bf16(v[4], v[5]); w.w = cvt_pk_bf16(v[6], v[7]);
            *(LAS u32x4*)(lds + n * 272 + g * 16) = w;
        }
        __syncthreads();
#pragma unroll
        for (int p = 0; p < 2; ++p) {
            const int q = tid + 512 * p, row = q >> 4, pc = q & 15;
            const u32x4 w = *(const LAS u32x4*)(lds + row * 272 + pc * 16);
            const int nn = nt * 64 + row;
            const size_t drow = (size_t)b * J.rows_per_batch + (size_t)(nn / J.grp) * J.grp_stride + (nn % J.grp) + J.add;
            *(u32x4*)(J.dst + drow * J.K + kt * 128 + pc * 8) = w;
        }
        __syncthreads();
    }
}

__device__ __forceinline__ void norm_rows_bf16(const float* __restrict__ x, const float* __restrict__ g, bf16_t* __restrict__ out, int wg, int nwg, int wave_s) {
    const int tid = opaque_tid(wave_s), lane = tid & 63, wv = tid >> 6;
    for (int row = wg * 8 + wv; row < T_; row += nwg * 8) {
        const float4* xr = (const float4*)(x + (size_t)row * D_);
        float4 v[8]; float ss = 0.f;
#pragma unroll
        for (int i = 0; i < 8; ++i) { v[i] = xr[lane + 64 * i]; ss += v[i].x * v[i].x + v[i].y * v[i].y + v[i].z * v[i].z + v[i].w * v[i].w; }
        ss = wave_sum(ss);
        const float r = rsqrtf(ss * (1.f / D_) + 1e-6f);
#pragma unroll
        for (int i = 0; i < 8; ++i) { const float4 gg = ((const float4*)g)[lane + 64 * i];
            u32x2 o; o.x = cvt_pk_bf16(v[i].x * r * gg.x, v[i].y * r * gg.y); o.y = cvt_pk_bf16(v[i].z * r * gg.z, v[i].w * r * gg.w);
            *(u32x2*)(out + (size_t)row * D_ + (lane + 64 * i) * 4) = o; }
    }
}
__device__ __forceinline__ void rope_tab_phase(LAS unsigned char* lds, float* cn, float* sn, float* ct, float* st, int wg, int nwg, int wave_s) {
    LAS double* inv = (LAS double*)lds; const int tid = opaque_tid(wave_s);
    if (tid < 128) inv[tid] = exp2(-(double)tid * (13.287712379549449 / 128.0)) * 0.15915494309189535;
    __syncthreads();
    for (int i = wg * NTHR + tid; i < T_ * 128; i += nwg * NTHR) {
        const int pos = i >> 7, j = i & 127;
        const double rev = (double)pos * inv[j];
        const float fr = (float)(rev - rint(rev));
        const float c = __builtin_amdgcn_cosf(fr), s = __builtin_amdgcn_sinf(fr);
        cn[i] = c; sn[i] = s; ct[(size_t)j * T_ + pos] = c; st[(size_t)j * T_ + pos] = s;
    }
    __syncthreads();
}

__device__ __forceinline__ float gelu_fast(float x) { const float u = 0.7978845608028654f * (x + 0.044715f * x * x * x); return x / (1.f + __expf(-2.f * u)); }
__device__ __forceinline__ float silu_fast(float x) { return x / (1.f + __expf(-x)); }

struct EpiInAB {
    bf16_t *qb, *kb, *khatT, *vT, *sgb, *ugb, *gvT;
    const float *cn, *sn, *ct, *st;
    __device__ __forceinline__ bool swapped(int pn) const { return (pn >= 8 && pn < 12) || pn >= 20; }
    __device__ __forceinline__ int brow0(int pn) const { return pn * 256; }
    __device__ __forceinline__ void operator()(const f32x4 (&acc)[8][4], int pm, int pn, int wr, int wc, int fr, int fq) const {
        if (pn < 8) {
            bf16_t* dst = (pn < 4 ? qb : kb) + (pn & 3) * 256; const float sc = pn < 4 ? 1.f : 0.0625f;
#pragma unroll
            for (int m = 0; m < 8; ++m) { int row = pm * 256 + arow_of<8>(wr, m, fr); asm volatile("" : "+v"(row));
                u32x4 lo, hi;
                const float* cp = cn + (size_t)row * 128 + wc * 32 + 8 * fq; const float* sp = sn + (size_t)row * 128 + wc * 32 + 8 * fq;
#pragma unroll
                for (int nn = 0; nn < 2; ++nn) {
                    const f32x4 c = *(const f32x4*)(cp + 4 * nn), s = *(const f32x4*)(sp + 4 * nn);
                    const f32x4 x1 = acc[m][nn], x2 = acc[m][nn + 2];
                    const f32x4 o1 = (x1 * c - x2 * s) * sc, o2 = (x2 * c + x1 * s) * sc;
                    if (nn == 0) { lo.x = cvt_pk_bf16(o1[0], o1[1]); lo.y = cvt_pk_bf16(o1[2], o1[3]); hi.x = cvt_pk_bf16(o2[0], o2[1]); hi.y = cvt_pk_bf16(o2[2], o2[3]); }
                    else         { lo.z = cvt_pk_bf16(o1[0], o1[1]); lo.w = cvt_pk_bf16(o1[2], o1[3]); hi.z = cvt_pk_bf16(o2[0], o2[1]); hi.w = cvt_pk_bf16(o2[2], o2[3]); } }
                bf16_t* rp = dst + (size_t)row * 1024 + wc * 32 + 8 * fq;
                *(u32x4*)rp = lo; *(u32x4*)(rp + 128) = hi; asm volatile("" ::: "memory"); }
        } else if (pn >= 12 && pn < 20) {
            const bool isg = pn < 16; bf16_t* dst = (isg ? sgb : ugb) + (pn & 3) * 256;
#pragma unroll
            for (int m = 0; m < 8; ++m) { int row = pm * 256 + arow_of<8>(wr, m, fr); asm volatile("" : "+v"(row));
#pragma unroll
                for (int hf = 0; hf < 2; ++hf) { u32x4 w; const f32x4 a = acc[m][2 * hf], b = acc[m][2 * hf + 1];
                    float v[8] = {a[0], a[1], a[2], a[3], b[0], b[1], b[2], b[3]};
#pragma unroll
                    for (int e = 0; e < 8; ++e) v[e] = isg ? silu_fast(v[e]) : gelu_fast(v[e]);
                    w.x = cvt_pk_bf16(v[0], v[1]); w.y = cvt_pk_bf16(v[2], v[3]); w.z = cvt_pk_bf16(v[4], v[5]); w.w = cvt_pk_bf16(v[6], v[7]);
                    *(u32x4*)(dst + (size_t)row * 1024 + hf * 128 + wc * 32 + 8 * fq) = w; } asm volatile("" ::: "memory"); }
        } else {
            const bool isv = pn < 12; bf16_t* dst = (isv ? vT : gvT) + (size_t)((pn & 3) * 256) * T_ + pm * 256;
#pragma unroll
            for (int m = 0; m < 8; ++m) { int f = arow_of<8>(wr, m, fr); asm volatile("" : "+v"(f));
#pragma unroll
                for (int hf = 0; hf < 2; ++hf) { u32x4 w; const f32x4 a = acc[m][2 * hf], b = acc[m][2 * hf + 1];
                    float v[8] = {a[0], a[1], a[2], a[3], b[0], b[1], b[2], b[3]};
                    if (!isv) {
#pragma unroll
                        for (int e = 0; e < 8; ++e) v[e] = gelu_fast(v[e]); }
                    w.x = cvt_pk_bf16(v[0], v[1]); w.y = cvt_pk_bf16(v[2], v[3]); w.z = cvt_pk_bf16(v[4], v[5]); w.w = cvt_pk_bf16(v[6], v[7]);
                    *(u32x4*)(dst + (size_t)f * T_ + hf * 128 + wc * 32 + 8 * fq) = w; } asm volatile("" ::: "memory"); }
        }
    }
};

struct EpiKhat {
    bf16_t* khatT; const float *ct, *st;
    __device__ __forceinline__ bool swapped(int) const { return true; }
    __device__ __forceinline__ int brow0(int pn) const { return (4 + pn) * 256; }
    __device__ __forceinline__ void operator()(const f32x4 (&acc)[8][4], int pm, int pn, int wr, int wc, int fr, int fq) const {
        {
            const int h = pn; const float l2g = log2f(1.f - exp2f(-5.f - (float)h));
            bf16_t* dst = khatT + (size_t)(h * 256) * T_ + pm * 256;
#pragma unroll
            for (int m = 0; m < 4; ++m) { int f = wr * 64 + m * 16 + fr; asm volatile("" : "+v"(f));
                const float* cp = ct + (size_t)f * T_ + pm * 256 + wc * 32 + 8 * fq; const float* sp = st + (size_t)f * T_ + pm * 256 + wc * 32 + 8 * fq;
#pragma unroll
                for (int hf = 0; hf < 2; ++hf) { u32x4 w1, w2;
#pragma unroll
                    for (int nn = 0; nn < 2; ++nn) { const int n = 2 * hf + nn; const int t0 = hf * 128 + wc * 32 + 8 * fq + 4 * nn;
                        const f32x4 c = *(const f32x4*)(cp + hf * 128 + 4 * nn), s = *(const f32x4*)(sp + hf * 128 + 4 * nn);
                        const f32x4 x1 = acc[m][n], x2 = acc[m + 4][n];
                        f32x4 o1 = x1 * c - x2 * s, o2 = x2 * c + x1 * s;
#pragma unroll
                        for (int e = 0; e < 4; ++e) { const float d = 0.0625f * exp2f((float)(127 - ((t0 + e) & 127)) * l2g); o1[e] *= d; o2[e] *= d; }
                        if (nn == 0) { w1.x = cvt_pk_bf16(o1[0], o1[1]); w1.y = cvt_pk_bf16(o1[2], o1[3]); w2.x = cvt_pk_bf16(o2[0], o2[1]); w2.y = cvt_pk_bf16(o2[2], o2[3]); }
                        else         { w1.z = cvt_pk_bf16(o1[0], o1[1]); w1.w = cvt_pk_bf16(o1[2], o1[3]); w2.z = cvt_pk_bf16(o2[0], o2[1]); w2.w = cvt_pk_bf16(o2[2], o2[3]); } }
                    *(u32x4*)(dst + (size_t)f * T_ + hf * 128 + wc * 32 + 8 * fq) = w1;
                    *(u32x4*)(dst + (size_t)(f + 128) * T_ + hf * 128 + wc * 32 + 8 * fq) = w2; asm volatile("" ::: "memory"); } }
        }
    }
};
__device__ __forceinline__ void ret_kv_phase(LAS unsigned char* lds, const bf16_t* vT, const bf16_t* khatT, float* KVT, int wg, int nwg, int wave_s) {
    typedef Core<8, 4> C;
    const int tid = opaque_tid(wave_s), wid = __builtin_amdgcn_readfirstlane(tid >> 6), lane = tid & 63, wr = wid >> 2, wc = wid & 3, fr = lane & 15, fq = lane >> 4;
    unsigned aoff[4], boff[4];
#pragma unroll
    for (int i = 0; i < 4; ++i) { int r, c; C::apiece(tid, i, r, c); aoff[i] = (unsigned)(r * T_ + c) * 2u; C::bpiece(tid, i, r, c); boff[i] = (unsigned)(r * T_ + c) * 2u; }
    for (int u = wg; u < 512; u += nwg) {
        const int n = u >> 2, h = u & 3;
        const char* Ab = (const char*)(vT + (size_t)(h * 256) * T_ + n * 128); const char* Bb = (const char*)(khatT + (size_t)(h * 256) * T_ + n * 128);
        f32x4 acc[8][4]; C::zero(acc);
        C::loop_gg(lds, Ab, aoff, Bb, boff, 2, acc, wid, wr, wc, fr, fq);
        float* dst = KVT + (size_t)u * 65536;
#pragma unroll
        for (int m = 0; m < 8; ++m) { float* rp = dst + arow_of<8>(wr, m, fr) * 256;
#pragma unroll
            for (int nn = 0; nn < 4; ++nn) *(f32x4*)(rp + bcol_of<4>(wc, nn, fq, 0)) = acc[m][nn]; }
    }
}
__device__ __forceinline__ void ret_scan_phase(const float* KVT, bf16_t* STb, int wg, int nwg, int wave_s) {
    const int tid = opaque_tid(wave_s);
    for (int e = (wg * NTHR + tid) * 2; e < 4 * 65536; e += nwg * NTHR * 2) {
        const int h = e >> 16; const float g = exp2f(128.f * log2f(1.f - exp2f(-5.f - (float)h)));
        float s0 = 0.f, s1 = 0.f;
        for (int n0 = 0; n0 < 128; n0 += 8) {
            float2 kv[8];
#pragma unroll
            for (int i = 0; i < 8; ++i) kv[i] = *(const float2*)(KVT + (size_t)(n0 + i) * 262144 + e);
#pragma unroll
            for (int i = 0; i < 8; ++i) { *(unsigned*)(STb + (size_t)(n0 + i) * 262144 + e) = cvt_pk_bf16(s0, s1); s0 = g * s0 + kv[i].x; s1 = g * s1 + kv[i].y; }
        }
    }
}
__device__ __forceinline__ void ret_out_phase(LAS unsigned char* lds, const bf16_t* qb, const bf16_t* kb, const bf16_t* vT, const bf16_t* STb, const bf16_t* sgb,
                                              const float* gain, bf16_t* mixb, int wg, int nwg, int wave_s) {
    typedef Core<4, 2> CA; typedef Core<4, 4> CB;
    const int tid = opaque_tid(wave_s), wid = __builtin_amdgcn_readfirstlane(tid >> 6), lane = tid & 63, wr = wid >> 2, wc = wid & 3, fr = lane & 15, fq = lane >> 4;
    LAS unsigned char* ldsP = lds + 98304;
    LAS float* stat = (LAS float*)lds;
    unsigned qoff[2], koff[2], soff[4], voff[4];
#pragma unroll
    for (int i = 0; i < 2; ++i) { int r, c; CA::apiece(tid, i, r, c); qoff[i] = (unsigned)(r * 1024 + c) * 2u; CA::bpiece(tid, i, r, c); koff[i] = (unsigned)(r * 1024 + c) * 2u; }
#pragma unroll
    for (int i = 0; i < 4; ++i) { int r, c; CB::bpiece(tid, i, r, c); soff[i] = (unsigned)(r * 256 + c) * 2u; voff[i] = (unsigned)(r * T_ + c) * 2u; }
    for (int u = wg; u < 512; u += nwg) {
        const int n = u >> 2, h = u & 3; const float l2g = log2f(1.f - exp2f(-5.f - (float)h));
        const char* Qb = (const char*)(qb + (size_t)(n * 128) * 1024 + h * 256); const char* Kb = (const char*)(kb + (size_t)(n * 128) * 1024 + h * 256);
        {
            f32x4 sa[4][2]; CA::zero(sa);
            CA::loop_gg(lds, Qb, qoff, Kb, koff, 4, sa, wid, wr, wc, fr, fq);
#pragma unroll
            for (int m = 0; m < 4; ++m) { const int i = wr * 64 + m * 16 + fr; const int j0 = wc * 32 + 8 * fq;
                float p[8];
#pragma unroll
                for (int e = 0; e < 8; ++e) { const int j = j0 + e; const float s = e < 4 ? sa[m][0][e] : sa[m][1][e - 4]; p[e] = (j <= i) ? s * exp2f((float)(i - j) * l2g) : 0.f; }
                u32x4 w; w.x = cvt_pk_bf16(p[0], p[1]); w.y = cvt_pk_bf16(p[2], p[3]); w.z = cvt_pk_bf16(p[4], p[5]); w.w = cvt_pk_bf16(p[6], p[7]);
                *(LAS u32x4*)(ldsP + (wc >> 1) * 16384 + lds_byte(i, j0 & 63)) = w; }
        }
        f32x4 acc[4][4]; CB::zero(acc);
        CB::loop_gg(lds, Qb, qoff, (const char*)(STb + (size_t)u * 65536), soff, 4, acc, wid, wr, wc, fr, fq);
#pragma unroll
        for (int m = 0; m < 4; ++m) { const float sc = exp2f((float)(wr * 64 + m * 16 + fr + 1) * l2g);
#pragma unroll
            for (int nn = 0; nn < 4; ++nn) acc[m][nn] *= sc; }
        CB::loop_lg(ldsP, lds, (const char*)(vT + (size_t)(h * 256) * T_ + n * 128), voff, 2, acc, wid, wr, wc, fr, fq);
#pragma unroll
        for (int m = 0; m < 4; ++m) { float s = 0.f, ss = 0.f;
#pragma unroll
            for (int nn = 0; nn < 4; ++nn)
#pragma unroll
                for (int e = 0; e < 4; ++e) { const float v = acc[m][nn][e]; s += v; ss += v * v; }
            s += __shfl_xor(s, 16); ss += __shfl_xor(ss, 16); s += __shfl_xor(s, 32); ss += __shfl_xor(ss, 32);
            if (fq == 0) { const int i = wr * 64 + m * 16 + fr; stat[(i * 4 + wc) * 2] = s; stat[(i * 4 + wc) * 2 + 1] = ss; } }
        __syncthreads();
#pragma unroll
        for (int m = 0; m < 4; ++m) { const int i = wr * 64 + m * 16 + fr; float s = 0.f, ss = 0.f;
#pragma unroll
            for (int w4 = 0; w4 < 4; ++w4) { s += stat[(i * 4 + w4) * 2]; ss += stat[(i * 4 + w4) * 2 + 1]; }
            const float mean = s * (1.f / 256.f); const float var = ss * (1.f / 256.f) - mean * mean; const float rstd = rsqrtf(var + 1e-6f);
            const size_t t = (size_t)n * 128 + i;
#pragma unroll
            for (int hf = 0; hf < 2; ++hf) { const int c0 = h * 256 + hf * 128 + wc * 32 + 8 * fq;
                const u32x4 sg = *(const u32x4*)(sgb + t * 1024 + c0);
                const f32x4 g0 = *(const f32x4*)(gain + c0), g1 = *(const f32x4*)(gain + c0 + 4);
                const f32x4 a = acc[m][2 * hf], b = acc[m][2 * hf + 1];
                float o[8];
                o[0] = (a[0] - mean) * rstd * g0[0] * bflo(sg.x); o[1] = (a[1] - mean) * rstd * g0[1] * bfhi(sg.x);
                o[2] = (a[2] - mean) * rstd * g0[2] * bflo(sg.y); o[3] = (a[3] - mean) * rstd * g0[3] * bfhi(sg.y);
                o[4] = (b[0] - mean) * rstd * g1[0] * bflo(sg.z); o[5] = (b[1] - mean) * rstd * g1[1] * bfhi(sg.z);
                o[6] = (b[2] - mean) * rstd * g1[2] * bflo(sg.w); o[7] = (b[3] - mean) * rstd * g1[3] * bfhi(sg.w);
                u32x4 w; w.x = cvt_pk_bf16(o[0], o[1]); w.y = cvt_pk_bf16(o[2], o[3]); w.z = cvt_pk_bf16(o[4], o[5]); w.w = cvt_pk_bf16(o[6], o[7]);
                *(u32x4*)(mixb + t * 2048 + c0) = w; } }
        __syncthreads();
    }
}
__device__ __forceinline__ void wsm_phase(const float* ws, bf16_t* WsM, int wg, int nwg, int wave_s) {
    const int tid = opaque_tid(wave_s);
    for (int i = wg * NTHR + tid; i < 4 * 128 * 128; i += nwg * NTHR) { const int t = (i >> 7) & 127, s = i & 127; WsM[i] = (bf16_t)(cvt_pk_bf16(s <= t ? ws[i] : 0.f, 0.f) & 0xffffu); }
}
__device__ __forceinline__ void gmlp_norm_phase(LAS unsigned char* lds, bf16_t* gvT, const float* gain, int wg, int nwg, int wave_s) {
    const int tid = opaque_tid(wave_s), sp = tid & 63, cq = tid >> 6;
    LAS float* red = (LAS float*)lds;
    for (int u = wg; u < 512; u += nwg) {
        const int n = u >> 2, g = u & 3;
        bf16_t* base = gvT + (size_t)(g * 256 + cq * 32) * T_ + n * 128 + 2 * sp;
        float s0 = 0.f, q0 = 0.f, s1 = 0.f, q1 = 0.f;
        for (int c = 0; c < 32; ++c) { const unsigned w = *(const unsigned*)(base + (size_t)c * T_); const float a = bflo(w), b = bfhi(w); s0 += a; q0 += a * a; s1 += b; q1 += b * b; }
        red[(cq * 128 + 2 * sp) * 2] = s0; red[(cq * 128 + 2 * sp) * 2 + 1] = q0; red[(cq * 128 + 2 * sp + 1) * 2] = s1; red[(cq * 128 + 2 * sp + 1) * 2 + 1] = q1;
        __syncthreads();
        float m0 = 0.f, v0 = 0.f, m1 = 0.f, v1 = 0.f;
#pragma unroll
        for (int k = 0; k < 8; ++k) { m0 += red[(k * 128 + 2 * sp) * 2]; v0 += red[(k * 128 + 2 * sp) * 2 + 1]; m1 += red[(k * 128 + 2 * sp + 1) * 2]; v1 += red[(k * 128 + 2 * sp + 1) * 2 + 1]; }
        m0 *= (1.f / 256.f); m1 *= (1.f / 256.f);
        const float r0 = rsqrtf(v0 * (1.f / 256.f) - m0 * m0 + 1e-6f), r1 = rsqrtf(v1 * (1.f / 256.f) - m1 * m1 + 1e-6f);
        for (int c = 0; c < 32; ++c) { const unsigned w = *(const unsigned*)(base + (size_t)c * T_); const float gn = gain[g * 256 + cq * 32 + c];
            *(unsigned*)(base + (size_t)c * T_) = cvt_pk_bf16((bflo(w) - m0) * r0 * gn, (bfhi(w) - m1) * r1 * gn); }
        __syncthreads();
    }
}
__device__ __forceinline__ void gmlp_mix_phase(LAS unsigned char* lds, const bf16_t* WsM, const bf16_t* vnT, const bf16_t* ugb, const float* bs, bf16_t* mixb, int wg, int nwg, int wave_s) {
    typedef Core<4, 4> C;
    const int tid = opaque_tid(wave_s), wid = __builtin_amdgcn_readfirstlane(tid >> 6), lane = tid & 63, wr = wid >> 2, wc = wid & 3, fr = lane & 15, fq = lane >> 4;
    unsigned aoff[2], boff[4];
#pragma unroll
    for (int i = 0; i < 2; ++i) { int r, c; C::apiece(tid, i, r, c); aoff[i] = (unsigned)(r * 128 + c) * 2u; }
#pragma unroll
    for (int i = 0; i < 4; ++i) { int r, c; C::bpiece(tid, i, r, c); boff[i] = (unsigned)(r * T_ + c) * 2u; }
    for (int u = wg; u < 512; u += nwg) {
        const int n = u >> 2, g = u & 3;
        f32x4 acc[4][4]; C::zero(acc);
        C::loop_gg(lds, (const char*)(WsM + g * 16384), aoff, (const char*)(vnT + (size_t)(g * 256) * T_ + n * 128), boff, 2, acc, wid, wr, wc, fr, fq);
#pragma unroll
        for (int m = 0; m < 4; ++m) { const int i = wr * 64 + m * 16 + fr; const float bias = bs[g * 128 + i]; const size_t t = (size_t)n * 128 + i;
#pragma unroll
            for (int hf = 0; hf < 2; ++hf) { const int c0 = g * 256 + hf * 128 + wc * 32 + 8 * fq;
                const u32x4 ug = *(const u32x4*)(ugb + t * 1024 + c0);
                const f32x4 a = acc[m][2 * hf], b = acc[m][2 * hf + 1];
                u32x4 w; w.x = cvt_pk_bf16((a[0] + bias) * bflo(ug.x), (a[1] + bias) * bfhi(ug.x)); w.y = cvt_pk_bf16((a[2] + bias) * bflo(ug.y), (a[3] + bias) * bfhi(ug.y));
                w.z = cvt_pk_bf16((b[0] + bias) * bflo(ug.z), (b[1] + bias) * bfhi(ug.z)); w.w = cvt_pk_bf16((b[2] + bias) * bflo(ug.w), (b[3] + bias) * bfhi(ug.w));
                *(u32x4*)(mixb + t * 2048 + 1024 + c0) = w; } }
    }
}
struct EpiResidual {
    const float* xin; float* xout;
    __device__ __forceinline__ bool swapped(int) const { return false; }
    __device__ __forceinline__ int brow0(int pn) const { return pn * 256; }
    __device__ __forceinline__ void operator()(const f32x4 (&acc)[8][4], int pm, int pn, int wr, int wc, int fr, int fq) const {
#pragma unroll
        for (int m = 0; m < 8; ++m) { int row = pm * 256 + arow_of<8>(wr, m, fr); asm volatile("" : "+v"(row));
            const float* ip = xin + (size_t)row * D_ + pn * 256; float* op = xout + (size_t)row * D_ + pn * 256;
#pragma unroll
            for (int n = 0; n < 4; ++n) { const int c = bcol_of<4>(wc, n, fq, 0); *(f32x4*)(op + c) = *(const f32x4*)(ip + c) + acc[m][n]; }
            asm volatile("" ::: "memory"); }
    }
};

#define CAPF 16384
__device__ __forceinline__ void wr_phase(const float* wrg, const float* wre, bf16_t* WrT, int wg, int nwg, int wave_s) {
    const int tid = opaque_tid(wave_s);
    for (int i = wg * NTHR + tid; i < 64 * 2048; i += nwg * NTHR) { const int r = i >> 11, k = i & 2047;
        const float v = r < 4 ? wrg[k * 4 + r] : (r < 36 ? wre[k * 32 + (r - 4)] : 0.f);
        WrT[i] = (bf16_t)(cvt_pk_bf16(v, 0.f) & 0xffffu); }
}
__device__ __forceinline__ void moe_route_phase(LAS unsigned char* lds, const float* x1, const float* g, bf16_t* hb, const bf16_t* WrT, const float* brg, const float* bre,
                                                int* cnt, int* list, float* gate, int wg, int nwg, int wave_s) {
    typedef Core<2, 1> C;
    const int tid = opaque_tid(wave_s), wid = __builtin_amdgcn_readfirstlane(tid >> 6), lane = tid & 63, wr = wid >> 2, wc = wid & 3, fr = lane & 15, fq = lane >> 4;
    unsigned aoff[1], boff[1];
    { int r, c; C::apiece(tid, 0, r, c); aoff[0] = (unsigned)(r * 2048 + c) * 2u; C::bpiece(tid, 0, r, c); boff[0] = (unsigned)(r * 2048 + c) * 2u; }
    LAS float* lg = (LAS float*)lds;
    for (int u = wg; u < T_ / 64; u += nwg) {
        for (int rr = 0; rr < 8; ++rr) { const int row = u * 64 + wid * 8 + rr;
            const float4* xr = (const float4*)(x1 + (size_t)row * D_);
            float4 v[8]; float ss = 0.f;
#pragma unroll
            for (int i = 0; i < 8; ++i) { v[i] = xr[lane + 64 * i]; ss += v[i].x * v[i].x + v[i].y * v[i].y + v[i].z * v[i].z + v[i].w * v[i].w; }
            ss = wave_sum(ss);
            const float r = rsqrtf(ss * (1.f / D_) + 1e-6f);
#pragma unroll
            for (int i = 0; i < 8; ++i) { const float4 gg = ((const float4*)g)[lane + 64 * i];
                u32x2 o; o.x = cvt_pk_bf16(v[i].x * r * gg.x, v[i].y * r * gg.y); o.y = cvt_pk_bf16(v[i].z * r * gg.z, v[i].w * r * gg.w);
                *(u32x2*)(hb + (size_t)row * D_ + (lane + 64 * i) * 4) = o; } }
        WAIT_V0(); __syncthreads();
        f32x4 acc[2][1]; C::zero(acc);
        C::loop_gg(lds, (const char*)(hb + (size_t)u * 64 * D_), aoff, (const char*)WrT, boff, 32, acc, wid, wr, wc, fr, fq);
#pragma unroll
        for (int m = 0; m < 2; ++m) { const int row = wr * 32 + m * 16 + fr;
#pragma unroll
            for (int j = 0; j < 4; ++j) { const int col = wc * 16 + 4 * fq + j; if (col < 36) lg[row * 40 + col] = acc[m][0][j] + (col < 4 ? brg[col] : bre[col - 4]); } }
        __syncthreads();
        if (tid < 64) {
            const int t = u * 64 + tid; const LAS float* L = lg + tid * 40;
            float l4[4], le[32];
#pragma unroll
            for (int i = 0; i < 4; ++i) l4[i] = L[i];
#pragma unroll
            for (int i = 0; i < 32; ++i) le[i] = L[4 + i];
            int gs = 0; float gm = l4[0];
#pragma unroll
            for (int i = 1; i < 4; ++i) if (l4[i] > gm) { gm = l4[i]; gs = i; }
            float den = 0.f;
#pragma unroll
            for (int i = 0; i < 4; ++i) den += __expf(l4[i] - gm);
            const float psel = 1.f / den;
            float l8[8];
#pragma unroll
            for (int i = 0; i < 8; ++i) l8[i] = gs == 0 ? le[i] : gs == 1 ? le[8 + i] : gs == 2 ? le[16 + i] : le[24 + i];
            int e1 = 0; float m1 = l8[0];
#pragma unroll
            for (int i = 1; i < 8; ++i) if (l8[i] > m1) { m1 = l8[i]; e1 = i; }
            int e2 = -1; float m2 = -3.0e38f;
#pragma unroll
            for (int i = 0; i < 8; ++i) if (i != e1 && l8[i] > m2) { m2 = l8[i]; e2 = i; }
            const float z = __expf(m2 - m1);
            const int ex1 = gs * 8 + e1, ex2 = gs * 8 + e2;
            const int p1 = atomicAdd(&cnt[ex1], 1); list[ex1 * CAPF + p1] = t * 2;
            const int p2 = atomicAdd(&cnt[ex2], 1); list[ex2 * CAPF + p2] = t * 2 + 1;
            gate[t * 2] = psel / (1.f + z); gate[t * 2 + 1] = psel * z / (1.f + z);
        }
        __syncthreads();
    }
}
__device__ __forceinline__ void moe_prefix(LAS int* tp, LAS int* cn, const int* cnt, int tid) {
    if (tid == 0) { int s = 0; for (int e = 0; e < 32; ++e) { const int c = cnt[e]; cn[e] = c; tp[e] = s; s += (c + 255) >> 8; } tp[32] = s; }
    __syncthreads();
}
__device__ __forceinline__ void moe_gu_phase(LAS unsigned char* lds, const bf16_t* hb, const bf16_t* Wgu, const int* cnt, const int* list, bf16_t* hid, int wg, int nwg, int wave_s) {
    typedef Core<8, 4> C;
    const int tid = opaque_tid(wave_s), wid = __builtin_amdgcn_readfirstlane(tid >> 6), lane = tid & 63, wr = wid >> 2, wc = wid & 3, fr = lane & 15, fq = lane >> 4;
    LAS int* tp = (LAS int*)(lds + 143360); LAS int* cn = tp + 40;
    moe_prefix(tp, cn, cnt, tid);
    int ar[4], ac[4]; unsigned boff[4];
#pragma unroll
    for (int i = 0; i < 4; ++i) { int r, c; C::apiece(tid, i, ar[i], ac[i]); C::bpiece(tid, i, r, c); boff[i] = (unsigned)(r * 2048 + c) * 2u; }
    const int total = tp[32] * 8;
    for (int u = wg; u < total; u += nwg) {
        const int R = u >> 3, pn = u & 7; int e = 0;
        for (int k = 1; k < 32; ++k) e += (tp[k] <= R) ? 1 : 0;
        const int rt = R - tp[e], ne = cn[e];
        unsigned aoff[4];
#pragma unroll
        for (int i = 0; i < 4; ++i) { int gr = rt * 256 + ar[i]; gr = gr < ne ? gr : ne - 1; const int slot = list[e * CAPF + gr]; aoff[i] = (unsigned)((slot >> 1) * 2048 + ac[i]) * 2u; }
        f32x4 acc[8][4]; C::zero(acc);
        C::loop_gg(lds, (const char*)hb, aoff, (const char*)(Wgu + ((size_t)e * 2048 + pn * 256) * 2048), boff, 32, acc, wid, wr, wc, fr, fq);
#pragma unroll
        for (int m = 0; m < 8; ++m) { int gr = rt * 256 + arow_of<8>(wr, m, fr); asm volatile("" : "+v"(gr));
            if (gr < ne) {
                u32x4 w;
                { const f32x4 a = acc[m][0], b = acc[m][2]; w.x = cvt_pk_bf16(silu_fast(a[0]) * b[0], silu_fast(a[1]) * b[1]); w.y = cvt_pk_bf16(silu_fast(a[2]) * b[2], silu_fast(a[3]) * b[3]); }
                { const f32x4 a = acc[m][1], b = acc[m][3]; w.z = cvt_pk_bf16(silu_fast(a[0]) * b[0], silu_fast(a[1]) * b[1]); w.w = cvt_pk_bf16(silu_fast(a[2]) * b[2], silu_fast(a[3]) * b[3]); }
                *(u32x4*)(hid + ((size_t)tp[e] * 256 + gr) * 1024 + pn * 128 + wc * 32 + 8 * fq) = w; }
            asm volatile("" ::: "memory"); }
    }
}
__device__ __forceinline__ void moe_down_phase(LAS unsigned char* lds, const bf16_t* hid, const bf16_t* Wdn, const int* cnt, const int* list, const float* gate, bf16_t* y, int wg, int nwg, int wave_s) {
    typedef Core<8, 4> C;
    const int tid = opaque_tid(wave_s), wid = __builtin_amdgcn_readfirstlane(tid >> 6), lane = tid & 63, wr = wid >> 2, wc = wid & 3, fr = lane & 15, fq = lane >> 4;
    LAS int* tp = (LAS int*)(lds + 143360); LAS int* cn = tp + 40;
    moe_prefix(tp, cn, cnt, tid);
    unsigned aoff[4], boff[4];
#pragma unroll
    for (int i = 0; i < 4; ++i) { int r, c; C::apiece(tid, i, r, c); aoff[i] = (unsigned)(r * 1024 + c) * 2u; C::bpiece(tid, i, r, c); boff[i] = (unsigned)(r * 1024 + c) * 2u; }
    const int total = tp[32] * 8;
    for (int u = wg; u < total; u += nwg) {
        const int R = u >> 3, pn = u & 7; int e = 0;
        for (int k = 1; k < 32; ++k) e += (tp[k] <= R) ? 1 : 0;
        const int rt = R - tp[e], ne = cn[e];
        f32x4 acc[8][4]; C::zero(acc);
        C::loop_gg(lds, (const char*)(hid + (size_t)R * 256 * 1024), aoff, (const char*)(Wdn + ((size_t)e * 2048 + pn * 256) * 1024), boff, 16, acc, wid, wr, wc, fr, fq);
#pragma unroll
        for (int m = 0; m < 8; ++m) { int gr = rt * 256 + arow_of<8>(wr, m, fr); asm volatile("" : "+v"(gr));
            if (gr < ne) { const int slot = list[e * CAPF + gr]; const float gt = gate[slot];
                bf16_t* yp = y + (size_t)slot * 2048 + pn * 256 + wc * 32 + 8 * fq;
#pragma unroll
                for (int hf = 0; hf < 2; ++hf) { const f32x4 a = acc[m][2 * hf], b = acc[m][2 * hf + 1]; u32x4 w;
                    w.x = cvt_pk_bf16(gt * a[0], gt * a[1]); w.y = cvt_pk_bf16(gt * a[2], gt * a[3]); w.z = cvt_pk_bf16(gt * b[0], gt * b[1]); w.w = cvt_pk_bf16(gt * b[2], gt * b[3]);
                    *(u32x4*)(yp + hf * 128) = w; } }
            asm volatile("" ::: "memory"); }
    }
}
__device__ __forceinline__ void moe_combine_phase(float* x1, const bf16_t* y, const float* g, bf16_t* hb, float* outf, int wg, int nwg, int wave_s) {
    const int tid = opaque_tid(wave_s), lane = tid & 63, wv = tid >> 6;
    for (int row = wg * 8 + wv; row < T_; row += nwg * 8) {
        float4* xr = (float4*)(x1 + (size_t)row * D_);
        const u32x2* y0 = (const u32x2*)(y + (size_t)(2 * row) * D_); const u32x2* y1 = (const u32x2*)(y + (size_t)(2 * row + 1) * D_);
        float4 v[8]; float ss = 0.f;
#pragma unroll
        for (int i = 0; i < 8; ++i) { v[i] = xr[lane + 64 * i]; const u32x2 a = y0[lane + 64 * i], b = y1[lane + 64 * i];
            v[i].x += bflo(a.x) + bflo(b.x); v[i].y += bfhi(a.x) + bfhi(b.x); v[i].z += bflo(a.y) + bflo(b.y); v[i].w += bfhi(a.y) + bfhi(b.y);
            ss += v[i].x * v[i].x + v[i].y * v[i].y + v[i].z * v[i].z + v[i].w * v[i].w; }
        ss = wave_sum(ss);
        const float r = rsqrtf(ss * (1.f / D_) + 1e-6f);
#pragma unroll
        for (int i = 0; i < 8; ++i) { const float4 gg = ((const float4*)g)[lane + 64 * i];
            if (hb) { xr[lane + 64 * i] = v[i];
                u32x2 o; o.x = cvt_pk_bf16(v[i].x * r * gg.x, v[i].y * r * gg.y); o.y = cvt_pk_bf16(v[i].z * r * gg.z, v[i].w * r * gg.w);
                *(u32x2*)(hb + (size_t)row * D_ + (lane + 64 * i) * 4) = o; }
            else { float4 o; o.x = v[i].x * r * gg.x; o.y = v[i].y * r * gg.y; o.z = v[i].z * r * gg.z; o.w = v[i].w * r * gg.w; ((float4*)(outf + (size_t)row * D_))[lane + 64 * i] = o; } }
    }
}
__device__ __forceinline__ void lb_phase(const float* lbp, float* lbv, int wg, int nwg, int wave_s) {
    const int tid = opaque_tid(wave_s);
    for (int i = wg * NTHR + tid; i < 2048; i += nwg * NTHR) lbv[i] = 1.f / (1.f + __expf(lbp[i] - lbp[2048 + i]));
}
struct EpiInC {
    bf16_t *qs, *vT, *sg; float* lf; const float* lbv;
    __device__ __forceinline__ bool swapped(int pn) const { return pn >= 16 && pn < 24; }
    __device__ __forceinline__ int brow0(int pn) const { return pn * 256; }
    __device__ __forceinline__ void operator()(const f32x4 (&acc)[8][4], int pm, int pn, int wr, int wc, int fr, int fq) const {
        if (pn < 8 || pn >= 24) {
            bf16_t* dst = (pn < 8 ? qs : sg) + (pn & 7) * 256;
#pragma unroll
            for (int m = 0; m < 8; ++m) { int row = pm * 256 + arow_of<8>(wr, m, fr); asm volatile("" : "+v"(row));
#pragma unroll
                for (int hf = 0; hf < 2; ++hf) { u32x4 w; const f32x4 a = acc[m][2 * hf], b = acc[m][2 * hf + 1];
                    w.x = cvt_pk_bf16(silu_fast(a[0]), silu_fast(a[1])); w.y = cvt_pk_bf16(silu_fast(a[2]), silu_fast(a[3]));
                    w.z = cvt_pk_bf16(silu_fast(b[0]), silu_fast(b[1])); w.w = cvt_pk_bf16(silu_fast(b[2]), silu_fast(b[3]));
                    *(u32x4*)(dst + (size_t)row * 2048 + hf * 128 + wc * 32 + 8 * fq) = w; } asm volatile("" ::: "memory"); }
        } else if (pn < 16) {
            const int cb = (pn - 8) * 256;
#pragma unroll
            for (int m = 0; m < 8; ++m) { int row = pm * 256 + arow_of<8>(wr, m, fr); asm volatile("" : "+v"(row));
#pragma unroll
                for (int n = 0; n < 4; ++n) { const int c = cb + bcol_of<4>(wc, n, fq, 0); const f32x4 lb = *(const f32x4*)(lbv + c); const f32x4 z = acc[m][n]; f32x4 o;
#pragma unroll
                    for (int e = 0; e < 4; ++e) o[e] = __logf(lb[e] + (1.f - lb[e]) / (1.f + __expf(-z[e])));
                    *(f32x4*)(lf + (size_t)row * 2048 + c) = o; } asm volatile("" ::: "memory"); }
        } else {
            bf16_t* dst = vT + (size_t)((pn - 16) * 256) * T_ + pm * 256;
#pragma unroll
            for (int m = 0; m < 8; ++m) { int f = arow_of<8>(wr, m, fr); asm volatile("" : "+v"(f));
#pragma unroll
                for (int hf = 0; hf < 2; ++hf) { u32x4 w; const f32x4 a = acc[m][2 * hf], b = acc[m][2 * hf + 1];
                    w.x = cvt_pk_bf16(a[0], a[1]); w.y = cvt_pk_bf16(a[2], a[3]); w.z = cvt_pk_bf16(b[0], b[1]); w.w = cvt_pk_bf16(b[2], b[3]);
                    *(u32x4*)(dst + (size_t)f * T_ + hf * 128 + wc * 32 + 8 * fq) = w; } asm volatile("" ::: "memory"); }
        }
    }
};
__device__ __forceinline__ int bcol_to_slot2(int c) { const int c5 = c & 31; return (c & ~31) + ((c5 >> 2) & 1) * 16 + (c5 >> 3) * 4 + (c5 & 3); }
__device__ __forceinline__ void hgrn_kv_phase(LAS unsigned char* lds, const bf16_t* qs, const float* lf, const bf16_t* vT, bf16_t* qh, bf16_t* kt, float* dec, float* KVT2,
                                              int wg, int nwg, int wave_s) {
    typedef Core<4, 2> C;
    const int tid = opaque_tid(wave_s), wid = __builtin_amdgcn_readfirstlane(tid >> 6), lane = tid & 63, wr = wid >> 2, wc = wid & 3, fr = lane & 15, fq = lane >> 4;
    const int dk = tid & 127, qtr = tid >> 7;
    LAS unsigned char* ldsB = lds + 65536;
    LAS float* tot = (LAS float*)(lds + 131072);
    unsigned aoff[2];
#pragma unroll
    for (int i = 0; i < 2; ++i) { int r, c; C::apiece(tid, i, r, c); aoff[i] = (unsigned)(r * T_ + c) * 2u; }
    const int slot = bcol_to_slot2(dk);
    for (int u = wg; u < 2048; u += nwg) {
        const int n = u >> 4, h = u & 15;
        const size_t t0 = (size_t)n * 128 + qtr * 32; const int col = h * 128 + dk;
        float l[32]; float s = 0.f;
#pragma unroll
        for (int j = 0; j < 32; ++j) { l[j] = lf[(t0 + j) * 2048 + col]; s += l[j]; }
        tot[qtr * 128 + dk] = s;
        __syncthreads();
        float pre = 0.f, total = 0.f;
#pragma unroll
        for (int q = 0; q < 4; ++q) { const float v = tot[q * 128 + dk]; total += v; pre += (q < qtr) ? v : 0.f; }
        if (qtr == 0) dec[(size_t)n * 2048 + col] = __expf(total);
        float cum = pre;
#pragma unroll
        for (int p = 0; p < 4; ++p) { float kh[8];
#pragma unroll
            for (int e = 0; e < 8; ++e) { const int j = p * 8 + e; cum += l[j];
                const float k = 1.f - __expf(l[j]); const float q = bf2f(qs[(t0 + j) * 2048 + col]);
                qh[(t0 + j) * 2048 + col] = (bf16_t)(cvt_pk_bf16(q * __expf(cum), 0.f) & 0xffffu);
                kt[(t0 + j) * 2048 + col] = (bf16_t)(cvt_pk_bf16(k * __expf(-cum), 0.f) & 0xffffu);
                kh[e] = k * __expf(total - cum); }
            u32x4 w; w.x = cvt_pk_bf16(kh[0], kh[1]); w.y = cvt_pk_bf16(kh[2], kh[3]); w.z = cvt_pk_bf16(kh[4], kh[5]); w.w = cvt_pk_bf16(kh[6], kh[7]);
            const int jj = qtr * 32 + p * 8;
            *(LAS u32x4*)(ldsB + (jj >> 6) * 16384 + lds_byte(slot, jj & 63)) = w; }
        __syncthreads();
        f32x4 acc[4][2]; C::zero(acc);
        C::loop_gl(lds, (const char*)(vT + (size_t)(h * 128) * T_ + n * 128), aoff, ldsB, 2, acc, wid, wr, wc, fr, fq);
        float* dst = KVT2 + (size_t)u * 16384;
#pragma unroll
        for (int m = 0; m < 4; ++m) { float* rp = dst + (wr * 64 + m * 16 + fr) * 128 + wc * 32 + 8 * fq;
            *(f32x4*)rp = acc[m][0]; *(f32x4*)(rp + 4) = acc[m][1]; }
    }
}
__device__ __forceinline__ void hgrn_scan_phase(const float* KVT2, const float* dec, bf16_t* STb2, int wg, int nwg, int wave_s) {
    const int tid = opaque_tid(wave_s);
    for (int e = (wg * NTHR + tid) * 2; e < 262144; e += nwg * NTHR * 2) {
        const int c = (e >> 14) * 128 + (e & 127);
        float s0 = 0.f, s1 = 0.f;
        for (int n0 = 0; n0 < 128; n0 += 8) {
            float2 kv[8], d[8];
#pragma unroll
            for (int i = 0; i < 8; ++i) { kv[i] = *(const float2*)(KVT2 + (size_t)(n0 + i) * 262144 + e); d[i] = *(const float2*)(dec + (size_t)(n0 + i) * 2048 + c); }
#pragma unroll
            for (int i = 0; i < 8; ++i) { *(unsigned*)(STb2 + (size_t)(n0 + i) * 262144 + e) = cvt_pk_bf16(s0, s1); s0 = d[i].x * s0 + kv[i].x; s1 = d[i].y * s1 + kv[i].y; }
        }
    }
}
__device__ __forceinline__ void hgrn_out_phase(LAS unsigned char* lds, const bf16_t* qh, const bf16_t* kt, const bf16_t* vT, const bf16_t* STb2, const bf16_t* sg,
                                               const float* gain, bf16_t* mixb, int wg, int nwg, int wave_s) {
    typedef Core<4, 2> C;
    const int tid = opaque_tid(wave_s), wid = __builtin_amdgcn_readfirstlane(tid >> 6), lane = tid & 63, wr = wid >> 2, wc = wid & 3, fr = lane & 15, fq = lane >> 4;
    LAS unsigned char* ldsP = lds + 65536;
    LAS float* stat = (LAS float*)lds;
    unsigned qoff[2], koff[2], soff[2], voff[2];
#pragma unroll
    for (int i = 0; i < 2; ++i) { int r, c; C::apiece(tid, i, r, c); qoff[i] = (unsigned)(r * 2048 + c) * 2u; C::bpiece(tid, i, r, c); koff[i] = (unsigned)(r * 2048 + c) * 2u;
        soff[i] = (unsigned)(r * 128 + c) * 2u; voff[i] = (unsigned)(r * T_ + c) * 2u; }
    for (int u = wg; u < 2048; u += nwg) {
        const int n = u >> 4, h = u & 15;
        const char* Qb = (const char*)(qh + (size_t)(n * 128) * 2048 + h * 128); const char* Kb = (const char*)(kt + (size_t)(n * 128) * 2048 + h * 128);
        {
            f32x4 sa[4][2]; C::zero(sa);
            C::loop_gg(lds, Qb, qoff, Kb, koff, 2, sa, wid, wr, wc, fr, fq);
#pragma unroll
            for (int m = 0; m < 4; ++m) { const int i = wr * 64 + m * 16 + fr; const int j0 = wc * 32 + 8 * fq;
                float p[8];
#pragma unroll
                for (int e = 0; e < 8; ++e) { const float s = e < 4 ? sa[m][0][e] : sa[m][1][e - 4]; p[e] = (j0 + e <= i) ? s : 0.f; }
                u32x4 w; w.x = cvt_pk_bf16(p[0], p[1]); w.y = cvt_pk_bf16(p[2], p[3]); w.z = cvt_pk_bf16(p[4], p[5]); w.w = cvt_pk_bf16(p[6], p[7]);
                *(LAS u32x4*)(ldsP + (wc >> 1) * 16384 + lds_byte(i, j0 & 63)) = w; }
        }
        f32x4 acc[4][2]; C::zero(acc);
        C::loop_gg(lds, Qb, qoff, (const char*)(STb2 + (size_t)u * 16384), soff, 2, acc, wid, wr, wc, fr, fq);
        C::loop_lg(ldsP, lds, (const char*)(vT + (size_t)(h * 128) * T_ + n * 128), voff, 2, acc, wid, wr, wc, fr, fq);
#pragma unroll
        for (int m = 0; m < 4; ++m) { float ss = 0.f;
#pragma unroll
            for (int nn = 0; nn < 2; ++nn)
#pragma unroll
                for (int e = 0; e < 4; ++e) { const float v = acc[m][nn][e]; ss += v * v; }
            ss += __shfl_xor(ss, 16); ss += __shfl_xor(ss, 32);
            if (fq == 0) stat[(wr * 64 + m * 16 + fr) * 4 + wc] = ss; }
        __syncthreads();
#pragma unroll
        for (int m = 0; m < 4; ++m) { const int i = wr * 64 + m * 16 + fr;
            const float ss = stat[i * 4] + stat[i * 4 + 1] + stat[i * 4 + 2] + stat[i * 4 + 3];
            const float rstd = rsqrtf(ss * (1.f / 128.f) + 1e-6f);
            const size_t t = (size_t)n * 128 + i; const int c0 = h * 128 + wc * 32 + 8 * fq;
            const u32x4 g8 = *(const u32x4*)(sg + t * 2048 + c0);
            const f32x4 g0 = *(const f32x4*)(gain + c0), g1 = *(const f32x4*)(gain + c0 + 4);
            const f32x4 a = acc[m][0], b = acc[m][1];
            u32x4 w; w.x = cvt_pk_bf16(a[0] * rstd * g0[0] * bflo(g8.x), a[1] * rstd * g0[1] * bfhi(g8.x)); w.y = cvt_pk_bf16(a[2] * rstd * g0[2] * bflo(g8.y), a[3] * rstd * g0[3] * bfhi(g8.y));
            w.z = cvt_pk_bf16(b[0] * rstd * g1[0] * bflo(g8.z), b[1] * rstd * g1[1] * bfhi(g8.z)); w.w = cvt_pk_bf16(b[2] * rstd * g1[2] * bflo(g8.w), b[3] * rstd * g1[3] * bfhi(g8.w));
            *(u32x4*)(mixb + t * 2048 + c0) = w; }
        __syncthreads();
    }
}
#define LDS_BYTES 147456
#define MiB(x) ((size_t)(x) << 20)
#define WS_CTL     ((size_t)0)
#define CTL_BYTES  65536
#define CTL_CNT    1024
#define CTL_BAR    4096
#define WS_X1      MiB(1)
#define WS_HB      MiB(129)
#define WS_ROPE    MiB(193)
#define WS_WSM     MiB(225)
#define WS_WR      MiB(226)
#define WS_WINAB   MiB(228)
#define WS_WOUTAB  MiB(252)
#define WS_WINC    MiB(260)
#define WS_WOUTC   MiB(292)
#define WS_WGU     MiB(300)
#define WS_WDN     MiB(812)
#define WS_SCR     MiB(1068)
#define WS_QB      (WS_SCR)
#define WS_KVT     (WS_SCR + MiB(224))
#define WS_STB     (WS_SCR + MiB(352))
#define WS_MIXB    (WS_SCR + MiB(416))
#define WS_HID     (WS_SCR)
#define WS_Y       (WS_SCR + MiB(80))
#define WS_LIST    (WS_SCR + MiB(208))
#define WS_GATE    (WS_SCR + MiB(210))
struct FArgs { const float* in[21]; float* out; unsigned char* ws; int ph_lo, ph_hi; };
#define WS1_QS     (WS_SCR)
#define WS1_VT     (WS_SCR + MiB(64))
#define WS1_SG     (WS_SCR + MiB(128))
#define WS1_LF     (WS_SCR + MiB(192))
#define WS1_QH     (WS_SCR + MiB(320))
#define WS1_KT     (WS_SCR + MiB(480))
#define WS1_KVT    (WS_SCR + MiB(544))
#define WS1_STB    (WS_SCR + MiB(672))
#define WS1_DEC    (WS_SCR + MiB(736))
#define WS_LBV     (WS_WR + MiB(1))
#define N_PHASES 20
__global__ void __launch_bounds__(NTHR, 2) fwd(FArgs a) {
    extern __shared__ __attribute__((aligned(16))) unsigned char lds_raw[];
    LAS unsigned char* lds = (LAS unsigned char*)lds_raw;
    const int lo = a.ph_lo, hi = a.ph_hi;
    const int wave_s = __builtin_amdgcn_readfirstlane(threadIdx.x >> 6);
    const int wg = blockIdx.x, nwg = gridDim.x;
#define IN(k) (lo <= (k) && (k) < hi)
#define BOTH(k) (IN(k) && IN((k) + 1))
    unsigned char* ws = a.ws;
    float* x1 = (float*)(ws + WS_X1); bf16_t* hb = (bf16_t*)(ws + WS_HB); float* rope = (float*)(ws + WS_ROPE);
    bf16_t* WsM = (bf16_t*)(ws + WS_WSM); bf16_t* WrT = (bf16_t*)(ws + WS_WR); float* lbv = (float*)(ws + WS_LBV);
    bf16_t* winab = (bf16_t*)(ws + WS_WINAB); bf16_t* woutab = (bf16_t*)(ws + WS_WOUTAB); bf16_t* winc = (bf16_t*)(ws + WS_WINC); bf16_t* woutc = (bf16_t*)(ws + WS_WOUTC);
    bf16_t* wgu = (bf16_t*)(ws + WS_WGU); bf16_t* wdn = (bf16_t*)(ws + WS_WDN);
    bf16_t* qb = (bf16_t*)(ws + WS_QB); float* KVT = (float*)(ws + WS_KVT); bf16_t* STb = (bf16_t*)(ws + WS_STB); bf16_t* mixb = (bf16_t*)(ws + WS_MIXB);
    bf16_t* hid = (bf16_t*)(ws + WS_HID); bf16_t* yb = (bf16_t*)(ws + WS_Y); int* list = (int*)(ws + WS_LIST); float* gate = (float*)(ws + WS_GATE);
    int* cnt = (int*)(ws + WS_CTL + CTL_CNT);
    const size_t TS = (size_t)T_ * 1024; const size_t WGU_L = (size_t)32 * 2048 * 2048, WDN_L = (size_t)32 * 2048 * 1024;
    const float *cn = rope, *sn = rope + (size_t)T_ * 128, *ct = rope + (size_t)T_ * 256, *st = rope + (size_t)T_ * 384;
    if (IN(0)) {
        { ConvJob J{a.in[4], winab, 2048, 6144, 1, 6144, 6144, 6144, 0, 0}; conv_phase(lds, J, wg, nwg, wave_s); }
        { ConvJob J{a.in[9], woutab, 2048, 2048, 1, 2048, 2048, 2048, 0, 0}; conv_phase(lds, J, wg, nwg, wave_s); }
        { ConvJob J{a.in[10], winc, 2048, 8192, 1, 8192, 8192, 8192, 0, 0}; conv_phase(lds, J, wg, nwg, wave_s); }
        { ConvJob J{a.in[13], woutc, 2048, 2048, 1, 2048, 2048, 2048, 0, 0}; conv_phase(lds, J, wg, nwg, wave_s); }
        { ConvJob J{a.in[18], wgu, 2048, 1024, 64, 2048, 128, 256, 0, 0}; conv_phase(lds, J, wg, nwg, wave_s); }
        { ConvJob J{a.in[19], wgu, 2048, 1024, 64, 2048, 128, 256, 128, 0}; conv_phase(lds, J, wg, nwg, wave_s); }
        { ConvJob J{a.in[20], wdn, 1024, 2048, 64, 2048, 2048, 2048, 0, 0}; conv_phase(lds, J, wg, nwg, wave_s); }
        wr_phase(a.in[14], a.in[16], WrT, wg, nwg, wave_s);
        wr_phase(a.in[14] + 2048 * 4, a.in[16] + 2048 * 32, WrT + 64 * 2048, wg, nwg, wave_s);
        wsm_phase(a.in[7], WsM, wg, nwg, wave_s);
        lb_phase(a.in[11], lbv, wg, nwg, wave_s);
        rope_tab_phase(lds, rope, rope + (size_t)T_ * 128, rope + (size_t)T_ * 256, rope + (size_t)T_ * 384, wg, nwg, wave_s);
        if (BOTH(0)) GRID_BAR();
    }
    if (IN(1)) { norm_rows_bf16(a.in[0], a.in[1], hb, wg, nwg, wave_s); if (BOTH(1)) GRID_BAR(); }
    if (IN(2)) { EpiInAB E{qb, qb + TS, qb + 2 * TS, qb + 3 * TS, qb + 4 * TS, qb + 5 * TS, qb + 6 * TS, cn, sn, ct, st}; gemm_phase(lds, hb, winab, 64, 24, 2048, E, wave_s);
                 EpiKhat E2{qb + 2 * TS, ct, st}; gemm_phase(lds, hb, winab, 64, 4, 2048, E2, wave_s); if (BOTH(2)) GRID_BAR(); }
    if (IN(3)) { gmlp_norm_phase(lds, qb + 6 * TS, a.in[6], wg, nwg, wave_s); ret_kv_phase(lds, qb + 3 * TS, qb + 2 * TS, KVT, wg, nwg, wave_s); if (BOTH(3)) GRID_BAR(); }
    if (IN(4)) { ret_scan_phase(KVT, STb, wg, nwg, wave_s); if (BOTH(4)) GRID_BAR(); }
    if (IN(5)) { ret_out_phase(lds, qb, qb + TS, qb + 3 * TS, STb, qb + 4 * TS, a.in[5], mixb, wg, nwg, wave_s);
                 gmlp_mix_phase(lds, WsM, qb + 6 * TS, qb + 5 * TS, a.in[8], mixb, wg, nwg, wave_s); if (BOTH(5)) GRID_BAR(); }
    if (IN(6)) { EpiResidual E{a.in[0], x1}; gemm_phase(lds, mixb, woutab, 64, 8, 2048, E, wave_s); if (BOTH(6)) GRID_BAR(); }
    if (IN(7)) { moe_route_phase(lds, x1, a.in[2], hb, WrT, a.in[15], a.in[17], cnt, list, gate, wg, nwg, wave_s); if (BOTH(7)) GRID_BAR(); }
    if (IN(8)) { moe_gu_phase(lds, hb, wgu, cnt, list, hid, wg, nwg, wave_s); if (BOTH(8)) GRID_BAR(); }
    if (IN(9)) { moe_down_phase(lds, hid, wdn, cnt, list, gate, yb, wg, nwg, wave_s); if (BOTH(9)) GRID_BAR(); }
    if (IN(10)) { moe_combine_phase(x1, yb, a.in[1] + D_, hb, nullptr, wg, nwg, wave_s); if (BOTH(10)) GRID_BAR(); }
    bf16_t* qs = (bf16_t*)(ws + WS1_QS); bf16_t* vT1 = (bf16_t*)(ws + WS1_VT); bf16_t* sg1 = (bf16_t*)(ws + WS1_SG); float* lf = (float*)(ws + WS1_LF);
    bf16_t* qh = (bf16_t*)(ws + WS1_QH); bf16_t* kt = (bf16_t*)(ws + WS1_KT); float* KVT2 = (float*)(ws + WS1_KVT); bf16_t* STb2 = (bf16_t*)(ws + WS1_STB); float* dec = (float*)(ws + WS1_DEC);
    if (IN(11)) { EpiInC E{qs, vT1, sg1, lf, lbv}; gemm_phase(lds, hb, winc, 64, 32, 2048, E, wave_s); if (BOTH(11)) GRID_BAR(); }
    if (IN(12)) { hgrn_kv_phase(lds, qs, lf, vT1, qh, kt, dec, KVT2, wg, nwg, wave_s); if (BOTH(12)) GRID_BAR(); }
    if (IN(13)) { hgrn_scan_phase(KVT2, dec, STb2, wg, nwg, wave_s); if (BOTH(13)) GRID_BAR(); }
    if (IN(14)) { hgrn_out_phase(lds, qh, kt, vT1, STb2, sg1, a.in[12], mixb, wg, nwg, wave_s); if (BOTH(14)) GRID_BAR(); }
    if (IN(15)) { EpiResidual E{x1, x1}; gemm_phase(lds, mixb, woutc, 64, 8, 2048, E, wave_s); if (BOTH(15)) GRID_BAR(); }
    if (IN(16)) { moe_route_phase(lds, x1, a.in[2] + D_, hb, WrT + 64 * 2048, a.in[15] + 4, a.in[17] + 32, cnt + 32, list, gate, wg, nwg, wave_s); if (BOTH(16)) GRID_BAR(); }
    if (IN(17)) { moe_gu_phase(lds, hb, wgu + WGU_L, cnt + 32, list, hid, wg, nwg, wave_s); if (BOTH(17)) GRID_BAR(); }
    if (IN(18)) { moe_down_phase(lds, hid, wdn + WDN_L, cnt + 32, list, gate, yb, wg, nwg, wave_s); if (BOTH(18)) GRID_BAR(); }
    if (IN(19)) { moe_combine_phase(x1, yb, a.in[3], nullptr, a.out, wg, nwg, wave_s); }
#undef IN
#undef BOTH
}
#ifndef N_LAUNCH_PER_PHASE
#define N_LAUNCH_PER_PHASE 1
#endif
extern "C" void kernel_launch(void* const* d_in, const int* in_sizes, int n_in, void* d_out, int out_size, void* d_ws, size_t ws_size, hipStream_t stream) {
    static bool attr = false;
    if (!attr) { (void)hipFuncSetAttribute((const void*)fwd, hipFuncAttributeMaxDynamicSharedMemorySize, LDS_BYTES); attr = true; }
    FArgs fa{}; for (int i = 0; i < 21; ++i) fa.in[i] = (const float*)d_in[i];
    fa.out = (float*)d_out; fa.ws = (unsigned char*)d_ws;
    (void)hipMemsetAsync((char*)d_ws + WS_CTL, 0, CTL_BYTES, stream);
#if N_LAUNCH_PER_PHASE
    for (int p = 0; p < N_PHASES; ++p) { fa.ph_lo = p; fa.ph_hi = p + 1; hipLaunchKernelGGL(fwd, dim3(256), dim3(NTHR), LDS_BYTES, stream, fa); }
#else
    fa.ph_lo = 0; fa.ph_hi = N_PHASES; hipLaunchKernelGGL(fwd, dim3(256), dim3(NTHR), LDS_BYTES, stream, fa);
#endif
}
```

```cpp
#include <hip/hip_runtime.h>
#include <stdint.h>
#define T_ 16384
#define D_ 2048
__device__ __forceinline__ float wave_sum(float v) {
#pragma unroll
    for (int o = 32; o > 0; o >>= 1) v += __shfl_xor(v, o);
    return v;
}
typedef unsigned short bf16_t;
typedef short bf16x8 __attribute__((ext_vector_type(8)));
typedef float f32x4 __attribute__((ext_vector_type(4)));
typedef unsigned u32x4 __attribute__((ext_vector_type(4)));
typedef unsigned u32x2 __attribute__((ext_vector_type(2)));
#define LAS __attribute__((address_space(3)))
#define NTHR 512

__device__ __forceinline__ unsigned cvt_pk_bf16(float lo, float hi) { unsigned r; asm volatile("v_cvt_pk_bf16_f32 %0, %1, %2" : "=v"(r) : "v"(lo), "v"(hi)); return r; }
__device__ __forceinline__ float bf2f(bf16_t b) { return __uint_as_float(((unsigned)b) << 16); }
__device__ __forceinline__ float bflo(unsigned w) { return __uint_as_float(w << 16); }
__device__ __forceinline__ float bfhi(unsigned w) { return __uint_as_float(w & 0xffff0000u); }

__device__ __forceinline__ int lds_byte(int r, int c) { const int st = (r >> 4) * 2 + (c >> 5), ob = (r & 15) * 64 + (c & 31) * 2; return st * 1024 + (ob ^ (((ob >> 9) & 1) << 5)); }
__device__ __forceinline__ void stage_rc(int b, int& R, int& C) { const int st = b >> 10, sb = b & 1023, swz = sb ^ (((sb >> 9) & 1) << 5); R = (st >> 1) * 16 + swz / 64; C = (st & 1) * 32 + (swz % 64) / 2; }

#define WAIT_V0() asm volatile("s_waitcnt vmcnt(0)" ::: "memory")
__device__ __forceinline__ int opaque_tid(int wave_s) { int l; asm volatile("v_mbcnt_lo_u32_b32 %0, -1, 0\n\tv_mbcnt_hi_u32_b32 %0, -1, %0" : "=v"(l)); return wave_s * 64 + l; }

template <int MF> __device__ __forceinline__ int arow_of(int wr, int m, int fr) { if (MF == 8) return (m >> 2) * 128 + wr * 64 + (m & 3) * 16 + fr; return wr * (MF * 16) + m * 16 + fr; }
template <int NF> __device__ __forceinline__ int bcol_of(int wc, int n, int fq, int j) {
    if (NF == 4) return (n >> 1) * 128 + wc * 32 + 8 * fq + 4 * (n & 1) + j;
    if (NF == 2) return wc * 32 + 8 * fq + 4 * n + j;
    return wc * 16 + 4 * fq + j; }
template <int MF> __device__ __forceinline__ int aslot_to_row(int s) { const int wr = s / (MF * 16), m = (s >> 4) % MF, fr = s & 15; return arow_of<MF>(wr, m, fr); }
template <int NF> __device__ __forceinline__ int bslot_to_col(int s) { const int wc = s / (NF * 16), n = (s >> 4) % NF, i = s & 15; return bcol_of<NF>(wc, n, i >> 2, i & 3); }

template <int MF, int NF> struct Core {
    static constexpr int BM = 32 * MF, BN = 64 * NF;
    static constexpr int GA = BM / 64, GB = BN / 64;
    static constexpr int TA = BM * 128, TB = BN * 128;
    static __device__ __forceinline__ void apiece(int tid, int i, int& row, int& c) { int R, C; stage_rc((tid >> 6) * 1024 + i * 8192 + (tid & 63) * 16, R, C); row = aslot_to_row<MF>(R); c = C; }
    static __device__ __forceinline__ void bpiece(int tid, int i, int& col, int& c) { int R, C; stage_rc((tid >> 6) * 1024 + i * 8192 + (tid & 63) * 16, R, C); col = bslot_to_col<NF>(R); c = C; }
    static __device__ __forceinline__ void zero(f32x4 (&acc)[MF][NF]) {
#pragma unroll
        for (int m = 0; m < MF; ++m)
#pragma unroll
            for (int n = 0; n < NF; ++n) acc[m][n] = (f32x4){0.f, 0.f, 0.f, 0.f}; }
    static __device__ __forceinline__ void compute(LAS unsigned char* la, LAS unsigned char* lb, f32x4 (&acc)[MF][NF], int wr, int wc, int fr, int fq) {
        const int ao = lds_byte(wr * MF * 16 + fr, fq * 8), bo = lds_byte(wc * NF * 16 + fr, fq * 8);
#pragma unroll
        for (int ks = 0; ks < 2; ++ks) {
            bf16x8 At[MF], Bf[NF];
#pragma unroll
            for (int m = 0; m < MF; ++m) At[m] = *(const LAS bf16x8*)(la + ao + m * 2048 + ks * 1024);
#pragma unroll
            for (int n = 0; n < NF; ++n) Bf[n] = *(const LAS bf16x8*)(lb + bo + n * 2048 + ks * 1024);
#pragma unroll
            for (int m = 0; m < MF; ++m)
#pragma unroll
                for (int n = 0; n < NF; ++n) acc[m][n] = __builtin_amdgcn_mfma_f32_16x16x32_bf16(Bf[n], At[m], acc[m][n], 0, 0, 0);
            __builtin_amdgcn_sched_barrier(0);
        }
    }
    static __device__ __forceinline__ void stage_a(LAS unsigned char* dst, const char* base, const unsigned (&off)[GA], unsigned kbyte, int wid) {
        const __amdgpu_buffer_rsrc_t r = __builtin_amdgcn_make_buffer_rsrc((void*)base, 0, 0x7ffffff0, 0x00020000);
#pragma unroll
        for (int i = 0; i < GA; ++i) __builtin_amdgcn_raw_ptr_buffer_load_lds(r, (LAS void*)(dst + wid * 1024 + i * 8192), 16, (int)off[i], (int)kbyte, 0, 0); }
    static __device__ __forceinline__ void stage_b(LAS unsigned char* dst, const char* base, const unsigned (&off)[GB], unsigned kbyte, int wid) {
        const __amdgpu_buffer_rsrc_t r = __builtin_amdgcn_make_buffer_rsrc((void*)base, 0, 0x7ffffff0, 0x00020000);
#pragma unroll
        for (int i = 0; i < GB; ++i) __builtin_amdgcn_raw_ptr_buffer_load_lds(r, (LAS void*)(dst + wid * 1024 + i * 8192), 16, (int)off[i], (int)kbyte, 0, 0); }
    static __device__ __forceinline__ void loop_gg(LAS unsigned char* lds, const char* Ab, const unsigned (&aoff)[GA], const char* Bb, const unsigned (&boff)[GB], int nt,
                                                   f32x4 (&acc)[MF][NF], int wid, int wr, int wc, int fr, int fq) {
        constexpr int STG = TA + TB;
        stage_a(lds, Ab, aoff, 0, wid); stage_b(lds + TA, Bb, boff, 0, wid);
        WAIT_V0(); __syncthreads();
        for (int t = 0; t < nt; ++t) {
            const int cur = t & 1;
            if (t + 1 < nt) { stage_a(lds + (cur ^ 1) * STG, Ab, aoff, (unsigned)(t + 1) * 128u, wid); stage_b(lds + (cur ^ 1) * STG + TA, Bb, boff, (unsigned)(t + 1) * 128u, wid); }
            compute(lds + cur * STG, lds + cur * STG + TA, acc, wr, wc, fr, fq);
            WAIT_V0(); __syncthreads();
        }
    }
    static __device__ __forceinline__ void burst_gg(LAS unsigned char* la, LAS unsigned char* lb, const char* Ab, const unsigned (&aoff)[GA], const char* Bb, const unsigned (&boff)[GB], int nt,
                                                    f32x4 (&acc)[MF][NF], int wid, int wr, int wc, int fr, int fq) {
        for (int t = 0; t < nt; ++t) { stage_a(la + t * TA, Ab, aoff, (unsigned)t * 128u, wid); stage_b(lb + t * TB, Bb, boff, (unsigned)t * 128u, wid); }
        WAIT_V0(); __syncthreads();
        for (int t = 0; t < nt; ++t) compute(la + t * TA, lb + t * TB, acc, wr, wc, fr, fq);
    }
    static __device__ __forceinline__ void loop_lg(LAS unsigned char* la, LAS unsigned char* lb, const char* Bb, const unsigned (&boff)[GB], int nt,
                                                   f32x4 (&acc)[MF][NF], int wid, int wr, int wc, int fr, int fq) {
        stage_b(lb, Bb, boff, 0, wid);
        WAIT_V0(); __syncthreads();
        for (int t = 0; t < nt; ++t) {
            const int cur = t & 1;
            if (t + 1 < nt) stage_b(lb + (cur ^ 1) * TB, Bb, boff, (unsigned)(t + 1) * 128u, wid);
            compute(la + t * TA, lb + cur * TB, acc, wr, wc, fr, fq);
            WAIT_V0(); __syncthreads();
        }
    }
    static __device__ __forceinline__ void loop_gl(LAS unsigned char* la, const char* Ab, const unsigned (&aoff)[GA], LAS unsigned char* lb, int nt,
                                                   f32x4 (&acc)[MF][NF], int wid, int wr, int wc, int fr, int fq) {
        stage_a(la, Ab, aoff, 0, wid);
        WAIT_V0(); __syncthreads();
        for (int t = 0; t < nt; ++t) {
            const int cur = t & 1;
            if (t + 1 < nt) stage_a(la + (cur ^ 1) * TA, Ab, aoff, (unsigned)(t + 1) * 128u, wid);
            compute(la + cur * TA, lb + t * TB, acc, wr, wc, fr, fq);
            WAIT_V0(); __syncthreads();
        }
    }
};
#define XB_TMO      128
#define XB_XCNT(j)  (256  + 64 * (j))
#define XB_XSUB(j)  (1280 + 64 * (j))
#define XB_XGEN(j)  (2304 + 64 * (j))
#define XB_TOP      3328
#define XB_TOPGEN   3392
#define XCD_BAR_WORDS 3456
#define XB_SPIN_CAP (1u << 18)
#define LAS __attribute__((address_space(3)))

__device__ __forceinline__ unsigned xb_ld(unsigned* p)              { return __hip_atomic_load(p, __ATOMIC_RELAXED, __HIP_MEMORY_SCOPE_AGENT); }
__device__ __forceinline__ unsigned xb_add(unsigned* p, unsigned v) { return __hip_atomic_fetch_add(p, v, __ATOMIC_RELAXED, __HIP_MEMORY_SCOPE_AGENT); }
__device__ __forceinline__ unsigned xb_xcc_id() { return (unsigned)__builtin_amdgcn_s_getreg((3 << 11) | 20) & 0xFu; }
#define XB_SPIN(cond, bar) do { unsigned _sp = 0; while (cond) { __builtin_amdgcn_s_sleep(1); \
    if ((++_sp & 255u) == 0u) { if (xb_ld(&(bar)[XB_TMO])) break; if (_sp > XB_SPIN_CAP) { atomicAdd(&(bar)[XB_TMO], 1u); break; } } } } while (0)

struct XcdBarrier {
    unsigned* bar; unsigned x;
    volatile LAS unsigned* st;
};

__device__ __forceinline__ XcdBarrier xcd_barrier_post(unsigned* bar, volatile LAS unsigned* st) {
    XcdBarrier b; b.bar = bar; b.x = xb_xcc_id(); b.st = st;
    if (threadIdx.x == 0) (void)xb_add(&bar[XB_XCNT(b.x)], 1u);
    return b;
}
__device__ __forceinline__ void xcd_barrier_complete(unsigned* bar, unsigned x, unsigned& nloc, unsigned& nx) {
    const unsigned G = gridDim.x * gridDim.y * gridDim.z;
    unsigned sum, cnt, mine, sp = 0u;
    for (;;) {
        sum = 0u; cnt = 0u; mine = 0u;
#pragma unroll
        for (unsigned j = 0; j < 16; ++j) { const unsigned c = xb_ld(&bar[XB_XCNT(j)]); sum += c; cnt += (c > 0u) ? 1u : 0u; mine = (j == x) ? c : mine; }
        if (sum == G) break;
        __builtin_amdgcn_s_sleep(1);
        if ((++sp & 255u) == 0u) { if (xb_ld(&bar[XB_TMO])) break; if (sp > XB_SPIN_CAP) { atomicAdd(&bar[XB_TMO], 1u); break; } }
    }
    nloc = mine > 0u ? mine : 1u; nx = cnt > 0u ? cnt : 1u;
}

__device__ __forceinline__ void xcd_barrier(const XcdBarrier& b) {
    asm volatile("s_waitcnt vmcnt(0)" ::: "memory");
    __syncthreads();
    if (threadIdx.x == 0) {
        unsigned* bar = b.bar;
        __builtin_amdgcn_s_waitcnt(0);
        unsigned nloc = b.st[0], nx = b.st[1];
        if (nloc == 0u) { xcd_barrier_complete(bar, b.x, nloc, nx); b.st[0] = nloc; b.st[1] = nx; }
        const unsigned old = xb_add(&bar[XB_XSUB(b.x)], 1u);
        const unsigned gen = old / nloc;
        if (old + 1u == (gen + 1u) * nloc) {
            __builtin_amdgcn_fence(__ATOMIC_RELEASE, "agent");
            asm volatile("s_waitcnt vmcnt(0)" ::: "memory");
            const unsigned og = xb_add(&bar[XB_TOP], 1u);
            const unsigned tg = og / nx;
            if (og + 1u == (tg + 1u) * nx) xb_add(&bar[XB_TOPGEN], 1u);
            else XB_SPIN(xb_ld(&bar[XB_TOPGEN]) == tg, bar);
            __builtin_amdgcn_fence(__ATOMIC_ACQUIRE, "agent");
            xb_add(&bar[XB_XGEN(b.x)], 1u);
            asm volatile("s_waitcnt vmcnt(0)" ::: "memory");
        } else {
            XB_SPIN(xb_ld(&bar[XB_XGEN(b.x)]) == gen, bar);
            __builtin_amdgcn_fence(__ATOMIC_ACQUIRE, "agent");
            asm volatile("s_waitcnt vmcnt(0)" ::: "memory");
        }
    }
    __syncthreads();
}

__device__ __forceinline__ bool unit_of(long L, int nM, int nN, int& pm, int& pn) {
    const int nwg = nM * nN; if (L >= nwg) return false;
    int wgid = (int)L; { const int q = nwg / 8, r = nwg % 8, xcd = wgid % 8, off = wgid / 8; wgid = (xcd < r ? xcd * (q + 1) : r * (q + 1) + (xcd - r) * q) + off; }
    const int nig = 8 * nN, gid = wgid / nig, fm = gid * 8, gsz = (nM - fm) < 8 ? (nM - fm) : 8;
    pm = fm + ((wgid % nig) % gsz); pn = (wgid % nig) / gsz; return true;
}

struct EpiPlainF32 {
    float* Cout; int ldc;
    __device__ __forceinline__ bool swapped(int) const { return false; }
    __device__ __forceinline__ int brow0(int pn) const { return pn * 256; }
    __device__ __forceinline__ void operator()(const f32x4 (&acc)[8][4], int pm, int pn, int wr, int wc, int fr, int fq) const {
#pragma unroll
        for (int m = 0; m < 8; ++m) { float* rp = Cout + (size_t)(pm * 256 + arow_of<8>(wr, m, fr)) * ldc + pn * 256;
#pragma unroll
            for (int n = 0; n < 4; ++n) *(f32x4*)(rp + bcol_of<4>(wc, n, fq, 0)) = acc[m][n]; }
    }
};

__device__ __forceinline__ unsigned pk4_fp8(float a, float b, float c, float d) { int w = 0; w = __builtin_amdgcn_cvt_pk_fp8_f32(a, b, w, false); w = __builtin_amdgcn_cvt_pk_fp8_f32(c, d, w, true); return (unsigned)w; }
struct ConvJob { const float* W; bf16_t* dst; int K, N, batch, rows_per_batch, grp, grp_stride, add, pad; };
template <bool FP8>
__device__ __forceinline__ void conv_tiles(LAS unsigned char* lds, const ConvJob& J, float sc, int wg, int nwg, int wave_s) {
    const int tid = opaque_tid(wave_s), n4 = tid & 31, kg = tid >> 5;
    const int tk = J.K / 128, tn = J.N / 128, per = tk * tn, total = per * J.batch;
    constexpr int RS = FP8 ? 144 : 272;
    unsigned char* dst8 = (unsigned char*)J.dst;
    for (int u = wg; u < total; u += nwg) {
        const int b = u / per, r = u % per, kt = r / tn, nt = r % tn;
        const float* src = J.W + ((size_t)b * J.K + (size_t)kt * 128 + kg * 8) * J.N + nt * 128 + 4 * n4;
        float4 v[8];
#pragma unroll
        for (int j = 0; j < 8; ++j) v[j] = *(const float4*)(src + (size_t)j * J.N);
#pragma unroll
        for (int i = 0; i < 4; ++i) { float e[8];
#pragma unroll
            for (int j = 0; j < 8; ++j) e[j] = (i == 0 ? v[j].x : i == 1 ? v[j].y : i == 2 ? v[j].z : v[j].w) * (FP8 ? sc : 1.f);
            if (FP8) { u32x2 w; w.x = pk4_fp8(e[0], e[1], e[2], e[3]); w.y = pk4_fp8(e[4], e[5], e[6], e[7]); *(LAS u32x2*)(lds + (4 * n4 + i) * RS + kg * 8) = w; }
            else { u32x4 w; w.x = cvt_pk_bf16(e[0], e[1]); w.y = cvt_pk_bf16(e[2], e[3]); w.z = cvt_pk_bf16(e[4], e[5]); w.w = cvt_pk_bf16(e[6], e[7]); *(LAS u32x4*)(lds + (4 * n4 + i) * RS + kg * 16) = w; } }
        __syncthreads();
        const int nn0 = nt * 128;
        const size_t drow0 = (size_t)b * J.rows_per_batch + (size_t)(nn0 / J.grp) * J.grp_stride + (nn0 % J.grp) + J.add;
#pragma unroll
        for (int p = 0; p < (FP8 ? 2 : 4); ++p) { const int q = tid + 512 * p, row = FP8 ? (q >> 3) : (q >> 4), pc = FP8 ? (q & 7) : (q & 15);
            const u32x4 w = *(const LAS u32x4*)(lds + row * RS + pc * 16);
            if (FP8) *(u32x4*)(dst8 + (drow0 + row) * J.K + kt * 128 + pc * 16) = w;
            else *(u32x4*)(J.dst + (drow0 + row) * J.K + kt * 128 + pc * 8) = w; }
        __syncthreads();
    }
}
__device__ __forceinline__ void conv_phase(LAS unsigned char* lds, const ConvJob& J, int wg, int nwg, int wave_s) { conv_tiles<false>(lds, J, 1.f, wg, nwg, wave_s); }
__device__ __forceinline__ void conv8_phase(LAS unsigned char* lds, const ConvJob& J, float sc, int wg, int nwg, int wave_s) { conv_tiles<true>(lds, J, sc, wg, nwg, wave_s); }

__device__ __forceinline__ void norm_rows_bf16(const float* __restrict__ x, const float* __restrict__ g, bf16_t* __restrict__ out, int wg, int nwg, int wave_s) {
    const int tid = opaque_tid(wave_s), lane = tid & 63, wv = tid >> 6;
    for (int row = wg * 8 + wv; row < T_; row += nwg * 8) {
        const float4* xr = (const float4*)(x + (size_t)row * D_);
        float4 v[8]; float ss = 0.f;
#pragma unroll
        for (int i = 0; i < 8; ++i) { v[i] = xr[2 * (lane + 64 * (i >> 1)) + (i & 1)]; ss += v[i].x * v[i].x + v[i].y * v[i].y + v[i].z * v[i].z + v[i].w * v[i].w; }
        ss = wave_sum(ss);
        const float r = rsqrtf(ss * (1.f / D_) + 1e-6f);
#pragma unroll
        for (int i = 0; i < 4; ++i) { const int e0 = 8 * (lane + 64 * i); const float4 ga = *(const float4*)(g + e0), gb = *(const float4*)(g + e0 + 4); const float4 a = v[2 * i], b = v[2 * i + 1];
            u32x4 o; o.x = cvt_pk_bf16(a.x * r * ga.x, a.y * r * ga.y); o.y = cvt_pk_bf16(a.z * r * ga.z, a.w * r * ga.w); o.z = cvt_pk_bf16(b.x * r * gb.x, b.y * r * gb.y); o.w = cvt_pk_bf16(b.z * r * gb.z, b.w * r * gb.w);
            *(u32x4*)(out + (size_t)row * D_ + e0) = o; }
    }
}
__device__ __forceinline__ int perm32(int rho) { const int n = rho >> 4, i = rho & 15; return 8 * (i >> 2) + 4 * n + (i & 3); }
#define HTB 16384
typedef int i32x4 __attribute__((ext_vector_type(4)));
typedef int i32x8 __attribute__((ext_vector_type(8)));
#ifndef G8_ABLATE
#define G8_ABLATE 0
#endif
template <bool FP8, class Sched, class Epi, int ABL = 0>
__device__ __forceinline__ void gemm8_phase(LAS unsigned char* lds, int RB, const Sched& S, const Epi& E, int wave_s) {
    typedef typename Sched::U U;
    const int tid = opaque_tid(wave_s), wid = __builtin_amdgcn_readfirstlane(tid >> 6), lane = tid & 63, wr = wid >> 2, wc = wid & 3, fr = lane & 15, fq = lane >> 4;
    const int nt = RB / 128;
    int R0, C0; stage_rc(tid * 16, R0, C0);
    const unsigned c2 = (unsigned)C0 * 2u, r64 = (unsigned)64 * RB;
    const unsigned voffB0 = (unsigned)(((R0 & ~31) + perm32(R0 & 31)) * RB) + c2, voffA0 = (unsigned)(R0 * RB) + c2;
    const unsigned hstep = (unsigned)128 * RB;
    const unsigned ldsw = (unsigned)wid * 1024u;
    const int aoff = lds_byte(wr * 64 + fr, fq * 8), boff = lds_byte(wc * 32 + fr, fq * 8);
#define G8_SA(b, h) (((b) * 2 + (h)) * HTB)
#define G8_SB(b, h) ((4 + (b) * 2 + (h)) * HTB)
#define G8_STAGE2(bufoff, rs, v0, s0, v1, s1) do { __builtin_amdgcn_raw_ptr_buffer_load_lds(rs, (LAS void*)(lds + (bufoff) + ldsw), 16, (int)(v0), (int)(s0), 0, 0); \
        __builtin_amdgcn_raw_ptr_buffer_load_lds(rs, (LAS void*)(lds + (bufoff) + ldsw + 8192), 16, (int)(v1), (int)(s1), 0, 0); } while (0)
#define G8_STB(bufoff, rs, so) G8_STAGE2(bufoff, rs, voffB0, (so), voffB0, (so) + r64)
#define G8_STA(bufoff, rs, pk, h, so) do { if (Sched::GATHER) { const unsigned _p = (pk)[h]; G8_STAGE2(bufoff, rs, (_p & 0xffffu) * (unsigned)RB + c2, (so), (_p >> 16) * (unsigned)RB + c2, (so)); } \
        else G8_STAGE2(bufoff, rs, voffA0, (so) + (h) * hstep, voffA0, (so) + (h) * hstep + r64); } while (0)
#define G8_LDA(dst, b, h) do { _Pragma("unroll") for (int m = 0; m < 4; ++m) dst[m] = __builtin_shufflevector(*(const LAS i32x4*)(lds + G8_SA(b, h) + aoff + m * 2048), *(const LAS i32x4*)(lds + G8_SA(b, h) + aoff + m * 2048 + 1024), 0, 1, 2, 3, 4, 5, 6, 7); } while (0)
#define G8_LDB(dst, b, h) do { _Pragma("unroll") for (int n = 0; n < 2; ++n) dst[n] = __builtin_shufflevector(*(const LAS i32x4*)(lds + G8_SB(b, h) + boff + n * 2048), *(const LAS i32x4*)(lds + G8_SB(b, h) + boff + n * 2048 + 1024), 0, 1, 2, 3, 4, 5, 6, 7); } while (0)
#define G8_MMA1(ai, bj, At, Bt, m, n) do { \
        if constexpr (FP8) asm volatile("v_mfma_scale_f32_16x16x128_f8f6f4 %0, %1, %2, %0, %3, %3 op_sel_hi:[0,0,0]" : "+v"(acc[(ai) * 4 + m][(bj) * 2 + n]) : "v"(Bt[n]), "v"(At[m]), "v"(one_scale)); \
        else { acc[(ai) * 4 + m][(bj) * 2 + n] = __builtin_amdgcn_mfma_f32_16x16x32_bf16(__builtin_bit_cast(bf16x8, __builtin_shufflevector(Bt[n], Bt[n], 0, 1, 2, 3)), __builtin_bit_cast(bf16x8, __builtin_shufflevector(At[m], At[m], 0, 1, 2, 3)), acc[(ai) * 4 + m][(bj) * 2 + n], 0, 0, 0); \
               acc[(ai) * 4 + m][(bj) * 2 + n] = __builtin_amdgcn_mfma_f32_16x16x32_bf16(__builtin_bit_cast(bf16x8, __builtin_shufflevector(Bt[n], Bt[n], 4, 5, 6, 7)), __builtin_bit_cast(bf16x8, __builtin_shufflevector(At[m], At[m], 4, 5, 6, 7)), acc[(ai) * 4 + m][(bj) * 2 + n], 0, 0, 0); } } while (0)
#define G8_MMA(ai, bj, At, Bt) do { if (ABL == 1) { _Pragma("unroll") for (int m = 0; m < 4; ++m) asm volatile("" :: "v"(At[m])); _Pragma("unroll") for (int n = 0; n < 2; ++n) asm volatile("" :: "v"(Bt[n])); break; } \
        __builtin_amdgcn_s_setprio(1); _Pragma("unroll") for (int m = 0; m < 4; ++m) _Pragma("unroll") for (int n = 0; n < 2; ++n) G8_MMA1(ai, bj, At, Bt, m, n); __builtin_amdgcn_s_setprio(0); } while (0)
#define G8_WAIT_V(n) asm volatile("s_waitcnt vmcnt(" #n ")" ::: "memory")
#define G8_WAIT_L(n) asm volatile("s_waitcnt lgkmcnt(" #n ")" ::: "memory")
#define G8_BAR __builtin_amdgcn_s_barrier()
#define G8_SCHED __builtin_amdgcn_sched_barrier(0)
#define G8_RSRC(p) __builtin_amdgcn_make_buffer_rsrc((void*)(p), 0, 0x7ffffff0, 0x00020000)
    U cur, nxt; int ui = 0;
    if (!S.next(0, cur)) return;
    f32x4 acc[8][4];
#pragma unroll
    for (int m = 0; m < 8; ++m)
#pragma unroll
        for (int n = 0; n < 4; ++n) acc[m][n] = (f32x4){0.f, 0.f, 0.f, 0.f};
    i32x8 At[4], B0[2], B1[2];
    const int one_scale = 0x7F7F7F7F;
    unsigned pkc[2] = {0u, 0u}, pkn[2] = {0u, 0u};
    if (Sched::GATHER) S.gather(cur, R0, pkc);
    pkn[0] = pkc[0]; pkn[1] = pkc[1];
    const char* cA = S.abase(cur); const char* cB = S.bbase(cur);
    {
        const __amdgpu_buffer_rsrc_t rA = G8_RSRC(cA), rB = G8_RSRC(cB);
        G8_STB(G8_SB(0, 0), rB, 0u); G8_STA(G8_SA(0, 0), rA, pkc, 0, 0u); G8_STB(G8_SB(0, 1), rB, hstep); G8_STA(G8_SA(0, 1), rA, pkc, 1, 0u);
        if (wr == 1) G8_BAR;
        G8_WAIT_V(4); G8_BAR;
        G8_STB(G8_SB(1, 0), rB, 128u); G8_STA(G8_SA(1, 0), rA, pkc, 0, 128u); G8_STB(G8_SB(1, 1), rB, hstep + 128u);
        G8_WAIT_V(6); G8_BAR;
    }
    for (;;) {
        const bool has_next = S.next(ui + 1, nxt);
        if (Sched::GATHER && has_next) { const int tz = opaque_tid(wave_s); int R2, C2; stage_rc(tz * 16, R2, C2); S.gather(nxt, R2, pkn); }
        const char* nA = has_next ? S.abase(nxt) : cA; const char* nB = has_next ? S.bbase(nxt) : cB;
        const __amdgpu_buffer_rsrc_t rA = G8_RSRC(cA);
#pragma unroll 1
        for (int t = 0; t < nt; t += 2) {
            int lastv = __builtin_amdgcn_readfirstlane((t == nt - 2) ? 1 : 0); asm volatile("" : "+s"(lastv)); const bool last = lastv != 0;
            const unsigned k1 = (unsigned)(t + 1) * 128u;
            const unsigned k2 = last ? 0u : (unsigned)(t + 2) * 128u, k3 = k2 + 128u;
            const __amdgpu_buffer_rsrc_t rA2 = G8_RSRC(last ? nA : cA), rB2 = G8_RSRC(last ? nB : cB);
            const unsigned px[2] = {last ? pkn[0] : pkc[0], last ? pkn[1] : pkc[1]};
            G8_LDB(B0, 0, 0); G8_SCHED; G8_LDA(At, 0, 0); G8_STA(G8_SA(1, 1), rA, pkc, 1, k1);
            G8_WAIT_L(8); G8_BAR; G8_WAIT_L(0); G8_MMA(0, 0, At, B0); G8_BAR; G8_SCHED;
            G8_LDB(B1, 0, 1); G8_STB(G8_SB(0, 0), rB2, k2);
            G8_BAR; G8_WAIT_L(0); G8_MMA(0, 1, At, B1); G8_BAR;
            G8_LDA(At, 0, 1); G8_STA(G8_SA(0, 0), rA2, px, 0, k2);
            G8_BAR; G8_WAIT_L(0); G8_MMA(1, 0, At, B0); G8_BAR; G8_SCHED;
            G8_STB(G8_SB(0, 1), rB2, k2 + hstep);
            G8_WAIT_V(6); G8_BAR; G8_MMA(1, 1, At, B1); G8_BAR;
            G8_LDB(B0, 1, 0); G8_SCHED; G8_LDA(At, 1, 0); G8_STA(G8_SA(0, 1), rA2, px, 1, k2);
            G8_WAIT_L(8); G8_BAR; G8_WAIT_L(0); G8_MMA(0, 0, At, B0); G8_BAR; G8_SCHED;
            G8_LDB(B1, 1, 1); G8_STB(G8_SB(1, 0), rB2, k3);
            G8_BAR; G8_WAIT_L(0); G8_MMA(0, 1, At, B1); G8_BAR;
            G8_LDA(At, 1, 1); G8_STA(G8_SA(1, 0), rA2, px, 0, k3);
            G8_BAR; G8_WAIT_L(0); G8_MMA(1, 0, At, B0); G8_BAR; G8_SCHED;
            G8_STB(G8_SB(1, 1), rB2, k3 + hstep);
            G8_WAIT_V(6); G8_BAR; G8_MMA(1, 1, At, B1); G8_BAR;
        }
        if (FP8) asm volatile("s_nop 15\n\ts_nop 15" ::: "memory");
        {
            const int tz = opaque_tid(wave_s), lz = tz & 63, wz = __builtin_amdgcn_readfirstlane(tz >> 6);
            E(acc, cur, wz >> 2, wz & 3, lz & 15, lz >> 4); }
        if (!has_next) break;
#pragma unroll
        for (int m = 0; m < 8; ++m)
#pragma unroll
            for (int n = 0; n < 4; ++n) acc[m][n] = (f32x4){0.f, 0.f, 0.f, 0.f};
        cur = nxt; cA = nA; cB = nB; ++ui;
        pkc[0] = pkn[0]; pkc[1] = pkn[1];
    }
    G8_WAIT_V(0);
    if (wr == 0) G8_BAR;
    G8_BAR;
#undef G8_SA
#undef G8_SB
#undef G8_STAGE2
#undef G8_STB
#undef G8_STA
#undef G8_LDA
#undef G8_LDB
#undef G8_MMA
#undef G8_MMA1
#undef G8_WAIT_V
#undef G8_WAIT_L
#undef G8_BAR
#undef G8_SCHED
#undef G8_RSRC
}

struct DenseU { int pm, pn; };
template <class Epi> struct DenseSched {
    typedef DenseU U; static constexpr bool GATHER = false; static constexpr bool RAGGED = false;
    __device__ __forceinline__ int nvalid(const U&) const { return 256; }
    const bf16_t* A; const bf16_t* Bt; int nM, nN, K; const Epi* E; int wg, nwg;
    __device__ __forceinline__ bool next(int i, U& u) const { return unit_of((long)i * nwg + wg, nM, nN, u.pm, u.pn); }
    __device__ __forceinline__ const char* abase(const U& u) const { return E->swapped(u.pn) ? (const char*)(Bt + (size_t)E->brow0(u.pn) * K) : (const char*)(A + (size_t)u.pm * 256 * K); }
    __device__ __forceinline__ const char* bbase(const U& u) const { return E->swapped(u.pn) ? (const char*)(A + (size_t)u.pm * 256 * K) : (const char*)(Bt + (size_t)E->brow0(u.pn) * K); }
    __device__ __forceinline__ void gather(const U&, int, unsigned (&)[2]) const {}
};
template <class Epi> struct DenseEpi { const Epi* E;
    __device__ __forceinline__ void operator()(const f32x4 (&acc)[8][4], const DenseU& u, int wr, int wc, int fr, int fq) const { (*E)(acc, u.pm, u.pn, wr, wc, fr, fq); } };
template <class Epi>
__device__ __forceinline__ void gemm_phase(LAS unsigned char* lds, const bf16_t* A, const bf16_t* Bt, int nM, int nN, int K, const Epi& E, int wave_s) {
    DenseSched<Epi> S{A, Bt, nM, nN, K, &E, (int)blockIdx.x, (int)gridDim.x}; DenseEpi<Epi> DE{&E};
    gemm8_phase<false>(lds, K * 2, S, DE, wave_s);
}
__device__ __forceinline__ void rope_freq(int j, float& fhi, float& flo) {
    const double f = exp2(-(double)j * (13.287712379549449 / 128.0)) * 0.15915494309189535;
    fhi = (float)f; flo = (float)(f - (double)fhi);
}
__device__ __forceinline__ void rope_cs(float pos, float fhi, float flo, float& c, float& s) {
    const float p = pos * fhi; const float e = __builtin_fmaf(pos, fhi, -p);
    float r = p - __builtin_rintf(p); r += e + pos * flo;
    c = __builtin_amdgcn_cosf(r); s = __builtin_amdgcn_sinf(r);
}
__device__ __forceinline__ float gelu_fast(float x) { const float u = x * (-2.3022081981971123f - 0.10294324276067f * x * x); return x * __builtin_amdgcn_rcpf(1.f + __builtin_amdgcn_exp2f(u)); }
__device__ __forceinline__ float silu_fast(float x) { return x * __builtin_amdgcn_rcpf(1.f + __builtin_amdgcn_exp2f(-1.4426950408889634f * x)); }

struct EpiInAB {
    bf16_t *qb, *kb, *vT, *sgb, *ugb, *gvT;
    __device__ __forceinline__ bool swapped(int pn) const { return (pn >= 8 && pn < 12) || pn >= 20; }
    __device__ __forceinline__ int brow0(int pn) const { return pn * 256; }
    __device__ __forceinline__ void operator()(const f32x4 (&acc)[8][4], int pm, int pn, int wr, int wc, int fr, int fq) const {
        if (pn < 8) {
            bf16_t* dst = (pn < 4 ? qb : kb) + (pn & 3) * 256; const float sc = pn < 4 ? 1.f : 0.0625f;
            float fh[8], fl[8];
#pragma unroll
            for (int e = 0; e < 8; ++e) rope_freq(wc * 32 + 8 * fq + e, fh[e], fl[e]);
#pragma unroll
            for (int m = 0; m < 8; ++m) { int row = pm * 256 + arow_of<8>(wr, m, fr); asm volatile("" : "+v"(row));
                const float pos = (float)row; float o1[8], o2[8];
#pragma unroll
                for (int e = 0; e < 8; ++e) { float c, s; rope_cs(pos, fh[e], fl[e], c, s);
                    const float x1 = acc[m][e >> 2][e & 3], x2 = acc[m][(e >> 2) + 2][e & 3];
                    o1[e] = (x1 * c - x2 * s) * sc; o2[e] = (x2 * c + x1 * s) * sc; }
                u32x4 lo, hi;
                lo.x = cvt_pk_bf16(o1[0], o1[1]); lo.y = cvt_pk_bf16(o1[2], o1[3]); lo.z = cvt_pk_bf16(o1[4], o1[5]); lo.w = cvt_pk_bf16(o1[6], o1[7]);
                hi.x = cvt_pk_bf16(o2[0], o2[1]); hi.y = cvt_pk_bf16(o2[2], o2[3]); hi.z = cvt_pk_bf16(o2[4], o2[5]); hi.w = cvt_pk_bf16(o2[6], o2[7]);
                bf16_t* rp = dst + (size_t)row * 1024 + wc * 32 + 8 * fq;
                *(u32x4*)rp = lo; *(u32x4*)(rp + 128) = hi; }
        } else if (pn >= 12 && pn < 20) {
            const bool isg = pn < 16; bf16_t* dst = (isg ? sgb : ugb) + (pn & 3) * 256;
#pragma unroll
            for (int m = 0; m < 8; ++m) { int row = pm * 256 + arow_of<8>(wr, m, fr); asm volatile("" : "+v"(row));
#pragma unroll
                for (int hf = 0; hf < 2; ++hf) { u32x4 w; const f32x4 a = acc[m][2 * hf], b = acc[m][2 * hf + 1];
                    float v[8] = {a[0], a[1], a[2], a[3], b[0], b[1], b[2], b[3]};
#pragma unroll
                    for (int e = 0; e < 8; ++e) v[e] = isg ? silu_fast(v[e]) : gelu_fast(v[e]);
                    w.x = cvt_pk_bf16(v[0], v[1]); w.y = cvt_pk_bf16(v[2], v[3]); w.z = cvt_pk_bf16(v[4], v[5]); w.w = cvt_pk_bf16(v[6], v[7]);
                    *(u32x4*)(dst + (size_t)row * 1024 + hf * 128 + wc * 32 + 8 * fq) = w; } }
        } else {
            const bool isv = pn < 12; bf16_t* dst = (isv ? vT : gvT) + (size_t)((pn & 3) * 256) * T_ + pm * 256;
#pragma unroll
            for (int m = 0; m < 8; ++m) { int f = arow_of<8>(wr, m, fr); asm volatile("" : "+v"(f));
#pragma unroll
                for (int hf = 0; hf < 2; ++hf) { u32x4 w; const f32x4 a = acc[m][2 * hf], b = acc[m][2 * hf + 1];
                    float v[8] = {a[0], a[1], a[2], a[3], b[0], b[1], b[2], b[3]};
                    if (!isv) {
#pragma unroll
                        for (int e = 0; e < 8; ++e) v[e] = gelu_fast(v[e]); }
                    w.x = cvt_pk_bf16(v[0], v[1]); w.y = cvt_pk_bf16(v[2], v[3]); w.z = cvt_pk_bf16(v[4], v[5]); w.w = cvt_pk_bf16(v[6], v[7]);
                    *(u32x4*)(dst + (size_t)f * T_ + hf * 128 + wc * 32 + 8 * fq) = w; } }
        }
    }
};

struct EpiKhat {
    bf16_t* khatT;
    __device__ __forceinline__ bool swapped(int) const { return true; }
    __device__ __forceinline__ int brow0(int pn) const { return (4 + pn) * 256; }
    __device__ __forceinline__ void operator()(const f32x4 (&acc)[8][4], int pm, int pn, int wr, int wc, int fr, int fq) const {
        const int h = pn; const float l2g = log2f(1.f - exp2f(-5.f - (float)h));
        bf16_t* dst = khatT + (size_t)(h * 256) * T_ + pm * 256;
#pragma unroll
        for (int m = 0; m < 4; ++m) { int f = wr * 64 + m * 16 + fr; asm volatile("" : "+v"(f));
            float fh, fl; rope_freq(f, fh, fl);
#pragma unroll
            for (int hf = 0; hf < 2; ++hf) { float o1[8], o2[8]; const int t0 = hf * 128 + wc * 32 + 8 * fq;
#pragma unroll
                for (int e = 0; e < 8; ++e) { float c, s; rope_cs((float)(pm * 256 + t0 + e), fh, fl, c, s);
                    const float x1 = acc[m][2 * hf + (e >> 2)][e & 3], x2 = acc[m + 4][2 * hf + (e >> 2)][e & 3];
                    const float d = 0.0625f * exp2f((float)(127 - ((t0 + e) & 127)) * l2g);
                    o1[e] = (x1 * c - x2 * s) * d; o2[e] = (x2 * c + x1 * s) * d; }
                u32x4 w1, w2;
                w1.x = cvt_pk_bf16(o1[0], o1[1]); w1.y = cvt_pk_bf16(o1[2], o1[3]); w1.z = cvt_pk_bf16(o1[4], o1[5]); w1.w = cvt_pk_bf16(o1[6], o1[7]);
                w2.x = cvt_pk_bf16(o2[0], o2[1]); w2.y = cvt_pk_bf16(o2[2], o2[3]); w2.z = cvt_pk_bf16(o2[4], o2[5]); w2.w = cvt_pk_bf16(o2[6], o2[7]);
                *(u32x4*)(dst + (size_t)f * T_ + t0) = w1;
                *(u32x4*)(dst + (size_t)(f + 128) * T_ + t0) = w2; } }
    }
};
typedef short s16x4 __attribute__((ext_vector_type(4)));
__device__ __forceinline__ void ret_kv_phase(LAS unsigned char* lds, const bf16_t* vT, const bf16_t* kb, bf16_t* KVT, int wg, int nwg, int wave_s) {
    typedef Core<8, 4> C;
    constexpr int RS = 576;
    const int tid = opaque_tid(wave_s), wid = __builtin_amdgcn_readfirstlane(tid >> 6), lane = tid & 63, wr = wid >> 2, wc = wid & 3, fr = lane & 15, fq = lane >> 4;
    LAS unsigned char* ldsT = lds + 65536;
    unsigned aoff[4];
#pragma unroll
    for (int i = 0; i < 4; ++i) { int r, c; C::apiece(tid, i, r, c); aoff[i] = (unsigned)(r * T_ + c) * 2u; }
    const int ao = lds_byte(wr * 128 + fr, fq * 8);
    LAS unsigned char* trb = ldsT + (8 * fq + (fr >> 2)) * RS + 2 * (wc * 32 + 8 * (fr & 3));
    for (int u = wg; u < 512; u += nwg) {
        const int n = u >> 2, h = u & 3; const float l2g = log2f(1.f - exp2f(-5.f - (float)h));
        const bf16_t* kt = kb + (size_t)(n * 128) * 1024 + h * 256;
        { const char* Vb = (const char*)(vT + (size_t)(h * 256) * T_ + n * 128); C::stage_a(lds, Vb, aoff, 0u, wid); C::stage_a(lds + 32768, Vb, aoff, 128u, wid); }
#pragma unroll
        for (int p = 0; p < 8; ++p) { int idx = tid + 512 * p; asm volatile("" : "+v"(idx)); const int j = idx >> 5, d0 = (idx & 31) * 8;
            const u32x4 w = *(const u32x4*)(kt + (size_t)j * 1024 + d0);
            const float d = exp2f((float)(127 - j) * l2g);
            u32x4 o; o.x = cvt_pk_bf16(bflo(w.x) * d, bfhi(w.x) * d); o.y = cvt_pk_bf16(bflo(w.y) * d, bfhi(w.y) * d); o.z = cvt_pk_bf16(bflo(w.z) * d, bfhi(w.z) * d); o.w = cvt_pk_bf16(bflo(w.w) * d, bfhi(w.w) * d);
            *(LAS u32x4*)(ldsT + j * RS + d0 * 2) = o; }
        WAIT_V0(); __syncthreads();
        f32x4 acc[8][4]; C::zero(acc);
#pragma unroll
        for (int kk = 0; kk < 4; ++kk) {
            bf16x8 At[8], Bf[4];
#pragma unroll
            for (int m = 0; m < 8; ++m) At[m] = *(const LAS bf16x8*)(lds + (kk >> 1) * 32768 + ao + m * 2048 + (kk & 1) * 1024);
#pragma unroll
            for (int nn = 0; nn < 4; ++nn) { LAS unsigned char* a = trb + (kk * 32) * RS + 2 * ((nn >> 1) * 128 + 4 * (nn & 1));
                const s16x4 lo = __builtin_amdgcn_ds_read_tr16_b64_v4i16((LAS s16x4*)a), hi = __builtin_amdgcn_ds_read_tr16_b64_v4i16((LAS s16x4*)(a + 4 * RS));
                Bf[nn] = __builtin_shufflevector(lo, hi, 0, 1, 2, 3, 4, 5, 6, 7); }
#pragma unroll
            for (int m = 0; m < 8; ++m)
#pragma unroll
                for (int nn = 0; nn < 4; ++nn) acc[m][nn] = __builtin_amdgcn_mfma_f32_16x16x32_bf16(Bf[nn], At[m], acc[m][nn], 0, 0, 0);
            __builtin_amdgcn_sched_barrier(0);
        }
        __syncthreads();
        bf16_t* dst = KVT + (size_t)u * 65536;
#pragma unroll
        for (int m = 0; m < 8; ++m) { bf16_t* rp = dst + arow_of<8>(wr, m, fr) * 256 + wc * 32 + 8 * fq;
#pragma unroll
            for (int hf = 0; hf < 2; ++hf) { const f32x4 a = acc[m][2 * hf], b = acc[m][2 * hf + 1]; u32x4 w;
                w.x = cvt_pk_bf16(a[0], a[1]); w.y = cvt_pk_bf16(a[2], a[3]); w.z = cvt_pk_bf16(b[0], b[1]); w.w = cvt_pk_bf16(b[2], b[3]); *(u32x4*)(rp + hf * 128) = w; } }
    }
}
__device__ __forceinline__ void ret_scan_phase(const bf16_t* KVT, bf16_t* STb, int wg, int nwg, int wave_s) {
    const int tid = opaque_tid(wave_s);
    for (int e = (wg * NTHR + tid) * 2; e < 4 * 65536; e += nwg * NTHR * 2) {
        const int h = e >> 16; const float g = exp2f(128.f * log2f(1.f - exp2f(-5.f - (float)h)));
        float s0 = 0.f, s1 = 0.f;
        for (int n0 = 0; n0 < 128; n0 += 8) {
            unsigned kv[8];
#pragma unroll
            for (int i = 0; i < 8; ++i) kv[i] = *(const unsigned*)(KVT + (size_t)(n0 + i) * 262144 + e);
#pragma unroll
            for (int i = 0; i < 8; ++i) { *(unsigned*)(STb + (size_t)(n0 + i) * 262144 + e) = cvt_pk_bf16(s0, s1); s0 = g * s0 + bflo(kv[i]); s1 = g * s1 + bfhi(kv[i]); }
        }
    }
}
__device__ __forceinline__ void ret_out_phase(LAS unsigned char* lds, const bf16_t* qb, const bf16_t* kb, const bf16_t* vT, const bf16_t* STb, const bf16_t* sgb,
                                              const float* gain, bf16_t* mixb, int wg, int nwg, int wave_s) {
    typedef Core<4, 2> CA; typedef Core<4, 4> CB;
    const int tid = opaque_tid(wave_s), wid = __builtin_amdgcn_readfirstlane(tid >> 6), lane = tid & 63, wr = wid >> 2, wc = wid & 3, fr = lane & 15, fq = lane >> 4;
    LAS unsigned char* ldsP = lds + 98304;
    LAS float* stat = (LAS float*)lds;
    unsigned qoff[2], koff[2], soff[4], voff[4];
#pragma unroll
    for (int i = 0; i < 2; ++i) { int r, c; CA::apiece(tid, i, r, c); qoff[i] = (unsigned)(r * 1024 + c) * 2u; CA::bpiece(tid, i, r, c); koff[i] = (unsigned)(r * 1024 + c) * 2u; }
#pragma unroll
    for (int i = 0; i < 4; ++i) { int r, c; CB::bpiece(tid, i, r, c); soff[i] = (unsigned)(r * 256 + c) * 2u; voff[i] = (unsigned)(r * T_ + c) * 2u; }
    for (int u = wg; u < 512; u += nwg) {
        const int n = u >> 2, h = u & 3; const float l2g = log2f(1.f - exp2f(-5.f - (float)h));
        const char* Qb = (const char*)(qb + (size_t)(n * 128) * 1024 + h * 256); const char* Kb = (const char*)(kb + (size_t)(n * 128) * 1024 + h * 256);
        {
            f32x4 sa[4][2]; CA::zero(sa);
            CA::loop_gg(lds, Qb, qoff, Kb, koff, 4, sa, wid, wr, wc, fr, fq);
#pragma unroll
            for (int m = 0; m < 4; ++m) { const int i = wr * 64 + m * 16 + fr; const int j0 = wc * 32 + 8 * fq;
                float p[8];
#pragma unroll
                for (int e = 0; e < 8; ++e) { const int j = j0 + e; const float s = e < 4 ? sa[m][0][e] : sa[m][1][e - 4]; p[e] = (j <= i) ? s * exp2f((float)(i - j) * l2g) : 0.f; }
                u32x4 w; w.x = cvt_pk_bf16(p[0], p[1]); w.y = cvt_pk_bf16(p[2], p[3]); w.z = cvt_pk_bf16(p[4], p[5]); w.w = cvt_pk_bf16(p[6], p[7]);
                *(LAS u32x4*)(ldsP + (wc >> 1) * 16384 + lds_byte(i, j0 & 63)) = w; }
        }
        f32x4 acc[4][4]; CB::zero(acc);
        CB::loop_gg(lds, Qb, qoff, (const char*)(STb + (size_t)u * 65536), soff, 4, acc, wid, wr, wc, fr, fq);
#pragma unroll
        for (int m = 0; m < 4; ++m) { const float sc = exp2f((float)(wr * 64 + m * 16 + fr + 1) * l2g);
#pragma unroll
            for (int nn = 0; nn < 4; ++nn) acc[m][nn] *= sc; }
        CB::loop_lg(ldsP, lds, (const char*)(vT + (size_t)(h * 256) * T_ + n * 128), voff, 2, acc, wid, wr, wc, fr, fq);
#pragma unroll
        for (int m = 0; m < 4; ++m) { float s = 0.f, ss = 0.f;
#pragma unroll
            for (int nn = 0; nn < 4; ++nn)
#pragma unroll
                for (int e = 0; e < 4; ++e) { const float v = acc[m][nn][e]; s += v; ss += v * v; }
            s += __shfl_xor(s, 16); ss += __shfl_xor(ss, 16); s += __shfl_xor(s, 32); ss += __shfl_xor(ss, 32);
            if (fq == 0) { const int i = wr * 64 + m * 16 + fr; stat[(i * 4 + wc) * 2] = s; stat[(i * 4 + wc) * 2 + 1] = ss; } }
        __syncthreads();
#pragma unroll
        for (int m = 0; m < 4; ++m) { const int i = wr * 64 + m * 16 + fr; float s = 0.f, ss = 0.f;
#pragma unroll
            for (int w4 = 0; w4 < 4; ++w4) { s += stat[(i * 4 + w4) * 2]; ss += stat[(i * 4 + w4) * 2 + 1]; }
            const float mean = s * (1.f / 256.f); const float var = ss * (1.f / 256.f) - mean * mean; const float rstd = rsqrtf(var + 1e-6f);
            const size_t t = (size_t)n * 128 + i;
#pragma unroll
            for (int hf = 0; hf < 2; ++hf) { const int c0 = h * 256 + hf * 128 + wc * 32 + 8 * fq;
                const u32x4 sg = *(const u32x4*)(sgb + t * 1024 + c0);
                const f32x4 g0 = *(const f32x4*)(gain + c0), g1 = *(const f32x4*)(gain + c0 + 4);
                const f32x4 a = acc[m][2 * hf], b = acc[m][2 * hf + 1];
                float o[8];
                o[0] = (a[0] - mean) * rstd * g0[0] * bflo(sg.x); o[1] = (a[1] - mean) * rstd * g0[1] * bfhi(sg.x);
                o[2] = (a[2] - mean) * rstd * g0[2] * bflo(sg.y); o[3] = (a[3] - mean) * rstd * g0[3] * bfhi(sg.y);
                o[4] = (b[0] - mean) * rstd * g1[0] * bflo(sg.z); o[5] = (b[1] - mean) * rstd * g1[1] * bfhi(sg.z);
                o[6] = (b[2] - mean) * rstd * g1[2] * bflo(sg.w); o[7] = (b[3] - mean) * rstd * g1[3] * bfhi(sg.w);
                u32x4 w; w.x = cvt_pk_bf16(o[0], o[1]); w.y = cvt_pk_bf16(o[2], o[3]); w.z = cvt_pk_bf16(o[4], o[5]); w.w = cvt_pk_bf16(o[6], o[7]);
                *(u32x4*)(mixb + t * 2048 + c0) = w; } }
        __syncthreads();
    }
}
__device__ __forceinline__ void wsm_phase(const float* ws, bf16_t* WsM, int wg, int nwg, int wave_s) {
    const int tid = opaque_tid(wave_s);
    for (int i = wg * NTHR + tid; i < 4 * 128 * 128; i += nwg * NTHR) { const int t = (i >> 7) & 127, s = i & 127; WsM[i] = (bf16_t)(cvt_pk_bf16(s <= t ? ws[i] : 0.f, 0.f) & 0xffffu); }
}
__device__ __forceinline__ void gmlp_norm_phase(LAS unsigned char* lds, const bf16_t* gvT, bf16_t* vnT, const float* gain, int wg, int nwg, int wave_s) {
    const int tid = opaque_tid(wave_s), tg = tid & 15, c0 = tid >> 4;
    LAS float* red = (LAS float*)lds;
    for (int u = wg; u < 512; u += nwg) {
        const int n = u >> 2, g = u & 3;
        const size_t boff = (size_t)(g * 256 + c0) * T_ + n * 128 + tg * 8;
        u32x4 w[8]; float s[8], q[8];
#pragma unroll
        for (int e = 0; e < 8; ++e) { s[e] = 0.f; q[e] = 0.f; }
#pragma unroll
        for (int i = 0; i < 8; ++i) { w[i] = *(const u32x4*)(gvT + boff + (size_t)(32 * i) * T_);
            const float v[8] = {bflo(w[i].x), bfhi(w[i].x), bflo(w[i].y), bfhi(w[i].y), bflo(w[i].z), bfhi(w[i].z), bflo(w[i].w), bfhi(w[i].w)};
#pragma unroll
            for (int e = 0; e < 8; ++e) { s[e] += v[e]; q[e] += v[e] * v[e]; } }
#pragma unroll
        for (int e = 0; e < 8; ++e) { red[(c0 * 128 + tg * 8 + e) * 2] = s[e]; red[(c0 * 128 + tg * 8 + e) * 2 + 1] = q[e]; }
        __syncthreads();
        float mean[8], rstd[8];
#pragma unroll
        for (int e = 0; e < 8; ++e) { float a = 0.f, b = 0.f;
            for (int k = 0; k < 32; ++k) { a += red[(k * 128 + tg * 8 + e) * 2]; b += red[(k * 128 + tg * 8 + e) * 2 + 1]; }
            mean[e] = a * (1.f / 256.f); rstd[e] = rsqrtf(b * (1.f / 256.f) - mean[e] * mean[e] + 1e-6f); }
#pragma unroll
        for (int i = 0; i < 8; ++i) { const float gn = gain[g * 256 + c0 + 32 * i];
            const float v[8] = {bflo(w[i].x), bfhi(w[i].x), bflo(w[i].y), bfhi(w[i].y), bflo(w[i].z), bfhi(w[i].z), bflo(w[i].w), bfhi(w[i].w)};
            u32x4 o; o.x = cvt_pk_bf16((v[0] - mean[0]) * rstd[0] * gn, (v[1] - mean[1]) * rstd[1] * gn); o.y = cvt_pk_bf16((v[2] - mean[2]) * rstd[2] * gn, (v[3] - mean[3]) * rstd[3] * gn);
            o.z = cvt_pk_bf16((v[4] - mean[4]) * rstd[4] * gn, (v[5] - mean[5]) * rstd[5] * gn); o.w = cvt_pk_bf16((v[6] - mean[6]) * rstd[6] * gn, (v[7] - mean[7]) * rstd[7] * gn);
            *(u32x4*)(vnT + boff + (size_t)(32 * i) * T_) = o; }
        __syncthreads();
    }
}
__device__ __forceinline__ void gmlp_mix_phase(LAS unsigned char* lds, const bf16_t* WsM, const bf16_t* vnT, const bf16_t* ugb, const float* bs, bf16_t* mixb, int wg, int nwg, int wave_s) {
    typedef Core<4, 4> C;
    const int tid = opaque_tid(wave_s), wid = __builtin_amdgcn_readfirstlane(tid >> 6), lane = tid & 63, wr = wid >> 2, wc = wid & 3, fr = lane & 15, fq = lane >> 4;
    unsigned aoff[2], boff[4];
#pragma unroll
    for (int i = 0; i < 2; ++i) { int r, c; C::apiece(tid, i, r, c); aoff[i] = (unsigned)(r * 128 + c) * 2u; }
#pragma unroll
    for (int i = 0; i < 4; ++i) { int r, c; C::bpiece(tid, i, r, c); boff[i] = (unsigned)(r * T_ + c) * 2u; }
    for (int u = wg; u < 512; u += nwg) {
        const int n = u >> 2, g = u & 3;
        f32x4 acc[4][4]; C::zero(acc);
        C::burst_gg(lds, lds + 32768, (const char*)(WsM + g * 16384), aoff, (const char*)(vnT + (size_t)(g * 256) * T_ + n * 128), boff, 2, acc, wid, wr, wc, fr, fq);
#pragma unroll
        for (int m = 0; m < 4; ++m) { const int i = wr * 64 + m * 16 + fr; const float bias = bs[g * 128 + i]; const size_t t = (size_t)n * 128 + i;
#pragma unroll
            for (int hf = 0; hf < 2; ++hf) { const int c0 = g * 256 + hf * 128 + wc * 32 + 8 * fq;
                const u32x4 ug = *(const u32x4*)(ugb + t * 1024 + c0);
                const f32x4 a = acc[m][2 * hf], b = acc[m][2 * hf + 1];
                u32x4 w; w.x = cvt_pk_bf16((a[0] + bias) * bflo(ug.x), (a[1] + bias) * bfhi(ug.x)); w.y = cvt_pk_bf16((a[2] + bias) * bflo(ug.y), (a[3] + bias) * bfhi(ug.y));
                w.z = cvt_pk_bf16((b[0] + bias) * bflo(ug.z), (b[1] + bias) * bfhi(ug.z)); w.w = cvt_pk_bf16((b[2] + bias) * bflo(ug.w), (b[3] + bias) * bfhi(ug.w));
                *(u32x4*)(mixb + t * 2048 + 1024 + c0) = w; } }
        __syncthreads();
    }
}
template <bool B16> __device__ __forceinline__ float4 ld_x4(const void* base, size_t i4) {
    if (B16) { const u32x2 w = ((const u32x2*)base)[i4]; return make_float4(bflo(w.x), bfhi(w.x), bflo(w.y), bfhi(w.y)); }
    return ((const float4*)base)[i4]; }
template <bool B16> __device__ __forceinline__ void st_x4(void* base, size_t i4, float4 v) {
    if (B16) { u32x2 w; w.x = cvt_pk_bf16(v.x, v.y); w.y = cvt_pk_bf16(v.z, v.w); ((u32x2*)base)[i4] = w; }
    else ((float4*)base)[i4] = v; }
struct EpiResidual {
    const float* xin; float* xout;
    __device__ __forceinline__ bool swapped(int) const { return false; }
    __device__ __forceinline__ int brow0(int pn) const { return pn * 256; }
    __device__ __forceinline__ void operator()(const f32x4 (&acc)[8][4], int pm, int pn, int wr, int wc, int fr, int fq) const {
#pragma unroll
        for (int m2 = 0; m2 < 4; ++m2) {
            int row0 = pm * 256 + arow_of<8>(wr, 2 * m2, fr); asm volatile("" : "+v"(row0));
            const float* ip0 = xin + (size_t)row0 * D_ + pn * 256; float* op0 = xout + (size_t)row0 * D_ + pn * 256;
            f32x4 x[2][4];
#pragma unroll
            for (int r = 0; r < 2; ++r)
#pragma unroll
                for (int n = 0; n < 4; ++n) x[r][n] = *(const f32x4*)(ip0 + (size_t)r * 16 * D_ + bcol_of<4>(wc, n, fq, 0));
#pragma unroll
            for (int r = 0; r < 2; ++r)
#pragma unroll
                for (int n = 0; n < 4; ++n) *(f32x4*)(op0 + (size_t)r * 16 * D_ + bcol_of<4>(wc, n, fq, 0)) = x[r][n] + acc[2 * m2 + r][n];
            asm volatile("" ::: "memory"); }
    }
};
struct EpiResidual16 {
    bf16_t* x;
    __device__ __forceinline__ bool swapped(int) const { return false; }
    __device__ __forceinline__ int brow0(int pn) const { return pn * 256; }
    __device__ __forceinline__ void operator()(const f32x4 (&acc)[8][4], int pm, int pn, int wr, int wc, int fr, int fq) const {
#pragma unroll
        for (int m = 0; m < 8; ++m) { int row = pm * 256 + arow_of<8>(wr, m, fr); asm volatile("" : "+v"(row));
            bf16_t* p = x + (size_t)row * D_ + pn * 256 + wc * 32 + 8 * fq;
#pragma unroll
            for (int hf = 0; hf < 2; ++hf) { const u32x4 w = *(const u32x4*)(p + hf * 128); const f32x4 a = acc[m][2 * hf], b = acc[m][2 * hf + 1]; u32x4 o;
                o.x = cvt_pk_bf16(bflo(w.x) + a[0], bfhi(w.x) + a[1]); o.y = cvt_pk_bf16(bflo(w.y) + a[2], bfhi(w.y) + a[3]);
                o.z = cvt_pk_bf16(bflo(w.z) + b[0], bfhi(w.z) + b[1]); o.w = cvt_pk_bf16(bflo(w.w) + b[2], bfhi(w.w) + b[3]);
                *(u32x4*)(p + hf * 128) = o; }
            asm volatile("" ::: "memory"); }
    }
};
struct EpiResidualY {
    const float* xin; const bf16_t* y; float* xout;
    __device__ __forceinline__ bool swapped(int) const { return false; }
    __device__ __forceinline__ int brow0(int pn) const { return pn * 256; }
    __device__ __forceinline__ void operator()(const f32x4 (&acc)[8][4], int pm, int pn, int wr, int wc, int fr, int fq) const {
#pragma unroll
        for (int m = 0; m < 8; ++m) { int row = pm * 256 + arow_of<8>(wr, m, fr); asm volatile("" : "+v"(row));
            const float* ip = xin + (size_t)row * D_ + pn * 256; float* op = xout + (size_t)row * D_ + pn * 256;
            const bf16_t* y0 = y + (size_t)(2 * row) * D_ + pn * 256; const bf16_t* y1 = y0 + D_;
#pragma unroll
            for (int hf = 0; hf < 2; ++hf) { const int c = hf * 128 + wc * 32 + 8 * fq;
                const u32x4 a = *(const u32x4*)(y0 + c), b = *(const u32x4*)(y1 + c);
                f32x4 x0 = *(const f32x4*)(ip + c) + acc[m][2 * hf], x1v = *(const f32x4*)(ip + c + 4) + acc[m][2 * hf + 1];
                x0[0] += bflo(a.x) + bflo(b.x); x0[1] += bfhi(a.x) + bfhi(b.x); x0[2] += bflo(a.y) + bflo(b.y); x0[3] += bfhi(a.y) + bfhi(b.y);
                x1v[0] += bflo(a.z) + bflo(b.z); x1v[1] += bfhi(a.z) + bfhi(b.z); x1v[2] += bflo(a.w) + bflo(b.w); x1v[3] += bfhi(a.w) + bfhi(b.w);
                *(f32x4*)(op + c) = x0; *(f32x4*)(op + c + 4) = x1v; }
            asm volatile("" ::: "memory"); }
    }
};

#define CAPF 16384
typedef float f32x2 __attribute__((ext_vector_type(2)));
__device__ __forceinline__ void wr_phase(const float* wrg, const float* wre, bf16_t* WrT, int wg, int nwg, int wave_s) {
    const int tid = opaque_tid(wave_s);
    for (int i = wg * NTHR + tid; i < 64 * 2048; i += nwg * NTHR) { const int r = i >> 11, k = i & 2047;
        const float v = r < 4 ? wrg[k * 4 + r] : (r < 36 ? wre[k * 32 + (r - 4)] : 0.f);
        WrT[i] = (bf16_t)(cvt_pk_bf16(v, 0.f) & 0xffffu); }
}
template <bool XIN16>
__device__ __forceinline__ void moe_route_phase(LAS unsigned char* lds, const void* x1, const float* g, bf16_t* hb, unsigned char* hb8, const bf16_t* WrT, const float* brg, const float* bre,
                                                int* cnt, int* list, float* gate, int wg, int nwg, int wave_s) {
    typedef Core<2, 1> C;
    const int tid = opaque_tid(wave_s), wid = __builtin_amdgcn_readfirstlane(tid >> 6), lane = tid & 63, wr = wid >> 2, wc = wid & 3, fr = lane & 15, fq = lane >> 4;
    unsigned aoff[1], boff[1];
    { int r, c; C::apiece(tid, 0, r, c); aoff[0] = (unsigned)(r * 2048 + c) * 2u; C::bpiece(tid, 0, r, c); boff[0] = (unsigned)(r * 2048 + c) * 2u; }
    LAS float* lg = (LAS float*)lds;
    for (int u = wg; u < T_ / 64; u += nwg) {
        for (int rr = 0; rr < 8; ++rr) { const int row = u * 64 + wid * 8 + rr;
            float4 v[8]; float ss = 0.f;
#pragma unroll
            for (int i = 0; i < 8; ++i) { v[i] = ld_x4<XIN16>(x1, (size_t)row * (D_ / 4) + 2 * (lane + 64 * (i >> 1)) + (i & 1)); ss += v[i].x * v[i].x + v[i].y * v[i].y + v[i].z * v[i].z + v[i].w * v[i].w; }
            ss = wave_sum(ss);
            const float r = rsqrtf(ss * (1.f / D_) + 1e-6f);
#pragma unroll
            for (int i = 0; i < 4; ++i) { const int e0 = 8 * (lane + 64 * i); const float4 ga = *(const float4*)(g + e0), gb = *(const float4*)(g + e0 + 4); const float4 a = v[2 * i], b = v[2 * i + 1];
                const float h8[8] = {a.x * r * ga.x, a.y * r * ga.y, a.z * r * ga.z, a.w * r * ga.w, b.x * r * gb.x, b.y * r * gb.y, b.z * r * gb.z, b.w * r * gb.w};
                u32x4 o; o.x = cvt_pk_bf16(h8[0], h8[1]); o.y = cvt_pk_bf16(h8[2], h8[3]); o.z = cvt_pk_bf16(h8[4], h8[5]); o.w = cvt_pk_bf16(h8[6], h8[7]);
                *(u32x4*)(hb + (size_t)row * D_ + e0) = o;
                if (hb8) { u32x2 w; w.x = pk4_fp8(4.f * h8[0], 4.f * h8[1], 4.f * h8[2], 4.f * h8[3]); w.y = pk4_fp8(4.f * h8[4], 4.f * h8[5], 4.f * h8[6], 4.f * h8[7]); *(u32x2*)(hb8 + (size_t)row * D_ + e0) = w; } } }
        WAIT_V0(); __syncthreads();
        f32x4 acc[2][1]; C::zero(acc);
        for (int kb = 0; kb < 4; ++kb) {
            C::burst_gg(lds, lds + 65536, (const char*)(hb + (size_t)u * 64 * D_) + kb * 1024, aoff, (const char*)WrT + kb * 1024, boff, 8, acc, wid, wr, wc, fr, fq);
            __syncthreads(); }
#pragma unroll
        for (int m = 0; m < 2; ++m) { const int row = wr * 32 + m * 16 + fr;
#pragma unroll
            for (int j = 0; j < 4; ++j) { const int col = wc * 16 + 4 * fq + j; if (col < 36) lg[row * 40 + col] = acc[m][0][j] + (col < 4 ? brg[col] : bre[col - 4]); } }
        __syncthreads();
        if (tid < 64) {
            const int t = u * 64 + tid; const LAS float* L = lg + tid * 40;
            float l4[4], le[32];
#pragma unroll
            for (int i = 0; i < 4; ++i) l4[i] = L[i];
#pragma unroll
            for (int i = 0; i < 32; ++i) le[i] = L[4 + i];
            int gs = 0; float gm = l4[0];
#pragma unroll
            for (int i = 1; i < 4; ++i) if (l4[i] > gm) { gm = l4[i]; gs = i; }
            float den = 0.f;
#pragma unroll
            for (int i = 0; i < 4; ++i) den += __expf(l4[i] - gm);
            const float psel = 1.f / den;
            float l8[8];
#pragma unroll
            for (int i = 0; i < 8; ++i) l8[i] = gs == 0 ? le[i] : gs == 1 ? le[8 + i] : gs == 2 ? le[16 + i] : le[24 + i];
            int e1 = 0; float m1 = l8[0];
#pragma unroll
            for (int i = 1; i < 8; ++i) if (l8[i] > m1) { m1 = l8[i]; e1 = i; }
            int e2 = -1; float m2 = -3.0e38f;
#pragma unroll
            for (int i = 0; i < 8; ++i) if (i != e1 && l8[i] > m2) { m2 = l8[i]; e2 = i; }
            const float z = __expf(m2 - m1);
            const int ex1 = gs * 8 + e1, ex2 = gs * 8 + e2;
            LAS int* hist = (LAS int*)(lg + 64 * 40);
            if (tid < 32) hist[tid] = 0;
            const int r1 = __hip_atomic_fetch_add(hist + ex1, 1, __ATOMIC_RELAXED, __HIP_MEMORY_SCOPE_WORKGROUP);
            const int r2 = __hip_atomic_fetch_add(hist + ex2, 1, __ATOMIC_RELAXED, __HIP_MEMORY_SCOPE_WORKGROUP);
            if (tid < 32) { const int c = hist[tid]; hist[32 + tid] = c ? atomicAdd(&cnt[tid], c) : 0; }
            const int p1 = hist[32 + ex1] + r1, p2 = hist[32 + ex2] + r2;
            list[ex1 * CAPF + p1] = t * 2; list[ex2 * CAPF + p2] = t * 2 + 1;
            gate[t * 2] = psel / (1.f + z); gate[t * 2 + 1] = psel * z / (1.f + z);
        }
        __syncthreads();
    }
}
__device__ __forceinline__ void moe_prefix(LAS int* tp, LAS int* cn, LAS int* tab, const int* cnt, int tid) {
    if (tid == 0) { int s = 0; for (int e = 0; e < 32; ++e) { const int c = cnt[e]; cn[e] = c; tp[e] = s; s += (c + 255) >> 8; } tp[32] = s; }
    __syncthreads();
    if (tid < 32) { const int nf = (cn[tid] + 255) >> 8, k0 = tp[tid]; for (int r = 0; r < nf; ++r) tab[k0 + r] = (tid << 8) | r; }
    __syncthreads();
}
struct MoeU { int R, pn, e, rt, ne, tpe; };
__device__ __forceinline__ bool moe_unit(int idx, int total, const LAS int* tp, const LAS int* cn, const LAS int* tab, MoeU& u) {
    if (idx >= total) return false;
    u.pn = idx & 7;
    const int t = __builtin_amdgcn_readfirstlane(tab[idx >> 3]);
    u.e = t >> 8; u.rt = t & 255; u.tpe = __builtin_amdgcn_readfirstlane(tp[u.e]); u.R = u.tpe + u.rt; u.ne = __builtin_amdgcn_readfirstlane(cn[u.e]); return true;
}
struct GuSched {
    typedef MoeU U; static constexpr bool GATHER = true;
    static constexpr bool RAGGED = true;
    const char* hb; const char* Wgu; const int* list; const LAS int* tp; const LAS int* cn; const LAS int* tab; int wg, nwg, total, rb;
    __device__ __forceinline__ bool next(int i, U& u) const { return moe_unit(i * nwg + wg, total, tp, cn, tab, u); }
    __device__ __forceinline__ int nvalid(const U& u) const { const int r = u.ne - u.rt * 256; return r < 256 ? r : 256; }
    __device__ __forceinline__ const char* abase(const U&) const { return hb; }
    __device__ __forceinline__ const char* bbase(const U& u) const { return Wgu + ((size_t)u.e * 2048 + u.pn * 256) * rb; }
    __device__ __forceinline__ void gather(const U& u, int R0, unsigned (&pk)[2]) const {
#pragma unroll
        for (int h = 0; h < 2; ++h) { unsigned p = 0u;
#pragma unroll
            for (int i = 0; i < 2; ++i) { int gr = u.rt * 256 + h * 128 + R0 + 64 * i; gr = gr < u.ne ? gr : u.ne - 1; p |= (unsigned)(list[u.e * CAPF + gr] >> 1) << (16 * i); }
            pk[h] = p; } }
};
template <bool FP8> struct EpiGu { void* hid;
    __device__ __forceinline__ void operator()(const f32x4 (&acc)[8][4], const MoeU& u, int wr, int wc, int fr, int fq) const {
        const float si = FP8 ? (1.f / 256.f) : 1.f, so = FP8 ? 8.f : 1.f;
#pragma unroll
        for (int m = 0; m < 8; ++m) { int gr = u.rt * 256 + arow_of<8>(wr, m, fr); asm volatile("" : "+v"(gr));
            if (gr < u.ne) {
                float o[8];
#pragma unroll
                for (int e = 0; e < 8; ++e) { const float a = acc[m][e >> 2][e & 3] * si, b = acc[m][2 + (e >> 2)][e & 3] * si; o[e] = silu_fast(a) * b * so; if (FP8) o[e] = __builtin_amdgcn_fmed3f(o[e], -448.f, 448.f); }
                const size_t off = ((size_t)u.tpe * 256 + gr) * 1024 + u.pn * 128 + wc * 32 + 8 * fq;
                if (FP8) { u32x2 w; w.x = pk4_fp8(o[0], o[1], o[2], o[3]); w.y = pk4_fp8(o[4], o[5], o[6], o[7]); *(u32x2*)((unsigned char*)hid + off) = w; }
                else { u32x4 w; w.x = cvt_pk_bf16(o[0], o[1]); w.y = cvt_pk_bf16(o[2], o[3]); w.z = cvt_pk_bf16(o[4], o[5]); w.w = cvt_pk_bf16(o[6], o[7]); *(u32x4*)((bf16_t*)hid + off) = w; } }
            asm volatile("" ::: "memory"); }
    }
};
template <bool FP8>
__device__ __forceinline__ void moe_gu_phase(LAS unsigned char* lds, const void* h, const void* Wgu, const int* cnt, const int* list, void* hid, int wg, int nwg, int wave_s) {
    const int tid = opaque_tid(wave_s);
    LAS int* tp = (LAS int*)(lds + 143360); LAS int* cn = tp + 40; LAS int* tab = tp + 80;
    moe_prefix(tp, cn, tab, cnt, tid);
    const int rb = FP8 ? 2048 : 4096;
    GuSched S{(const char*)h, (const char*)Wgu, list, tp, cn, tab, wg, nwg, __builtin_amdgcn_readfirstlane(tp[32]) * 8, rb}; EpiGu<FP8> E{hid};
    gemm8_phase<FP8>(lds, rb, S, E, wave_s);
    __syncthreads();
}
struct DownSched {
    typedef MoeU U; static constexpr bool GATHER = false;
    static constexpr bool RAGGED = true;
    const char* hid; const char* Wdn; const LAS int* tp; const LAS int* cn; const LAS int* tab; int wg, nwg, total, rb;
    __device__ __forceinline__ bool next(int i, U& u) const { return moe_unit(i * nwg + wg, total, tp, cn, tab, u); }
    __device__ __forceinline__ int nvalid(const U& u) const { const int r = u.ne - u.rt * 256; return r < 256 ? r : 256; }
    __device__ __forceinline__ const char* abase(const U& u) const { return hid + (size_t)u.R * 256 * rb; }
    __device__ __forceinline__ const char* bbase(const U& u) const { return Wdn + ((size_t)u.e * 2048 + u.pn * 256) * rb; }
    __device__ __forceinline__ void gather(const U&, int, unsigned (&)[2]) const {}
};
template <bool Y8> struct EpiDown { const int* list; const float* gate; void* y; float sc;
    __device__ __forceinline__ void operator()(const f32x4 (&acc)[8][4], const MoeU& u, int wr, int wc, int fr, int fq) const {
        int slot[8]; float gt[8];
#pragma unroll
        for (int m = 0; m < 8; ++m) { int gr = u.rt * 256 + arow_of<8>(wr, m, fr); gr = gr < u.ne ? gr : u.ne - 1; slot[m] = list[u.e * CAPF + gr]; }
#pragma unroll
        for (int m = 0; m < 8; ++m) gt[m] = gate[slot[m]] * sc;
        { float dep = 0.f;
#pragma unroll
          for (int m = 0; m < 8; ++m) dep += gt[m];
          asm volatile("" :: "v"(dep)); }
#pragma unroll
        for (int m = 0; m < 8; ++m) { const int gr = u.rt * 256 + arow_of<8>(wr, m, fr);
            if (gr < u.ne) { const float g = gt[m];
                const size_t yo = (size_t)slot[m] * 2048 + u.pn * 256 + wc * 32 + 8 * fq;
#pragma unroll
                for (int hf = 0; hf < 2; ++hf) { const f32x4 a = acc[m][2 * hf], b = acc[m][2 * hf + 1];
                    if (Y8) { float o[8] = {g * a[0], g * a[1], g * a[2], g * a[3], g * b[0], g * b[1], g * b[2], g * b[3]};
#pragma unroll
                        for (int e = 0; e < 8; ++e) o[e] = __builtin_amdgcn_fmed3f(o[e], -448.f, 448.f);
                        u32x2 w; w.x = pk4_fp8(o[0], o[1], o[2], o[3]); w.y = pk4_fp8(o[4], o[5], o[6], o[7]); *(u32x2*)((unsigned char*)y + yo + hf * 128) = w; }
                    else { u32x4 w; w.x = cvt_pk_bf16(g * a[0], g * a[1]); w.y = cvt_pk_bf16(g * a[2], g * a[3]); w.z = cvt_pk_bf16(g * b[0], g * b[1]); w.w = cvt_pk_bf16(g * b[2], g * b[3]);
                        *(u32x4*)((bf16_t*)y + yo + hf * 128) = w; } } } }
    }
};
template <bool FP8, bool Y8>
__device__ __forceinline__ void moe_down_phase(LAS unsigned char* lds, const void* hid, const void* Wdn, const int* cnt, const int* list, const float* gate, void* y, int wg, int nwg, int wave_s) {
    const int tid = opaque_tid(wave_s);
    LAS int* tp = (LAS int*)(lds + 143360); LAS int* cn = tp + 40; LAS int* tab = tp + 80;
    moe_prefix(tp, cn, tab, cnt, tid);
    const int rb = FP8 ? 1024 : 2048;
    DownSched S{(const char*)hid, (const char*)Wdn, tp, cn, tab, wg, nwg, __builtin_amdgcn_readfirstlane(tp[32]) * 8, rb}; EpiDown<Y8> E{list, gate, y, (FP8 ? (1.f / 256.f) : 1.f) * (Y8 ? 64.f : 1.f)};
    gemm8_phase<FP8>(lds, rb, S, E, wave_s);
    __syncthreads();
}
template <bool WRITE_X, bool Y8, bool XIN16, bool XOUT16>
__device__ __forceinline__ void moe_combine_phase(const void* xin, void* xout, const void* y, const float* g, bf16_t* hb, float* outf, int wg, int nwg, int wave_s) {
    const int tid = opaque_tid(wave_s), lane = tid & 63, wv = tid >> 6;
    for (int row = wg * 8 + wv; row < T_; row += nwg * 8) {
        const size_t r4 = (size_t)row * (D_ / 4);
        float4 v[8]; float ss = 0.f;
#pragma unroll
        for (int i = 0; i < 4; ++i) { const int e0 = 8 * (lane + 64 * i);
            float4 a = ld_x4<XIN16>(xin, r4 + e0 / 4), b = ld_x4<XIN16>(xin, r4 + e0 / 4 + 1);
            if (Y8) { const u32x2 p = *(const u32x2*)((const unsigned char*)y + (size_t)(2 * row) * D_ + e0), q2 = *(const u32x2*)((const unsigned char*)y + (size_t)(2 * row + 1) * D_ + e0);
                const f32x2 p0 = __builtin_amdgcn_cvt_pk_f32_fp8((int)p.x, false), p1 = __builtin_amdgcn_cvt_pk_f32_fp8((int)p.x, true), p2 = __builtin_amdgcn_cvt_pk_f32_fp8((int)p.y, false), p3 = __builtin_amdgcn_cvt_pk_f32_fp8((int)p.y, true);
                const f32x2 s0 = __builtin_amdgcn_cvt_pk_f32_fp8((int)q2.x, false), s1 = __builtin_amdgcn_cvt_pk_f32_fp8((int)q2.x, true), s2 = __builtin_amdgcn_cvt_pk_f32_fp8((int)q2.y, false), s3 = __builtin_amdgcn_cvt_pk_f32_fp8((int)q2.y, true);
                a.x += (p0[0] + s0[0]) * (1.f / 64.f); a.y += (p0[1] + s0[1]) * (1.f / 64.f); a.z += (p1[0] + s1[0]) * (1.f / 64.f); a.w += (p1[1] + s1[1]) * (1.f / 64.f);
                b.x += (p2[0] + s2[0]) * (1.f / 64.f); b.y += (p2[1] + s2[1]) * (1.f / 64.f); b.z += (p3[0] + s3[0]) * (1.f / 64.f); b.w += (p3[1] + s3[1]) * (1.f / 64.f); }
            else { const u32x4 p = *(const u32x4*)((const bf16_t*)y + (size_t)(2 * row) * D_ + e0), q2 = *(const u32x4*)((const bf16_t*)y + (size_t)(2 * row + 1) * D_ + e0);
                a.x += bflo(p.x) + bflo(q2.x); a.y += bfhi(p.x) + bfhi(q2.x); a.z += bflo(p.y) + bflo(q2.y); a.w += bfhi(p.y) + bfhi(q2.y);
                b.x += bflo(p.z) + bflo(q2.z); b.y += bfhi(p.z) + bfhi(q2.z); b.z += bflo(p.w) + bflo(q2.w); b.w += bfhi(p.w) + bfhi(q2.w); }
            v[2 * i] = a; v[2 * i + 1] = b;
            ss += a.x * a.x + a.y * a.y + a.z * a.z + a.w * a.w + b.x * b.x + b.y * b.y + b.z * b.z + b.w * b.w; }
        ss = wave_sum(ss);
        const float r = rsqrtf(ss * (1.f / D_) + 1e-6f);
#pragma unroll
        for (int i = 0; i < 4; ++i) { const int e0 = 8 * (lane + 64 * i); const float4 ga = *(const float4*)(g + e0), gb = *(const float4*)(g + e0 + 4); const float4 a = v[2 * i], b = v[2 * i + 1];
            if (hb) { if (WRITE_X) { st_x4<XOUT16>(xout, r4 + e0 / 4, a); st_x4<XOUT16>(xout, r4 + e0 / 4 + 1, b); }
                u32x4 o; o.x = cvt_pk_bf16(a.x * r * ga.x, a.y * r * ga.y); o.y = cvt_pk_bf16(a.z * r * ga.z, a.w * r * ga.w); o.z = cvt_pk_bf16(b.x * r * gb.x, b.y * r * gb.y); o.w = cvt_pk_bf16(b.z * r * gb.z, b.w * r * gb.w);
                *(u32x4*)(hb + (size_t)row * D_ + e0) = o; }
            else { float4 oa, ob; oa.x = a.x * r * ga.x; oa.y = a.y * r * ga.y; oa.z = a.z * r * ga.z; oa.w = a.w * r * ga.w; ob.x = b.x * r * gb.x; ob.y = b.y * r * gb.y; ob.z = b.z * r * gb.z; ob.w = b.w * r * gb.w;
                *(float4*)(outf + (size_t)row * D_ + e0) = oa; *(float4*)(outf + (size_t)row * D_ + e0 + 4) = ob; } }
    }
}
__device__ __forceinline__ void moe_combine_phase2(const float* x1, const bf16_t* y, const float* g, bf16_t* hb, float* xd, int wg, int nwg, int wave_s) {
    const int tid = opaque_tid(wave_s), lane = tid & 63, wv = tid >> 6;
    for (int row = wg * 8 + wv; row < T_; row += nwg * 8) {
        const float4* xr = (const float4*)(x1 + (size_t)row * D_); float4* xo = (float4*)(xd + (size_t)row * D_);
        const u32x2* y0 = (const u32x2*)(y + (size_t)(2 * row) * D_); const u32x2* y1 = (const u32x2*)(y + (size_t)(2 * row + 1) * D_);
        float4 v[8]; float ss = 0.f;
#pragma unroll
        for (int i = 0; i < 8; ++i) { v[i] = xr[lane + 64 * i]; const u32x2 a = y0[lane + 64 * i], b = y1[lane + 64 * i];
            v[i].x += bflo(a.x) + bflo(b.x); v[i].y += bfhi(a.x) + bfhi(b.x); v[i].z += bflo(a.y) + bflo(b.y); v[i].w += bfhi(a.y) + bfhi(b.y);
            ss += v[i].x * v[i].x + v[i].y * v[i].y + v[i].z * v[i].z + v[i].w * v[i].w; }
        ss = wave_sum(ss);
        const float r = rsqrtf(ss * (1.f / D_) + 1e-6f);
#pragma unroll
        for (int i = 0; i < 8; ++i) { const float4 gg = ((const float4*)g)[lane + 64 * i]; xo[lane + 64 * i] = v[i];
            u32x2 o; o.x = cvt_pk_bf16(v[i].x * r * gg.x, v[i].y * r * gg.y); o.y = cvt_pk_bf16(v[i].z * r * gg.z, v[i].w * r * gg.w);
            *(u32x2*)(hb + (size_t)row * D_ + (lane + 64 * i) * 4) = o; }
    }
}
__device__ __forceinline__ void lb_phase(const float* lbp, float* lbv, int wg, int nwg, int wave_s) {
    const int tid = opaque_tid(wave_s);
    for (int i = wg * NTHR + tid; i < 2048; i += nwg * NTHR) lbv[i] = 1.f / (1.f + __expf(lbp[i] - lbp[2048 + i]));
}
struct EpiInC {
    bf16_t *qs, *vT, *sg, *lf; const float* lbv;
    __device__ __forceinline__ bool swapped(int pn) const { return pn >= 16 && pn < 24; }
    __device__ __forceinline__ int brow0(int pn) const { return pn * 256; }
    __device__ __forceinline__ void operator()(const f32x4 (&acc)[8][4], int pm, int pn, int wr, int wc, int fr, int fq) const {
        if (pn < 8 || pn >= 24) {
            bf16_t* dst = (pn < 8 ? qs : sg) + (pn & 7) * 256;
#pragma unroll
            for (int m = 0; m < 8; ++m) { int row = pm * 256 + arow_of<8>(wr, m, fr); asm volatile("" : "+v"(row));
#pragma unroll
                for (int hf = 0; hf < 2; ++hf) { u32x4 w; const f32x4 a = acc[m][2 * hf], b = acc[m][2 * hf + 1];
                    w.x = cvt_pk_bf16(silu_fast(a[0]), silu_fast(a[1])); w.y = cvt_pk_bf16(silu_fast(a[2]), silu_fast(a[3]));
                    w.z = cvt_pk_bf16(silu_fast(b[0]), silu_fast(b[1])); w.w = cvt_pk_bf16(silu_fast(b[2]), silu_fast(b[3]));
                    *(u32x4*)(dst + (size_t)row * 2048 + hf * 128 + wc * 32 + 8 * fq) = w; } }
        } else if (pn < 16) {
            const int cb = (pn - 8) * 256; f32x4 lb[4];
#pragma unroll
            for (int n = 0; n < 4; ++n) lb[n] = *(const f32x4*)(lbv + cb + bcol_of<4>(wc, n, fq, 0));
#pragma unroll
            for (int m = 0; m < 8; ++m) { int row = pm * 256 + arow_of<8>(wr, m, fr); asm volatile("" : "+v"(row));
#pragma unroll
                for (int hf = 0; hf < 2; ++hf) { float o[8];
#pragma unroll
                    for (int e = 0; e < 8; ++e) { const float z = acc[m][2 * hf + (e >> 2)][e & 3], l = lb[2 * hf + (e >> 2)][e & 3]; o[e] = 0.6931471805599453f * __builtin_amdgcn_logf(l + (1.f - l) * __builtin_amdgcn_rcpf(1.f + __builtin_amdgcn_exp2f(-1.4426950408889634f * z))); }
                    u32x4 w; w.x = cvt_pk_bf16(o[0], o[1]); w.y = cvt_pk_bf16(o[2], o[3]); w.z = cvt_pk_bf16(o[4], o[5]); w.w = cvt_pk_bf16(o[6], o[7]);
                    *(u32x4*)(lf + (size_t)row * 2048 + cb + hf * 128 + wc * 32 + 8 * fq) = w; } }
        } else {
            bf16_t* dst = vT + (size_t)((pn - 16) * 256) * T_ + pm * 256;
#pragma unroll
            for (int m = 0; m < 8; ++m) { int f = arow_of<8>(wr, m, fr); asm volatile("" : "+v"(f));
#pragma unroll
                for (int hf = 0; hf < 2; ++hf) { u32x4 w; const f32x4 a = acc[m][2 * hf], b = acc[m][2 * hf + 1];
                    w.x = cvt_pk_bf16(a[0], a[1]); w.y = cvt_pk_bf16(a[2], a[3]); w.z = cvt_pk_bf16(b[0], b[1]); w.w = cvt_pk_bf16(b[2], b[3]);
                    *(u32x4*)(dst + (size_t)f * T_ + hf * 128 + wc * 32 + 8 * fq) = w; } }
        }
    }
};
__device__ __forceinline__ int bcol_to_slot2(int c) { const int c5 = c & 31; return (c & ~31) + ((c5 >> 2) & 1) * 16 + (c5 >> 3) * 4 + (c5 & 3); }
__device__ __forceinline__ void hgrn_kv_phase(LAS unsigned char* lds, const bf16_t* lf, const bf16_t* vT, float* dec, bf16_t* KVT2, int wg, int nwg, int wave_s) {
    typedef Core<4, 2> C;
    const int tid = opaque_tid(wave_s), wid = __builtin_amdgcn_readfirstlane(tid >> 6), lane = tid & 63, wr = wid >> 2, wc = wid & 3, fr = lane & 15, fq = lane >> 4;
    LAS unsigned char* ldsB = lds + 65536;
    LAS float* tot = (LAS float*)(lds + 131072);
    unsigned aoff[2];
#pragma unroll
    for (int i = 0; i < 2; ++i) { int r, c; C::apiece(tid, i, r, c); aoff[i] = (unsigned)(r * T_ + c) * 2u; }
    const int q4 = lane & 31, s = wid * 2 + (lane >> 5), dk0 = 4 * q4;
    for (int u = wg; u < 2048; u += nwg) {
        const int n = u >> 4, h = u & 15;
        const size_t t0 = (size_t)n * 128 + s * 8; const int col = h * 128 + dk0;
        float l[8][4]; float sm[4] = {0.f, 0.f, 0.f, 0.f};
#pragma unroll
        for (int j = 0; j < 8; ++j) { const u32x2 w = *(const u32x2*)(lf + (t0 + j) * 2048 + col); l[j][0] = bflo(w.x); l[j][1] = bfhi(w.x); l[j][2] = bflo(w.y); l[j][3] = bfhi(w.y);
#pragma unroll
            for (int d = 0; d < 4; ++d) sm[d] += l[j][d]; }
        *(LAS f32x4*)(tot + s * 128 + dk0) = (f32x4){sm[0], sm[1], sm[2], sm[3]};
        __syncthreads();
        { const char* Vb = (const char*)(vT + (size_t)(h * 128) * T_ + n * 128); C::stage_a(lds, Vb, aoff, 0u, wid); C::stage_a(lds + 16384, Vb, aoff, 128u, wid); }
        float pre[4] = {0.f, 0.f, 0.f, 0.f}, tt[4] = {0.f, 0.f, 0.f, 0.f};
#pragma unroll
        for (int q = 0; q < 16; ++q) { const f32x4 v = *(const LAS f32x4*)(tot + q * 128 + dk0);
#pragma unroll
            for (int d = 0; d < 4; ++d) { tt[d] += v[d]; pre[d] += (q < s) ? v[d] : 0.f; } }
        if (s == 0) *(f32x4*)(dec + (size_t)n * 2048 + col) = (f32x4){__expf(tt[0]), __expf(tt[1]), __expf(tt[2]), __expf(tt[3])};
        float kh[4][8];
#pragma unroll
        for (int j = 0; j < 8; ++j)
#pragma unroll
            for (int d = 0; d < 4; ++d) { pre[d] += l[j][d]; kh[d][j] = (1.f - __expf(l[j][d])) * __expf(tt[d] - pre[d]); }
        const int jj = s * 8;
#pragma unroll
        for (int d = 0; d < 4; ++d) { u32x4 w; w.x = cvt_pk_bf16(kh[d][0], kh[d][1]); w.y = cvt_pk_bf16(kh[d][2], kh[d][3]); w.z = cvt_pk_bf16(kh[d][4], kh[d][5]); w.w = cvt_pk_bf16(kh[d][6], kh[d][7]);
            *(LAS u32x4*)(ldsB + (jj >> 6) * 16384 + lds_byte(bcol_to_slot2(dk0 + d), jj & 63)) = w; }
        WAIT_V0(); __syncthreads();
        f32x4 acc[4][2]; C::zero(acc);
        C::compute(lds, ldsB, acc, wr, wc, fr, fq); C::compute(lds + 16384, ldsB + 16384, acc, wr, wc, fr, fq);
        __syncthreads();
        bf16_t* dst = KVT2 + (size_t)u * 16384;
#pragma unroll
        for (int m = 0; m < 4; ++m) { const f32x4 a = acc[m][0], b = acc[m][1]; u32x4 w;
            w.x = cvt_pk_bf16(a[0], a[1]); w.y = cvt_pk_bf16(a[2], a[3]); w.z = cvt_pk_bf16(b[0], b[1]); w.w = cvt_pk_bf16(b[2], b[3]);
            *(u32x4*)(dst + (wr * 64 + m * 16 + fr) * 128 + wc * 32 + 8 * fq) = w; }
    }
}
__device__ __forceinline__ void hgrn_scan_phase(const bf16_t* KVT2, const float* dec, bf16_t* STb2, int wg, int nwg, int wave_s) {
    const int tid = opaque_tid(wave_s);
    for (int e = (wg * NTHR + tid) * 2; e < 262144; e += nwg * NTHR * 2) {
        const int c = (e >> 14) * 128 + (e & 127);
        float s0 = 0.f, s1 = 0.f;
        for (int n0 = 0; n0 < 128; n0 += 8) {
            unsigned kv[8]; float2 d[8];
#pragma unroll
            for (int i = 0; i < 8; ++i) { kv[i] = *(const unsigned*)(KVT2 + (size_t)(n0 + i) * 262144 + e); d[i] = *(const float2*)(dec + (size_t)(n0 + i) * 2048 + c); }
#pragma unroll
            for (int i = 0; i < 8; ++i) { *(unsigned*)(STb2 + (size_t)(n0 + i) * 262144 + e) = cvt_pk_bf16(s0, s1); s0 = d[i].x * s0 + bflo(kv[i]); s1 = d[i].y * s1 + bfhi(kv[i]); }
        }
    }
}
__device__ __forceinline__ void hgrn_out_phase(LAS unsigned char* lds, const bf16_t* qs, const bf16_t* lf, const bf16_t* vT, const bf16_t* STb2, const bf16_t* sg,
                                               const float* gain, bf16_t* mixb, int wg, int nwg, int wave_s) {
    typedef Core<4, 2> C;
    const int tid = opaque_tid(wave_s), wid = __builtin_amdgcn_readfirstlane(tid >> 6), lane = tid & 63, wr = wid >> 2, wc = wid & 3, fr = lane & 15, fq = lane >> 4;
    LAS unsigned char* lQ = lds; LAS unsigned char* lK = lds + 32768; LAS unsigned char* lS = lds + 65536; LAS unsigned char* lV = lds + 98304;
    LAS float* stat = (LAS float*)(lds + 131072);
    LAS float* tot = (LAS float*)(lds + 133120);
    unsigned soff[2], voff[2];
#pragma unroll
    for (int i = 0; i < 2; ++i) { int r, c; C::bpiece(tid, i, r, c); soff[i] = (unsigned)(r * 128 + c) * 2u; voff[i] = (unsigned)(r * T_ + c) * 2u; }
    const int q4 = lane & 31, s = wid * 2 + (lane >> 5), dk0 = 4 * q4;
    u32x2 lw[8], qw8[8];
    if (wg < 2048) { const size_t t0 = (size_t)(wg >> 4) * 128 + s * 8; const int col = (wg & 15) * 128 + dk0;
#pragma unroll
        for (int j = 0; j < 8; ++j) { lw[j] = *(const u32x2*)(lf + (t0 + j) * 2048 + col); qw8[j] = *(const u32x2*)(qs + (t0 + j) * 2048 + col); } }
    for (int u = wg; u < 2048; u += nwg) {
        const int n = u >> 4, h = u & 15;
        const char* Sb = (const char*)(STb2 + (size_t)u * 16384); const char* Vb = (const char*)(vT + (size_t)(h * 128) * T_ + n * 128);
        {
            const size_t t0 = (size_t)n * 128 + s * 8; const int col = h * 128 + dk0;
            float l[8][4]; float sm[4] = {0.f, 0.f, 0.f, 0.f};
#pragma unroll
            for (int j = 0; j < 8; ++j) { const u32x2 w = lw[j]; l[j][0] = bflo(w.x); l[j][1] = bfhi(w.x); l[j][2] = bflo(w.y); l[j][3] = bfhi(w.y);
#pragma unroll
                for (int d = 0; d < 4; ++d) sm[d] += l[j][d]; }
            *(LAS f32x4*)(tot + s * 128 + dk0) = (f32x4){sm[0], sm[1], sm[2], sm[3]};
            __syncthreads();
#pragma unroll
            for (int t = 0; t < 2; ++t) { C::stage_b(lS + t * 16384, Sb, soff, t * 128u, wid); C::stage_b(lV + t * 16384, Vb, voff, t * 128u, wid); }
            float pre[4] = {0.f, 0.f, 0.f, 0.f};
#pragma unroll
            for (int q = 0; q < 16; ++q) { const f32x4 v = *(const LAS f32x4*)(tot + q * 128 + dk0);
#pragma unroll
                for (int d = 0; d < 4; ++d) pre[d] += (q < s) ? v[d] : 0.f; }
#pragma unroll
            for (int j = 0; j < 8; ++j) { const u32x2 qw = qw8[j];
                const float qv[4] = {bflo(qw.x), bfhi(qw.x), bflo(qw.y), bfhi(qw.y)}; float oq[4], ok[4];
#pragma unroll
                for (int d = 0; d < 4; ++d) { pre[d] += l[j][d]; oq[d] = qv[d] * __expf(pre[d]); ok[d] = (1.f - __expf(l[j][d])) * __expf(-pre[d]); }
                const int tk = s * 8 + j;
                u32x2 w; w.x = cvt_pk_bf16(oq[0], oq[1]); w.y = cvt_pk_bf16(oq[2], oq[3]); *(LAS u32x2*)(lQ + (dk0 >> 6) * 16384 + lds_byte(tk, dk0 & 63)) = w;
                w.x = cvt_pk_bf16(ok[0], ok[1]); w.y = cvt_pk_bf16(ok[2], ok[3]); *(LAS u32x2*)(lK + (dk0 >> 6) * 16384 + lds_byte(bcol_to_slot2(tk), dk0 & 63)) = w; }
        }
        WAIT_V0(); __syncthreads();
        if (u + nwg < 2048) { const int un = u + nwg; const size_t t0n = (size_t)(un >> 4) * 128 + s * 8; const int coln = (un & 15) * 128 + dk0;
#pragma unroll
            for (int j = 0; j < 8; ++j) { lw[j] = *(const u32x2*)(lf + (t0n + j) * 2048 + coln); qw8[j] = *(const u32x2*)(qs + (t0n + j) * 2048 + coln); } }
        {
            f32x4 sa[4][2]; C::zero(sa);
            C::compute(lQ, lK, sa, wr, wc, fr, fq); C::compute(lQ + 16384, lK + 16384, sa, wr, wc, fr, fq);
            __syncthreads();
#pragma unroll
            for (int m = 0; m < 4; ++m) { const int i = wr * 64 + m * 16 + fr; const int j0 = wc * 32 + 8 * fq;
                float p[8];
#pragma unroll
                for (int e = 0; e < 8; ++e) { const float sv = e < 4 ? sa[m][0][e] : sa[m][1][e - 4]; p[e] = (j0 + e <= i) ? sv : 0.f; }
                u32x4 w; w.x = cvt_pk_bf16(p[0], p[1]); w.y = cvt_pk_bf16(p[2], p[3]); w.z = cvt_pk_bf16(p[4], p[5]); w.w = cvt_pk_bf16(p[6], p[7]);
                *(LAS u32x4*)(lK + (wc >> 1) * 16384 + lds_byte(i, j0 & 63)) = w; }
            __syncthreads();
        }
        f32x4 acc[4][2]; C::zero(acc);
        C::compute(lQ, lS, acc, wr, wc, fr, fq); C::compute(lQ + 16384, lS + 16384, acc, wr, wc, fr, fq);
        C::compute(lK, lV, acc, wr, wc, fr, fq); C::compute(lK + 16384, lV + 16384, acc, wr, wc, fr, fq);
#pragma unroll
        for (int m = 0; m < 4; ++m) { float ss = 0.f;
#pragma unroll
            for (int nn = 0; nn < 2; ++nn)
#pragma unroll
                for (int e = 0; e < 4; ++e) { const float v = acc[m][nn][e]; ss += v * v; }
            ss += __shfl_xor(ss, 16); ss += __shfl_xor(ss, 32);
            if (fq == 0) stat[(wr * 64 + m * 16 + fr) * 4 + wc] = ss; }
        __syncthreads();
#pragma unroll
        for (int m = 0; m < 4; ++m) { const int i = wr * 64 + m * 16 + fr;
            const float ss = stat[i * 4] + stat[i * 4 + 1] + stat[i * 4 + 2] + stat[i * 4 + 3];
            const float rstd = rsqrtf(ss * (1.f / 128.f) + 1e-6f);
            const size_t t = (size_t)n * 128 + i; const int c0 = h * 128 + wc * 32 + 8 * fq;
            const u32x4 g8 = *(const u32x4*)(sg + t * 2048 + c0);
            const f32x4 g0 = *(const f32x4*)(gain + c0), g1 = *(const f32x4*)(gain + c0 + 4);
            const f32x4 a = acc[m][0], b = acc[m][1];
            u32x4 w; w.x = cvt_pk_bf16(a[0] * rstd * g0[0] * bflo(g8.x), a[1] * rstd * g0[1] * bfhi(g8.x)); w.y = cvt_pk_bf16(a[2] * rstd * g0[2] * bflo(g8.y), a[3] * rstd * g0[3] * bfhi(g8.y));
            w.z = cvt_pk_bf16(b[0] * rstd * g1[0] * bflo(g8.z), b[1] * rstd * g1[1] * bfhi(g8.z)); w.w = cvt_pk_bf16(b[2] * rstd * g1[2] * bflo(g8.w), b[3] * rstd * g1[3] * bfhi(g8.w));
            *(u32x4*)(mixb + t * 2048 + c0) = w; }
        __syncthreads();
    }
}
#define LDS_BYTES 147456
#define MiB(x) ((size_t)(x) << 20)
#define WS_CTL     ((size_t)0)
#define CTL_BYTES  65536
#define CTL_CNT    1024
#define CTL_BAR    4096
#define WS_X1      MiB(1)
#define WS_HB      MiB(129)
#define WS_ROPE    MiB(193)
#define WS_WSM     MiB(225)
#define WS_WR      MiB(226)
#define WS_WINAB   MiB(228)
#define WS_WOUTAB  MiB(252)
#define WS_WINC    MiB(260)
#define WS_WOUTC   MiB(292)
#define WS_WGU     MiB(300)
#define WS_WDN     MiB(812)
#define WS_SCR     MiB(1068)
#define WS_QB      (WS_SCR)
#define WS_KVT     (WS_SCR + MiB(224))
#define WS_STB     (WS_SCR + MiB(352))
#define WS_MIXB    (WS_SCR + MiB(416))
#define WS_VNT     (WS_SCR + MiB(480))
#define WS_HID     (WS_SCR)
#define WS_Y       (WS_SCR + MiB(80))
#define WS_LIST    (WS_SCR + MiB(208))
#define WS_GATE    (WS_SCR + MiB(210))
struct FArgs { const float* in[21]; float* out; unsigned char* ws; int ph_lo, ph_hi; };
#define WS1_QS     (WS_SCR)
#define WS1_VT     (WS_SCR + MiB(64))
#define WS1_SG     (WS_SCR + MiB(128))
#define WS1_LF     (WS_SCR + MiB(192))
#define WS1_QH     (WS_SCR + MiB(320))
#define WS1_KT     (WS_SCR + MiB(480))
#define WS1_KVT    (WS_SCR + MiB(544))
#define WS1_STB    (WS_SCR + MiB(672))
#define WS1_DEC    (WS_SCR + MiB(736))
#define WS_Y0      (WS_SCR + MiB(740))
#define WS_LBV     (WS_WR + MiB(1))
#define N_PHASES 20
#ifndef FP8_L0
#define FP8_L0 1
#endif
#ifndef FP8_L1
#define FP8_L1 1
#endif
#ifndef XB16
#define XB16 0
#endif
#ifndef Y8_L0
#define Y8_L0 1
#endif
#ifndef Y8_L1
#define Y8_L1 1
#endif
__global__ void __launch_bounds__(NTHR, 2) fwd(FArgs a) {
    extern __shared__ __attribute__((aligned(16))) unsigned char lds_raw[];
    LAS unsigned char* lds = (LAS unsigned char*)lds_raw;
    const int lo = a.ph_lo, hi = a.ph_hi;
    const int wave_s = __builtin_amdgcn_readfirstlane(threadIdx.x >> 6);
    const int wg = blockIdx.x, nwg = gridDim.x;
    if (threadIdx.x == 0) *(LAS u32x4*)(lds + LDS_BYTES - 16) = (u32x4){0u, 0u, 0u, 0u};
    __syncthreads();
    XcdBarrier bar; bar.bar = (unsigned*)(a.ws + WS_CTL + CTL_BAR); bar.x = 0; bar.st = (volatile LAS unsigned*)(lds + LDS_BYTES - 16);
    if (hi - lo > 1) bar = xcd_barrier_post((unsigned*)(a.ws + WS_CTL + CTL_BAR), (volatile LAS unsigned*)(lds + LDS_BYTES - 16));
#define GRID_BAR() xcd_barrier(bar)
#define IN(k) (lo <= (k) && (k) < hi)
#define BOTH(k) (IN(k) && IN((k) + 1))
#ifndef DUP_MASK
#define DUP_MASK 0
#endif
#define DUP(k) ((DUP_MASK >> (k)) & 1)
#define PH(k, ...) if (IN(k)) { __VA_ARGS__ if (DUP(k)) { GRID_BAR(); __VA_ARGS__ } if (BOTH(k)) GRID_BAR(); }
    unsigned char* ws = a.ws;
    float* x1 = (float*)(ws + WS_X1); bf16_t* xb = (bf16_t*)(ws + WS1_QH);     bf16_t* hb = (bf16_t*)(ws + WS_HB);
    bf16_t* WsM = (bf16_t*)(ws + WS_WSM); bf16_t* WrT = (bf16_t*)(ws + WS_WR); float* lbv = (float*)(ws + WS_LBV);
    bf16_t* winab = (bf16_t*)(ws + WS_WINAB); bf16_t* woutab = (bf16_t*)(ws + WS_WOUTAB); bf16_t* winc = (bf16_t*)(ws + WS_WINC); bf16_t* woutc = (bf16_t*)(ws + WS_WOUTC);
    bf16_t* wgu = (bf16_t*)(ws + WS_WGU); bf16_t* wdn = (bf16_t*)(ws + WS_WDN);
    bf16_t* qb = (bf16_t*)(ws + WS_QB); bf16_t* KVT = (bf16_t*)(ws + WS_KVT); bf16_t* STb = (bf16_t*)(ws + WS_STB); bf16_t* mixb = (bf16_t*)(ws + WS_MIXB); bf16_t* vnT = (bf16_t*)(ws + WS_VNT);
    unsigned char* hb8 = ws + WS_ROPE;
    bf16_t* hid = (bf16_t*)(ws + WS_HID); bf16_t* yb = (bf16_t*)(ws + WS_Y); bf16_t* yb0 = (bf16_t*)(ws + WS_Y0); int* list = (int*)(ws + WS_LIST); float* gate = (float*)(ws + WS_GATE);
    int* cnt = (int*)(ws + WS_CTL + CTL_CNT);
    const size_t TS = (size_t)T_ * 1024; const size_t WGU_L = (size_t)32 * 2048 * 2048, WDN_L = (size_t)32 * 2048 * 1024;
    PH(0, {
        { ConvJob J{a.in[4], winab, 2048, 6144, 1, 6144, 6144, 6144, 0, 0}; conv_phase(lds, J, wg, nwg, wave_s); }
        { ConvJob J{a.in[9], woutab, 2048, 2048, 1, 2048, 2048, 2048, 0, 0}; conv_phase(lds, J, wg, nwg, wave_s); }
        { ConvJob J{a.in[10], winc, 2048, 8192, 1, 8192, 8192, 8192, 0, 0}; conv_phase(lds, J, wg, nwg, wave_s); }
        { ConvJob J{a.in[13], woutc, 2048, 2048, 1, 2048, 2048, 2048, 0, 0}; conv_phase(lds, J, wg, nwg, wave_s); }
        for (int L = 0; L < 2; ++L) {
            const bool f8 = L ? (FP8_L1 != 0) : (FP8_L0 != 0);
            const float* sg_ = a.in[18] + (size_t)L * 32 * 2048 * 1024; const float* su_ = a.in[19] + (size_t)L * 32 * 2048 * 1024; const float* sd_ = a.in[20] + (size_t)L * 32 * 2048 * 1024;
            ConvJob Jg{sg_, wgu + L * WGU_L, 2048, 1024, 32, 2048, 128, 256, 0, 0}, Ju{su_, wgu + L * WGU_L, 2048, 1024, 32, 2048, 128, 256, 128, 0}, Jd{sd_, wdn + L * WDN_L, 1024, 2048, 32, 2048, 2048, 2048, 0, 0};
            if (f8) { conv8_phase(lds, Jg, 64.f, wg, nwg, wave_s); conv8_phase(lds, Ju, 64.f, wg, nwg, wave_s); conv8_phase(lds, Jd, 32.f, wg, nwg, wave_s); }
            else { conv_phase(lds, Jg, wg, nwg, wave_s); conv_phase(lds, Ju, wg, nwg, wave_s); conv_phase(lds, Jd, wg, nwg, wave_s); }
        }
        wr_phase(a.in[14], a.in[16], WrT, wg, nwg, wave_s);
        wr_phase(a.in[14] + 2048 * 4, a.in[16] + 2048 * 32, WrT + 64 * 2048, wg, nwg, wave_s);
        wsm_phase(a.in[7], WsM, wg, nwg, wave_s);
        lb_phase(a.in[11], lbv, wg, nwg, wave_s);
        norm_rows_bf16(a.in[0], a.in[1], hb, wg, nwg, wave_s);
    })

    PH(2, { EpiInAB E{qb, qb + TS, qb + 3 * TS, qb + 4 * TS, qb + 5 * TS, qb + 6 * TS}; gemm_phase(lds, hb, winab, 64, 24, 2048, E, wave_s);
 })
    PH(3, { gmlp_norm_phase(lds, qb + 6 * TS, vnT, a.in[6], wg, nwg, wave_s); ret_kv_phase(lds, qb + 3 * TS, qb + TS, KVT, wg, nwg, wave_s); })
    PH(4, { ret_scan_phase(KVT, STb, wg, nwg, wave_s); })
    PH(5, { ret_out_phase(lds, qb, qb + TS, qb + 3 * TS, STb, qb + 4 * TS, a.in[5], mixb, wg, nwg, wave_s);
                 gmlp_mix_phase(lds, WsM, vnT, qb + 5 * TS, a.in[8], mixb, wg, nwg, wave_s); })
    PH(6, { EpiResidual E{a.in[0], x1}; gemm_phase(lds, mixb, woutab, 64, 8, 2048, E, wave_s); })
    PH(7, { moe_route_phase<false>(lds, x1, a.in[2], hb, FP8_L0 ? hb8 : nullptr, WrT, a.in[15], a.in[17], cnt, list, gate, wg, nwg, wave_s); })
    PH(8, { moe_gu_phase<FP8_L0 != 0>(lds, FP8_L0 ? (const void*)hb8 : (const void*)hb, wgu, cnt, list, hid, wg, nwg, wave_s); })
    PH(9, { moe_down_phase<FP8_L0 != 0, Y8_L0 != 0>(lds, hid, wdn, cnt, list, gate, yb, wg, nwg, wave_s); })
    PH(10, { moe_combine_phase<true, Y8_L0 != 0, false, XB16 != 0>(x1, XB16 ? (void*)xb : (void*)x1, yb, a.in[1] + D_, hb, nullptr, wg, nwg, wave_s); })
    bf16_t* qs = (bf16_t*)(ws + WS1_QS); bf16_t* vT1 = (bf16_t*)(ws + WS1_VT); bf16_t* sg1 = (bf16_t*)(ws + WS1_SG); bf16_t* lf = (bf16_t*)(ws + WS1_LF);
    bf16_t* qh = (bf16_t*)(ws + WS1_QH); bf16_t* kt = (bf16_t*)(ws + WS1_KT); bf16_t* KVT2 = (bf16_t*)(ws + WS1_KVT); bf16_t* STb2 = (bf16_t*)(ws + WS1_STB); float* dec = (float*)(ws + WS1_DEC);
    PH(11, { EpiInC E{qs, vT1, sg1, lf, lbv}; gemm_phase(lds, hb, winc, 64, 32, 2048, E, wave_s); })
    PH(12, { hgrn_kv_phase(lds, lf, vT1, dec, KVT2, wg, nwg, wave_s); })
    PH(13, { hgrn_scan_phase(KVT2, dec, STb2, wg, nwg, wave_s); })
    PH(14, { hgrn_out_phase(lds, qs, lf, vT1, STb2, sg1, a.in[12], mixb, wg, nwg, wave_s); })
    PH(15, { if (XB16) { EpiResidual16 E{xb}; gemm_phase(lds, mixb, woutc, 64, 8, 2048, E, wave_s); } else { EpiResidual E{x1, x1}; gemm_phase(lds, mixb, woutc, 64, 8, 2048, E, wave_s); } })
    PH(16, { moe_route_phase<XB16 != 0>(lds, XB16 ? (const void*)xb : (const void*)x1, a.in[2] + D_, hb, FP8_L1 ? hb8 : nullptr, WrT + 64 * 2048, a.in[15] + 4, a.in[17] + 32, cnt + 32, list, gate, wg, nwg, wave_s); })
    PH(17, { moe_gu_phase<FP8_L1 != 0>(lds, FP8_L1 ? (const void*)hb8 : (const void*)hb, wgu + WGU_L, cnt + 32, list, hid, wg, nwg, wave_s); })
    PH(18, { moe_down_phase<FP8_L1 != 0, Y8_L1 != 0>(lds, hid, wdn + WDN_L, cnt + 32, list, gate, yb, wg, nwg, wave_s); })
    PH(19, { moe_combine_phase<true, Y8_L1 != 0, XB16 != 0, false>(XB16 ? (const void*)xb : (const void*)x1, nullptr, yb, a.in[3], nullptr, a.out, wg, nwg, wave_s); })
#undef IN
#undef BOTH
#undef GRID_BAR
}
#ifndef N_LAUNCH_PER_PHASE
#define N_LAUNCH_PER_PHASE 0
#endif
extern "C" void kernel_launch(void* const* d_in, const int* in_sizes, int n_in, void* d_out, int out_size, void* d_ws, size_t ws_size, hipStream_t stream) {
    static int grid = 0;
    if (!grid) {
        int dev = 0, cus = 0, per_cu = 0;
        (void)hipGetDevice(&dev); (void)hipDeviceGetAttribute(&cus, hipDeviceAttributeMultiprocessorCount, dev);
        (void)hipFuncSetAttribute((const void*)fwd, hipFuncAttributeMaxDynamicSharedMemorySize, LDS_BYTES);
        if (hipOccupancyMaxActiveBlocksPerMultiprocessor(&per_cu, (const void*)fwd, NTHR, LDS_BYTES) != hipSuccess || per_cu < 1) per_cu = 1;
        (void)hipGetLastError();
        grid = cus > 0 ? cus : 256;
    }
    FArgs fa{}; for (int i = 0; i < 21; ++i) fa.in[i] = (const float*)d_in[i];
    fa.out = (float*)d_out; fa.ws = (unsigned char*)d_ws;
    (void)hipMemsetAsync((char*)d_ws + WS_CTL, 0, CTL_BYTES, stream);
#if N_LAUNCH_PER_PHASE
    for (int p = 0; p < N_PHASES; ++p) { fa.ph_lo = p; fa.ph_hi = p + 1; hipLaunchKernelGGL(fwd, dim3(grid), dim3(NTHR), LDS_BYTES, stream, fa); }
#else
    fa.ph_lo = 0; fa.ph_hi = N_PHASES; hipLaunchKernelGGL(fwd, dim3(grid), dim3(NTHR), LDS_BYTES, stream, fa);
#endif
}
```

```cpp
#include <hip/hip_runtime.h>
#include <stdint.h>
#define T_ 16384
#define D_ 2048
__device__ __forceinline__ float wave_sum(float v) {
#pragma unroll
    for (int o = 32; o > 0; o >>= 1) v += __shfl_xor(v, o);
    return v;
}
typedef unsigned short bf16_t;
typedef short bf16x8 __attribute__((ext_vector_type(8)));
typedef float f32x4 __attribute__((ext_vector_type(4)));
typedef unsigned u32x4 __attribute__((ext_vector_type(4)));
typedef unsigned u32x2 __attribute__((ext_vector_type(2)));
#define LAS __attribute__((address_space(3)))
#define NTHR 512

__device__ __forceinline__ unsigned cvt_pk_bf16(float lo, float hi) { unsigned r; asm volatile("v_cvt_pk_bf16_f32 %0, %1, %2" : "=v"(r) : "v"(lo), "v"(hi)); return r; }
__device__ __forceinline__ float bf2f(bf16_t b) { return __uint_as_float(((unsigned)b) << 16); }
__device__ __forceinline__ float bflo(unsigned w) { return __uint_as_float(w << 16); }
__device__ __forceinline__ float bfhi(unsigned w) { return __uint_as_float(w & 0xffff0000u); }

__device__ __forceinline__ int lds_byte(int r, int c) { const int st = (r >> 4) * 2 + (c >> 5), ob = (r & 15) * 64 + (c & 31) * 2; return st * 1024 + (ob ^ (((ob >> 9) & 1) << 5)); }
__device__ __forceinline__ void stage_rc(int b, int& R, int& C) { const int st = b >> 10, sb = b & 1023, swz = sb ^ (((sb >> 9) & 1) << 5); R = (st >> 1) * 16 + swz / 64; C = (st & 1) * 32 + (swz % 64) / 2; }

#define WAIT_V0() asm volatile("s_waitcnt vmcnt(0)" ::: "memory")
__device__ __forceinline__ int opaque_tid(int wave_s) { int l; asm volatile("v_mbcnt_lo_u32_b32 %0, -1, 0\n\tv_mbcnt_hi_u32_b32 %0, -1, %0" : "=v"(l)); return wave_s * 64 + l; }

template <int MF> __device__ __forceinline__ int arow_of(int wr, int m, int fr) { if (MF == 8) return (m >> 2) * 128 + wr * 64 + (m & 3) * 16 + fr; return wr * (MF * 16) + m * 16 + fr; }
template <int NF> __device__ __forceinline__ int bcol_of(int wc, int n, int fq, int j) {
    if (NF == 4) return (n >> 1) * 128 + wc * 32 + 8 * fq + 4 * (n & 1) + j;
    if (NF == 2) return wc * 32 + 8 * fq + 4 * n + j;
    return wc * 16 + 4 * fq + j; }
template <int MF> __device__ __forceinline__ int aslot_to_row(int s) { const int wr = s / (MF * 16), m = (s >> 4) % MF, fr = s & 15; return arow_of<MF>(wr, m, fr); }
template <int NF> __device__ __forceinline__ int bslot_to_col(int s) { const int wc = s / (NF * 16), n = (s >> 4) % NF, i = s & 15; return bcol_of<NF>(wc, n, i >> 2, i & 3); }

template <int MF, int NF> struct Core {
    static constexpr int BM = 32 * MF, BN = 64 * NF;
    static constexpr int GA = BM / 64, GB = BN / 64;
    static constexpr int TA = BM * 128, TB = BN * 128;
    static __device__ __forceinline__ void apiece(int tid, int i, int& row, int& c) { int R, C; stage_rc((tid >> 6) * 1024 + i * 8192 + (tid & 63) * 16, R, C); row = aslot_to_row<MF>(R); c = C; }
    static __device__ __forceinline__ void bpiece(int tid, int i, int& col, int& c) { int R, C; stage_rc((tid >> 6) * 1024 + i * 8192 + (tid & 63) * 16, R, C); col = bslot_to_col<NF>(R); c = C; }
    static __device__ __forceinline__ void zero(f32x4 (&acc)[MF][NF]) {
#pragma unroll
        for (int m = 0; m < MF; ++m)
#pragma unroll
            for (int n = 0; n < NF; ++n) acc[m][n] = (f32x4){0.f, 0.f, 0.f, 0.f}; }
    static __device__ __forceinline__ void compute(LAS unsigned char* la, LAS unsigned char* lb, f32x4 (&acc)[MF][NF], int wr, int wc, int fr, int fq) {
        const int ao = lds_byte(wr * MF * 16 + fr, fq * 8), bo = lds_byte(wc * NF * 16 + fr, fq * 8);
#pragma unroll
        for (int ks = 0; ks < 2; ++ks) {
            bf16x8 At[MF], Bf[NF];
#pragma unroll
            for (int m = 0; m < MF; ++m) At[m] = *(const LAS bf16x8*)(la + ao + m * 2048 + ks * 1024);
#pragma unroll
            for (int n = 0; n < NF; ++n) Bf[n] = *(const LAS bf16x8*)(lb + bo + n * 2048 + ks * 1024);
#pragma unroll
            for (int m = 0; m < MF; ++m)
#pragma unroll
                for (int n = 0; n < NF; ++n) acc[m][n] = __builtin_amdgcn_mfma_f32_16x16x32_bf16(Bf[n], At[m], acc[m][n], 0, 0, 0);
            __builtin_amdgcn_sched_barrier(0);
        }
    }
    static __device__ __forceinline__ void stage_a(LAS unsigned char* dst, const char* base, const unsigned (&off)[GA], unsigned kbyte, int wid) {
        const __amdgpu_buffer_rsrc_t r = __builtin_amdgcn_make_buffer_rsrc((void*)base, 0, 0x7ffffff0, 0x00020000);
#pragma unroll
        for (int i = 0; i < GA; ++i) __builtin_amdgcn_raw_ptr_buffer_load_lds(r, (LAS void*)(dst + wid * 1024 + i * 8192), 16, (int)off[i], (int)kbyte, 0, 0); }
    static __device__ __forceinline__ void stage_b(LAS unsigned char* dst, const char* base, const unsigned (&off)[GB], unsigned kbyte, int wid) {
        const __amdgpu_buffer_rsrc_t r = __builtin_amdgcn_make_buffer_rsrc((void*)base, 0, 0x7ffffff0, 0x00020000);
#pragma unroll
        for (int i = 0; i < GB; ++i) __builtin_amdgcn_raw_ptr_buffer_load_lds(r, (LAS void*)(dst + wid * 1024 + i * 8192), 16, (int)off[i], (int)kbyte, 0, 0); }
    static __device__ __forceinline__ void loop_gg(LAS unsigned char* lds, const char* Ab, const unsigned (&aoff)[GA], const char* Bb, const unsigned (&boff)[GB], int nt,
                                                   f32x4 (&acc)[MF][NF], int wid, int wr, int wc, int fr, int fq) {
        constexpr int STG = TA + TB;
        stage_a(lds, Ab, aoff, 0, wid); stage_b(lds + TA, Bb, boff, 0, wid);
        WAIT_V0(); __syncthreads();
        for (int t = 0; t < nt; ++t) {
            const int cur = t & 1;
            if (t + 1 < nt) { stage_a(lds + (cur ^ 1) * STG, Ab, aoff, (unsigned)(t + 1) * 128u, wid); stage_b(lds + (cur ^ 1) * STG + TA, Bb, boff, (unsigned)(t + 1) * 128u, wid); }
            compute(lds + cur * STG, lds + cur * STG + TA, acc, wr, wc, fr, fq);
            WAIT_V0(); __syncthreads();
        }
    }
    static __device__ __forceinline__ void burst_gg(LAS unsigned char* la, LAS unsigned char* lb, const char* Ab, const unsigned (&aoff)[GA], const char* Bb, const unsigned (&boff)[GB], int nt,
                                                    f32x4 (&acc)[MF][NF], int wid, int wr, int wc, int fr, int fq) {
        for (int t = 0; t < nt; ++t) { stage_a(la + t * TA, Ab, aoff, (unsigned)t * 128u, wid); stage_b(lb + t * TB, Bb, boff, (unsigned)t * 128u, wid); }
        WAIT_V0(); __syncthreads();
        for (int t = 0; t < nt; ++t) compute(la + t * TA, lb + t * TB, acc, wr, wc, fr, fq);
    }
    static __device__ __forceinline__ void loop_lg(LAS unsigned char* la, LAS unsigned char* lb, const char* Bb, const unsigned (&boff)[GB], int nt,
                                                   f32x4 (&acc)[MF][NF], int wid, int wr, int wc, int fr, int fq) {
        stage_b(lb, Bb, boff, 0, wid);
        WAIT_V0(); __syncthreads();
        for (int t = 0; t < nt; ++t) {
            const int cur = t & 1;
            if (t + 1 < nt) stage_b(lb + (cur ^ 1) * TB, Bb, boff, (unsigned)(t + 1) * 128u, wid);
            compute(la + t * TA, lb + cur * TB, acc, wr, wc, fr, fq);
            WAIT_V0(); __syncthreads();
        }
    }
    static __device__ __forceinline__ void loop_gl(LAS unsigned char* la, const char* Ab, const unsigned (&aoff)[GA], LAS unsigned char* lb, int nt,
                                                   f32x4 (&acc)[MF][NF], int wid, int wr, int wc, int fr, int fq) {
        stage_a(la, Ab, aoff, 0, wid);
        WAIT_V0(); __syncthreads();
        for (int t = 0; t < nt; ++t) {
            const int cur = t & 1;
            if (t + 1 < nt) stage_a(la + (cur ^ 1) * TA, Ab, aoff, (unsigned)(t + 1) * 128u, wid);
            compute(la + cur * TA, lb + t * TB, acc, wr, wc, fr, fq);
            WAIT_V0(); __syncthreads();
        }
    }
};
#define XB_TMO      128
#define XB_XCNT(j)  (256  + 64 * (j))
#define XB_XSUB(j)  (1280 + 64 * (j))
#define XB_XGEN(j)  (2304 + 64 * (j))
#define XB_TOP      3328
#define XB_TOPGEN   3392
#define XCD_BAR_WORDS 3456
#define XB_SPIN_CAP (1u << 18)
#define LAS __attribute__((address_space(3)))

__device__ __forceinline__ unsigned xb_ld(unsigned* p)              { return __hip_atomic_load(p, __ATOMIC_RELAXED, __HIP_MEMORY_SCOPE_AGENT); }
__device__ __forceinline__ unsigned xb_add(unsigned* p, unsigned v) { return __hip_atomic_fetch_add(p, v, __ATOMIC_RELAXED, __HIP_MEMORY_SCOPE_AGENT); }
__device__ __forceinline__ unsigned xb_xcc_id() { return (unsigned)__builtin_amdgcn_s_getreg((3 << 11) | 20) & 0xFu; }
#define XB_SPIN(cond, bar) do { unsigned _sp = 0; while (cond) { __builtin_amdgcn_s_sleep(1); \
    if ((++_sp & 255u) == 0u) { if (xb_ld(&(bar)[XB_TMO])) break; if (_sp > XB_SPIN_CAP) { atomicAdd(&(bar)[XB_TMO], 1u); break; } } } } while (0)

struct XcdBarrier {
    unsigned* bar; unsigned x;
    volatile LAS unsigned* st;
};

__device__ __forceinline__ XcdBarrier xcd_barrier_post(unsigned* bar, volatile LAS unsigned* st) {
    XcdBarrier b; b.bar = bar; b.x = xb_xcc_id(); b.st = st;
    if (threadIdx.x == 0) (void)xb_add(&bar[XB_XCNT(b.x)], 1u);
    return b;
}
__device__ __forceinline__ void xcd_barrier_complete(unsigned* bar, unsigned x, unsigned& nloc, unsigned& nx) {
    const unsigned G = gridDim.x * gridDim.y * gridDim.z;
    unsigned sum, cnt, mine, sp = 0u;
    for (;;) {
        sum = 0u; cnt = 0u; mine = 0u;
#pragma unroll
        for (unsigned j = 0; j < 16; ++j) { const unsigned c = xb_ld(&bar[XB_XCNT(j)]); sum += c; cnt += (c > 0u) ? 1u : 0u; mine = (j == x) ? c : mine; }
        if (sum == G) break;
        __builtin_amdgcn_s_sleep(1);
        if ((++sp & 255u) == 0u) { if (xb_ld(&bar[XB_TMO])) break; if (sp > XB_SPIN_CAP) { atomicAdd(&bar[XB_TMO], 1u); break; } }
    }
    nloc = mine > 0u ? mine : 1u; nx = cnt > 0u ? cnt : 1u;
}

__device__ __forceinline__ void xcd_barrier(const XcdBarrier& b) {
    asm volatile("s_waitcnt vmcnt(0)" ::: "memory");
    __syncthreads();
    if (threadIdx.x == 0) {
        unsigned* bar = b.bar;
        __builtin_amdgcn_s_waitcnt(0);
        unsigned nloc = b.st[0], nx = b.st[1];
        if (nloc == 0u) { xcd_barrier_complete(bar, b.x, nloc, nx); b.st[0] = nloc; b.st[1] = nx; }
        const unsigned old = xb_add(&bar[XB_XSUB(b.x)], 1u);
        const unsigned gen = old / nloc;
        if (old + 1u == (gen + 1u) * nloc) {
            __builtin_amdgcn_fence(__ATOMIC_RELEASE, "agent");
            asm volatile("s_waitcnt vmcnt(0)" ::: "memory");
            const unsigned og = xb_add(&bar[XB_TOP], 1u);
            const unsigned tg = og / nx;
            if (og + 1u == (tg + 1u) * nx) xb_add(&bar[XB_TOPGEN], 1u);
            else XB_SPIN(xb_ld(&bar[XB_TOPGEN]) == tg, bar);
            __builtin_amdgcn_fence(__ATOMIC_ACQUIRE, "agent");
            xb_add(&bar[XB_XGEN(b.x)], 1u);
            asm volatile("s_waitcnt vmcnt(0)" ::: "memory");
        } else {
            XB_SPIN(xb_ld(&bar[XB_XGEN(b.x)]) == gen, bar);
            __builtin_amdgcn_fence(__ATOMIC_ACQUIRE, "agent");
            asm volatile("s_waitcnt vmcnt(0)" ::: "memory");
        }
    }
    __syncthreads();
}

__device__ __forceinline__ bool unit_of(long L, int nM, int nN, int& pm, int& pn) {
    const int nwg = nM * nN; if (L >= nwg) return false;
    int wgid = (int)L; { const int q = nwg / 8, r = nwg % 8, xcd = wgid % 8, off = wgid / 8; wgid = (xcd < r ? xcd * (q + 1) : r * (q + 1) + (xcd - r) * q) + off; }
    const int nig = 8 * nN, gid = wgid / nig, fm = gid * 8, gsz = (nM - fm) < 8 ? (nM - fm) : 8;
    pm = fm + ((wgid % nig) % gsz); pn = (wgid % nig) / gsz; return true;
}

struct EpiPlainF32 {
    float* Cout; int ldc;
    __device__ __forceinline__ bool swapped(int) const { return false; }
    __device__ __forceinline__ int brow0(int pn) const { return pn * 256; }
    __device__ __forceinline__ void operator()(const f32x4 (&acc)[8][4], int pm, int pn, int wr, int wc, int fr, int fq) const {
#pragma unroll
        for (int m = 0; m < 8; ++m) { float* rp = Cout + (size_t)(pm * 256 + arow_of<8>(wr, m, fr)) * ldc + pn * 256;
#pragma unroll
            for (int n = 0; n < 4; ++n) *(f32x4*)(rp + bcol_of<4>(wc, n, fq, 0)) = acc[m][n]; }
    }
};

__device__ __forceinline__ unsigned pk4_fp8(float a, float b, float c, float d) { int w = 0; w = __builtin_amdgcn_cvt_pk_fp8_f32(a, b, w, false); w = __builtin_amdgcn_cvt_pk_fp8_f32(c, d, w, true); return (unsigned)w; }
struct ConvJob { const float* W; bf16_t* dst; int K, N, batch, rows_per_batch, grp, grp_stride, add, pad; };
template <bool FP8>
__device__ __forceinline__ void conv_tiles(LAS unsigned char* lds, const ConvJob& J, float sc, int wg, int nwg, int wave_s) {
    const int tid = opaque_tid(wave_s), n4 = tid & 31, kg = tid >> 5;
    const int tk = J.K / 128, tn = J.N / 128, per = tk * tn, total = per * J.batch;
    constexpr int RS = FP8 ? 144 : 272;
    unsigned char* dst8 = (unsigned char*)J.dst;
    for (int u = wg; u < total; u += nwg) {
        const int b = u / per, r = u % per, kt = r / tn, nt = r % tn;
        const float* src = J.W + ((size_t)b * J.K + (size_t)kt * 128 + kg * 8) * J.N + nt * 128 + 4 * n4;
        float4 v[8];
#pragma unroll
        for (int j = 0; j < 8; ++j) v[j] = *(const float4*)(src + (size_t)j * J.N);
#pragma unroll
        for (int i = 0; i < 4; ++i) { float e[8];
#pragma unroll
            for (int j = 0; j < 8; ++j) e[j] = (i == 0 ? v[j].x : i == 1 ? v[j].y : i == 2 ? v[j].z : v[j].w) * (FP8 ? sc : 1.f);
            if (FP8) { u32x2 w; w.x = pk4_fp8(e[0], e[1], e[2], e[3]); w.y = pk4_fp8(e[4], e[5], e[6], e[7]); *(LAS u32x2*)(lds + (4 * n4 + i) * RS + kg * 8) = w; }
            else { u32x4 w; w.x = cvt_pk_bf16(e[0], e[1]); w.y = cvt_pk_bf16(e[2], e[3]); w.z = cvt_pk_bf16(e[4], e[5]); w.w = cvt_pk_bf16(e[6], e[7]); *(LAS u32x4*)(lds + (4 * n4 + i) * RS + kg * 16) = w; } }
        __syncthreads();
        const int nn0 = nt * 128;
        const size_t drow0 = (size_t)b * J.rows_per_batch + (size_t)(nn0 / J.grp) * J.grp_stride + (nn0 % J.grp) + J.add;
#pragma unroll
        for (int p = 0; p < (FP8 ? 2 : 4); ++p) { const int q = tid + 512 * p, row = FP8 ? (q >> 3) : (q >> 4), pc = FP8 ? (q & 7) : (q & 15);
            const u32x4 w = *(const LAS u32x4*)(lds + row * RS + pc * 16);
            if (FP8) *(u32x4*)(dst8 + (drow0 + row) * J.K + kt * 128 + pc * 16) = w;
            else *(u32x4*)(J.dst + (drow0 + row) * J.K + kt * 128 + pc * 8) = w; }
        __syncthreads();
    }
}
__device__ __forceinline__ void conv_phase(LAS unsigned char* lds, const ConvJob& J, int wg, int nwg, int wave_s) { conv_tiles<false>(lds, J, 1.f, wg, nwg, wave_s); }
__device__ __forceinline__ void conv8_phase(LAS unsigned char* lds, const ConvJob& J, float sc, int wg, int nwg, int wave_s) { conv_tiles<true>(lds, J, sc, wg, nwg, wave_s); }

__device__ __forceinline__ void norm_rows_bf16(const float* __restrict__ x, const float* __restrict__ g, bf16_t* __restrict__ out, int wg, int nwg, int wave_s) {
    const int tid = opaque_tid(wave_s), lane = tid & 63, wv = tid >> 6;
    for (int row = wg * 8 + wv; row < T_; row += nwg * 8) {
        const float4* xr = (const float4*)(x + (size_t)row * D_);
        float4 v[8]; float ss = 0.f;
#pragma unroll
        for (int i = 0; i < 8; ++i) { v[i] = xr[2 * (lane + 64 * (i >> 1)) + (i & 1)]; ss += v[i].x * v[i].x + v[i].y * v[i].y + v[i].z * v[i].z + v[i].w * v[i].w; }
        ss = wave_sum(ss);
        const float r = rsqrtf(ss * (1.f / D_) + 1e-6f);
#pragma unroll
        for (int i = 0; i < 4; ++i) { const int e0 = 8 * (lane + 64 * i); const float4 ga = *(const float4*)(g + e0), gb = *(const float4*)(g + e0 + 4); const float4 a = v[2 * i], b = v[2 * i + 1];
            u32x4 o; o.x = cvt_pk_bf16(a.x * r * ga.x, a.y * r * ga.y); o.y = cvt_pk_bf16(a.z * r * ga.z, a.w * r * ga.w); o.z = cvt_pk_bf16(b.x * r * gb.x, b.y * r * gb.y); o.w = cvt_pk_bf16(b.z * r * gb.z, b.w * r * gb.w);
            *(u32x4*)(out + (size_t)row * D_ + e0) = o; }
    }
}

__device__ __forceinline__ void bg_issue(const float* wg_, const float* wu_, const float* wd_, int t, float4 (&v)[8], int tid) {
    const int n4 = tid & 31, kg = tid >> 5, m = t >> 12, r = t & 4095, b = r >> 7, q = r & 127;
    const int N = m == 2 ? 2048 : 1024, K = m == 2 ? 1024 : 2048, tn = N >> 7, kt = q / tn, nt = q % tn;
    const float* W = m == 0 ? wg_ : (m == 1 ? wu_ : wd_);
    const float* src = W + ((size_t)b * K + (size_t)kt * 128 + kg * 8) * N + nt * 128 + 4 * n4;
#pragma unroll
    for (int j = 0; j < 8; ++j) v[j] = *(const float4*)(src + (size_t)j * N);
}
__device__ __forceinline__ void bg_write(LAS unsigned char* img, const float4 (&v)[8], float sc, int tid) {
    const int n4 = tid & 31, kg = tid >> 5;
#pragma unroll
    for (int i = 0; i < 4; ++i) { float e[8];
#pragma unroll
        for (int j = 0; j < 8; ++j) e[j] = (i == 0 ? v[j].x : i == 1 ? v[j].y : i == 2 ? v[j].z : v[j].w) * sc;
        u32x2 w; w.x = pk4_fp8(e[0], e[1], e[2], e[3]); w.y = pk4_fp8(e[4], e[5], e[6], e[7]); *(LAS u32x2*)(img + (4 * n4 + i) * 144 + kg * 8) = w; }
}
__device__ __forceinline__ void bg_store(const LAS unsigned char* img, unsigned char* gu8, unsigned char* dn8, int t, int tid) {
    const int m = t >> 12, r = t & 4095, b = r >> 7, q = r & 127;
    const int N = m == 2 ? 2048 : 1024, K = m == 2 ? 1024 : 2048, tn = N >> 7, kt = q / tn, nt = q % tn;
    const size_t drow0 = (size_t)b * 2048 + (m == 2 ? (size_t)nt * 128 : (size_t)nt * 256 + (m == 1 ? 128 : 0));
    unsigned char* dst = m == 2 ? dn8 : gu8;
#pragma unroll
    for (int p = 0; p < 2; ++p) { const int qq = tid + 512 * p, row = qq >> 3, pc = qq & 7;
        *(u32x4*)(dst + (drow0 + row) * K + kt * 128 + pc * 16) = *(const LAS u32x4*)(img + row * 144 + pc * 16); }
}
__device__ __forceinline__ int perm32(int rho) { const int n = rho >> 4, i = rho & 15; return 8 * (i >> 2) + 4 * n + (i & 3); }
#define HTB 16384
typedef int i32x4 __attribute__((ext_vector_type(4)));
typedef int i32x8 __attribute__((ext_vector_type(8)));
#ifndef G8_ABLATE
#define G8_ABLATE 0
#endif
template <bool FP8, class Sched, class Epi, int ABL = 0>
__device__ __forceinline__ void gemm8_phase(LAS unsigned char* lds, int RB, const Sched& S, const Epi& E, int wave_s) {
    typedef typename Sched::U U;
    const int tid = opaque_tid(wave_s), wid = __builtin_amdgcn_readfirstlane(tid >> 6), lane = tid & 63, wr = wid >> 2, wc = wid & 3, fr = lane & 15, fq = lane >> 4;
    const int nt = RB / 128;
    int R0, C0; stage_rc(tid * 16, R0, C0);
    const unsigned c2 = (unsigned)C0 * 2u, r64 = (unsigned)64 * RB;
    const unsigned voffB0 = (unsigned)(((R0 & ~31) + perm32(R0 & 31)) * RB) + c2, voffA0 = (unsigned)(R0 * RB) + c2;
    const unsigned hstep = (unsigned)128 * RB;
    const unsigned ldsw = (unsigned)wid * 1024u;
    const int aoff = lds_byte(wr * 64 + fr, fq * 8), boff = lds_byte(wc * 32 + fr, fq * 8);
#define G8_SA(b, h) (((b) * 2 + (h)) * HTB)
#define G8_SB(b, h) ((4 + (b) * 2 + (h)) * HTB)
#define G8_STAGE2(bufoff, rs, v0, s0, v1, s1) do { __builtin_amdgcn_raw_ptr_buffer_load_lds(rs, (LAS void*)(lds + (bufoff) + ldsw), 16, (int)(v0), (int)(s0), 0, 0); \
        __builtin_amdgcn_raw_ptr_buffer_load_lds(rs, (LAS void*)(lds + (bufoff) + ldsw + 8192), 16, (int)(v1), (int)(s1), 0, 0); } while (0)
#define G8_STB(bufoff, rs, so) G8_STAGE2(bufoff, rs, voffB0, (so), voffB0, (so) + r64)
#define G8_STA(bufoff, rs, pk, h, so) do { if (Sched::GATHER) { const unsigned _p = (pk)[h]; G8_STAGE2(bufoff, rs, (_p & 0xffffu) * (unsigned)RB + c2, (so), (_p >> 16) * (unsigned)RB + c2, (so)); } \
        else G8_STAGE2(bufoff, rs, voffA0, (so) + (h) * hstep, voffA0, (so) + (h) * hstep + r64); } while (0)
#define G8_LDA(dst, b, h) do { _Pragma("unroll") for (int m = 0; m < 4; ++m) dst[m] = __builtin_shufflevector(*(const LAS i32x4*)(lds + G8_SA(b, h) + aoff + m * 2048), *(const LAS i32x4*)(lds + G8_SA(b, h) + aoff + m * 2048 + 1024), 0, 1, 2, 3, 4, 5, 6, 7); } while (0)
#define G8_LDB(dst, b, h) do { _Pragma("unroll") for (int n = 0; n < 2; ++n) dst[n] = __builtin_shufflevector(*(const LAS i32x4*)(lds + G8_SB(b, h) + boff + n * 2048), *(const LAS i32x4*)(lds + G8_SB(b, h) + boff + n * 2048 + 1024), 0, 1, 2, 3, 4, 5, 6, 7); } while (0)
#define G8_MMA1(ai, bj, At, Bt, m, n) do { \
        if constexpr (FP8) asm volatile("v_mfma_scale_f32_16x16x128_f8f6f4 %0, %1, %2, %0, %3, %3 op_sel_hi:[0,0,0]" : "+v"(acc[(ai) * 4 + m][(bj) * 2 + n]) : "v"(Bt[n]), "v"(At[m]), "v"(one_scale)); \
        else { acc[(ai) * 4 + m][(bj) * 2 + n] = __builtin_amdgcn_mfma_f32_16x16x32_bf16(__builtin_bit_cast(bf16x8, __builtin_shufflevector(Bt[n], Bt[n], 0, 1, 2, 3)), __builtin_bit_cast(bf16x8, __builtin_shufflevector(At[m], At[m], 0, 1, 2, 3)), acc[(ai) * 4 + m][(bj) * 2 + n], 0, 0, 0); \
               acc[(ai) * 4 + m][(bj) * 2 + n] = __builtin_amdgcn_mfma_f32_16x16x32_bf16(__builtin_bit_cast(bf16x8, __builtin_shufflevector(Bt[n], Bt[n], 4, 5, 6, 7)), __builtin_bit_cast(bf16x8, __builtin_shufflevector(At[m], At[m], 4, 5, 6, 7)), acc[(ai) * 4 + m][(bj) * 2 + n], 0, 0, 0); } } while (0)
#define G8_MMA(ai, bj, At, Bt) do { if (ABL == 1) { _Pragma("unroll") for (int m = 0; m < 4; ++m) asm volatile("" :: "v"(At[m])); _Pragma("unroll") for (int n = 0; n < 2; ++n) asm volatile("" :: "v"(Bt[n])); break; } \
        __builtin_amdgcn_s_setprio(1); _Pragma("unroll") for (int m = 0; m < 4; ++m) _Pragma("unroll") for (int n = 0; n < 2; ++n) G8_MMA1(ai, bj, At, Bt, m, n); __builtin_amdgcn_s_setprio(0); } while (0)
#define G8_WAIT_V(n) asm volatile("s_waitcnt vmcnt(" #n ")" ::: "memory")
#define G8_WAIT_L(n) asm volatile("s_waitcnt lgkmcnt(" #n ")" ::: "memory")
#define G8_BAR __builtin_amdgcn_s_barrier()
#define G8_SCHED __builtin_amdgcn_sched_barrier(0)
#define G8_RSRC(p) __builtin_amdgcn_make_buffer_rsrc((void*)(p), 0, 0x7ffffff0, 0x00020000)
    U cur, nxt; int ui = 0;
    if (!S.next(0, cur)) return;
    f32x4 acc[8][4];
#pragma unroll
    for (int m = 0; m < 8; ++m)
#pragma unroll
        for (int n = 0; n < 4; ++n) acc[m][n] = (f32x4){0.f, 0.f, 0.f, 0.f};
    i32x8 At[4], B0[2], B1[2];
    const int one_scale = 0x7F7F7F7F;
    unsigned pkc[2] = {0u, 0u}, pkn[2] = {0u, 0u};
    if (Sched::GATHER) S.gather(cur, R0, pkc);
    pkn[0] = pkc[0]; pkn[1] = pkc[1];
    const char* cA = S.abase(cur); const char* cB = S.bbase(cur);
    {
        const __amdgpu_buffer_rsrc_t rA = G8_RSRC(cA), rB = G8_RSRC(cB);
        G8_STB(G8_SB(0, 0), rB, 0u); G8_STA(G8_SA(0, 0), rA, pkc, 0, 0u); G8_STB(G8_SB(0, 1), rB, hstep); G8_STA(G8_SA(0, 1), rA, pkc, 1, 0u);
        if (wr == 1) G8_BAR;
        G8_WAIT_V(4); G8_BAR;
        G8_STB(G8_SB(1, 0), rB, 128u); G8_STA(G8_SA(1, 0), rA, pkc, 0, 128u); G8_STB(G8_SB(1, 1), rB, hstep + 128u);
        G8_WAIT_V(6); G8_BAR;
    }
    for (;;) {
        const bool has_next = S.next(ui + 1, nxt);
        if (Sched::GATHER && has_next) { const int tz = opaque_tid(wave_s); int R2, C2; stage_rc(tz * 16, R2, C2); S.gather(nxt, R2, pkn); }
        const char* nA = has_next ? S.abase(nxt) : cA; const char* nB = has_next ? S.bbase(nxt) : cB;
        const __amdgpu_buffer_rsrc_t rA = G8_RSRC(cA);
#pragma unroll 1
        for (int t = 0; t < nt; t += 2) {
            int lastv = __builtin_amdgcn_readfirstlane((t == nt - 2) ? 1 : 0); asm volatile("" : "+s"(lastv)); const bool last = lastv != 0;
            const unsigned k1 = (unsigned)(t + 1) * 128u;
            const unsigned k2 = last ? 0u : (unsigned)(t + 2) * 128u, k3 = k2 + 128u;
            const __amdgpu_buffer_rsrc_t rA2 = G8_RSRC(last ? nA : cA), rB2 = G8_RSRC(last ? nB : cB);
            const unsigned px[2] = {last ? pkn[0] : pkc[0], last ? pkn[1] : pkc[1]};
            G8_LDB(B0, 0, 0); G8_SCHED; G8_LDA(At, 0, 0); G8_STA(G8_SA(1, 1), rA, pkc, 1, k1);
            G8_WAIT_L(8); G8_BAR; G8_WAIT_L(0); G8_MMA(0, 0, At, B0); G8_BAR; G8_SCHED;
            G8_LDB(B1, 0, 1); G8_STB(G8_SB(0, 0), rB2, k2);
            G8_BAR; G8_WAIT_L(0); G8_MMA(0, 1, At, B1); G8_BAR;
            G8_LDA(At, 0, 1); G8_STA(G8_SA(0, 0), rA2, px, 0, k2);
            G8_BAR; G8_WAIT_L(0); G8_MMA(1, 0, At, B0); G8_BAR; G8_SCHED;
            G8_STB(G8_SB(0, 1), rB2, k2 + hstep);
            G8_WAIT_V(6); G8_BAR; G8_MMA(1, 1, At, B1); G8_BAR;
            G8_LDB(B0, 1, 0); G8_SCHED; G8_LDA(At, 1, 0); G8_STA(G8_SA(0, 1), rA2, px, 1, k2);
            G8_WAIT_L(8); G8_BAR; G8_WAIT_L(0); G8_MMA(0, 0, At, B0); G8_BAR; G8_SCHED;
            G8_LDB(B1, 1, 1); G8_STB(G8_SB(1, 0), rB2, k3);
            G8_BAR; G8_WAIT_L(0); G8_MMA(0, 1, At, B1); G8_BAR;
            G8_LDA(At, 1, 1); G8_STA(G8_SA(1, 0), rA2, px, 0, k3);
            G8_BAR; G8_WAIT_L(0); G8_MMA(1, 0, At, B0); G8_BAR; G8_SCHED;
            G8_STB(G8_SB(1, 1), rB2, k3 + hstep);
            G8_WAIT_V(6); G8_BAR; G8_MMA(1, 1, At, B1); G8_BAR;
        }
        if (FP8) asm volatile("s_nop 15\n\ts_nop 15" ::: "memory");
        {
            const int tz = opaque_tid(wave_s), lz = tz & 63, wz = __builtin_amdgcn_readfirstlane(tz >> 6);
            E(acc, cur, wz >> 2, wz & 3, lz & 15, lz >> 4); }
        if (!has_next) break;
#pragma unroll
        for (int m = 0; m < 8; ++m)
#pragma unroll
            for (int n = 0; n < 4; ++n) acc[m][n] = (f32x4){0.f, 0.f, 0.f, 0.f};
        cur = nxt; cA = nA; cB = nB; ++ui;
        pkc[0] = pkn[0]; pkc[1] = pkn[1];
    }
    G8_WAIT_V(0);
    if (wr == 0) G8_BAR;
    G8_BAR;
#undef G8_SA
#undef G8_SB
#undef G8_STAGE2
#undef G8_STB
#undef G8_STA
#undef G8_LDA
#undef G8_LDB
#undef G8_MMA
#undef G8_MMA1
#undef G8_WAIT_V
#undef G8_WAIT_L
#undef G8_BAR
#undef G8_SCHED
#undef G8_RSRC
}

struct DenseU { int pm, pn; };
template <class Epi> struct DenseSched {
    typedef DenseU U; static constexpr bool GATHER = false; static constexpr bool RAGGED = false;
    __device__ __forceinline__ int nvalid(const U&) const { return 256; }
    const char* A; const char* Bt; int nM, nN, RB; const Epi* E; int wg, nwg;
    __device__ __forceinline__ bool next(int i, U& u) const { return unit_of((long)i * nwg + wg, nM, nN, u.pm, u.pn); }
    __device__ __forceinline__ const char* abase(const U& u) const { return E->swapped(u.pn) ? (Bt + (size_t)E->brow0(u.pn) * RB) : (A + (size_t)u.pm * 256 * RB); }
    __device__ __forceinline__ const char* bbase(const U& u) const { return E->swapped(u.pn) ? (A + (size_t)u.pm * 256 * RB) : (Bt + (size_t)E->brow0(u.pn) * RB); }
    __device__ __forceinline__ void gather(const U&, int, unsigned (&)[2]) const {}
};
template <class Epi> struct DenseEpi { const Epi* E;
    __device__ __forceinline__ void operator()(const f32x4 (&acc)[8][4], const DenseU& u, int wr, int wc, int fr, int fq) const { (*E)(acc, u.pm, u.pn, wr, wc, fr, fq); } };
template <class Epi>
__device__ __forceinline__ void gemm_phase(LAS unsigned char* lds, const bf16_t* A, const bf16_t* Bt, int nM, int nN, int K, const Epi& E, int wave_s) {
    DenseSched<Epi> S{(const char*)A, (const char*)Bt, nM, nN, K * 2, &E, (int)blockIdx.x, (int)gridDim.x}; DenseEpi<Epi> DE{&E};
    gemm8_phase<false>(lds, K * 2, S, DE, wave_s);
}
template <class Epi>
__device__ __forceinline__ void gemm_phase_f8(LAS unsigned char* lds, const unsigned char* A, const unsigned char* Bt, int nM, int nN, int K, const Epi& E, int wave_s) {
    DenseSched<Epi> S{(const char*)A, (const char*)Bt, nM, nN, K, &E, (int)blockIdx.x, (int)gridDim.x}; DenseEpi<Epi> DE{&E};
    gemm8_phase<true>(lds, K, S, DE, wave_s);
}
__device__ __forceinline__ void rope_freq(int j, float& fhi, float& flo) {
    const double f = exp2(-(double)j * (13.287712379549449 / 128.0)) * 0.15915494309189535;
    fhi = (float)f; flo = (float)(f - (double)fhi);
}
__device__ __forceinline__ void rope_cs(float pos, float fhi, float flo, float& c, float& s) {
    const float p = pos * fhi; const float e = __builtin_fmaf(pos, fhi, -p);
    float r = p - __builtin_rintf(p); r += e + pos * flo;
    c = __builtin_amdgcn_cosf(r); s = __builtin_amdgcn_sinf(r);
}
__device__ __forceinline__ float gelu_fast(float x) { const float u = x * (-2.3022081981971123f - 0.10294324276067f * x * x); return x * __builtin_amdgcn_rcpf(1.f + __builtin_amdgcn_exp2f(u)); }
__device__ __forceinline__ float silu_fast(float x) { return x * __builtin_amdgcn_rcpf(1.f + __builtin_amdgcn_exp2f(-1.4426950408889634f * x)); }

struct EpiInAB {
    bf16_t *qb, *kb, *vT, *sgb, *ugb, *gvT;
    __device__ __forceinline__ bool swapped(int pn) const { return (pn >= 8 && pn < 12) || pn >= 20; }
    __device__ __forceinline__ int brow0(int pn) const { return pn * 256; }
    __device__ __forceinline__ void operator()(const f32x4 (&acc)[8][4], int pm, int pn, int wr, int wc, int fr, int fq) const {
        if (pn < 8) {
            bf16_t* dst = (pn < 4 ? qb : kb) + (pn & 3) * 256; const float sc = pn < 4 ? 1.f : 0.0625f;
            float fh[8], fl[8];
#pragma unroll
            for (int e = 0; e < 8; ++e) rope_freq(wc * 32 + 8 * fq + e, fh[e], fl[e]);
#pragma unroll
            for (int m = 0; m < 8; ++m) { int row = pm * 256 + arow_of<8>(wr, m, fr); asm volatile("" : "+v"(row));
                const float pos = (float)row; float o1[8], o2[8];
#pragma unroll
                for (int e = 0; e < 8; ++e) { float c, s; rope_cs(pos, fh[e], fl[e], c, s);
                    const float x1 = acc[m][e >> 2][e & 3], x2 = acc[m][(e >> 2) + 2][e & 3];
                    o1[e] = (x1 * c - x2 * s) * sc; o2[e] = (x2 * c + x1 * s) * sc; }
                u32x4 lo, hi;
                lo.x = cvt_pk_bf16(o1[0], o1[1]); lo.y = cvt_pk_bf16(o1[2], o1[3]); lo.z = cvt_pk_bf16(o1[4], o1[5]); lo.w = cvt_pk_bf16(o1[6], o1[7]);
                hi.x = cvt_pk_bf16(o2[0], o2[1]); hi.y = cvt_pk_bf16(o2[2], o2[3]); hi.z = cvt_pk_bf16(o2[4], o2[5]); hi.w = cvt_pk_bf16(o2[6], o2[7]);
                bf16_t* rp = dst + (size_t)row * 1024 + wc * 32 + 8 * fq;
                *(u32x4*)rp = lo; *(u32x4*)(rp + 128) = hi; }
        } else if (pn >= 12 && pn < 20) {
            const bool isg = pn < 16; bf16_t* dst = (isg ? sgb : ugb) + (pn & 3) * 256;
#pragma unroll
            for (int m = 0; m < 8; ++m) { int row = pm * 256 + arow_of<8>(wr, m, fr); asm volatile("" : "+v"(row));
#pragma unroll
                for (int hf = 0; hf < 2; ++hf) { u32x4 w; const f32x4 a = acc[m][2 * hf], b = acc[m][2 * hf + 1];
                    float v[8] = {a[0], a[1], a[2], a[3], b[0], b[1], b[2], b[3]};
#pragma unroll
                    for (int e = 0; e < 8; ++e) v[e] = isg ? silu_fast(v[e]) : gelu_fast(v[e]);
                    w.x = cvt_pk_bf16(v[0], v[1]); w.y = cvt_pk_bf16(v[2], v[3]); w.z = cvt_pk_bf16(v[4], v[5]); w.w = cvt_pk_bf16(v[6], v[7]);
                    *(u32x4*)(dst + (size_t)row * 1024 + hf * 128 + wc * 32 + 8 * fq) = w; } }
        } else {
            const bool isv = pn < 12; bf16_t* dst = (isv ? vT : gvT) + (size_t)((pn & 3) * 256) * T_ + pm * 256;
#pragma unroll
            for (int m = 0; m < 8; ++m) { int f = arow_of<8>(wr, m, fr); asm volatile("" : "+v"(f));
#pragma unroll
                for (int hf = 0; hf < 2; ++hf) { u32x4 w; const f32x4 a = acc[m][2 * hf], b = acc[m][2 * hf + 1];
                    float v[8] = {a[0], a[1], a[2], a[3], b[0], b[1], b[2], b[3]};
                    if (!isv) {
#pragma unroll
                        for (int e = 0; e < 8; ++e) v[e] = gelu_fast(v[e]); }
                    w.x = cvt_pk_bf16(v[0], v[1]); w.y = cvt_pk_bf16(v[2], v[3]); w.z = cvt_pk_bf16(v[4], v[5]); w.w = cvt_pk_bf16(v[6], v[7]);
                    *(u32x4*)(dst + (size_t)f * T_ + hf * 128 + wc * 32 + 8 * fq) = w; } }
        }
    }
};

struct EpiKhat {
    bf16_t* khatT;
    __device__ __forceinline__ bool swapped(int) const { return true; }
    __device__ __forceinline__ int brow0(int pn) const { return (4 + pn) * 256; }
    __device__ __forceinline__ void operator()(const f32x4 (&acc)[8][4], int pm, int pn, int wr, int wc, int fr, int fq) const {
        const int h = pn; const float l2g = log2f(1.f - exp2f(-5.f - (float)h));
        bf16_t* dst = khatT + (size_t)(h * 256) * T_ + pm * 256;
#pragma unroll
        for (int m = 0; m < 4; ++m) { int f = wr * 64 + m * 16 + fr; asm volatile("" : "+v"(f));
            float fh, fl; rope_freq(f, fh, fl);
#pragma unroll
            for (int hf = 0; hf < 2; ++hf) { float o1[8], o2[8]; const int t0 = hf * 128 + wc * 32 + 8 * fq;
#pragma unroll
                for (int e = 0; e < 8; ++e) { float c, s; rope_cs((float)(pm * 256 + t0 + e), fh, fl, c, s);
                    const float x1 = acc[m][2 * hf + (e >> 2)][e & 3], x2 = acc[m + 4][2 * hf + (e >> 2)][e & 3];
                    const float d = 0.0625f * exp2f((float)(127 - ((t0 + e) & 127)) * l2g);
                    o1[e] = (x1 * c - x2 * s) * d; o2[e] = (x2 * c + x1 * s) * d; }
                u32x4 w1, w2;
                w1.x = cvt_pk_bf16(o1[0], o1[1]); w1.y = cvt_pk_bf16(o1[2], o1[3]); w1.z = cvt_pk_bf16(o1[4], o1[5]); w1.w = cvt_pk_bf16(o1[6], o1[7]);
                w2.x = cvt_pk_bf16(o2[0], o2[1]); w2.y = cvt_pk_bf16(o2[2], o2[3]); w2.z = cvt_pk_bf16(o2[4], o2[5]); w2.w = cvt_pk_bf16(o2[6], o2[7]);
                *(u32x4*)(dst + (size_t)f * T_ + t0) = w1;
                *(u32x4*)(dst + (size_t)(f + 128) * T_ + t0) = w2; } }
    }
};
typedef short s16x4 __attribute__((ext_vector_type(4)));
__device__ __forceinline__ void ret_kv_phase(LAS unsigned char* lds, const bf16_t* vT, const bf16_t* kb, bf16_t* KVT, int wg, int nwg, int wave_s) {
    typedef Core<8, 4> C;
    constexpr int RS = 576;
    const int tid = opaque_tid(wave_s), wid = __builtin_amdgcn_readfirstlane(tid >> 6), lane = tid & 63, wr = wid >> 2, wc = wid & 3, fr = lane & 15, fq = lane >> 4;
    LAS unsigned char* ldsT = lds + 65536;
    unsigned aoff[4];
#pragma unroll
    for (int i = 0; i < 4; ++i) { int r, c; C::apiece(tid, i, r, c); aoff[i] = (unsigned)(r * T_ + c) * 2u; }
    const int ao = lds_byte(wr * 128 + fr, fq * 8);
    LAS unsigned char* trb = ldsT + (8 * fq + (fr >> 2)) * RS + 2 * (wc * 32 + 8 * (fr & 3));
    for (int u = wg; u < 512; u += nwg) {
        const int n = u >> 2, h = u & 3; const float l2g = log2f(1.f - exp2f(-5.f - (float)h));
        const bf16_t* kt = kb + (size_t)(n * 128) * 1024 + h * 256;
        { const char* Vb = (const char*)(vT + (size_t)(h * 256) * T_ + n * 128); C::stage_a(lds, Vb, aoff, 0u, wid); C::stage_a(lds + 32768, Vb, aoff, 128u, wid); }
#pragma unroll
        for (int p = 0; p < 8; ++p) { int idx = tid + 512 * p; asm volatile("" : "+v"(idx)); const int j = idx >> 5, d0 = (idx & 31) * 8;
            const u32x4 w = *(const u32x4*)(kt + (size_t)j * 1024 + d0);
            const float d = exp2f((float)(127 - j) * l2g);
            u32x4 o; o.x = cvt_pk_bf16(bflo(w.x) * d, bfhi(w.x) * d); o.y = cvt_pk_bf16(bflo(w.y) * d, bfhi(w.y) * d); o.z = cvt_pk_bf16(bflo(w.z) * d, bfhi(w.z) * d); o.w = cvt_pk_bf16(bflo(w.w) * d, bfhi(w.w) * d);
            *(LAS u32x4*)(ldsT + j * RS + d0 * 2) = o; }
        WAIT_V0(); __syncthreads();
        f32x4 acc[8][4]; C::zero(acc);
#pragma unroll
        for (int kk = 0; kk < 4; ++kk) {
            bf16x8 At[8], Bf[4];
#pragma unroll
            for (int m = 0; m < 8; ++m) At[m] = *(const LAS bf16x8*)(lds + (kk >> 1) * 32768 + ao + m * 2048 + (kk & 1) * 1024);
#pragma unroll
            for (int nn = 0; nn < 4; ++nn) { LAS unsigned char* a = trb + (kk * 32) * RS + 2 * ((nn >> 1) * 128 + 4 * (nn & 1));
                const s16x4 lo = __builtin_amdgcn_ds_read_tr16_b64_v4i16((LAS s16x4*)a), hi = __builtin_amdgcn_ds_read_tr16_b64_v4i16((LAS s16x4*)(a + 4 * RS));
                Bf[nn] = __builtin_shufflevector(lo, hi, 0, 1, 2, 3, 4, 5, 6, 7); }
#pragma unroll
            for (int m = 0; m < 8; ++m)
#pragma unroll
                for (int nn = 0; nn < 4; ++nn) acc[m][nn] = __builtin_amdgcn_mfma_f32_16x16x32_bf16(Bf[nn], At[m], acc[m][nn], 0, 0, 0);
            __builtin_amdgcn_sched_barrier(0);
        }
        __syncthreads();
        bf16_t* dst = KVT + (size_t)u * 65536;
#pragma unroll
        for (int m = 0; m < 8; ++m) { bf16_t* rp = dst + arow_of<8>(wr, m, fr) * 256 + wc * 32 + 8 * fq;
#pragma unroll
            for (int hf = 0; hf < 2; ++hf) { const f32x4 a = acc[m][2 * hf], b = acc[m][2 * hf + 1]; u32x4 w;
                w.x = cvt_pk_bf16(a[0], a[1]); w.y = cvt_pk_bf16(a[2], a[3]); w.z = cvt_pk_bf16(b[0], b[1]); w.w = cvt_pk_bf16(b[2], b[3]); *(u32x4*)(rp + hf * 128) = w; } }
    }
}
__device__ __forceinline__ void ret_scan_phase(const bf16_t* KVT, bf16_t* STb, int wg, int nwg, int wave_s) {
    const int tid = opaque_tid(wave_s);
    for (int e = (wg * NTHR + tid) * 2; e < 4 * 65536; e += nwg * NTHR * 2) {
        const int h = e >> 16; const float g = exp2f(128.f * log2f(1.f - exp2f(-5.f - (float)h)));
        float s0 = 0.f, s1 = 0.f;
        for (int n0 = 0; n0 < 128; n0 += 8) {
            unsigned kv[8];
#pragma unroll
            for (int i = 0; i < 8; ++i) kv[i] = *(const unsigned*)(KVT + (size_t)(n0 + i) * 262144 + e);
#pragma unroll
            for (int i = 0; i < 8; ++i) { *(unsigned*)(STb + (size_t)(n0 + i) * 262144 + e) = cvt_pk_bf16(s0, s1); s0 = g * s0 + bflo(kv[i]); s1 = g * s1 + bfhi(kv[i]); }
        }
    }
}
__device__ __forceinline__ void ret_out_phase(LAS unsigned char* lds, const bf16_t* qb, const bf16_t* kb, const bf16_t* vT, const bf16_t* STb, const bf16_t* sgb,
                                              const float* gain, bf16_t* mixb, int wg, int nwg, int wave_s) {
    typedef Core<4, 2> CA; typedef Core<4, 4> CB;
    const int tid = opaque_tid(wave_s), wid = __builtin_amdgcn_readfirstlane(tid >> 6), lane = tid & 63, wr = wid >> 2, wc = wid & 3, fr = lane & 15, fq = lane >> 4;
    LAS unsigned char* ldsP = lds + 98304;
    LAS float* stat = (LAS float*)lds;
    unsigned qoff[2], koff[2], soff[4], voff[4];
#pragma unroll
    for (int i = 0; i < 2; ++i) { int r, c; CA::apiece(tid, i, r, c); qoff[i] = (unsigned)(r * 1024 + c) * 2u; CA::bpiece(tid, i, r, c); koff[i] = (unsigned)(r * 1024 + c) * 2u; }
#pragma unroll
    for (int i = 0; i < 4; ++i) { int r, c; CB::bpiece(tid, i, r, c); soff[i] = (unsigned)(r * 256 + c) * 2u; voff[i] = (unsigned)(r * T_ + c) * 2u; }
    for (int u = wg; u < 512; u += nwg) {
        const int n = u >> 2, h = u & 3; const float l2g = log2f(1.f - exp2f(-5.f - (float)h));
        const char* Qb = (const char*)(qb + (size_t)(n * 128) * 1024 + h * 256); const char* Kb = (const char*)(kb + (size_t)(n * 128) * 1024 + h * 256);
        {
            f32x4 sa[4][2]; CA::zero(sa);
            CA::loop_gg(lds, Qb, qoff, Kb, koff, 4, sa, wid, wr, wc, fr, fq);
#pragma unroll
            for (int m = 0; m < 4; ++m) { const int i = wr * 64 + m * 16 + fr; const int j0 = wc * 32 + 8 * fq;
                float p[8];
#pragma unroll
                for (int e = 0; e < 8; ++e) { const int j = j0 + e; const float s = e < 4 ? sa[m][0][e] : sa[m][1][e - 4]; p[e] = (j <= i) ? s * exp2f((float)(i - j) * l2g) : 0.f; }
                u32x4 w; w.x = cvt_pk_bf16(p[0], p[1]); w.y = cvt_pk_bf16(p[2], p[3]); w.z = cvt_pk_bf16(p[4], p[5]); w.w = cvt_pk_bf16(p[6], p[7]);
                *(LAS u32x4*)(ldsP + (wc >> 1) * 16384 + lds_byte(i, j0 & 63)) = w; }
        }
        f32x4 acc[4][4]; CB::zero(acc);
        CB::loop_gg(lds, Qb, qoff, (const char*)(STb + (size_t)u * 65536), soff, 4, acc, wid, wr, wc, fr, fq);
#pragma unroll
        for (int m = 0; m < 4; ++m) { const float sc = exp2f((float)(wr * 64 + m * 16 + fr + 1) * l2g);
#pragma unroll
            for (int nn = 0; nn < 4; ++nn) acc[m][nn] *= sc; }
        CB::loop_lg(ldsP, lds, (const char*)(vT + (size_t)(h * 256) * T_ + n * 128), voff, 2, acc, wid, wr, wc, fr, fq);
#pragma unroll
        for (int m = 0; m < 4; ++m) { float s = 0.f, ss = 0.f;
#pragma unroll
            for (int nn = 0; nn < 4; ++nn)
#pragma unroll
                for (int e = 0; e < 4; ++e) { const float v = acc[m][nn][e]; s += v; ss += v * v; }
            s += __shfl_xor(s, 16); ss += __shfl_xor(ss, 16); s += __shfl_xor(s, 32); ss += __shfl_xor(ss, 32);
            if (fq == 0) { const int i = wr * 64 + m * 16 + fr; stat[(i * 4 + wc) * 2] = s; stat[(i * 4 + wc) * 2 + 1] = ss; } }
        __syncthreads();
#pragma unroll
        for (int m = 0; m < 4; ++m) { const int i = wr * 64 + m * 16 + fr; float s = 0.f, ss = 0.f;
#pragma unroll
            for (int w4 = 0; w4 < 4; ++w4) { s += stat[(i * 4 + w4) * 2]; ss += stat[(i * 4 + w4) * 2 + 1]; }
            const float mean = s * (1.f / 256.f); const float var = ss * (1.f / 256.f) - mean * mean; const float rstd = rsqrtf(var + 1e-6f);
            const size_t t = (size_t)n * 128 + i;
#pragma unroll
            for (int hf = 0; hf < 2; ++hf) { const int c0 = h * 256 + hf * 128 + wc * 32 + 8 * fq;
                const u32x4 sg = *(const u32x4*)(sgb + t * 1024 + c0);
                const f32x4 g0 = *(const f32x4*)(gain + c0), g1 = *(const f32x4*)(gain + c0 + 4);
                const f32x4 a = acc[m][2 * hf], b = acc[m][2 * hf + 1];
                float o[8];
                o[0] = (a[0] - mean) * rstd * g0[0] * bflo(sg.x); o[1] = (a[1] - mean) * rstd * g0[1] * bfhi(sg.x);
                o[2] = (a[2] - mean) * rstd * g0[2] * bflo(sg.y); o[3] = (a[3] - mean) * rstd * g0[3] * bfhi(sg.y);
                o[4] = (b[0] - mean) * rstd * g1[0] * bflo(sg.z); o[5] = (b[1] - mean) * rstd * g1[1] * bfhi(sg.z);
                o[6] = (b[2] - mean) * rstd * g1[2] * bflo(sg.w); o[7] = (b[3] - mean) * rstd * g1[3] * bfhi(sg.w);
                u32x4 w; w.x = cvt_pk_bf16(o[0], o[1]); w.y = cvt_pk_bf16(o[2], o[3]); w.z = cvt_pk_bf16(o[4], o[5]); w.w = cvt_pk_bf16(o[6], o[7]);
                *(u32x4*)(mixb + t * 2048 + c0) = w; } }
        __syncthreads();
    }
}
__device__ __forceinline__ void wsm_phase(const float* ws, bf16_t* WsM, int wg, int nwg, int wave_s) {
    const int tid = opaque_tid(wave_s);
    for (int i = wg * NTHR + tid; i < 4 * 128 * 128; i += nwg * NTHR) { const int t = (i >> 7) & 127, s = i & 127; WsM[i] = (bf16_t)(cvt_pk_bf16(s <= t ? ws[i] : 0.f, 0.f) & 0xffffu); }
}
__device__ __forceinline__ void gmlp_norm_phase(LAS unsigned char* lds, const bf16_t* gvT, bf16_t* vnT, const float* gain, int wg, int nwg, int wave_s) {
    const int tid = opaque_tid(wave_s), tg = tid & 15, c0 = tid >> 4;
    LAS float* red = (LAS float*)lds;
    for (int u = wg; u < 512; u += nwg) {
        const int n = u >> 2, g = u & 3;
        const size_t boff = (size_t)(g * 256 + c0) * T_ + n * 128 + tg * 8;
        u32x4 w[8]; float s[8], q[8];
#pragma unroll
        for (int e = 0; e < 8; ++e) { s[e] = 0.f; q[e] = 0.f; }
#pragma unroll
        for (int i = 0; i < 8; ++i) { w[i] = *(const u32x4*)(gvT + boff + (size_t)(32 * i) * T_);
            const float v[8] = {bflo(w[i].x), bfhi(w[i].x), bflo(w[i].y), bfhi(w[i].y), bflo(w[i].z), bfhi(w[i].z), bflo(w[i].w), bfhi(w[i].w)};
#pragma unroll
            for (int e = 0; e < 8; ++e) { s[e] += v[e]; q[e] += v[e] * v[e]; } }
#pragma unroll
        for (int e = 0; e < 8; ++e) { red[(c0 * 128 + tg * 8 + e) * 2] = s[e]; red[(c0 * 128 + tg * 8 + e) * 2 + 1] = q[e]; }
        __syncthreads();
        float mean[8], rstd[8];
#pragma unroll
        for (int e = 0; e < 8; ++e) { float a = 0.f, b = 0.f;
            for (int k = 0; k < 32; ++k) { a += red[(k * 128 + tg * 8 + e) * 2]; b += red[(k * 128 + tg * 8 + e) * 2 + 1]; }
            mean[e] = a * (1.f / 256.f); rstd[e] = rsqrtf(b * (1.f / 256.f) - mean[e] * mean[e] + 1e-6f); }
#pragma unroll
        for (int i = 0; i < 8; ++i) { const float gn = gain[g * 256 + c0 + 32 * i];
            const float v[8] = {bflo(w[i].x), bfhi(w[i].x), bflo(w[i].y), bfhi(w[i].y), bflo(w[i].z), bfhi(w[i].z), bflo(w[i].w), bfhi(w[i].w)};
            u32x4 o; o.x = cvt_pk_bf16((v[0] - mean[0]) * rstd[0] * gn, (v[1] - mean[1]) * rstd[1] * gn); o.y = cvt_pk_bf16((v[2] - mean[2]) * rstd[2] * gn, (v[3] - mean[3]) * rstd[3] * gn);
            o.z = cvt_pk_bf16((v[4] - mean[4]) * rstd[4] * gn, (v[5] - mean[5]) * rstd[5] * gn); o.w = cvt_pk_bf16((v[6] - mean[6]) * rstd[6] * gn, (v[7] - mean[7]) * rstd[7] * gn);
            *(u32x4*)(vnT + boff + (size_t)(32 * i) * T_) = o; }
        __syncthreads();
    }
}
__device__ __forceinline__ void gmlp_mix_phase(LAS unsigned char* lds, const bf16_t* WsM, const bf16_t* vnT, const bf16_t* ugb, const float* bs, bf16_t* mixb, int wg, int nwg, int wave_s) {
    typedef Core<4, 4> C;
    const int tid = opaque_tid(wave_s), wid = __builtin_amdgcn_readfirstlane(tid >> 6), lane = tid & 63, wr = wid >> 2, wc = wid & 3, fr = lane & 15, fq = lane >> 4;
    unsigned aoff[2], boff[4];
#pragma unroll
    for (int i = 0; i < 2; ++i) { int r, c; C::apiece(tid, i, r, c); aoff[i] = (unsigned)(r * 128 + c) * 2u; }
#pragma unroll
    for (int i = 0; i < 4; ++i) { int r, c; C::bpiece(tid, i, r, c); boff[i] = (unsigned)(r * T_ + c) * 2u; }
    for (int u = wg; u < 512; u += nwg) {
        const int n = u >> 2, g = u & 3;
        f32x4 acc[4][4]; C::zero(acc);
        C::burst_gg(lds, lds + 32768, (const char*)(WsM + g * 16384), aoff, (const char*)(vnT + (size_t)(g * 256) * T_ + n * 128), boff, 2, acc, wid, wr, wc, fr, fq);
#pragma unroll
        for (int m = 0; m < 4; ++m) { const int i = wr * 64 + m * 16 + fr; const float bias = bs[g * 128 + i]; const size_t t = (size_t)n * 128 + i;
#pragma unroll
            for (int hf = 0; hf < 2; ++hf) { const int c0 = g * 256 + hf * 128 + wc * 32 + 8 * fq;
                const u32x4 ug = *(const u32x4*)(ugb + t * 1024 + c0);
                const f32x4 a = acc[m][2 * hf], b = acc[m][2 * hf + 1];
                u32x4 w; w.x = cvt_pk_bf16((a[0] + bias) * bflo(ug.x), (a[1] + bias) * bfhi(ug.x)); w.y = cvt_pk_bf16((a[2] + bias) * bflo(ug.y), (a[3] + bias) * bfhi(ug.y));
                w.z = cvt_pk_bf16((b[0] + bias) * bflo(ug.z), (b[1] + bias) * bfhi(ug.z)); w.w = cvt_pk_bf16((b[2] + bias) * bflo(ug.w), (b[3] + bias) * bfhi(ug.w));
                *(u32x4*)(mixb + t * 2048 + 1024 + c0) = w; } }
        __syncthreads();
    }
}
template <bool B16> __device__ __forceinline__ float4 ld_x4(const void* base, size_t i4) {
    if (B16) { const u32x2 w = ((const u32x2*)base)[i4]; return make_float4(bflo(w.x), bfhi(w.x), bflo(w.y), bfhi(w.y)); }
    return ((const float4*)base)[i4]; }
template <bool B16> __device__ __forceinline__ void st_x4(void* base, size_t i4, float4 v) {
    if (B16) { u32x2 w; w.x = cvt_pk_bf16(v.x, v.y); w.y = cvt_pk_bf16(v.z, v.w); ((u32x2*)base)[i4] = w; }
    else ((float4*)base)[i4] = v; }
struct EpiResidual {
    const float* xin; float* xout;
    __device__ __forceinline__ bool swapped(int) const { return false; }
    __device__ __forceinline__ int brow0(int pn) const { return pn * 256; }
    __device__ __forceinline__ void operator()(const f32x4 (&acc)[8][4], int pm, int pn, int wr, int wc, int fr, int fq) const {
#pragma unroll
        for (int m2 = 0; m2 < 4; ++m2) {
            int row0 = pm * 256 + arow_of<8>(wr, 2 * m2, fr); asm volatile("" : "+v"(row0));
            const float* ip0 = xin + (size_t)row0 * D_ + pn * 256; float* op0 = xout + (size_t)row0 * D_ + pn * 256;
            f32x4 x[2][4];
#pragma unroll
            for (int r = 0; r < 2; ++r)
#pragma unroll
                for (int n = 0; n < 4; ++n) x[r][n] = *(const f32x4*)(ip0 + (size_t)r * 16 * D_ + bcol_of<4>(wc, n, fq, 0));
#pragma unroll
            for (int r = 0; r < 2; ++r)
#pragma unroll
                for (int n = 0; n < 4; ++n) *(f32x4*)(op0 + (size_t)r * 16 * D_ + bcol_of<4>(wc, n, fq, 0)) = x[r][n] + acc[2 * m2 + r][n];
            asm volatile("" ::: "memory"); }
    }
};
struct EpiResidual16 {
    bf16_t* x;
    __device__ __forceinline__ bool swapped(int) const { return false; }
    __device__ __forceinline__ int brow0(int pn) const { return pn * 256; }
    __device__ __forceinline__ void operator()(const f32x4 (&acc)[8][4], int pm, int pn, int wr, int wc, int fr, int fq) const {
#pragma unroll
        for (int m = 0; m < 8; ++m) { int row = pm * 256 + arow_of<8>(wr, m, fr); asm volatile("" : "+v"(row));
            bf16_t* p = x + (size_t)row * D_ + pn * 256 + wc * 32 + 8 * fq;
#pragma unroll
            for (int hf = 0; hf < 2; ++hf) { const u32x4 w = *(const u32x4*)(p + hf * 128); const f32x4 a = acc[m][2 * hf], b = acc[m][2 * hf + 1]; u32x4 o;
                o.x = cvt_pk_bf16(bflo(w.x) + a[0], bfhi(w.x) + a[1]); o.y = cvt_pk_bf16(bflo(w.y) + a[2], bfhi(w.y) + a[3]);
                o.z = cvt_pk_bf16(bflo(w.z) + b[0], bfhi(w.z) + b[1]); o.w = cvt_pk_bf16(bflo(w.w) + b[2], bfhi(w.w) + b[3]);
                *(u32x4*)(p + hf * 128) = o; }
            asm volatile("" ::: "memory"); }
    }
};
struct EpiResidualY {
    const float* xin; const bf16_t* y; float* xout;
    __device__ __forceinline__ bool swapped(int) const { return false; }
    __device__ __forceinline__ int brow0(int pn) const { return pn * 256; }
    __device__ __forceinline__ void operator()(const f32x4 (&acc)[8][4], int pm, int pn, int wr, int wc, int fr, int fq) const {
#pragma unroll
        for (int m = 0; m < 8; ++m) { int row = pm * 256 + arow_of<8>(wr, m, fr); asm volatile("" : "+v"(row));
            const float* ip = xin + (size_t)row * D_ + pn * 256; float* op = xout + (size_t)row * D_ + pn * 256;
            const bf16_t* y0 = y + (size_t)(2 * row) * D_ + pn * 256; const bf16_t* y1 = y0 + D_;
#pragma unroll
            for (int hf = 0; hf < 2; ++hf) { const int c = hf * 128 + wc * 32 + 8 * fq;
                const u32x4 a = *(const u32x4*)(y0 + c), b = *(const u32x4*)(y1 + c);
                f32x4 x0 = *(const f32x4*)(ip + c) + acc[m][2 * hf], x1v = *(const f32x4*)(ip + c + 4) + acc[m][2 * hf + 1];
                x0[0] += bflo(a.x) + bflo(b.x); x0[1] += bfhi(a.x) + bfhi(b.x); x0[2] += bflo(a.y) + bflo(b.y); x0[3] += bfhi(a.y) + bfhi(b.y);
                x1v[0] += bflo(a.z) + bflo(b.z); x1v[1] += bfhi(a.z) + bfhi(b.z); x1v[2] += bflo(a.w) + bflo(b.w); x1v[3] += bfhi(a.w) + bfhi(b.w);
                *(f32x4*)(op + c) = x0; *(f32x4*)(op + c + 4) = x1v; }
            asm volatile("" ::: "memory"); }
    }
};

#define CAPF 16384
typedef float f32x2 __attribute__((ext_vector_type(2)));
__device__ __forceinline__ void wr_phase(const float* wrg, const float* wre, bf16_t* WrT, int wg, int nwg, int wave_s) {
    const int tid = opaque_tid(wave_s);
    for (int i = wg * NTHR + tid; i < 64 * 2048; i += nwg * NTHR) { const int r = i >> 11, k = i & 2047;
        const float v = r < 4 ? wrg[k * 4 + r] : (r < 36 ? wre[k * 32 + (r - 4)] : 0.f);
        WrT[i] = (bf16_t)(cvt_pk_bf16(v, 0.f) & 0xffffu); }
}
template <bool XIN16>
__device__ __forceinline__ void moe_route_phase(LAS unsigned char* lds, const void* x1, const float* g, bf16_t* hb, unsigned char* hb8, const bf16_t* WrT, const float* brg, const float* bre,
                                                int* cnt, int* list, float* gate, int wg, int nwg, int wave_s) {
    typedef Core<2, 1> C;
    const int tid = opaque_tid(wave_s), wid = __builtin_amdgcn_readfirstlane(tid >> 6), lane = tid & 63, wr = wid >> 2, wc = wid & 3, fr = lane & 15, fq = lane >> 4;
    unsigned aoff[1], boff[1];
    { int r, c; C::apiece(tid, 0, r, c); aoff[0] = (unsigned)(r * 2048 + c) * 2u; C::bpiece(tid, 0, r, c); boff[0] = (unsigned)(r * 2048 + c) * 2u; }
    LAS float* lg = (LAS float*)lds;
    for (int u = wg; u < T_ / 64; u += nwg) {
        for (int rr = 0; rr < 8; ++rr) { const int row = u * 64 + wid * 8 + rr;
            float4 v[8]; float ss = 0.f;
#pragma unroll
            for (int i = 0; i < 8; ++i) { v[i] = ld_x4<XIN16>(x1, (size_t)row * (D_ / 4) + 2 * (lane + 64 * (i >> 1)) + (i & 1)); ss += v[i].x * v[i].x + v[i].y * v[i].y + v[i].z * v[i].z + v[i].w * v[i].w; }
            ss = wave_sum(ss);
            const float r = rsqrtf(ss * (1.f / D_) + 1e-6f);
#pragma unroll
            for (int i = 0; i < 4; ++i) { const int e0 = 8 * (lane + 64 * i); const float4 ga = *(const float4*)(g + e0), gb = *(const float4*)(g + e0 + 4); const float4 a = v[2 * i], b = v[2 * i + 1];
                const float h8[8] = {a.x * r * ga.x, a.y * r * ga.y, a.z * r * ga.z, a.w * r * ga.w, b.x * r * gb.x, b.y * r * gb.y, b.z * r * gb.z, b.w * r * gb.w};
                u32x4 o; o.x = cvt_pk_bf16(h8[0], h8[1]); o.y = cvt_pk_bf16(h8[2], h8[3]); o.z = cvt_pk_bf16(h8[4], h8[5]); o.w = cvt_pk_bf16(h8[6], h8[7]);
                *(u32x4*)(hb + (size_t)row * D_ + e0) = o;
                if (hb8) { u32x2 w; w.x = pk4_fp8(4.f * h8[0], 4.f * h8[1], 4.f * h8[2], 4.f * h8[3]); w.y = pk4_fp8(4.f * h8[4], 4.f * h8[5], 4.f * h8[6], 4.f * h8[7]); *(u32x2*)(hb8 + (size_t)row * D_ + e0) = w; } } }
        WAIT_V0(); __syncthreads();
        f32x4 acc[2][1]; C::zero(acc);
        for (int kb = 0; kb < 4; ++kb) {
            C::burst_gg(lds, lds + 65536, (const char*)(hb + (size_t)u * 64 * D_) + kb * 1024, aoff, (const char*)WrT + kb * 1024, boff, 8, acc, wid, wr, wc, fr, fq);
            __syncthreads(); }
#pragma unroll
        for (int m = 0; m < 2; ++m) { const int row = wr * 32 + m * 16 + fr;
#pragma unroll
            for (int j = 0; j < 4; ++j) { const int col = wc * 16 + 4 * fq + j; if (col < 36) lg[row * 40 + col] = acc[m][0][j] + (col < 4 ? brg[col] : bre[col - 4]); } }
        __syncthreads();
        if (tid < 64) {
            const int t = u * 64 + tid; const LAS float* L = lg + tid * 40;
            float l4[4], le[32];
#pragma unroll
            for (int i = 0; i < 4; ++i) l4[i] = L[i];
#pragma unroll
            for (int i = 0; i < 32; ++i) le[i] = L[4 + i];
            int gs = 0; float gm = l4[0];
#pragma unroll
            for (int i = 1; i < 4; ++i) if (l4[i] > gm) { gm = l4[i]; gs = i; }
            float den = 0.f;
#pragma unroll
            for (int i = 0; i < 4; ++i) den += __expf(l4[i] - gm);
            const float psel = 1.f / den;
            float l8[8];
#pragma unroll
            for (int i = 0; i < 8; ++i) l8[i] = gs == 0 ? le[i] : gs == 1 ? le[8 + i] : gs == 2 ? le[16 + i] : le[24 + i];
            int e1 = 0; float m1 = l8[0];
#pragma unroll
            for (int i = 1; i < 8; ++i) if (l8[i] > m1) { m1 = l8[i]; e1 = i; }
            int e2 = -1; float m2 = -3.0e38f;
#pragma unroll
            for (int i = 0; i < 8; ++i) if (i != e1 && l8[i] > m2) { m2 = l8[i]; e2 = i; }
            const float z = __expf(m2 - m1);
            const int ex1 = gs * 8 + e1, ex2 = gs * 8 + e2;
            LAS int* hist = (LAS int*)(lg + 64 * 40);
            if (tid < 32) hist[tid] = 0;
            const int r1 = __hip_atomic_fetch_add(hist + ex1, 1, __ATOMIC_RELAXED, __HIP_MEMORY_SCOPE_WORKGROUP);
            const int r2 = __hip_atomic_fetch_add(hist + ex2, 1, __ATOMIC_RELAXED, __HIP_MEMORY_SCOPE_WORKGROUP);
            if (tid < 32) { const int c = hist[tid]; hist[32 + tid] = c ? atomicAdd(&cnt[tid], c) : 0; }
            const int p1 = hist[32 + ex1] + r1, p2 = hist[32 + ex2] + r2;
            list[ex1 * CAPF + p1] = t * 2; list[ex2 * CAPF + p2] = t * 2 + 1;
            gate[t * 2] = psel / (1.f + z); gate[t * 2 + 1] = psel * z / (1.f + z);
        }
        __syncthreads();
    }
}
__device__ __forceinline__ void moe_prefix(LAS int* tp, LAS int* cn, LAS int* tab, const int* cnt, int tid) {
    if (tid == 0) { int s = 0; for (int e = 0; e < 32; ++e) { const int c = cnt[e]; cn[e] = c; tp[e] = s; s += (c + 255) >> 8; } tp[32] = s; }
    __syncthreads();
    if (tid < 32) { const int nf = (cn[tid] + 255) >> 8, k0 = tp[tid]; for (int r = 0; r < nf; ++r) tab[k0 + r] = (tid << 8) | r; }
    __syncthreads();
}
struct MoeU { int R, pn, e, rt, ne, tpe; };
__device__ __forceinline__ bool moe_unit(int idx, int total, const LAS int* tp, const LAS int* cn, const LAS int* tab, MoeU& u) {
    if (idx >= total) return false;
    u.pn = idx & 7;
    const int t = __builtin_amdgcn_readfirstlane(tab[idx >> 3]);
    u.e = t >> 8; u.rt = t & 255; u.tpe = __builtin_amdgcn_readfirstlane(tp[u.e]); u.R = u.tpe + u.rt; u.ne = __builtin_amdgcn_readfirstlane(cn[u.e]); return true;
}
struct GuSched {
    typedef MoeU U; static constexpr bool GATHER = true;
    static constexpr bool RAGGED = true;
    const char* hb; const char* Wgu; const int* list; const LAS int* tp; const LAS int* cn; const LAS int* tab; int wg, nwg, total, rb;
    __device__ __forceinline__ bool next(int i, U& u) const { return moe_unit(i * nwg + wg, total, tp, cn, tab, u); }
    __device__ __forceinline__ int nvalid(const U& u) const { const int r = u.ne - u.rt * 256; return r < 256 ? r : 256; }
    __device__ __forceinline__ const char* abase(const U&) const { return hb; }
    __device__ __forceinline__ const char* bbase(const U& u) const { return Wgu + ((size_t)u.e * 2048 + u.pn * 256) * rb; }
    __device__ __forceinline__ void gather(const U& u, int R0, unsigned (&pk)[2]) const {
#pragma unroll
        for (int h = 0; h < 2; ++h) { unsigned p = 0u;
#pragma unroll
            for (int i = 0; i < 2; ++i) { int gr = u.rt * 256 + h * 128 + R0 + 64 * i; gr = gr < u.ne ? gr : u.ne - 1; p |= (unsigned)(list[u.e * CAPF + gr] >> 1) << (16 * i); }
            pk[h] = p; } }
};
template <bool FP8> struct EpiGu { void* hid;
    __device__ __forceinline__ void operator()(const f32x4 (&acc)[8][4], const MoeU& u, int wr, int wc, int fr, int fq) const {
        const float si = FP8 ? (1.f / 256.f) : 1.f, so = FP8 ? 8.f : 1.f;
#pragma unroll
        for (int m = 0; m < 8; ++m) { int gr = u.rt * 256 + arow_of<8>(wr, m, fr); asm volatile("" : "+v"(gr));
            if (gr < u.ne) {
                float o[8];
#pragma unroll
                for (int e = 0; e < 8; ++e) { const float a = acc[m][e >> 2][e & 3] * si, b = acc[m][2 + (e >> 2)][e & 3] * si; o[e] = silu_fast(a) * b * so; if (FP8) o[e] = __builtin_amdgcn_fmed3f(o[e], -448.f, 448.f); }
                const size_t off = ((size_t)u.tpe * 256 + gr) * 1024 + u.pn * 128 + wc * 32 + 8 * fq;
                if (FP8) { u32x2 w; w.x = pk4_fp8(o[0], o[1], o[2], o[3]); w.y = pk4_fp8(o[4], o[5], o[6], o[7]); *(u32x2*)((unsigned char*)hid + off) = w; }
                else { u32x4 w; w.x = cvt_pk_bf16(o[0], o[1]); w.y = cvt_pk_bf16(o[2], o[3]); w.z = cvt_pk_bf16(o[4], o[5]); w.w = cvt_pk_bf16(o[6], o[7]); *(u32x4*)((bf16_t*)hid + off) = w; } }
            asm volatile("" ::: "memory"); }
    }
};
template <bool FP8>
__device__ __forceinline__ void moe_gu_phase(LAS unsigned char* lds, const void* h, const void* Wgu, const int* cnt, const int* list, void* hid, int wg, int nwg, int wave_s) {
    const int tid = opaque_tid(wave_s);
    LAS int* tp = (LAS int*)(lds + 143360); LAS int* cn = tp + 40; LAS int* tab = tp + 80;
    moe_prefix(tp, cn, tab, cnt, tid);
    const int rb = FP8 ? 2048 : 4096;
    GuSched S{(const char*)h, (const char*)Wgu, list, tp, cn, tab, wg, nwg, __builtin_amdgcn_readfirstlane(tp[32]) * 8, rb}; EpiGu<FP8> E{hid};
    gemm8_phase<FP8>(lds, rb, S, E, wave_s);
    __syncthreads();
}
struct DownSched {
    typedef MoeU U; static constexpr bool GATHER = false;
    static constexpr bool RAGGED = true;
    const char* hid; const char* Wdn; const LAS int* tp; const LAS int* cn; const LAS int* tab; int wg, nwg, total, rb;
    __device__ __forceinline__ bool next(int i, U& u) const { return moe_unit(i * nwg + wg, total, tp, cn, tab, u); }
    __device__ __forceinline__ int nvalid(const U& u) const { const int r = u.ne - u.rt * 256; return r < 256 ? r : 256; }
    __device__ __forceinline__ const char* abase(const U& u) const { return hid + (size_t)u.R * 256 * rb; }
    __device__ __forceinline__ const char* bbase(const U& u) const { return Wdn + ((size_t)u.e * 2048 + u.pn * 256) * rb; }
    __device__ __forceinline__ void gather(const U&, int, unsigned (&)[2]) const {}
};
template <bool Y8> struct EpiDown { const int* list; const float* gate; void* y; float sc;
    __device__ __forceinline__ void operator()(const f32x4 (&acc)[8][4], const MoeU& u, int wr, int wc, int fr, int fq) const {
        int slot[8]; float gt[8];
#pragma unroll
        for (int m = 0; m < 8; ++m) { int gr = u.rt * 256 + arow_of<8>(wr, m, fr); gr = gr < u.ne ? gr : u.ne - 1; slot[m] = list[u.e * CAPF + gr]; }
#pragma unroll
        for (int m = 0; m < 8; ++m) gt[m] = gate[slot[m]] * sc;
        { float dep = 0.f;
#pragma unroll
          for (int m = 0; m < 8; ++m) dep += gt[m];
          asm volatile("" :: "v"(dep)); }
#pragma unroll
        for (int m = 0; m < 8; ++m) { const int gr = u.rt * 256 + arow_of<8>(wr, m, fr);
            if (gr < u.ne) { const float g = gt[m];
                const size_t yo = (size_t)slot[m] * 2048 + u.pn * 256 + wc * 32 + 8 * fq;
#pragma unroll
                for (int hf = 0; hf < 2; ++hf) { const f32x4 a = acc[m][2 * hf], b = acc[m][2 * hf + 1];
                    if (Y8) { float o[8] = {g * a[0], g * a[1], g * a[2], g * a[3], g * b[0], g * b[1], g * b[2], g * b[3]};
#pragma unroll
                        for (int e = 0; e < 8; ++e) o[e] = __builtin_amdgcn_fmed3f(o[e], -448.f, 448.f);
                        u32x2 w; w.x = pk4_fp8(o[0], o[1], o[2], o[3]); w.y = pk4_fp8(o[4], o[5], o[6], o[7]); *(u32x2*)((unsigned char*)y + yo + hf * 128) = w; }
                    else { u32x4 w; w.x = cvt_pk_bf16(g * a[0], g * a[1]); w.y = cvt_pk_bf16(g * a[2], g * a[3]); w.z = cvt_pk_bf16(g * b[0], g * b[1]); w.w = cvt_pk_bf16(g * b[2], g * b[3]);
                        *(u32x4*)((bf16_t*)y + yo + hf * 128) = w; } } } }
    }
};
template <bool FP8, bool Y8>
__device__ __forceinline__ void moe_down_phase(LAS unsigned char* lds, const void* hid, const void* Wdn, const int* cnt, const int* list, const float* gate, void* y, int wg, int nwg, int wave_s) {
    const int tid = opaque_tid(wave_s);
    LAS int* tp = (LAS int*)(lds + 143360); LAS int* cn = tp + 40; LAS int* tab = tp + 80;
    moe_prefix(tp, cn, tab, cnt, tid);
    const int rb = FP8 ? 1024 : 2048;
    DownSched S{(const char*)hid, (const char*)Wdn, tp, cn, tab, wg, nwg, __builtin_amdgcn_readfirstlane(tp[32]) * 8, rb}; EpiDown<Y8> E{list, gate, y, (FP8 ? (1.f / 256.f) : 1.f) * (Y8 ? 64.f : 1.f)};
    gemm8_phase<FP8>(lds, rb, S, E, wave_s);
    __syncthreads();
}
template <bool WRITE_X, bool Y8, bool XIN16, bool XOUT16, bool HB8 = false>
__device__ __forceinline__ void moe_combine_phase(const void* xin, void* xout, const void* y, const float* g, bf16_t* hb, float* outf, int wg, int nwg, int wave_s) {
    const int tid = opaque_tid(wave_s), lane = tid & 63, wv = tid >> 6;
    for (int row = wg * 8 + wv; row < T_; row += nwg * 8) {
        const size_t r4 = (size_t)row * (D_ / 4);
        float4 v[8]; float ss = 0.f;
#pragma unroll
        for (int i = 0; i < 4; ++i) { const int e0 = 8 * (lane + 64 * i);
            float4 a = ld_x4<XIN16>(xin, r4 + e0 / 4), b = ld_x4<XIN16>(xin, r4 + e0 / 4 + 1);
            if (Y8) { const u32x2 p = *(const u32x2*)((const unsigned char*)y + (size_t)(2 * row) * D_ + e0), q2 = *(const u32x2*)((const unsigned char*)y + (size_t)(2 * row + 1) * D_ + e0);
                const f32x2 p0 = __builtin_amdgcn_cvt_pk_f32_fp8((int)p.x, false), p1 = __builtin_amdgcn_cvt_pk_f32_fp8((int)p.x, true), p2 = __builtin_amdgcn_cvt_pk_f32_fp8((int)p.y, false), p3 = __builtin_amdgcn_cvt_pk_f32_fp8((int)p.y, true);
                const f32x2 s0 = __builtin_amdgcn_cvt_pk_f32_fp8((int)q2.x, false), s1 = __builtin_amdgcn_cvt_pk_f32_fp8((int)q2.x, true), s2 = __builtin_amdgcn_cvt_pk_f32_fp8((int)q2.y, false), s3 = __builtin_amdgcn_cvt_pk_f32_fp8((int)q2.y, true);
                a.x += (p0[0] + s0[0]) * (1.f / 64.f); a.y += (p0[1] + s0[1]) * (1.f / 64.f); a.z += (p1[0] + s1[0]) * (1.f / 64.f); a.w += (p1[1] + s1[1]) * (1.f / 64.f);
                b.x += (p2[0] + s2[0]) * (1.f / 64.f); b.y += (p2[1] + s2[1]) * (1.f / 64.f); b.z += (p3[0] + s3[0]) * (1.f / 64.f); b.w += (p3[1] + s3[1]) * (1.f / 64.f); }
            else { const u32x4 p = *(const u32x4*)((const bf16_t*)y + (size_t)(2 * row) * D_ + e0), q2 = *(const u32x4*)((const bf16_t*)y + (size_t)(2 * row + 1) * D_ + e0);
                a.x += bflo(p.x) + bflo(q2.x); a.y += bfhi(p.x) + bfhi(q2.x); a.z += bflo(p.y) + bflo(q2.y); a.w += bfhi(p.y) + bfhi(q2.y);
                b.x += bflo(p.z) + bflo(q2.z); b.y += bfhi(p.z) + bfhi(q2.z); b.z += bflo(p.w) + bflo(q2.w); b.w += bfhi(p.w) + bfhi(q2.w); }
            v[2 * i] = a; v[2 * i + 1] = b;
            ss += a.x * a.x + a.y * a.y + a.z * a.z + a.w * a.w + b.x * b.x + b.y * b.y + b.z * b.z + b.w * b.w; }
        ss = wave_sum(ss);
        const float r = rsqrtf(ss * (1.f / D_) + 1e-6f);
#pragma unroll
        for (int i = 0; i < 4; ++i) { const int e0 = 8 * (lane + 64 * i); const float4 ga = *(const float4*)(g + e0), gb = *(const float4*)(g + e0 + 4); const float4 a = v[2 * i], b = v[2 * i + 1];
            if (hb) { if (WRITE_X) { st_x4<XOUT16>(xout, r4 + e0 / 4, a); st_x4<XOUT16>(xout, r4 + e0 / 4 + 1, b); }
                if (HB8) { const float r4s = 4.f * r; u32x2 o; o.x = pk4_fp8(a.x * r4s * ga.x, a.y * r4s * ga.y, a.z * r4s * ga.z, a.w * r4s * ga.w); o.y = pk4_fp8(b.x * r4s * gb.x, b.y * r4s * gb.y, b.z * r4s * gb.z, b.w * r4s * gb.w);
                    *(u32x2*)((unsigned char*)hb + (size_t)row * D_ + e0) = o; }
                else { u32x4 o; o.x = cvt_pk_bf16(a.x * r * ga.x, a.y * r * ga.y); o.y = cvt_pk_bf16(a.z * r * ga.z, a.w * r * ga.w); o.z = cvt_pk_bf16(b.x * r * gb.x, b.y * r * gb.y); o.w = cvt_pk_bf16(b.z * r * gb.z, b.w * r * gb.w);
                *(u32x4*)(hb + (size_t)row * D_ + e0) = o; } }
            else { float4 oa, ob; oa.x = a.x * r * ga.x; oa.y = a.y * r * ga.y; oa.z = a.z * r * ga.z; oa.w = a.w * r * ga.w; ob.x = b.x * r * gb.x; ob.y = b.y * r * gb.y; ob.z = b.z * r * gb.z; ob.w = b.w * r * gb.w;
                *(float4*)(outf + (size_t)row * D_ + e0) = oa; *(float4*)(outf + (size_t)row * D_ + e0 + 4) = ob; } }
    }
}
__device__ __forceinline__ void moe_combine_phase2(const float* x1, const bf16_t* y, const float* g, bf16_t* hb, float* xd, int wg, int nwg, int wave_s) {
    const int tid = opaque_tid(wave_s), lane = tid & 63, wv = tid >> 6;
    for (int row = wg * 8 + wv; row < T_; row += nwg * 8) {
        const float4* xr = (const float4*)(x1 + (size_t)row * D_); float4* xo = (float4*)(xd + (size_t)row * D_);
        const u32x2* y0 = (const u32x2*)(y + (size_t)(2 * row) * D_); const u32x2* y1 = (const u32x2*)(y + (size_t)(2 * row + 1) * D_);
        float4 v[8]; float ss = 0.f;
#pragma unroll
        for (int i = 0; i < 8; ++i) { v[i] = xr[lane + 64 * i]; const u32x2 a = y0[lane + 64 * i], b = y1[lane + 64 * i];
            v[i].x += bflo(a.x) + bflo(b.x); v[i].y += bfhi(a.x) + bfhi(b.x); v[i].z += bflo(a.y) + bflo(b.y); v[i].w += bfhi(a.y) + bfhi(b.y);
            ss += v[i].x * v[i].x + v[i].y * v[i].y + v[i].z * v[i].z + v[i].w * v[i].w; }
        ss = wave_sum(ss);
        const float r = rsqrtf(ss * (1.f / D_) + 1e-6f);
#pragma unroll
        for (int i = 0; i < 8; ++i) { const float4 gg = ((const float4*)g)[lane + 64 * i]; xo[lane + 64 * i] = v[i];
            u32x2 o; o.x = cvt_pk_bf16(v[i].x * r * gg.x, v[i].y * r * gg.y); o.y = cvt_pk_bf16(v[i].z * r * gg.z, v[i].w * r * gg.w);
            *(u32x2*)(hb + (size_t)row * D_ + (lane + 64 * i) * 4) = o; }
    }
}
__device__ __forceinline__ void lb_phase(const float* lbp, float* lbv, int wg, int nwg, int wave_s) {
    const int tid = opaque_tid(wave_s);
    for (int i = wg * NTHR + tid; i < 2048; i += nwg * NTHR) lbv[i] = 1.f / (1.f + __expf(lbp[i] - lbp[2048 + i]));
}
template <bool S8> struct EpiInC {
    bf16_t *qs, *vT, *sg, *lf; const float* lbv;
    static constexpr float SC = S8 ? (1.f / 256.f) : 1.f;
    __device__ __forceinline__ bool swapped(int pn) const { return pn >= 16 && pn < 24; }
    __device__ __forceinline__ int brow0(int pn) const { return pn * 256; }
    __device__ __forceinline__ void operator()(const f32x4 (&acc)[8][4], int pm, int pn, int wr, int wc, int fr, int fq) const {
        if (pn < 8 || pn >= 24) {
            bf16_t* dst = (pn < 8 ? qs : sg) + (pn & 7) * 256;
#pragma unroll
            for (int m = 0; m < 8; ++m) { int row = pm * 256 + arow_of<8>(wr, m, fr); asm volatile("" : "+v"(row));
#pragma unroll
                for (int hf = 0; hf < 2; ++hf) { u32x4 w; const f32x4 a = acc[m][2 * hf], b = acc[m][2 * hf + 1];
                    w.x = cvt_pk_bf16(silu_fast(SC * a[0]), silu_fast(SC * a[1])); w.y = cvt_pk_bf16(silu_fast(SC * a[2]), silu_fast(SC * a[3]));
                    w.z = cvt_pk_bf16(silu_fast(SC * b[0]), silu_fast(SC * b[1])); w.w = cvt_pk_bf16(silu_fast(SC * b[2]), silu_fast(SC * b[3]));
                    *(u32x4*)(dst + (size_t)row * 2048 + hf * 128 + wc * 32 + 8 * fq) = w; } }
        } else if (pn < 16) {
            const int cb = (pn - 8) * 256; f32x4 lb[4];
#pragma unroll
            for (int n = 0; n < 4; ++n) lb[n] = *(const f32x4*)(lbv + cb + bcol_of<4>(wc, n, fq, 0));
#pragma unroll
            for (int m = 0; m < 8; ++m) { int row = pm * 256 + arow_of<8>(wr, m, fr); asm volatile("" : "+v"(row));
#pragma unroll
                for (int hf = 0; hf < 2; ++hf) { float o[8];
#pragma unroll
                    for (int e = 0; e < 8; ++e) { const float z = acc[m][2 * hf + (e >> 2)][e & 3], l = lb[2 * hf + (e >> 2)][e & 3]; o[e] = 0.6931471805599453f * __builtin_amdgcn_logf(l + (1.f - l) * __builtin_amdgcn_rcpf(1.f + __builtin_amdgcn_exp2f((-1.4426950408889634f * SC) * z))); }
                    u32x4 w; w.x = cvt_pk_bf16(o[0], o[1]); w.y = cvt_pk_bf16(o[2], o[3]); w.z = cvt_pk_bf16(o[4], o[5]); w.w = cvt_pk_bf16(o[6], o[7]);
                    *(u32x4*)(lf + (size_t)row * 2048 + cb + hf * 128 + wc * 32 + 8 * fq) = w; } }
        } else {
            bf16_t* dst = vT + (size_t)((pn - 16) * 256) * T_ + pm * 256;
#pragma unroll
            for (int m = 0; m < 8; ++m) { int f = arow_of<8>(wr, m, fr); asm volatile("" : "+v"(f));
#pragma unroll
                for (int hf = 0; hf < 2; ++hf) { u32x4 w; const f32x4 a = acc[m][2 * hf], b = acc[m][2 * hf + 1];
                    w.x = cvt_pk_bf16(SC * a[0], SC * a[1]); w.y = cvt_pk_bf16(SC * a[2], SC * a[3]); w.z = cvt_pk_bf16(SC * b[0], SC * b[1]); w.w = cvt_pk_bf16(SC * b[2], SC * b[3]);
                    *(u32x4*)(dst + (size_t)f * T_ + hf * 128 + wc * 32 + 8 * fq) = w; } }
        }
    }
};
__device__ __forceinline__ int bcol_to_slot2(int c) { const int c5 = c & 31; return (c & ~31) + ((c5 >> 2) & 1) * 16 + (c5 >> 3) * 4 + (c5 & 3); }
template <bool BG>
__device__ __forceinline__ void hgrn_kv_phase(LAS unsigned char* lds, const bf16_t* lf, const bf16_t* vT, float* dec, bf16_t* KVT2, const float* bw0, const float* bw1, const float* bw2, unsigned char* bgu, unsigned char* bdn, int tile0, int wg, int nwg, int wave_s) {
    typedef Core<4, 2> C;
    const int tid = opaque_tid(wave_s), wid = __builtin_amdgcn_readfirstlane(tid >> 6), lane = tid & 63, wr = wid >> 2, wc = wid & 3, fr = lane & 15, fq = lane >> 4;
    LAS unsigned char* ldsB = lds + 65536;
    LAS float* tot = (LAS float*)(lds + 131072);
    unsigned aoff[2];
#pragma unroll
    for (int i = 0; i < 2; ++i) { int r, c; C::apiece(tid, i, r, c); aoff[i] = (unsigned)(r * T_ + c) * 2u; }
    const int q4 = lane & 31, s = wid * 2 + (lane >> 5), dk0 = 4 * q4;
    for (int u = wg; u < 2048; u += nwg) {
        const int n = u >> 4, h = u & 15;
        const size_t t0 = (size_t)n * 128 + s * 8; const int col = h * 128 + dk0;
        float4 bg[3][8];
        if (BG) {
#pragma unroll
            for (int b3 = 0; b3 < 3; ++b3) bg_issue(bw0, bw1, bw2, tile0 + 3 * u + b3, bg[b3], tid); }
        float l[8][4]; float sm[4] = {0.f, 0.f, 0.f, 0.f};
#pragma unroll
        for (int j = 0; j < 8; ++j) { const u32x2 w = *(const u32x2*)(lf + (t0 + j) * 2048 + col); l[j][0] = bflo(w.x); l[j][1] = bfhi(w.x); l[j][2] = bflo(w.y); l[j][3] = bfhi(w.y);
#pragma unroll
            for (int d = 0; d < 4; ++d) sm[d] += l[j][d]; }
        *(LAS f32x4*)(tot + s * 128 + dk0) = (f32x4){sm[0], sm[1], sm[2], sm[3]};
        __syncthreads();
        { const char* Vb = (const char*)(vT + (size_t)(h * 128) * T_ + n * 128); C::stage_a(lds, Vb, aoff, 0u, wid); C::stage_a(lds + 16384, Vb, aoff, 128u, wid); }
        float pre[4] = {0.f, 0.f, 0.f, 0.f}, tt[4] = {0.f, 0.f, 0.f, 0.f};
#pragma unroll
        for (int q = 0; q < 16; ++q) { const f32x4 v = *(const LAS f32x4*)(tot + q * 128 + dk0);
#pragma unroll
            for (int d = 0; d < 4; ++d) { tt[d] += v[d]; pre[d] += (q < s) ? v[d] : 0.f; } }
        if (s == 0) *(f32x4*)(dec + (size_t)n * 2048 + col) = (f32x4){__expf(tt[0]), __expf(tt[1]), __expf(tt[2]), __expf(tt[3])};
        float kh[4][8];
#pragma unroll
        for (int j = 0; j < 8; ++j)
#pragma unroll
            for (int d = 0; d < 4; ++d) { pre[d] += l[j][d]; kh[d][j] = (1.f - __expf(l[j][d])) * __expf(tt[d] - pre[d]); }
        const int jj = s * 8;
#pragma unroll
        for (int d = 0; d < 4; ++d) { u32x4 w; w.x = cvt_pk_bf16(kh[d][0], kh[d][1]); w.y = cvt_pk_bf16(kh[d][2], kh[d][3]); w.z = cvt_pk_bf16(kh[d][4], kh[d][5]); w.w = cvt_pk_bf16(kh[d][6], kh[d][7]);
            *(LAS u32x4*)(ldsB + (jj >> 6) * 16384 + lds_byte(bcol_to_slot2(dk0 + d), jj & 63)) = w; }
        WAIT_V0(); __syncthreads();
        f32x4 acc[4][2]; C::zero(acc);
        C::compute(lds, ldsB, acc, wr, wc, fr, fq); C::compute(lds + 16384, ldsB + 16384, acc, wr, wc, fr, fq);
        __syncthreads();
        bf16_t* dst = KVT2 + (size_t)u * 16384;
#pragma unroll
        for (int m = 0; m < 4; ++m) { const f32x4 a = acc[m][0], b = acc[m][1]; u32x4 w;
            w.x = cvt_pk_bf16(a[0], a[1]); w.y = cvt_pk_bf16(a[2], a[3]); w.z = cvt_pk_bf16(b[0], b[1]); w.w = cvt_pk_bf16(b[2], b[3]);
            *(u32x4*)(dst + (wr * 64 + m * 16 + fr) * 128 + wc * 32 + 8 * fq) = w; }
        if (BG) {
#pragma unroll
            for (int b3 = 0; b3 < 3; ++b3) bg_write(lds + b3 * 18432, bg[b3], (tile0 + 3 * u + b3) >= 8192 ? 32.f : 64.f, tid);
            __syncthreads();
#pragma unroll
            for (int b3 = 0; b3 < 3; ++b3) bg_store(lds + b3 * 18432, bgu, bdn, tile0 + 3 * u + b3, tid);
            __syncthreads(); }
    }
}
__device__ __forceinline__ void hgrn_scan_phase(const bf16_t* KVT2, const float* dec, bf16_t* STb2, int wg, int nwg, int wave_s) {
    const int tid = opaque_tid(wave_s);
    for (int e = (wg * NTHR + tid) * 2; e < 262144; e += nwg * NTHR * 2) {
        const int c = (e >> 14) * 128 + (e & 127);
        float s0 = 0.f, s1 = 0.f;
        for (int n0 = 0; n0 < 128; n0 += 8) {
            unsigned kv[8]; float2 d[8];
#pragma unroll
            for (int i = 0; i < 8; ++i) { kv[i] = *(const unsigned*)(KVT2 + (size_t)(n0 + i) * 262144 + e); d[i] = *(const float2*)(dec + (size_t)(n0 + i) * 2048 + c); }
#pragma unroll
            for (int i = 0; i < 8; ++i) { *(unsigned*)(STb2 + (size_t)(n0 + i) * 262144 + e) = cvt_pk_bf16(s0, s1); s0 = d[i].x * s0 + bflo(kv[i]); s1 = d[i].y * s1 + bfhi(kv[i]); }
        }
    }
}
template <bool BG>
__device__ __forceinline__ void hgrn_out_phase(LAS unsigned char* lds, const bf16_t* qs, const bf16_t* lf, const bf16_t* vT, const bf16_t* STb2, const bf16_t* sg,
                                               const float* gain, bf16_t* mixb, const float* bw0, const float* bw1, const float* bw2, unsigned char* bgu, unsigned char* bdn, int tile0, int wg, int nwg, int wave_s) {
    typedef Core<4, 2> C;
    const int tid = opaque_tid(wave_s), wid = __builtin_amdgcn_readfirstlane(tid >> 6), lane = tid & 63, wr = wid >> 2, wc = wid & 3, fr = lane & 15, fq = lane >> 4;
    LAS unsigned char* lQ = lds; LAS unsigned char* lK = lds + 32768; LAS unsigned char* lS = lds + 65536; LAS unsigned char* lV = lds + 98304;
    LAS float* stat = (LAS float*)(lds + 131072);
    LAS float* tot = (LAS float*)(lds + 133120);
    unsigned soff[2], voff[2];
#pragma unroll
    for (int i = 0; i < 2; ++i) { int r, c; C::bpiece(tid, i, r, c); soff[i] = (unsigned)(r * 128 + c) * 2u; voff[i] = (unsigned)(r * T_ + c) * 2u; }
    const int q4 = lane & 31, s = wid * 2 + (lane >> 5), dk0 = 4 * q4;
    u32x2 lw[8], qw8[8];
    if (wg < 2048) { const size_t t0 = (size_t)(wg >> 4) * 128 + s * 8; const int col = (wg & 15) * 128 + dk0;
#pragma unroll
        for (int j = 0; j < 8; ++j) { lw[j] = *(const u32x2*)(lf + (t0 + j) * 2048 + col); qw8[j] = *(const u32x2*)(qs + (t0 + j) * 2048 + col); } }
    for (int u = wg; u < 2048; u += nwg) {
        const int n = u >> 4, h = u & 15;
        const char* Sb = (const char*)(STb2 + (size_t)u * 16384); const char* Vb = (const char*)(vT + (size_t)(h * 128) * T_ + n * 128);
        float4 bg[3][8];
        if (BG) {
#pragma unroll
            for (int b3 = 0; b3 < 3; ++b3) bg_issue(bw0, bw1, bw2, tile0 + 3 * u + b3, bg[b3], tid); }
        {
            const size_t t0 = (size_t)n * 128 + s * 8; const int col = h * 128 + dk0;
            float l[8][4]; float sm[4] = {0.f, 0.f, 0.f, 0.f};
#pragma unroll
            for (int j = 0; j < 8; ++j) { const u32x2 w = lw[j]; l[j][0] = bflo(w.x); l[j][1] = bfhi(w.x); l[j][2] = bflo(w.y); l[j][3] = bfhi(w.y);
#pragma unroll
                for (int d = 0; d < 4; ++d) sm[d] += l[j][d]; }
            *(LAS f32x4*)(tot + s * 128 + dk0) = (f32x4){sm[0], sm[1], sm[2], sm[3]};
            __syncthreads();
#pragma unroll
            for (int t = 0; t < 2; ++t) { C::stage_b(lS + t * 16384, Sb, soff, t * 128u, wid); C::stage_b(lV + t * 16384, Vb, voff, t * 128u, wid); }
            float pre[4] = {0.f, 0.f, 0.f, 0.f};
#pragma unroll
            for (int q = 0; q < 16; ++q) { const f32x4 v = *(const LAS f32x4*)(tot + q * 128 + dk0);
#pragma unroll
                for (int d = 0; d < 4; ++d) pre[d] += (q < s) ? v[d] : 0.f; }
#pragma unroll
            for (int j = 0; j < 8; ++j) { const u32x2 qw = qw8[j];
                const float qv[4] = {bflo(qw.x), bfhi(qw.x), bflo(qw.y), bfhi(qw.y)}; float oq[4], ok[4];
#pragma unroll
                for (int d = 0; d < 4; ++d) { pre[d] += l[j][d]; oq[d] = qv[d] * __expf(pre[d]); ok[d] = (1.f - __expf(l[j][d])) * __expf(-pre[d]); }
                const int tk = s * 8 + j;
                u32x2 w; w.x = cvt_pk_bf16(oq[0], oq[1]); w.y = cvt_pk_bf16(oq[2], oq[3]); *(LAS u32x2*)(lQ + (dk0 >> 6) * 16384 + lds_byte(tk, dk0 & 63)) = w;
                w.x = cvt_pk_bf16(ok[0], ok[1]); w.y = cvt_pk_bf16(ok[2], ok[3]); *(LAS u32x2*)(lK + (dk0 >> 6) * 16384 + lds_byte(bcol_to_slot2(tk), dk0 & 63)) = w; }
        }
        WAIT_V0(); __syncthreads();
        if (u + nwg < 2048) { const int un = u + nwg; const size_t t0n = (size_t)(un >> 4) * 128 + s * 8; const int coln = (un & 15) * 128 + dk0;
#pragma unroll
            for (int j = 0; j < 8; ++j) { lw[j] = *(const u32x2*)(lf + (t0n + j) * 2048 + coln); qw8[j] = *(const u32x2*)(qs + (t0n + j) * 2048 + coln); } }
        {
            f32x4 sa[4][2]; C::zero(sa);
            C::compute(lQ, lK, sa, wr, wc, fr, fq); C::compute(lQ + 16384, lK + 16384, sa, wr, wc, fr, fq);
            __syncthreads();
#pragma unroll
            for (int m = 0; m < 4; ++m) { const int i = wr * 64 + m * 16 + fr; const int j0 = wc * 32 + 8 * fq;
                float p[8];
#pragma unroll
                for (int e = 0; e < 8; ++e) { const float sv = e < 4 ? sa[m][0][e] : sa[m][1][e - 4]; p[e] = (j0 + e <= i) ? sv : 0.f; }
                u32x4 w; w.x = cvt_pk_bf16(p[0], p[1]); w.y = cvt_pk_bf16(p[2], p[3]); w.z = cvt_pk_bf16(p[4], p[5]); w.w = cvt_pk_bf16(p[6], p[7]);
                *(LAS u32x4*)(lK + (wc >> 1) * 16384 + lds_byte(i, j0 & 63)) = w; }
            __syncthreads();
        }
        f32x4 acc[4][2]; C::zero(acc);
        C::compute(lQ, lS, acc, wr, wc, fr, fq); C::compute(lQ + 16384, lS + 16384, acc, wr, wc, fr, fq);
        C::compute(lK, lV, acc, wr, wc, fr, fq); C::compute(lK + 16384, lV + 16384, acc, wr, wc, fr, fq);
#pragma unroll
        for (int m = 0; m < 4; ++m) { float ss = 0.f;
#pragma unroll
            for (int nn = 0; nn < 2; ++nn)
#pragma unroll
                for (int e = 0; e < 4; ++e) { const float v = acc[m][nn][e]; ss += v * v; }
            ss += __shfl_xor(ss, 16); ss += __shfl_xor(ss, 32);
            if (fq == 0) stat[(wr * 64 + m * 16 + fr) * 4 + wc] = ss; }
        __syncthreads();
#pragma unroll
        for (int m = 0; m < 4; ++m) { const int i = wr * 64 + m * 16 + fr;
            const float ss = stat[i * 4] + stat[i * 4 + 1] + stat[i * 4 + 2] + stat[i * 4 + 3];
            const float rstd = rsqrtf(ss * (1.f / 128.f) + 1e-6f);
            const size_t t = (size_t)n * 128 + i; const int c0 = h * 128 + wc * 32 + 8 * fq;
            const u32x4 g8 = *(const u32x4*)(sg + t * 2048 + c0);
            const f32x4 g0 = *(const f32x4*)(gain + c0), g1 = *(const f32x4*)(gain + c0 + 4);
            const f32x4 a = acc[m][0], b = acc[m][1];
            u32x4 w; w.x = cvt_pk_bf16(a[0] * rstd * g0[0] * bflo(g8.x), a[1] * rstd * g0[1] * bfhi(g8.x)); w.y = cvt_pk_bf16(a[2] * rstd * g0[2] * bflo(g8.y), a[3] * rstd * g0[3] * bfhi(g8.y));
            w.z = cvt_pk_bf16(b[0] * rstd * g1[0] * bflo(g8.z), b[1] * rstd * g1[1] * bfhi(g8.z)); w.w = cvt_pk_bf16(b[2] * rstd * g1[2] * bflo(g8.w), b[3] * rstd * g1[3] * bfhi(g8.w));
            *(u32x4*)(mixb + t * 2048 + c0) = w; }
        __syncthreads();
        if (BG) {
#pragma unroll
            for (int b3 = 0; b3 < 3; ++b3) bg_write(lds + b3 * 18432, bg[b3], (tile0 + 3 * u + b3) >= 8192 ? 32.f : 64.f, tid);
            __syncthreads();
#pragma unroll
            for (int b3 = 0; b3 < 3; ++b3) bg_store(lds + b3 * 18432, bgu, bdn, tile0 + 3 * u + b3, tid);
            __syncthreads(); }
    }
}
#define LDS_BYTES 147456
#define MiB(x) ((size_t)(x) << 20)
#define WS_CTL     ((size_t)0)
#define CTL_BYTES  65536
#define CTL_CNT    1024
#define CTL_BAR    4096
#define WS_X1      MiB(1)
#define WS_HB      MiB(129)
#define WS_ROPE    MiB(193)
#define WS_WSM     MiB(225)
#define WS_WR      MiB(226)
#define WS_WINAB   MiB(228)
#define WS_WOUTAB  MiB(252)
#define WS_WINC    MiB(260)
#define WS_WOUTC   MiB(292)
#define WS_WGU     MiB(300)
#define WS_WDN     MiB(812)
#define WS_SCR     MiB(1068)
#define WS_QB      (WS_SCR)
#define WS_KVT     (WS_SCR + MiB(224))
#define WS_STB     (WS_SCR + MiB(352))
#define WS_MIXB    (WS_SCR + MiB(416))
#define WS_VNT     (WS_SCR + MiB(480))
#define WS_HID     (WS_SCR)
#define WS_Y       (WS_SCR + MiB(80))
#define WS_LIST    (WS_SCR + MiB(208))
#define WS_GATE    (WS_SCR + MiB(210))
struct FArgs { const float* in[21]; float* out; unsigned char* ws; int ph_lo, ph_hi; };
#define WS1_QS     (WS_SCR)
#define WS1_VT     (WS_SCR + MiB(64))
#define WS1_SG     (WS_SCR + MiB(128))
#define WS1_LF     (WS_SCR + MiB(192))
#define WS1_QH     (WS_SCR + MiB(320))
#define WS1_KT     (WS_SCR + MiB(480))
#define WS1_KVT    (WS_SCR + MiB(544))
#define WS1_STB    (WS_SCR + MiB(672))
#define WS1_DEC    (WS_SCR + MiB(736))
#define WS_Y0      (WS_SCR + MiB(740))
#define WS_LBV     (WS_WR + MiB(1))
#define N_PHASES 20
#ifndef FP8_L0
#define FP8_L0 1
#endif
#ifndef FP8_L1
#define FP8_L1 1
#endif
#ifndef BGCONV_L1
#define BGCONV_L1 0
#endif
#ifndef F8_INC
#define F8_INC 1
#endif
#ifndef XB16
#define XB16 0
#endif
#ifndef Y8_L0
#define Y8_L0 1
#endif
#ifndef Y8_L1
#define Y8_L1 1
#endif
__global__ void __launch_bounds__(NTHR, 2) fwd(FArgs a) {
    extern __shared__ __attribute__((aligned(16))) unsigned char lds_raw[];
    LAS unsigned char* lds = (LAS unsigned char*)lds_raw;
    const int lo = a.ph_lo, hi = a.ph_hi;
    const int wave_s = __builtin_amdgcn_readfirstlane(threadIdx.x >> 6);
    const int wg = blockIdx.x, nwg = gridDim.x;
    if (threadIdx.x == 0) *(LAS u32x4*)(lds + LDS_BYTES - 16) = (u32x4){0u, 0u, 0u, 0u};
    __syncthreads();
    XcdBarrier bar; bar.bar = (unsigned*)(a.ws + WS_CTL + CTL_BAR); bar.x = 0; bar.st = (volatile LAS unsigned*)(lds + LDS_BYTES - 16);
    if (hi - lo > 1) bar = xcd_barrier_post((unsigned*)(a.ws + WS_CTL + CTL_BAR), (volatile LAS unsigned*)(lds + LDS_BYTES - 16));
#define GRID_BAR() xcd_barrier(bar)
#define IN(k) (lo <= (k) && (k) < hi)
#define BOTH(k) (IN(k) && IN((k) + 1))
#ifndef DUP_MASK
#define DUP_MASK 0
#endif
#define DUP(k) ((DUP_MASK >> (k)) & 1)
#define PH(k, ...) if (IN(k)) { __VA_ARGS__ if (DUP(k)) { GRID_BAR(); __VA_ARGS__ } if (BOTH(k)) GRID_BAR(); }
    unsigned char* ws = a.ws;
    float* x1 = (float*)(ws + WS_X1); bf16_t* xb = (bf16_t*)(ws + WS1_QH);     bf16_t* hb = (bf16_t*)(ws + WS_HB);
    bf16_t* WsM = (bf16_t*)(ws + WS_WSM); bf16_t* WrT = (bf16_t*)(ws + WS_WR); float* lbv = (float*)(ws + WS_LBV);
    bf16_t* winab = (bf16_t*)(ws + WS_WINAB); bf16_t* woutab = (bf16_t*)(ws + WS_WOUTAB); bf16_t* winc = (bf16_t*)(ws + WS_WINC); bf16_t* woutc = (bf16_t*)(ws + WS_WOUTC);
    bf16_t* wgu = (bf16_t*)(ws + WS_WGU); bf16_t* wdn = (bf16_t*)(ws + WS_WDN);
    bf16_t* qb = (bf16_t*)(ws + WS_QB); bf16_t* KVT = (bf16_t*)(ws + WS_KVT); bf16_t* STb = (bf16_t*)(ws + WS_STB); bf16_t* mixb = (bf16_t*)(ws + WS_MIXB); bf16_t* vnT = (bf16_t*)(ws + WS_VNT);
    unsigned char* hb8 = ws + WS_ROPE;
    bf16_t* hid = (bf16_t*)(ws + WS_HID); bf16_t* yb = (bf16_t*)(ws + WS_Y); bf16_t* yb0 = (bf16_t*)(ws + WS_Y0); int* list = (int*)(ws + WS_LIST); float* gate = (float*)(ws + WS_GATE);
    int* cnt = (int*)(ws + WS_CTL + CTL_CNT);
    const size_t TS = (size_t)T_ * 1024; const size_t WGU_L = (size_t)32 * 2048 * 2048, WDN_L = (size_t)32 * 2048 * 1024;
    PH(0, {
        { ConvJob J{a.in[4], winab, 2048, 6144, 1, 6144, 6144, 6144, 0, 0}; conv_phase(lds, J, wg, nwg, wave_s); }
        { ConvJob J{a.in[9], woutab, 2048, 2048, 1, 2048, 2048, 2048, 0, 0}; conv_phase(lds, J, wg, nwg, wave_s); }
        { ConvJob J{a.in[10], winc, 2048, 8192, 1, 8192, 8192, 8192, 0, 0}; if (F8_INC) conv8_phase(lds, J, 64.f, wg, nwg, wave_s); else conv_phase(lds, J, wg, nwg, wave_s); }
        { ConvJob J{a.in[13], woutc, 2048, 2048, 1, 2048, 2048, 2048, 0, 0}; conv_phase(lds, J, wg, nwg, wave_s); }
        for (int L = 0; L < 2; ++L) {
            const bool f8 = L ? (FP8_L1 != 0) : (FP8_L0 != 0);
            if (L == 1 && BGCONV_L1 && FP8_L1) continue;
            const float* sg_ = a.in[18] + (size_t)L * 32 * 2048 * 1024; const float* su_ = a.in[19] + (size_t)L * 32 * 2048 * 1024; const float* sd_ = a.in[20] + (size_t)L * 32 * 2048 * 1024;
            ConvJob Jg{sg_, wgu + L * WGU_L, 2048, 1024, 32, 2048, 128, 256, 0, 0}, Ju{su_, wgu + L * WGU_L, 2048, 1024, 32, 2048, 128, 256, 128, 0}, Jd{sd_, wdn + L * WDN_L, 1024, 2048, 32, 2048, 2048, 2048, 0, 0};
            if (f8) { conv8_phase(lds, Jg, 64.f, wg, nwg, wave_s); conv8_phase(lds, Ju, 64.f, wg, nwg, wave_s); conv8_phase(lds, Jd, 32.f, wg, nwg, wave_s); }
            else { conv_phase(lds, Jg, wg, nwg, wave_s); conv_phase(lds, Ju, wg, nwg, wave_s); conv_phase(lds, Jd, wg, nwg, wave_s); }
        }
        wr_phase(a.in[14], a.in[16], WrT, wg, nwg, wave_s);
        wr_phase(a.in[14] + 2048 * 4, a.in[16] + 2048 * 32, WrT + 64 * 2048, wg, nwg, wave_s);
        wsm_phase(a.in[7], WsM, wg, nwg, wave_s);
        lb_phase(a.in[11], lbv, wg, nwg, wave_s);
        norm_rows_bf16(a.in[0], a.in[1], hb, wg, nwg, wave_s);
    })

    PH(2, { EpiInAB E{qb, qb + TS, qb + 3 * TS, qb + 4 * TS, qb + 5 * TS, qb + 6 * TS}; gemm_phase(lds, hb, winab, 64, 24, 2048, E, wave_s);
 })
    PH(3, { gmlp_norm_phase(lds, qb + 6 * TS, vnT, a.in[6], wg, nwg, wave_s); ret_kv_phase(lds, qb + 3 * TS, qb + TS, KVT, wg, nwg, wave_s); })
    PH(4, { ret_scan_phase(KVT, STb, wg, nwg, wave_s); })
    PH(5, { ret_out_phase(lds, qb, qb + TS, qb + 3 * TS, STb, qb + 4 * TS, a.in[5], mixb, wg, nwg, wave_s);
                 gmlp_mix_phase(lds, WsM, vnT, qb + 5 * TS, a.in[8], mixb, wg, nwg, wave_s); })
    PH(6, { EpiResidual E{a.in[0], x1}; gemm_phase(lds, mixb, woutab, 64, 8, 2048, E, wave_s); })
    PH(7, { moe_route_phase<false>(lds, x1, a.in[2], hb, FP8_L0 ? hb8 : nullptr, WrT, a.in[15], a.in[17], cnt, list, gate, wg, nwg, wave_s); })
    PH(8, { moe_gu_phase<FP8_L0 != 0>(lds, FP8_L0 ? (const void*)hb8 : (const void*)hb, wgu, cnt, list, hid, wg, nwg, wave_s); })
    PH(9, { moe_down_phase<FP8_L0 != 0, Y8_L0 != 0>(lds, hid, wdn, cnt, list, gate, yb, wg, nwg, wave_s); })
    PH(10, { moe_combine_phase<true, Y8_L0 != 0, false, XB16 != 0, F8_INC != 0>(x1, XB16 ? (void*)xb : (void*)x1, yb, a.in[1] + D_, hb, nullptr, wg, nwg, wave_s); })
    bf16_t* qs = (bf16_t*)(ws + WS1_QS); bf16_t* vT1 = (bf16_t*)(ws + WS1_VT); bf16_t* sg1 = (bf16_t*)(ws + WS1_SG); bf16_t* lf = (bf16_t*)(ws + WS1_LF);
    bf16_t* qh = (bf16_t*)(ws + WS1_QH); bf16_t* kt = (bf16_t*)(ws + WS1_KT); bf16_t* KVT2 = (bf16_t*)(ws + WS1_KVT); bf16_t* STb2 = (bf16_t*)(ws + WS1_STB); float* dec = (float*)(ws + WS1_DEC);
    PH(11, { EpiInC<F8_INC != 0> E{qs, vT1, sg1, lf, lbv}; if (F8_INC) gemm_phase_f8(lds, (const unsigned char*)hb, (const unsigned char*)winc, 64, 32, 2048, E, wave_s); else gemm_phase(lds, hb, winc, 64, 32, 2048, E, wave_s); })
    PH(12, { hgrn_kv_phase<(BGCONV_L1 && FP8_L1)>(lds, lf, vT1, dec, KVT2, a.in[18] + (size_t)32 * 2048 * 1024, a.in[19] + (size_t)32 * 2048 * 1024, a.in[20] + (size_t)32 * 2048 * 1024, (unsigned char*)(wgu + WGU_L), (unsigned char*)(wdn + WDN_L), 0, wg, nwg, wave_s); })
    PH(13, { hgrn_scan_phase(KVT2, dec, STb2, wg, nwg, wave_s); })
    PH(14, { hgrn_out_phase<(BGCONV_L1 && FP8_L1)>(lds, qs, lf, vT1, STb2, sg1, a.in[12], mixb, a.in[18] + (size_t)32 * 2048 * 1024, a.in[19] + (size_t)32 * 2048 * 1024, a.in[20] + (size_t)32 * 2048 * 1024, (unsigned char*)(wgu + WGU_L), (unsigned char*)(wdn + WDN_L), 6144, wg, nwg, wave_s); })
    PH(15, { if (XB16) { EpiResidual16 E{xb}; gemm_phase(lds, mixb, woutc, 64, 8, 2048, E, wave_s); } else { EpiResidual E{x1, x1}; gemm_phase(lds, mixb, woutc, 64, 8, 2048, E, wave_s); } })
    PH(16, { moe_route_phase<XB16 != 0>(lds, XB16 ? (const void*)xb : (const void*)x1, a.in[2] + D_, hb, FP8_L1 ? hb8 : nullptr, WrT + 64 * 2048, a.in[15] + 4, a.in[17] + 32, cnt + 32, list, gate, wg, nwg, wave_s); })
    PH(17, { moe_gu_phase<FP8_L1 != 0>(lds, FP8_L1 ? (const void*)hb8 : (const void*)hb, wgu + WGU_L, cnt + 32, list, hid, wg, nwg, wave_s); })
    PH(18, { moe_down_phase<FP8_L1 != 0, Y8_L1 != 0>(lds, hid, wdn + WDN_L, cnt + 32, list, gate, yb, wg, nwg, wave_s); })
    PH(19, { moe_combine_phase<true, Y8_L1 != 0, XB16 != 0, false>(XB16 ? (const void*)xb : (const void*)x1, nullptr, yb, a.in[3], nullptr, a.out, wg, nwg, wave_s); })
#undef IN
#undef BOTH
#undef GRID_BAR
}
#ifndef N_LAUNCH_PER_PHASE
#define N_LAUNCH_PER_PHASE 0
#endif
extern "C" void kernel_launch(void* const* d_in, const int* in_sizes, int n_in, void* d_out, int out_size, void* d_ws, size_t ws_size, hipStream_t stream) {
    static int grid = 0;
    if (!grid) {
        int dev = 0, cus = 0, per_cu = 0;
        (void)hipGetDevice(&dev); (void)hipDeviceGetAttribute(&cus, hipDeviceAttributeMultiprocessorCount, dev);
        (void)hipFuncSetAttribute((const void*)fwd, hipFuncAttributeMaxDynamicSharedMemorySize, LDS_BYTES);
        if (hipOccupancyMaxActiveBlocksPerMultiprocessor(&per_cu, (const void*)fwd, NTHR, LDS_BYTES) != hipSuccess || per_cu < 1) per_cu = 1;
        (void)hipGetLastError();
        grid = cus > 0 ? cus : 256;
    }
    FArgs fa{}; for (int i = 0; i < 21; ++i) fa.in[i] = (const float*)d_in[i];
    fa.out = (float*)d_out; fa.ws = (unsigned char*)d_ws;
    (void)hipMemsetAsync((char*)d_ws + WS_CTL, 0, CTL_BYTES, stream);
#if N_LAUNCH_PER_PHASE
    for (int p = 0; p < N_PHASES; ++p) { fa.ph_lo = p; fa.ph_hi = p + 1; hipLaunchKernelGGL(fwd, dim3(grid), dim3(NTHR), LDS_BYTES, stream, fa); }
#else
    fa.ph_lo = 0; fa.ph_hi = N_PHASES; hipLaunchKernelGGL(fwd, dim3(grid), dim3(NTHR), LDS_BYTES, stream, fa);
#endif
}
```

```cpp
#include <hip/hip_runtime.h>
#include <stdint.h>
#define T_ 16384
#define D_ 2048
__device__ __forceinline__ float wave_sum(float v) {
#pragma unroll
    for (int o = 32; o > 0; o >>= 1) v += __shfl_xor(v, o);
    return v;
}
typedef unsigned short bf16_t;
typedef short bf16x8 __attribute__((ext_vector_type(8)));
typedef float f32x4 __attribute__((ext_vector_type(4)));
typedef unsigned u32x4 __attribute__((ext_vector_type(4)));
typedef unsigned u32x2 __attribute__((ext_vector_type(2)));
#define LAS __attribute__((address_space(3)))
#define NTHR 512

__device__ __forceinline__ unsigned cvt_pk_bf16(float lo, float hi) { unsigned r; asm volatile("v_cvt_pk_bf16_f32 %0, %1, %2" : "=v"(r) : "v"(lo), "v"(hi)); return r; }
__device__ __forceinline__ float bf2f(bf16_t b) { return __uint_as_float(((unsigned)b) << 16); }
__device__ __forceinline__ float bflo(unsigned w) { return __uint_as_float(w << 16); }
__device__ __forceinline__ float bfhi(unsigned w) { return __uint_as_float(w & 0xffff0000u); }

__device__ __forceinline__ int lds_byte(int r, int c) { const int st = (r >> 4) * 2 + (c >> 5), ob = (r & 15) * 64 + (c & 31) * 2; return st * 1024 + (ob ^ (((ob >> 9) & 1) << 5)); }
__device__ __forceinline__ void stage_rc(int b, int& R, int& C) { const int st = b >> 10, sb = b & 1023, swz = sb ^ (((sb >> 9) & 1) << 5); R = (st >> 1) * 16 + swz / 64; C = (st & 1) * 32 + (swz % 64) / 2; }

#define WAIT_V0() asm volatile("s_waitcnt vmcnt(0)" ::: "memory")
__device__ __forceinline__ int opaque_tid(int wave_s) { int l; asm volatile("v_mbcnt_lo_u32_b32 %0, -1, 0\n\tv_mbcnt_hi_u32_b32 %0, -1, %0" : "=v"(l)); return wave_s * 64 + l; }

template <int MF> __device__ __forceinline__ int arow_of(int wr, int m, int fr) { if (MF == 8) return (m >> 2) * 128 + wr * 64 + (m & 3) * 16 + fr; return wr * (MF * 16) + m * 16 + fr; }
template <int NF> __device__ __forceinline__ int bcol_of(int wc, int n, int fq, int j) {
    if (NF == 4) return (n >> 1) * 128 + wc * 32 + 8 * fq + 4 * (n & 1) + j;
    if (NF == 2) return wc * 32 + 8 * fq + 4 * n + j;
    return wc * 16 + 4 * fq + j; }
template <int MF> __device__ __forceinline__ int aslot_to_row(int s) { const int wr = s / (MF * 16), m = (s >> 4) % MF, fr = s & 15; return arow_of<MF>(wr, m, fr); }
template <int NF> __device__ __forceinline__ int bslot_to_col(int s) { const int wc = s / (NF * 16), n = (s >> 4) % NF, i = s & 15; return bcol_of<NF>(wc, n, i >> 2, i & 3); }

template <int MF, int NF> struct Core {
    static constexpr int BM = 32 * MF, BN = 64 * NF;
    static constexpr int GA = BM / 64, GB = BN / 64;
    static constexpr int TA = BM * 128, TB = BN * 128;
    static __device__ __forceinline__ void apiece(int tid, int i, int& row, int& c) { int R, C; stage_rc((tid >> 6) * 1024 + i * 8192 + (tid & 63) * 16, R, C); row = aslot_to_row<MF>(R); c = C; }
    static __device__ __forceinline__ void bpiece(int tid, int i, int& col, int& c) { int R, C; stage_rc((tid >> 6) * 1024 + i * 8192 + (tid & 63) * 16, R, C); col = bslot_to_col<NF>(R); c = C; }
    static __device__ __forceinline__ void zero(f32x4 (&acc)[MF][NF]) {
#pragma unroll
        for (int m = 0; m < MF; ++m)
#pragma unroll
            for (int n = 0; n < NF; ++n) acc[m][n] = (f32x4){0.f, 0.f, 0.f, 0.f}; }
    static __device__ __forceinline__ void compute(LAS unsigned char* la, LAS unsigned char* lb, f32x4 (&acc)[MF][NF], int wr, int wc, int fr, int fq) {
        const int ao = lds_byte(wr * MF * 16 + fr, fq * 8), bo = lds_byte(wc * NF * 16 + fr, fq * 8);
#pragma unroll
        for (int ks = 0; ks < 2; ++ks) {
            bf16x8 At[MF], Bf[NF];
#pragma unroll
            for (int m = 0; m < MF; ++m) At[m] = *(const LAS bf16x8*)(la + ao + m * 2048 + ks * 1024);
#pragma unroll
            for (int n = 0; n < NF; ++n) Bf[n] = *(const LAS bf16x8*)(lb + bo + n * 2048 + ks * 1024);
#pragma unroll
            for (int m = 0; m < MF; ++m)
#pragma unroll
                for (int n = 0; n < NF; ++n) acc[m][n] = __builtin_amdgcn_mfma_f32_16x16x32_bf16(Bf[n], At[m], acc[m][n], 0, 0, 0);
            __builtin_amdgcn_sched_barrier(0);
        }
    }
    static __device__ __forceinline__ void stage_a(LAS unsigned char* dst, const char* base, const unsigned (&off)[GA], unsigned kbyte, int wid) {
        const __amdgpu_buffer_rsrc_t r = __builtin_amdgcn_make_buffer_rsrc((void*)base, 0, 0x7ffffff0, 0x00020000);
#pragma unroll
        for (int i = 0; i < GA; ++i) __builtin_amdgcn_raw_ptr_buffer_load_lds(r, (LAS void*)(dst + wid * 1024 + i * 8192), 16, (int)off[i], (int)kbyte, 0, 0); }
    static __device__ __forceinline__ void stage_b(LAS unsigned char* dst, const char* base, const unsigned (&off)[GB], unsigned kbyte, int wid) {
        const __amdgpu_buffer_rsrc_t r = __builtin_amdgcn_make_buffer_rsrc((void*)base, 0, 0x7ffffff0, 0x00020000);
#pragma unroll
        for (int i = 0; i < GB; ++i) __builtin_amdgcn_raw_ptr_buffer_load_lds(r, (LAS void*)(dst + wid * 1024 + i * 8192), 16, (int)off[i], (int)kbyte, 0, 0); }
    static __device__ __forceinline__ void loop_gg(LAS unsigned char* lds, const char* Ab, const unsigned (&aoff)[GA], const char* Bb, const unsigned (&boff)[GB], int nt,
                                                   f32x4 (&acc)[MF][NF], int wid, int wr, int wc, int fr, int fq) {
        constexpr int STG = TA + TB;
        stage_a(lds, Ab, aoff, 0, wid); stage_b(lds + TA, Bb, boff, 0, wid);
        WAIT_V0(); __syncthreads();
        for (int t = 0; t < nt; ++t) {
            const int cur = t & 1;
            if (t + 1 < nt) { stage_a(lds + (cur ^ 1) * STG, Ab, aoff, (unsigned)(t + 1) * 128u, wid); stage_b(lds + (cur ^ 1) * STG + TA, Bb, boff, (unsigned)(t + 1) * 128u, wid); }
            compute(lds + cur * STG, lds + cur * STG + TA, acc, wr, wc, fr, fq);
            WAIT_V0(); __syncthreads();
        }
    }
    static __device__ __forceinline__ void burst_gg(LAS unsigned char* la, LAS unsigned char* lb, const char* Ab, const unsigned (&aoff)[GA], const char* Bb, const unsigned (&boff)[GB], int nt,
                                                    f32x4 (&acc)[MF][NF], int wid, int wr, int wc, int fr, int fq) {
        for (int t = 0; t < nt; ++t) { stage_a(la + t * TA, Ab, aoff, (unsigned)t * 128u, wid); stage_b(lb + t * TB, Bb, boff, (unsigned)t * 128u, wid); }
        WAIT_V0(); __syncthreads();
        for (int t = 0; t < nt; ++t) compute(la + t * TA, lb + t * TB, acc, wr, wc, fr, fq);
    }
    static __device__ __forceinline__ void loop_lg(LAS unsigned char* la, LAS unsigned char* lb, const char* Bb, const unsigned (&boff)[GB], int nt,
                                                   f32x4 (&acc)[MF][NF], int wid, int wr, int wc, int fr, int fq) {
        stage_b(lb, Bb, boff, 0, wid);
        WAIT_V0(); __syncthreads();
        for (int t = 0; t < nt; ++t) {
            const int cur = t & 1;
            if (t + 1 < nt) stage_b(lb + (cur ^ 1) * TB, Bb, boff, (unsigned)(t + 1) * 128u, wid);
            compute(la + t * TA, lb + cur * TB, acc, wr, wc, fr, fq);
            WAIT_V0(); __syncthreads();
        }
    }
    static __device__ __forceinline__ void loop_gl(LAS unsigned char* la, const char* Ab, const unsigned (&aoff)[GA], LAS unsigned char* lb, int nt,
                                                   f32x4 (&acc)[MF][NF], int wid, int wr, int wc, int fr, int fq) {
        stage_a(la, Ab, aoff, 0, wid);
        WAIT_V0(); __syncthreads();
        for (int t = 0; t < nt; ++t) {
            const int cur = t & 1;
            if (t + 1 < nt) stage_a(la + (cur ^ 1) * TA, Ab, aoff, (unsigned)(t + 1) * 128u, wid);
            compute(la + cur * TA, lb + t * TB, acc, wr, wc, fr, fq);
            WAIT_V0(); __syncthreads();
        }
    }
};
#define XB_TMO      128
#define XB_XCNT(j)  (256  + 64 * (j))
#define XB_XSUB(j)  (1280 + 64 * (j))
#define XB_XGEN(j)  (2304 + 64 * (j))
#define XB_TOP      3328
#define XB_TOPGEN   3392
#define XCD_BAR_WORDS 3456
#define XB_SPIN_CAP (1u << 18)
#define LAS __attribute__((address_space(3)))

__device__ __forceinline__ unsigned xb_ld(unsigned* p)              { return __hip_atomic_load(p, __ATOMIC_RELAXED, __HIP_MEMORY_SCOPE_AGENT); }
__device__ __forceinline__ unsigned xb_add(unsigned* p, unsigned v) { return __hip_atomic_fetch_add(p, v, __ATOMIC_RELAXED, __HIP_MEMORY_SCOPE_AGENT); }
__device__ __forceinline__ unsigned xb_xcc_id() { return (unsigned)__builtin_amdgcn_s_getreg((3 << 11) | 20) & 0xFu; }
#define XB_SPIN(cond, bar) do { unsigned _sp = 0; while (cond) { __builtin_amdgcn_s_sleep(1); \
    if ((++_sp & 255u) == 0u) { if (xb_ld(&(bar)[XB_TMO])) break; if (_sp > XB_SPIN_CAP) { atomicAdd(&(bar)[XB_TMO], 1u); break; } } } } while (0)

struct XcdBarrier {
    unsigned* bar; unsigned x;
    volatile LAS unsigned* st;
};

__device__ __forceinline__ XcdBarrier xcd_barrier_post(unsigned* bar, volatile LAS unsigned* st) {
    XcdBarrier b; b.bar = bar; b.x = xb_xcc_id(); b.st = st;
    if (threadIdx.x == 0) (void)xb_add(&bar[XB_XCNT(b.x)], 1u);
    return b;
}
__device__ __forceinline__ void xcd_barrier_complete(unsigned* bar, unsigned x, unsigned& nloc, unsigned& nx) {
    const unsigned G = gridDim.x * gridDim.y * gridDim.z;
    unsigned sum, cnt, mine, sp = 0u;
    for (;;) {
        sum = 0u; cnt = 0u; mine = 0u;
#pragma unroll
        for (unsigned j = 0; j < 16; ++j) { const unsigned c = xb_ld(&bar[XB_XCNT(j)]); sum += c; cnt += (c > 0u) ? 1u : 0u; mine = (j == x) ? c : mine; }
        if (sum == G) break;
        __builtin_amdgcn_s_sleep(1);
        if ((++sp & 255u) == 0u) { if (xb_ld(&bar[XB_TMO])) break; if (sp > XB_SPIN_CAP) { atomicAdd(&bar[XB_TMO], 1u); break; } }
    }
    nloc = mine > 0u ? mine : 1u; nx = cnt > 0u ? cnt : 1u;
}

__device__ __forceinline__ void xcd_barrier(const XcdBarrier& b) {
    asm volatile("s_waitcnt vmcnt(0)" ::: "memory");
    __syncthreads();
    if (threadIdx.x == 0) {
        unsigned* bar = b.bar;
        __builtin_amdgcn_s_waitcnt(0);
        unsigned nloc = b.st[0], nx = b.st[1];
        if (nloc == 0u) { xcd_barrier_complete(bar, b.x, nloc, nx); b.st[0] = nloc; b.st[1] = nx; }
        const unsigned old = xb_add(&bar[XB_XSUB(b.x)], 1u);
        const unsigned gen = old / nloc;
        if (old + 1u == (gen + 1u) * nloc) {
            __builtin_amdgcn_fence(__ATOMIC_RELEASE, "agent");
            asm volatile("s_waitcnt vmcnt(0)" ::: "memory");
            const unsigned og = xb_add(&bar[XB_TOP], 1u);
            const unsigned tg = og / nx;
            if (og + 1u == (tg + 1u) * nx) xb_add(&bar[XB_TOPGEN], 1u);
            else XB_SPIN(xb_ld(&bar[XB_TOPGEN]) == tg, bar);
            __builtin_amdgcn_fence(__ATOMIC_ACQUIRE, "agent");
            xb_add(&bar[XB_XGEN(b.x)], 1u);
            asm volatile("s_waitcnt vmcnt(0)" ::: "memory");
        } else {
            XB_SPIN(xb_ld(&bar[XB_XGEN(b.x)]) == gen, bar);
            __builtin_amdgcn_fence(__ATOMIC_ACQUIRE, "agent");
            asm volatile("s_waitcnt vmcnt(0)" ::: "memory");
        }
    }
    __syncthreads();
}

__device__ __forceinline__ bool unit_of(long L, int nM, int nN, int& pm, int& pn) {
    const int nwg = nM * nN; if (L >= nwg) return false;
    int wgid = (int)L; { const int q = nwg / 8, r = nwg % 8, xcd = wgid % 8, off = wgid / 8; wgid = (xcd < r ? xcd * (q + 1) : r * (q + 1) + (xcd - r) * q) + off; }
    const int nig = 8 * nN, gid = wgid / nig, fm = gid * 8, gsz = (nM - fm) < 8 ? (nM - fm) : 8;
    pm = fm + ((wgid % nig) % gsz); pn = (wgid % nig) / gsz; return true;
}

struct EpiPlainF32 {
    float* Cout; int ldc;
    __device__ __forceinline__ bool swapped(int) const { return false; }
    __device__ __forceinline__ int brow0(int pn) const { return pn * 256; }
    __device__ __forceinline__ void operator()(const f32x4 (&acc)[8][4], int pm, int pn, int wr, int wc, int fr, int fq) const {
#pragma unroll
        for (int m = 0; m < 8; ++m) { float* rp = Cout + (size_t)(pm * 256 + arow_of<8>(wr, m, fr)) * ldc + pn * 256;
#pragma unroll
            for (int n = 0; n < 4; ++n) *(f32x4*)(rp + bcol_of<4>(wc, n, fq, 0)) = acc[m][n]; }
    }
};

__device__ __forceinline__ unsigned pk4_fp8(float a, float b, float c, float d) { int w = 0; w = __builtin_amdgcn_cvt_pk_fp8_f32(a, b, w, false); w = __builtin_amdgcn_cvt_pk_fp8_f32(c, d, w, true); return (unsigned)w; }
struct ConvJob { const float* W; bf16_t* dst; int K, N, batch, rows_per_batch, grp, grp_stride, add, pad; };
template <bool FP8>
__device__ __forceinline__ void conv_tiles(LAS unsigned char* lds, const ConvJob& J, float sc, int wg, int nwg, int wave_s) {
    const int tid = opaque_tid(wave_s), n4 = tid & 31, kg = tid >> 5;
    const int tk = J.K / 128, tn = J.N / 128, per = tk * tn, total = per * J.batch;
    constexpr int RS = FP8 ? 144 : 272;
    unsigned char* dst8 = (unsigned char*)J.dst;
    for (int u = wg; u < total; u += nwg) {
        const int b = u / per, r = u % per, kt = r / tn, nt = r % tn;
        const float* src = J.W + ((size_t)b * J.K + (size_t)kt * 128 + kg * 8) * J.N + nt * 128 + 4 * n4;
        float4 v[8];
#pragma unroll
        for (int j = 0; j < 8; ++j) v[j] = *(const float4*)(src + (size_t)j * J.N);
#pragma unroll
        for (int i = 0; i < 4; ++i) { float e[8];
#pragma unroll
            for (int j = 0; j < 8; ++j) e[j] = (i == 0 ? v[j].x : i == 1 ? v[j].y : i == 2 ? v[j].z : v[j].w) * (FP8 ? sc : 1.f);
            if (FP8) { u32x2 w; w.x = pk4_fp8(e[0], e[1], e[2], e[3]); w.y = pk4_fp8(e[4], e[5], e[6], e[7]); *(LAS u32x2*)(lds + (4 * n4 + i) * RS + kg * 8) = w; }
            else { u32x4 w; w.x = cvt_pk_bf16(e[0], e[1]); w.y = cvt_pk_bf16(e[2], e[3]); w.z = cvt_pk_bf16(e[4], e[5]); w.w = cvt_pk_bf16(e[6], e[7]); *(LAS u32x4*)(lds + (4 * n4 + i) * RS + kg * 16) = w; } }
        __syncthreads();
        const int nn0 = nt * 128;
        const size_t drow0 = (size_t)b * J.rows_per_batch + (size_t)(nn0 / J.grp) * J.grp_stride + (nn0 % J.grp) + J.add;
#pragma unroll
        for (int p = 0; p < (FP8 ? 2 : 4); ++p) { const int q = tid + 512 * p, row = FP8 ? (q >> 3) : (q >> 4), pc = FP8 ? (q & 7) : (q & 15);
            const u32x4 w = *(const LAS u32x4*)(lds + row * RS + pc * 16);
            if (FP8) *(u32x4*)(dst8 + (drow0 + row) * J.K + kt * 128 + pc * 16) = w;
            else *(u32x4*)(J.dst + (drow0 + row) * J.K + kt * 128 + pc * 8) = w; }
        __syncthreads();
    }
}
__device__ __forceinline__ void conv_phase(LAS unsigned char* lds, const ConvJob& J, int wg, int nwg, int wave_s) { conv_tiles<false>(lds, J, 1.f, wg, nwg, wave_s); }
__device__ __forceinline__ void conv8_phase(LAS unsigned char* lds, const ConvJob& J, float sc, int wg, int nwg, int wave_s) { conv_tiles<true>(lds, J, sc, wg, nwg, wave_s); }

template <bool HB8>
__device__ __forceinline__ void norm_rows_bf16(const float* __restrict__ x, const float* __restrict__ g, bf16_t* __restrict__ out, int wg, int nwg, int wave_s) {
    const int tid = opaque_tid(wave_s), lane = tid & 63, wv = tid >> 6;
    f32x4 gv[8], xa[8];
#pragma unroll
    for (int i = 0; i < 4; ++i) { const int e0 = 8 * (lane + 64 * i); gv[2 * i] = *(const f32x4*)(g + e0); gv[2 * i + 1] = *(const f32x4*)(g + e0 + 4); }
#define NR_LOAD(row_) do { const size_t rb_ = (size_t)(row_) * D_; _Pragma("unroll") for (int i = 0; i < 4; ++i) { const int e0 = 8 * (lane + 64 * i); xa[2 * i] = *(const f32x4*)(x + rb_ + e0); xa[2 * i + 1] = *(const f32x4*)(x + rb_ + e0 + 4); } } while (0)
    int row = wg * 8 + wv;
    if (row < T_) NR_LOAD(row);
    for (; row < T_; row += nwg * 8) {
        f32x4 v[8]; float ss = 0.f;
#pragma unroll
        for (int i = 0; i < 8; ++i) { v[i] = xa[i]; ss += v[i][0] * v[i][0] + v[i][1] * v[i][1] + v[i][2] * v[i][2] + v[i][3] * v[i][3]; }
        asm volatile("" ::: "memory");
        if (row + nwg * 8 < T_) NR_LOAD(row + nwg * 8);
        asm volatile("" ::: "memory");
        ss = wave_sum(ss);
        const float r = rsqrtf(ss * (1.f / D_) + 1e-6f);
#pragma unroll
        for (int i = 0; i < 4; ++i) { const int e0 = 8 * (lane + 64 * i); const f32x4 ga = gv[2 * i], gb = gv[2 * i + 1], a = v[2 * i], b = v[2 * i + 1];
            if (HB8) { const float r4s = 4.f * r; u32x2 o; o.x = pk4_fp8(a[0] * r4s * ga[0], a[1] * r4s * ga[1], a[2] * r4s * ga[2], a[3] * r4s * ga[3]); o.y = pk4_fp8(b[0] * r4s * gb[0], b[1] * r4s * gb[1], b[2] * r4s * gb[2], b[3] * r4s * gb[3]);
                *(u32x2*)((unsigned char*)out + (size_t)row * D_ + e0) = o; }
            else { u32x4 o; o.x = cvt_pk_bf16(a[0] * r * ga[0], a[1] * r * ga[1]); o.y = cvt_pk_bf16(a[2] * r * ga[2], a[3] * r * ga[3]); o.z = cvt_pk_bf16(b[0] * r * gb[0], b[1] * r * gb[1]); o.w = cvt_pk_bf16(b[2] * r * gb[2], b[3] * r * gb[3]);
                *(u32x4*)(out + (size_t)row * D_ + e0) = o; } }
    }
#undef NR_LOAD
}

__device__ __forceinline__ void bg_issue(const float* wg_, const float* wu_, const float* wd_, int t, float4 (&v)[8], int tid) {
    const int n4 = tid & 31, kg = tid >> 5, m = t >> 12, r = t & 4095, b = r >> 7, q = r & 127;
    const int N = m == 2 ? 2048 : 1024, K = m == 2 ? 1024 : 2048, tn = N >> 7, kt = q / tn, nt = q % tn;
    const float* W = m == 0 ? wg_ : (m == 1 ? wu_ : wd_);
    const float* src = W + ((size_t)b * K + (size_t)kt * 128 + kg * 8) * N + nt * 128 + 4 * n4;
#pragma unroll
    for (int j = 0; j < 8; ++j) v[j] = *(const float4*)(src + (size_t)j * N);
}
__device__ __forceinline__ void bg_write(LAS unsigned char* img, const float4 (&v)[8], float sc, int tid) {
    const int n4 = tid & 31, kg = tid >> 5;
#pragma unroll
    for (int i = 0; i < 4; ++i) { float e[8];
#pragma unroll
        for (int j = 0; j < 8; ++j) e[j] = (i == 0 ? v[j].x : i == 1 ? v[j].y : i == 2 ? v[j].z : v[j].w) * sc;
        u32x2 w; w.x = pk4_fp8(e[0], e[1], e[2], e[3]); w.y = pk4_fp8(e[4], e[5], e[6], e[7]); *(LAS u32x2*)(img + (4 * n4 + i) * 144 + kg * 8) = w; }
}
__device__ __forceinline__ void bg_store(const LAS unsigned char* img, unsigned char* gu8, unsigned char* dn8, int t, int tid) {
    const int m = t >> 12, r = t & 4095, b = r >> 7, q = r & 127;
    const int N = m == 2 ? 2048 : 1024, K = m == 2 ? 1024 : 2048, tn = N >> 7, kt = q / tn, nt = q % tn;
    const size_t drow0 = (size_t)b * 2048 + (m == 2 ? (size_t)nt * 128 : (size_t)nt * 256 + (m == 1 ? 128 : 0));
    unsigned char* dst = m == 2 ? dn8 : gu8;
#pragma unroll
    for (int p = 0; p < 2; ++p) { const int qq = tid + 512 * p, row = qq >> 3, pc = qq & 7;
        *(u32x4*)(dst + (drow0 + row) * K + kt * 128 + pc * 16) = *(const LAS u32x4*)(img + row * 144 + pc * 16); }
}

#ifndef CS_NS
#define CS_NS 4
#endif
#define CS_STR2(x) #x
#define CS_STR(x) CS_STR2(x)
__device__ __forceinline__ void conv_stream(LAS unsigned char* lds, const float* sg, const float* su, const float* sd, unsigned char* gu8, unsigned char* dn8, int t_lo, int t_hi, int c, int nc, int wave_s) {
    const int tid = opaque_tid(wave_s), n4 = tid & 31, kg = tid >> 5;
    const size_t LSRC = (size_t)32 * 2048 * 1024, LGU = (size_t)2 * 32 * 2048 * 2048, LDN = (size_t)2 * 32 * 2048 * 1024;
    f32x4 v[CS_NS][8];
    const int tmax = t_hi - 1;
    const unsigned wofs = (unsigned)((4 * n4) * 144 + ((kg ^ (2 * ((n4 >> 2) & 7))) * 8));
#define CS_ISSUE(s, ts) do { const int tc_ = (ts) < tmax ? (ts) : tmax, L_ = tc_ >= 12288 ? 1 : 0, t_ = tc_ - L_ * 12288, m_ = t_ >> 12, r_ = t_ & 4095, b_ = r_ >> 7, q_ = r_ & 127; \
        const int N_ = m_ == 2 ? 2048 : 1024, K_ = m_ == 2 ? 1024 : 2048, tn_ = N_ >> 7, kt_ = q_ / tn_, nt_ = q_ % tn_; \
        const float* W_ = (m_ == 0 ? sg : (m_ == 1 ? su : sd)) + L_ * LSRC + ((size_t)b_ * K_ + (size_t)kt_ * 128) * N_ + nt_ * 128; \
        const unsigned vo_ = (unsigned)(kg * 8 * N_ + 4 * n4) * 4u; \
        _Pragma("unroll") for (int j_ = 0; j_ < 8; ++j_) { const float* rb_ = W_ + (size_t)j_ * N_; asm volatile("global_load_dwordx4 %0, %1, %2 nt" : "=v"(v[s][j_]) : "v"(vo_), "s"(rb_) : "memory"); } } while (0)
#define CS_WAIT(s, n) asm volatile("s_waitcnt vmcnt(" CS_STR(n) ")" : "+v"(v[s][0]), "+v"(v[s][1]), "+v"(v[s][2]), "+v"(v[s][3]), "+v"(v[s][4]), "+v"(v[s][5]), "+v"(v[s][6]), "+v"(v[s][7]) :: "memory")
#pragma unroll
    for (int s = 0; s < CS_NS; ++s) CS_ISSUE(s, t_lo + c + s * nc);
    for (int t = t_lo + c; t < t_hi; t += CS_NS * nc) {
#pragma unroll
        for (int s = 0; s < CS_NS; ++s) { const int ts0 = t + s * nc, ts = ts0 < tmax ? ts0 : tmax;
            const int tt = ts >= 12288 ? ts - 12288 : ts; const float sc = tt >= 8192 ? 32.f : 64.f;
            CS_WAIT(s, 8 * (CS_NS - 1));
#pragma unroll
            for (int i = 0; i < 4; ++i) { float e[8];
#pragma unroll
                for (int j = 0; j < 8; ++j) e[j] = v[s][j][i] * sc;
                u32x2 w; w.x = pk4_fp8(e[0], e[1], e[2], e[3]); w.y = pk4_fp8(e[4], e[5], e[6], e[7]); *(LAS u32x2*)(lds + s * 18432 + wofs + i * 144) = w; }
            CS_ISSUE(s, ts0 + CS_NS * nc); }
        asm volatile("s_waitcnt lgkmcnt(0)" ::: "memory"); __builtin_amdgcn_s_barrier();
#pragma unroll
        for (int s = 0; s < CS_NS; ++s) { const int ts0 = t + s * nc, ts = ts0 < tmax ? ts0 : tmax;
            const int L_ = ts >= 12288 ? 1 : 0, t_ = ts - L_ * 12288, m = t_ >> 12, r = t_ & 4095, b = r >> 7, q = r & 127;
            const int N = m == 2 ? 2048 : 1024, K = m == 2 ? 1024 : 2048, tn = N >> 7, kt = q / tn, nt = q % tn;
            const size_t drow0 = (size_t)b * 2048 + (m == 2 ? (size_t)nt * 128 : (size_t)nt * 256 + (m == 1 ? 128 : 0));
            unsigned char* dst = (m == 2 ? dn8 + L_ * LDN : gu8 + L_ * LGU) + drow0 * K + kt * 128;
#pragma unroll
            for (int p = 0; p < 2; ++p) { const int qq = tid + 512 * p, row = qq >> 3, pc = qq & 7;
                const u32x4 w = *(const LAS u32x4*)(lds + s * 18432 + row * 144 + ((pc ^ ((row >> 4) & 7)) * 16));
                asm volatile("global_store_dwordx4 %0, %1, %2 nt" :: "v"((unsigned)(row * K + pc * 16)), "v"(w), "s"(dst) : "memory"); } }
        asm volatile("s_waitcnt lgkmcnt(0)" ::: "memory"); __builtin_amdgcn_s_barrier();
    }
    asm volatile("s_waitcnt vmcnt(0)" ::: "memory");
#undef CS_ISSUE
#undef CS_WAIT
}
__device__ __forceinline__ int perm32(int rho) { const int n = rho >> 4, i = rho & 15; return 8 * (i >> 2) + 4 * n + (i & 3); }
#define HTB 16384
typedef int i32x4 __attribute__((ext_vector_type(4)));
typedef int i32x8 __attribute__((ext_vector_type(8)));
#ifndef G8_ABLATE
#define G8_ABLATE 0
#endif
template <bool FP8, class Sched, class Epi, int ABL = 0>
__device__ __forceinline__ void gemm8_phase(LAS unsigned char* lds, int RB, const Sched& S, const Epi& E, int wave_s) {
    typedef typename Sched::U U;
    const int tid = opaque_tid(wave_s), wid = __builtin_amdgcn_readfirstlane(tid >> 6), lane = tid & 63, wr = wid >> 2, wc = wid & 3, fr = lane & 15, fq = lane >> 4;
    const int nt = RB / 128;
    int R0, C0; stage_rc(tid * 16, R0, C0);
    const unsigned c2 = (unsigned)C0 * 2u, r64 = (unsigned)64 * RB;
    const unsigned voffB0 = (unsigned)(((R0 & ~31) + perm32(R0 & 31)) * RB) + c2, voffA0 = (unsigned)(R0 * RB) + c2;
    const unsigned hstep = (unsigned)128 * RB;
    const unsigned ldsw = (unsigned)wid * 1024u;
    const int aoff = lds_byte(wr * 64 + fr, fq * 8), boff = lds_byte(wc * 32 + fr, fq * 8);
#define G8_SA(b, h) (((b) * 2 + (h)) * HTB)
#define G8_SB(b, h) ((4 + (b) * 2 + (h)) * HTB)
#define G8_STAGE2(bufoff, rs, v0, s0, v1, s1) do { __builtin_amdgcn_raw_ptr_buffer_load_lds(rs, (LAS void*)(lds + (bufoff) + ldsw), 16, (int)(v0), (int)(s0), 0, 0); \
        __builtin_amdgcn_raw_ptr_buffer_load_lds(rs, (LAS void*)(lds + (bufoff) + ldsw + 8192), 16, (int)(v1), (int)(s1), 0, 0); } while (0)
#define G8_STB(bufoff, rs, so) G8_STAGE2(bufoff, rs, voffB0, (so), voffB0, (so) + r64)
#define G8_STA(bufoff, rs, pk, h, so) do { if (Sched::GATHER) { const unsigned _p = (pk)[h]; G8_STAGE2(bufoff, rs, (_p & 0xffffu) * (unsigned)RB + c2, (so), (_p >> 16) * (unsigned)RB + c2, (so)); } \
        else G8_STAGE2(bufoff, rs, voffA0, (so) + (h) * hstep, voffA0, (so) + (h) * hstep + r64); } while (0)
#define G8_LDA(dst, b, h) do { _Pragma("unroll") for (int m = 0; m < 4; ++m) dst[m] = __builtin_shufflevector(*(const LAS i32x4*)(lds + G8_SA(b, h) + aoff + m * 2048), *(const LAS i32x4*)(lds + G8_SA(b, h) + aoff + m * 2048 + 1024), 0, 1, 2, 3, 4, 5, 6, 7); } while (0)
#define G8_LDB(dst, b, h) do { _Pragma("unroll") for (int n = 0; n < 2; ++n) dst[n] = __builtin_shufflevector(*(const LAS i32x4*)(lds + G8_SB(b, h) + boff + n * 2048), *(const LAS i32x4*)(lds + G8_SB(b, h) + boff + n * 2048 + 1024), 0, 1, 2, 3, 4, 5, 6, 7); } while (0)
#define G8_MMA1(ai, bj, At, Bt, m, n) do { \
        if constexpr (FP8) asm volatile("v_mfma_scale_f32_16x16x128_f8f6f4 %0, %1, %2, %0, %3, %3 op_sel_hi:[0,0,0]" : "+v"(acc[(ai) * 4 + m][(bj) * 2 + n]) : "v"(Bt[n]), "v"(At[m]), "v"(one_scale)); \
        else { acc[(ai) * 4 + m][(bj) * 2 + n] = __builtin_amdgcn_mfma_f32_16x16x32_bf16(__builtin_bit_cast(bf16x8, __builtin_shufflevector(Bt[n], Bt[n], 0, 1, 2, 3)), __builtin_bit_cast(bf16x8, __builtin_shufflevector(At[m], At[m], 0, 1, 2, 3)), acc[(ai) * 4 + m][(bj) * 2 + n], 0, 0, 0); \
               acc[(ai) * 4 + m][(bj) * 2 + n] = __builtin_amdgcn_mfma_f32_16x16x32_bf16(__builtin_bit_cast(bf16x8, __builtin_shufflevector(Bt[n], Bt[n], 4, 5, 6, 7)), __builtin_bit_cast(bf16x8, __builtin_shufflevector(At[m], At[m], 4, 5, 6, 7)), acc[(ai) * 4 + m][(bj) * 2 + n], 0, 0, 0); } } while (0)
#define G8_MMA(ai, bj, At, Bt) do { if (ABL == 1) { _Pragma("unroll") for (int m = 0; m < 4; ++m) asm volatile("" :: "v"(At[m])); _Pragma("unroll") for (int n = 0; n < 2; ++n) asm volatile("" :: "v"(Bt[n])); break; } \
        __builtin_amdgcn_s_setprio(1); _Pragma("unroll") for (int m = 0; m < 4; ++m) _Pragma("unroll") for (int n = 0; n < 2; ++n) G8_MMA1(ai, bj, At, Bt, m, n); __builtin_amdgcn_s_setprio(0); } while (0)
#define G8_WAIT_V(n) asm volatile("s_waitcnt vmcnt(" #n ")" ::: "memory")
#define G8_WAIT_L(n) asm volatile("s_waitcnt lgkmcnt(" #n ")" ::: "memory")
#define G8_BAR __builtin_amdgcn_s_barrier()
#define G8_SCHED __builtin_amdgcn_sched_barrier(0)
#define G8_RSRC(p) __builtin_amdgcn_make_buffer_rsrc((void*)(p), 0, 0x7ffffff0, 0x00020000)
    U cur, nxt; int ui = 0;
    if (!S.next(0, cur)) return;
    f32x4 acc[8][4];
#pragma unroll
    for (int m = 0; m < 8; ++m)
#pragma unroll
        for (int n = 0; n < 4; ++n) acc[m][n] = (f32x4){0.f, 0.f, 0.f, 0.f};
    i32x8 At[4], B0[2], B1[2];
    const int one_scale = 0x7F7F7F7F;
    unsigned pkc[2] = {0u, 0u}, pkn[2] = {0u, 0u};
    if (Sched::GATHER) S.gather(cur, R0, pkc);
    pkn[0] = pkc[0]; pkn[1] = pkc[1];
    const char* cA = S.abase(cur); const char* cB = S.bbase(cur);
    {
        const __amdgpu_buffer_rsrc_t rA = G8_RSRC(cA), rB = G8_RSRC(cB);
        G8_STB(G8_SB(0, 0), rB, 0u); G8_STA(G8_SA(0, 0), rA, pkc, 0, 0u); G8_STB(G8_SB(0, 1), rB, hstep); G8_STA(G8_SA(0, 1), rA, pkc, 1, 0u);
        if (wr == 1) G8_BAR;
        G8_WAIT_V(4); G8_BAR;
        G8_STB(G8_SB(1, 0), rB, 128u); G8_STA(G8_SA(1, 0), rA, pkc, 0, 128u); G8_STB(G8_SB(1, 1), rB, hstep + 128u);
        G8_WAIT_V(6); G8_BAR;
    }
    for (;;) {
        const bool has_next = S.next(ui + 1, nxt);
        if (Sched::GATHER && has_next) { const int tz = opaque_tid(wave_s); int R2, C2; stage_rc(tz * 16, R2, C2); S.gather(nxt, R2, pkn); }
        const char* nA = has_next ? S.abase(nxt) : cA; const char* nB = has_next ? S.bbase(nxt) : cB;
        const __amdgpu_buffer_rsrc_t rA = G8_RSRC(cA);
#pragma unroll 1
        for (int t = 0; t < nt; t += 2) {
            int lastv = __builtin_amdgcn_readfirstlane((t == nt - 2) ? 1 : 0); asm volatile("" : "+s"(lastv)); const bool last = lastv != 0;
            const unsigned k1 = (unsigned)(t + 1) * 128u;
            const unsigned k2 = last ? 0u : (unsigned)(t + 2) * 128u, k3 = k2 + 128u;
            const __amdgpu_buffer_rsrc_t rA2 = G8_RSRC(last ? nA : cA), rB2 = G8_RSRC(last ? nB : cB);
            const unsigned px[2] = {last ? pkn[0] : pkc[0], last ? pkn[1] : pkc[1]};
            G8_LDB(B0, 0, 0); G8_SCHED; G8_LDA(At, 0, 0); G8_STA(G8_SA(1, 1), rA, pkc, 1, k1);
            G8_WAIT_L(8); G8_BAR; G8_WAIT_L(0); G8_MMA(0, 0, At, B0); G8_BAR; G8_SCHED;
            G8_LDB(B1, 0, 1); G8_STB(G8_SB(0, 0), rB2, k2);
            G8_BAR; G8_WAIT_L(0); G8_MMA(0, 1, At, B1); G8_BAR;
            G8_LDA(At, 0, 1); G8_STA(G8_SA(0, 0), rA2, px, 0, k2);
            G8_BAR; G8_WAIT_L(0); G8_MMA(1, 0, At, B0); G8_BAR; G8_SCHED;
            G8_STB(G8_SB(0, 1), rB2, k2 + hstep);
            G8_WAIT_V(6); G8_BAR; G8_MMA(1, 1, At, B1); G8_BAR;
            G8_LDB(B0, 1, 0); G8_SCHED; G8_LDA(At, 1, 0); G8_STA(G8_SA(0, 1), rA2, px, 1, k2);
            G8_WAIT_L(8); G8_BAR; G8_WAIT_L(0); G8_MMA(0, 0, At, B0); G8_BAR; G8_SCHED;
            G8_LDB(B1, 1, 1); G8_STB(G8_SB(1, 0), rB2, k3);
            G8_BAR; G8_WAIT_L(0); G8_MMA(0, 1, At, B1); G8_BAR;
            G8_LDA(At, 1, 1); G8_STA(G8_SA(1, 0), rA2, px, 0, k3);
            G8_BAR; G8_WAIT_L(0); G8_MMA(1, 0, At, B0); G8_BAR; G8_SCHED;
            G8_STB(G8_SB(1, 1), rB2, k3 + hstep);
            G8_WAIT_V(6); G8_BAR; G8_MMA(1, 1, At, B1); G8_BAR;
        }
        if (FP8) asm volatile("s_nop 15\n\ts_nop 15" ::: "memory");
        {
            const int tz = opaque_tid(wave_s), lz = tz & 63, wz = __builtin_amdgcn_readfirstlane(tz >> 6);
            E(acc, cur, wz >> 2, wz & 3, lz & 15, lz >> 4); }
        if (!has_next) break;
#pragma unroll
        for (int m = 0; m < 8; ++m)
#pragma unroll
            for (int n = 0; n < 4; ++n) acc[m][n] = (f32x4){0.f, 0.f, 0.f, 0.f};
        cur = nxt; cA = nA; cB = nB; ++ui;
        pkc[0] = pkn[0]; pkc[1] = pkn[1];
    }
    G8_WAIT_V(0);
    if (wr == 0) G8_BAR;
    G8_BAR;
#undef G8_SA
#undef G8_SB
#undef G8_STAGE2
#undef G8_STB
#undef G8_STA
#undef G8_LDA
#undef G8_LDB
#undef G8_MMA
#undef G8_MMA1
#undef G8_WAIT_V
#undef G8_WAIT_L
#undef G8_BAR
#undef G8_SCHED
#undef G8_RSRC
}

struct DenseU { int pm, pn; };
template <class Epi> struct DenseSched {
    typedef DenseU U; static constexpr bool GATHER = false; static constexpr bool RAGGED = false;
    __device__ __forceinline__ int nvalid(const U&) const { return 256; }
    const char* A; const char* Bt; int nM, nN, RB; const Epi* E; int wg, nwg;
    __device__ __forceinline__ bool next(int i, U& u) const { return unit_of((long)i * nwg + wg, nM, nN, u.pm, u.pn); }
    __device__ __forceinline__ const char* abase(const U& u) const { return E->swapped(u.pn) ? (Bt + (size_t)E->brow0(u.pn) * RB) : (A + (size_t)u.pm * 256 * RB); }
    __device__ __forceinline__ const char* bbase(const U& u) const { return E->swapped(u.pn) ? (A + (size_t)u.pm * 256 * RB) : (Bt + (size_t)E->brow0(u.pn) * RB); }
    __device__ __forceinline__ void gather(const U&, int, unsigned (&)[2]) const {}
};
template <class Epi> struct DenseEpi { const Epi* E;
    __device__ __forceinline__ void operator()(const f32x4 (&acc)[8][4], const DenseU& u, int wr, int wc, int fr, int fq) const { (*E)(acc, u.pm, u.pn, wr, wc, fr, fq); } };
template <class Epi>
__device__ __forceinline__ void gemm_phase(LAS unsigned char* lds, const bf16_t* A, const bf16_t* Bt, int nM, int nN, int K, const Epi& E, int wave_s, int wg = (int)blockIdx.x, int nwg = (int)gridDim.x) {
    DenseSched<Epi> S{(const char*)A, (const char*)Bt, nM, nN, K * 2, &E, wg, nwg}; DenseEpi<Epi> DE{&E};
    gemm8_phase<false>(lds, K * 2, S, DE, wave_s);
}
template <class Epi>
__device__ __forceinline__ void gemm_phase_f8(LAS unsigned char* lds, const unsigned char* A, const unsigned char* Bt, int nM, int nN, int K, const Epi& E, int wave_s, int wg = (int)blockIdx.x, int nwg = (int)gridDim.x) {
    DenseSched<Epi> S{(const char*)A, (const char*)Bt, nM, nN, K, &E, wg, nwg}; DenseEpi<Epi> DE{&E};
    gemm8_phase<true>(lds, K, S, DE, wave_s);
}
__device__ __forceinline__ void rope_freq(int j, float& fhi, float& flo) {
    const double f = exp2(-(double)j * (13.287712379549449 / 128.0)) * 0.15915494309189535;
    fhi = (float)f; flo = (float)(f - (double)fhi);
}
__device__ __forceinline__ void rope_cs(float pos, float fhi, float flo, float& c, float& s) {
    const float p = pos * fhi; const float e = __builtin_fmaf(pos, fhi, -p);
    float r = p - __builtin_rintf(p); r += e + pos * flo;
    c = __builtin_amdgcn_cosf(r); s = __builtin_amdgcn_sinf(r);
}
__device__ __forceinline__ float gelu_fast(float x) { const float u = x * (-2.3022081981971123f - 0.10294324276067f * x * x); return x * __builtin_amdgcn_rcpf(1.f + __builtin_amdgcn_exp2f(u)); }
__device__ __forceinline__ float silu_fast(float x) { return x * __builtin_amdgcn_rcpf(1.f + __builtin_amdgcn_exp2f(-1.4426950408889634f * x)); }

template <bool S8> struct EpiInAB {
    bf16_t *qb, *kb, *vT, *sgb, *ugb, *gvT;
    static constexpr float SC = S8 ? (1.f / 256.f) : 1.f;
    __device__ __forceinline__ bool swapped(int pn) const { return (pn >= 8 && pn < 12) || pn >= 20; }
    __device__ __forceinline__ int brow0(int pn) const { return pn * 256; }
    __device__ __forceinline__ void operator()(const f32x4 (&acc)[8][4], int pm, int pn, int wr, int wc, int fr, int fq) const {
        if (pn < 8) {
            bf16_t* dst = (pn < 4 ? qb : kb) + (pn & 3) * 256; const float sc = (pn < 4 ? 1.f : 0.0625f) * SC;
            float fh[8], fl[8];
#pragma unroll
            for (int e = 0; e < 8; ++e) rope_freq(wc * 32 + 8 * fq + e, fh[e], fl[e]);
#pragma unroll
            for (int m = 0; m < 8; ++m) { int row = pm * 256 + arow_of<8>(wr, m, fr); asm volatile("" : "+v"(row));
                const float pos = (float)row; float o1[8], o2[8];
#pragma unroll
                for (int e = 0; e < 8; ++e) { float c, s; rope_cs(pos, fh[e], fl[e], c, s);
                    const float x1 = acc[m][e >> 2][e & 3], x2 = acc[m][(e >> 2) + 2][e & 3];
                    o1[e] = (x1 * c - x2 * s) * sc; o2[e] = (x2 * c + x1 * s) * sc; }
                u32x4 lo, hi;
                lo.x = cvt_pk_bf16(o1[0], o1[1]); lo.y = cvt_pk_bf16(o1[2], o1[3]); lo.z = cvt_pk_bf16(o1[4], o1[5]); lo.w = cvt_pk_bf16(o1[6], o1[7]);
                hi.x = cvt_pk_bf16(o2[0], o2[1]); hi.y = cvt_pk_bf16(o2[2], o2[3]); hi.z = cvt_pk_bf16(o2[4], o2[5]); hi.w = cvt_pk_bf16(o2[6], o2[7]);
                bf16_t* rp = dst + (size_t)row * 1024 + wc * 32 + 8 * fq;
                *(u32x4*)rp = lo; *(u32x4*)(rp + 128) = hi; }
        } else if (pn >= 12 && pn < 20) {
            const bool isg = pn < 16; bf16_t* dst = (isg ? sgb : ugb) + (pn & 3) * 256;
#pragma unroll
            for (int m = 0; m < 8; ++m) { int row = pm * 256 + arow_of<8>(wr, m, fr); asm volatile("" : "+v"(row));
#pragma unroll
                for (int hf = 0; hf < 2; ++hf) { u32x4 w; const f32x4 a = acc[m][2 * hf], b = acc[m][2 * hf + 1];
                    float v[8] = {SC * a[0], SC * a[1], SC * a[2], SC * a[3], SC * b[0], SC * b[1], SC * b[2], SC * b[3]};
#pragma unroll
                    for (int e = 0; e < 8; ++e) v[e] = isg ? silu_fast(v[e]) : gelu_fast(v[e]);
                    w.x = cvt_pk_bf16(v[0], v[1]); w.y = cvt_pk_bf16(v[2], v[3]); w.z = cvt_pk_bf16(v[4], v[5]); w.w = cvt_pk_bf16(v[6], v[7]);
                    *(u32x4*)(dst + (size_t)row * 1024 + hf * 128 + wc * 32 + 8 * fq) = w; } }
        } else {
            const bool isv = pn < 12; bf16_t* dst = (isv ? vT : gvT) + (size_t)((pn & 3) * 256) * T_ + pm * 256;
#pragma unroll
            for (int m = 0; m < 8; ++m) { int f = arow_of<8>(wr, m, fr); asm volatile("" : "+v"(f));
#pragma unroll
                for (int hf = 0; hf < 2; ++hf) { u32x4 w; const f32x4 a = acc[m][2 * hf], b = acc[m][2 * hf + 1];
                    float v[8] = {SC * a[0], SC * a[1], SC * a[2], SC * a[3], SC * b[0], SC * b[1], SC * b[2], SC * b[3]};
                    if (!isv) {
#pragma unroll
                        for (int e = 0; e < 8; ++e) v[e] = gelu_fast(v[e]); }
                    w.x = cvt_pk_bf16(v[0], v[1]); w.y = cvt_pk_bf16(v[2], v[3]); w.z = cvt_pk_bf16(v[4], v[5]); w.w = cvt_pk_bf16(v[6], v[7]);
                    *(u32x4*)(dst + (size_t)f * T_ + hf * 128 + wc * 32 + 8 * fq) = w; } }
        }
    }
};

struct EpiKhat {
    bf16_t* khatT;
    __device__ __forceinline__ bool swapped(int) const { return true; }
    __device__ __forceinline__ int brow0(int pn) const { return (4 + pn) * 256; }
    __device__ __forceinline__ void operator()(const f32x4 (&acc)[8][4], int pm, int pn, int wr, int wc, int fr, int fq) const {
        const int h = pn; const float l2g = log2f(1.f - exp2f(-5.f - (float)h));
        bf16_t* dst = khatT + (size_t)(h * 256) * T_ + pm * 256;
#pragma unroll
        for (int m = 0; m < 4; ++m) { int f = wr * 64 + m * 16 + fr; asm volatile("" : "+v"(f));
            float fh, fl; rope_freq(f, fh, fl);
#pragma unroll
            for (int hf = 0; hf < 2; ++hf) { float o1[8], o2[8]; const int t0 = hf * 128 + wc * 32 + 8 * fq;
#pragma unroll
                for (int e = 0; e < 8; ++e) { float c, s; rope_cs((float)(pm * 256 + t0 + e), fh, fl, c, s);
                    const float x1 = acc[m][2 * hf + (e >> 2)][e & 3], x2 = acc[m + 4][2 * hf + (e >> 2)][e & 3];
                    const float d = 0.0625f * exp2f((float)(127 - ((t0 + e) & 127)) * l2g);
                    o1[e] = (x1 * c - x2 * s) * d; o2[e] = (x2 * c + x1 * s) * d; }
                u32x4 w1, w2;
                w1.x = cvt_pk_bf16(o1[0], o1[1]); w1.y = cvt_pk_bf16(o1[2], o1[3]); w1.z = cvt_pk_bf16(o1[4], o1[5]); w1.w = cvt_pk_bf16(o1[6], o1[7]);
                w2.x = cvt_pk_bf16(o2[0], o2[1]); w2.y = cvt_pk_bf16(o2[2], o2[3]); w2.z = cvt_pk_bf16(o2[4], o2[5]); w2.w = cvt_pk_bf16(o2[6], o2[7]);
                *(u32x4*)(dst + (size_t)f * T_ + t0) = w1;
                *(u32x4*)(dst + (size_t)(f + 128) * T_ + t0) = w2; } }
    }
};
typedef short s16x4 __attribute__((ext_vector_type(4)));
__device__ __forceinline__ void ret_kv_phase(LAS unsigned char* lds, const bf16_t* vT, const bf16_t* kb, bf16_t* KVT, int wg, int nwg, int wave_s) {
    typedef Core<8, 4> C;
    constexpr int RS = 576;
    const int tid = opaque_tid(wave_s), wid = __builtin_amdgcn_readfirstlane(tid >> 6), lane = tid & 63, wr = wid >> 2, wc = wid & 3, fr = lane & 15, fq = lane >> 4;
    LAS unsigned char* ldsT = lds + 65536;
    unsigned aoff[4];
#pragma unroll
    for (int i = 0; i < 4; ++i) { int r, c; C::apiece(tid, i, r, c); aoff[i] = (unsigned)(r * T_ + c) * 2u; }
    const int ao = lds_byte(wr * 128 + fr, fq * 8);
    LAS unsigned char* trb = ldsT + (8 * fq + (fr >> 2)) * RS + 2 * (wc * 32 + 8 * (fr & 3));
    for (int u = wg; u < 512; u += nwg) {
        const int n = u >> 2, h = u & 3; const float l2g = log2f(1.f - exp2f(-5.f - (float)h));
        const bf16_t* kt = kb + (size_t)(n * 128) * 1024 + h * 256;
        { const char* Vb = (const char*)(vT + (size_t)(h * 256) * T_ + n * 128); C::stage_a(lds, Vb, aoff, 0u, wid); C::stage_a(lds + 32768, Vb, aoff, 128u, wid); }
        u32x4 wk[8];
#pragma unroll
        for (int p = 0; p < 8; ++p) { int idx = tid + 512 * p; asm volatile("" : "+v"(idx)); const int j = idx >> 5, d0 = (idx & 31) * 8; wk[p] = *(const u32x4*)(kt + (size_t)j * 1024 + d0); }
#pragma unroll
        for (int p = 0; p < 8; ++p) { int idx = tid + 512 * p; asm volatile("" : "+v"(idx)); const int j = idx >> 5, d0 = (idx & 31) * 8;
            const u32x4 w = wk[p];
            const float d = exp2f((float)(127 - j) * l2g);
            u32x4 o; o.x = cvt_pk_bf16(bflo(w.x) * d, bfhi(w.x) * d); o.y = cvt_pk_bf16(bflo(w.y) * d, bfhi(w.y) * d); o.z = cvt_pk_bf16(bflo(w.z) * d, bfhi(w.z) * d); o.w = cvt_pk_bf16(bflo(w.w) * d, bfhi(w.w) * d);
            *(LAS u32x4*)(ldsT + j * RS + d0 * 2) = o; }
        WAIT_V0(); __syncthreads();
        f32x4 acc[8][4]; C::zero(acc);
#pragma unroll
        for (int kk = 0; kk < 4; ++kk) {
            bf16x8 At[8], Bf[4];
#pragma unroll
            for (int m = 0; m < 8; ++m) At[m] = *(const LAS bf16x8*)(lds + (kk >> 1) * 32768 + ao + m * 2048 + (kk & 1) * 1024);
#pragma unroll
            for (int nn = 0; nn < 4; ++nn) { LAS unsigned char* a = trb + (kk * 32) * RS + 2 * ((nn >> 1) * 128 + 4 * (nn & 1));
                const s16x4 lo = __builtin_amdgcn_ds_read_tr16_b64_v4i16((LAS s16x4*)a), hi = __builtin_amdgcn_ds_read_tr16_b64_v4i16((LAS s16x4*)(a + 4 * RS));
                Bf[nn] = __builtin_shufflevector(lo, hi, 0, 1, 2, 3, 4, 5, 6, 7); }
#pragma unroll
            for (int m = 0; m < 8; ++m)
#pragma unroll
                for (int nn = 0; nn < 4; ++nn) acc[m][nn] = __builtin_amdgcn_mfma_f32_16x16x32_bf16(Bf[nn], At[m], acc[m][nn], 0, 0, 0);
            __builtin_amdgcn_sched_barrier(0);
        }
        __syncthreads();
        bf16_t* dst = KVT + (size_t)u * 65536;
#pragma unroll
        for (int m = 0; m < 8; ++m) { bf16_t* rp = dst + arow_of<8>(wr, m, fr) * 256 + wc * 32 + 8 * fq;
#pragma unroll
            for (int hf = 0; hf < 2; ++hf) { const f32x4 a = acc[m][2 * hf], b = acc[m][2 * hf + 1]; u32x4 w;
                w.x = cvt_pk_bf16(a[0], a[1]); w.y = cvt_pk_bf16(a[2], a[3]); w.z = cvt_pk_bf16(b[0], b[1]); w.w = cvt_pk_bf16(b[2], b[3]); *(u32x4*)(rp + hf * 128) = w; } }
    }
}
__device__ __forceinline__ void ret_scan_phase(const bf16_t* KVT, bf16_t* STb, int wg, int nwg, int wave_s) {
    const int tid = opaque_tid(wave_s);
    for (int e = (wg * NTHR + tid) * 2; e < 4 * 65536; e += nwg * NTHR * 2) {
        const int h = e >> 16; const float g = exp2f(128.f * log2f(1.f - exp2f(-5.f - (float)h)));
        float s0 = 0.f, s1 = 0.f;
        for (int n0 = 0; n0 < 128; n0 += 8) {
            unsigned kv[8];
#pragma unroll
            for (int i = 0; i < 8; ++i) kv[i] = *(const unsigned*)(KVT + (size_t)(n0 + i) * 262144 + e);
#pragma unroll
            for (int i = 0; i < 8; ++i) { *(unsigned*)(STb + (size_t)(n0 + i) * 262144 + e) = cvt_pk_bf16(s0, s1); s0 = g * s0 + bflo(kv[i]); s1 = g * s1 + bfhi(kv[i]); }
        }
    }
}
__device__ __forceinline__ void ret_out_phase(LAS unsigned char* lds, const bf16_t* qb, const bf16_t* kb, const bf16_t* vT, const bf16_t* STb, const bf16_t* sgb,
                                              const float* gain, bf16_t* mixb, int wg, int nwg, int wave_s) {
    typedef Core<4, 2> CA; typedef Core<4, 4> CB;
    const int tid = opaque_tid(wave_s), wid = __builtin_amdgcn_readfirstlane(tid >> 6), lane = tid & 63, wr = wid >> 2, wc = wid & 3, fr = lane & 15, fq = lane >> 4;
    LAS unsigned char* ldsP = lds + 98304;
    LAS float* stat = (LAS float*)lds;
    unsigned qoff[2], koff[2], soff[4], voff[4];
#pragma unroll
    for (int i = 0; i < 2; ++i) { int r, c; CA::apiece(tid, i, r, c); qoff[i] = (unsigned)(r * 1024 + c) * 2u; CA::bpiece(tid, i, r, c); koff[i] = (unsigned)(r * 1024 + c) * 2u; }
#pragma unroll
    for (int i = 0; i < 4; ++i) { int r, c; CB::bpiece(tid, i, r, c); soff[i] = (unsigned)(r * 256 + c) * 2u; voff[i] = (unsigned)(r * T_ + c) * 2u; }
    for (int u = wg; u < 512; u += nwg) {
        const int n = u >> 2, h = u & 3; const float l2g = log2f(1.f - exp2f(-5.f - (float)h));
        const char* Qb = (const char*)(qb + (size_t)(n * 128) * 1024 + h * 256); const char* Kb = (const char*)(kb + (size_t)(n * 128) * 1024 + h * 256);
        {
            f32x4 sa[4][2]; CA::zero(sa);
            CA::loop_gg(lds, Qb, qoff, Kb, koff, 4, sa, wid, wr, wc, fr, fq);
#pragma unroll
            for (int m = 0; m < 4; ++m) { const int i = wr * 64 + m * 16 + fr; const int j0 = wc * 32 + 8 * fq;
                float p[8];
#pragma unroll
                for (int e = 0; e < 8; ++e) { const int j = j0 + e; const float s = e < 4 ? sa[m][0][e] : sa[m][1][e - 4]; p[e] = (j <= i) ? s * exp2f((float)(i - j) * l2g) : 0.f; }
                u32x4 w; w.x = cvt_pk_bf16(p[0], p[1]); w.y = cvt_pk_bf16(p[2], p[3]); w.z = cvt_pk_bf16(p[4], p[5]); w.w = cvt_pk_bf16(p[6], p[7]);
                *(LAS u32x4*)(ldsP + (wc >> 1) * 16384 + lds_byte(i, j0 & 63)) = w; }
        }
        f32x4 acc[4][4]; CB::zero(acc);
        CB::loop_gg(lds, Qb, qoff, (const char*)(STb + (size_t)u * 65536), soff, 4, acc, wid, wr, wc, fr, fq);
#pragma unroll
        for (int m = 0; m < 4; ++m) { const float sc = exp2f((float)(wr * 64 + m * 16 + fr + 1) * l2g);
#pragma unroll
            for (int nn = 0; nn < 4; ++nn) acc[m][nn] *= sc; }
        CB::loop_lg(ldsP, lds, (const char*)(vT + (size_t)(h * 256) * T_ + n * 128), voff, 2, acc, wid, wr, wc, fr, fq);
#pragma unroll
        for (int m = 0; m < 4; ++m) { float s = 0.f, ss = 0.f;
#pragma unroll
            for (int nn = 0; nn < 4; ++nn)
#pragma unroll
                for (int e = 0; e < 4; ++e) { const float v = acc[m][nn][e]; s += v; ss += v * v; }
            s += __shfl_xor(s, 16); ss += __shfl_xor(ss, 16); s += __shfl_xor(s, 32); ss += __shfl_xor(ss, 32);
            if (fq == 0) { const int i = wr * 64 + m * 16 + fr; stat[(i * 4 + wc) * 2] = s; stat[(i * 4 + wc) * 2 + 1] = ss; } }
        __syncthreads();
        u32x4 sgv[4][2]; f32x4 gnv[2][2];
#pragma unroll
        for (int hf = 0; hf < 2; ++hf) { const int c0 = h * 256 + hf * 128 + wc * 32 + 8 * fq; gnv[hf][0] = *(const f32x4*)(gain + c0); gnv[hf][1] = *(const f32x4*)(gain + c0 + 4);
#pragma unroll
            for (int m = 0; m < 4; ++m) sgv[m][hf] = *(const u32x4*)(sgb + ((size_t)n * 128 + wr * 64 + m * 16 + fr) * 1024 + c0); }
        asm volatile("" ::: "memory");
#pragma unroll
        for (int m = 0; m < 4; ++m) { const int i = wr * 64 + m * 16 + fr; float s = 0.f, ss = 0.f;
#pragma unroll
            for (int w4 = 0; w4 < 4; ++w4) { s += stat[(i * 4 + w4) * 2]; ss += stat[(i * 4 + w4) * 2 + 1]; }
            const float mean = s * (1.f / 256.f); const float var = ss * (1.f / 256.f) - mean * mean; const float rstd = rsqrtf(var + 1e-6f);
            const size_t t = (size_t)n * 128 + i;
#pragma unroll
            for (int hf = 0; hf < 2; ++hf) { const int c0 = h * 256 + hf * 128 + wc * 32 + 8 * fq;
                const u32x4 sg = sgv[m][hf];
                const f32x4 g0 = gnv[hf][0], g1 = gnv[hf][1];
                const f32x4 a = acc[m][2 * hf], b = acc[m][2 * hf + 1];
                float o[8];
                o[0] = (a[0] - mean) * rstd * g0[0] * bflo(sg.x); o[1] = (a[1] - mean) * rstd * g0[1] * bfhi(sg.x);
                o[2] = (a[2] - mean) * rstd * g0[2] * bflo(sg.y); o[3] = (a[3] - mean) * rstd * g0[3] * bfhi(sg.y);
                o[4] = (b[0] - mean) * rstd * g1[0] * bflo(sg.z); o[5] = (b[1] - mean) * rstd * g1[1] * bfhi(sg.z);
                o[6] = (b[2] - mean) * rstd * g1[2] * bflo(sg.w); o[7] = (b[3] - mean) * rstd * g1[3] * bfhi(sg.w);
                u32x4 w; w.x = cvt_pk_bf16(o[0], o[1]); w.y = cvt_pk_bf16(o[2], o[3]); w.z = cvt_pk_bf16(o[4], o[5]); w.w = cvt_pk_bf16(o[6], o[7]);
                *(u32x4*)(mixb + t * 2048 + c0) = w; } }
        __syncthreads();
    }
}
__device__ __forceinline__ void wsm_phase(const float* ws, bf16_t* WsM, int wg, int nwg, int wave_s) {
    const int tid = opaque_tid(wave_s);
    for (int i = wg * NTHR + tid; i < 4 * 128 * 128; i += nwg * NTHR) { const int t = (i >> 7) & 127, s = i & 127; WsM[i] = (bf16_t)(cvt_pk_bf16(s <= t ? ws[i] : 0.f, 0.f) & 0xffffu); }
}
__device__ __forceinline__ void gmlp_norm_phase(LAS unsigned char* lds, const bf16_t* gvT, bf16_t* vnT, const float* gain, int wg, int nwg, int wave_s) {
    const int tid = opaque_tid(wave_s), tg = tid & 15, c0 = tid >> 4;
    LAS float* red = (LAS float*)lds;
    for (int u = wg; u < 512; u += nwg) {
        const int n = u >> 2, g = u & 3;
        const size_t boff = (size_t)(g * 256 + c0) * T_ + n * 128 + tg * 8;
        u32x4 w[8]; float s[8], q[8], gn8[8];
#pragma unroll
        for (int i = 0; i < 8; ++i) gn8[i] = gain[g * 256 + c0 + 32 * i];
#pragma unroll
        for (int e = 0; e < 8; ++e) { s[e] = 0.f; q[e] = 0.f; }
#pragma unroll
        for (int i = 0; i < 8; ++i) { w[i] = *(const u32x4*)(gvT + boff + (size_t)(32 * i) * T_);
            const float v[8] = {bflo(w[i].x), bfhi(w[i].x), bflo(w[i].y), bfhi(w[i].y), bflo(w[i].z), bfhi(w[i].z), bflo(w[i].w), bfhi(w[i].w)};
#pragma unroll
            for (int e = 0; e < 8; ++e) { s[e] += v[e]; q[e] += v[e] * v[e]; } }
#pragma unroll
        for (int e = 0; e < 8; ++e) { red[(c0 * 128 + tg * 8 + e) * 2] = s[e]; red[(c0 * 128 + tg * 8 + e) * 2 + 1] = q[e]; }
        __syncthreads();
        float mean[8], rstd[8];
#pragma unroll
        for (int e = 0; e < 8; ++e) { float a = 0.f, b = 0.f;
            for (int k = 0; k < 32; ++k) { a += red[(k * 128 + tg * 8 + e) * 2]; b += red[(k * 128 + tg * 8 + e) * 2 + 1]; }
            mean[e] = a * (1.f / 256.f); rstd[e] = rsqrtf(b * (1.f / 256.f) - mean[e] * mean[e] + 1e-6f); }
#pragma unroll
        for (int i = 0; i < 8; ++i) { const float gn = gn8[i];
            const float v[8] = {bflo(w[i].x), bfhi(w[i].x), bflo(w[i].y), bfhi(w[i].y), bflo(w[i].z), bfhi(w[i].z), bflo(w[i].w), bfhi(w[i].w)};
            u32x4 o; o.x = cvt_pk_bf16((v[0] - mean[0]) * rstd[0] * gn, (v[1] - mean[1]) * rstd[1] * gn); o.y = cvt_pk_bf16((v[2] - mean[2]) * rstd[2] * gn, (v[3] - mean[3]) * rstd[3] * gn);
            o.z = cvt_pk_bf16((v[4] - mean[4]) * rstd[4] * gn, (v[5] - mean[5]) * rstd[5] * gn); o.w = cvt_pk_bf16((v[6] - mean[6]) * rstd[6] * gn, (v[7] - mean[7]) * rstd[7] * gn);
            *(u32x4*)(vnT + boff + (size_t)(32 * i) * T_) = o; }
        __syncthreads();
    }
}
__device__ __forceinline__ void gmlp_mix_phase(LAS unsigned char* lds, const bf16_t* WsM, const bf16_t* vnT, const bf16_t* ugb, const float* bs, bf16_t* mixb, int wg, int nwg, int wave_s) {
    typedef Core<4, 4> C;
    const int tid = opaque_tid(wave_s), wid = __builtin_amdgcn_readfirstlane(tid >> 6), lane = tid & 63, wr = wid >> 2, wc = wid & 3, fr = lane & 15, fq = lane >> 4;
    unsigned aoff[2], boff[4];
#pragma unroll
    for (int i = 0; i < 2; ++i) { int r, c; C::apiece(tid, i, r, c); aoff[i] = (unsigned)(r * 128 + c) * 2u; }
#pragma unroll
    for (int i = 0; i < 4; ++i) { int r, c; C::bpiece(tid, i, r, c); boff[i] = (unsigned)(r * T_ + c) * 2u; }
    for (int u = wg; u < 512; u += nwg) {
        const int n = u >> 2, g = u & 3;
        f32x4 acc[4][4]; C::zero(acc);
        C::burst_gg(lds, lds + 32768, (const char*)(WsM + g * 16384), aoff, (const char*)(vnT + (size_t)(g * 256) * T_ + n * 128), boff, 2, acc, wid, wr, wc, fr, fq);
        u32x4 ugv[4][2]; float bsv[4];
#pragma unroll
        for (int m = 0; m < 4; ++m) { const int i = wr * 64 + m * 16 + fr; bsv[m] = bs[g * 128 + i];
#pragma unroll
            for (int hf = 0; hf < 2; ++hf) ugv[m][hf] = *(const u32x4*)(ugb + ((size_t)n * 128 + i) * 1024 + g * 256 + hf * 128 + wc * 32 + 8 * fq); }
        asm volatile("" ::: "memory");
#pragma unroll
        for (int m = 0; m < 4; ++m) { const int i = wr * 64 + m * 16 + fr; const float bias = bsv[m]; const size_t t = (size_t)n * 128 + i;
#pragma unroll
            for (int hf = 0; hf < 2; ++hf) { const int c0 = g * 256 + hf * 128 + wc * 32 + 8 * fq;
                const u32x4 ug = ugv[m][hf];
                const f32x4 a = acc[m][2 * hf], b = acc[m][2 * hf + 1];
                u32x4 w; w.x = cvt_pk_bf16((a[0] + bias) * bflo(ug.x), (a[1] + bias) * bfhi(ug.x)); w.y = cvt_pk_bf16((a[2] + bias) * bflo(ug.y), (a[3] + bias) * bfhi(ug.y));
                w.z = cvt_pk_bf16((b[0] + bias) * bflo(ug.z), (b[1] + bias) * bfhi(ug.z)); w.w = cvt_pk_bf16((b[2] + bias) * bflo(ug.w), (b[3] + bias) * bfhi(ug.w));
                *(u32x4*)(mixb + t * 2048 + 1024 + c0) = w; } }
        __syncthreads();
    }
}
template <bool B16> __device__ __forceinline__ float4 ld_x4(const void* base, size_t i4) {
    if (B16) { const u32x2 w = ((const u32x2*)base)[i4]; return make_float4(bflo(w.x), bfhi(w.x), bflo(w.y), bfhi(w.y)); }
    return ((const float4*)base)[i4]; }
template <bool B16> __device__ __forceinline__ void st_x4(void* base, size_t i4, float4 v) {
    if (B16) { u32x2 w; w.x = cvt_pk_bf16(v.x, v.y); w.y = cvt_pk_bf16(v.z, v.w); ((u32x2*)base)[i4] = w; }
    else ((float4*)base)[i4] = v; }
template <bool OUT16 = false> struct EpiResidualT {
    const float* xin; float* xout; float sc = 1.f;
    __device__ __forceinline__ bool swapped(int) const { return false; }
    __device__ __forceinline__ int brow0(int pn) const { return pn * 256; }
    __device__ __forceinline__ void operator()(const f32x4 (&acc)[8][4], int pm, int pn, int wr, int wc, int fr, int fq) const {
        f32x4 xa[2][4], xb[2][4];
#define ER_ROW(m2) (pm * 256 + arow_of<8>(wr, 2 * (m2), fr))
#define ER_LD(buf, m2) do { int row0_ = ER_ROW(m2); asm volatile("" : "+v"(row0_)); const float* ip0_ = xin + (size_t)row0_ * D_ + pn * 256; \
        _Pragma("unroll") for (int r = 0; r < 2; ++r) _Pragma("unroll") for (int n = 0; n < 4; ++n) buf[r][n] = *(const f32x4*)(ip0_ + (size_t)r * 16 * D_ + bcol_of<4>(wc, n, fq, 0)); } while (0)
#define ER_ST(buf, m2) do { int row0_ = ER_ROW(m2); asm volatile("" : "+v"(row0_)); \
        if (OUT16) { bf16_t* op0_ = (bf16_t*)xout + (size_t)row0_ * D_ + pn * 256; \
            _Pragma("unroll") for (int r = 0; r < 2; ++r) _Pragma("unroll") for (int hf = 0; hf < 2; ++hf) { const f32x4 a_ = buf[r][2 * hf] + acc[2 * (m2) + r][2 * hf] * sc, b_ = buf[r][2 * hf + 1] + acc[2 * (m2) + r][2 * hf + 1] * sc; \
                u32x4 o_; o_.x = cvt_pk_bf16(a_[0], a_[1]); o_.y = cvt_pk_bf16(a_[2], a_[3]); o_.z = cvt_pk_bf16(b_[0], b_[1]); o_.w = cvt_pk_bf16(b_[2], b_[3]); *(u32x4*)(op0_ + (size_t)r * 16 * D_ + hf * 128 + wc * 32 + 8 * fq) = o_; } } \
        else { float* op0_ = xout + (size_t)row0_ * D_ + pn * 256; \
        _Pragma("unroll") for (int r = 0; r < 2; ++r) _Pragma("unroll") for (int n = 0; n < 4; ++n) *(f32x4*)(op0_ + (size_t)r * 16 * D_ + bcol_of<4>(wc, n, fq, 0)) = buf[r][n] + acc[2 * (m2) + r][n] * sc; } } while (0)
        ER_LD(xa, 0); ER_LD(xb, 1); asm volatile("" ::: "memory");
        ER_ST(xa, 0); asm volatile("" ::: "memory"); ER_LD(xa, 2); asm volatile("" ::: "memory");
        ER_ST(xb, 1); asm volatile("" ::: "memory"); ER_LD(xb, 3); asm volatile("" ::: "memory");
        ER_ST(xa, 2); ER_ST(xb, 3); asm volatile("" ::: "memory");
#undef ER_ROW
#undef ER_LD
#undef ER_ST
    }
};
typedef EpiResidualT<false> EpiResidual;
struct EpiResidual16 {
    bf16_t* x; float sc = 1.f;
    __device__ __forceinline__ bool swapped(int) const { return false; }
    __device__ __forceinline__ int brow0(int pn) const { return pn * 256; }
    __device__ __forceinline__ void operator()(const f32x4 (&acc)[8][4], int pm, int pn, int wr, int wc, int fr, int fq) const {
#pragma unroll
        for (int mb = 0; mb < 8; mb += 4) {
            u32x4 w[4][2];
#pragma unroll
            for (int m = 0; m < 4; ++m) { int row = pm * 256 + arow_of<8>(wr, mb + m, fr); asm volatile("" : "+v"(row)); const bf16_t* p = x + (size_t)row * D_ + pn * 256 + wc * 32 + 8 * fq;
                w[m][0] = *(const u32x4*)p; w[m][1] = *(const u32x4*)(p + 128); }
            asm volatile("" ::: "memory");
#pragma unroll
            for (int m = 0; m < 4; ++m) { int row = pm * 256 + arow_of<8>(wr, mb + m, fr); asm volatile("" : "+v"(row)); bf16_t* p = x + (size_t)row * D_ + pn * 256 + wc * 32 + 8 * fq;
#pragma unroll
                for (int hf = 0; hf < 2; ++hf) { const u32x4 ww = w[m][hf]; const f32x4 a = acc[mb + m][2 * hf] * sc, b = acc[mb + m][2 * hf + 1] * sc; u32x4 o;
                    o.x = cvt_pk_bf16(bflo(ww.x) + a[0], bfhi(ww.x) + a[1]); o.y = cvt_pk_bf16(bflo(ww.y) + a[2], bfhi(ww.y) + a[3]);
                    o.z = cvt_pk_bf16(bflo(ww.z) + b[0], bfhi(ww.z) + b[1]); o.w = cvt_pk_bf16(bflo(ww.w) + b[2], bfhi(ww.w) + b[3]);
                    *(u32x4*)(p + hf * 128) = o; } }
            asm volatile("" ::: "memory"); }
    }
};
struct EpiResidualY {
    const float* xin; const bf16_t* y; float* xout;
    __device__ __forceinline__ bool swapped(int) const { return false; }
    __device__ __forceinline__ int brow0(int pn) const { return pn * 256; }
    __device__ __forceinline__ void operator()(const f32x4 (&acc)[8][4], int pm, int pn, int wr, int wc, int fr, int fq) const {
#pragma unroll
        for (int m = 0; m < 8; ++m) { int row = pm * 256 + arow_of<8>(wr, m, fr); asm volatile("" : "+v"(row));
            const float* ip = xin + (size_t)row * D_ + pn * 256; float* op = xout + (size_t)row * D_ + pn * 256;
            const bf16_t* y0 = y + (size_t)(2 * row) * D_ + pn * 256; const bf16_t* y1 = y0 + D_;
#pragma unroll
            for (int hf = 0; hf < 2; ++hf) { const int c = hf * 128 + wc * 32 + 8 * fq;
                const u32x4 a = *(const u32x4*)(y0 + c), b = *(const u32x4*)(y1 + c);
                f32x4 x0 = *(const f32x4*)(ip + c) + acc[m][2 * hf], x1v = *(const f32x4*)(ip + c + 4) + acc[m][2 * hf + 1];
                x0[0] += bflo(a.x) + bflo(b.x); x0[1] += bfhi(a.x) + bfhi(b.x); x0[2] += bflo(a.y) + bflo(b.y); x0[3] += bfhi(a.y) + bfhi(b.y);
                x1v[0] += bflo(a.z) + bflo(b.z); x1v[1] += bfhi(a.z) + bfhi(b.z); x1v[2] += bflo(a.w) + bflo(b.w); x1v[3] += bfhi(a.w) + bfhi(b.w);
                *(f32x4*)(op + c) = x0; *(f32x4*)(op + c + 4) = x1v; }
            asm volatile("" ::: "memory"); }
    }
};

#define CAPF 16384
typedef float f32x2 __attribute__((ext_vector_type(2)));
__device__ __forceinline__ void wr_phase(const float* wrg, const float* wre, bf16_t* WrT, int wg, int nwg, int wave_s) {
    const int tid = opaque_tid(wave_s);
    for (int i = wg * NTHR + tid; i < 64 * 2048; i += nwg * NTHR) { const int r = i >> 11, k = i & 2047;
        const float v = r < 4 ? wrg[k * 4 + r] : (r < 36 ? wre[k * 32 + (r - 4)] : 0.f);
        WrT[i] = (bf16_t)(cvt_pk_bf16(v, 0.f) & 0xffffu); }
}
template <bool XIN16>
__device__ __forceinline__ void moe_route_phase(LAS unsigned char* lds, const void* x1, const float* g, bf16_t* hb, unsigned char* hb8, const bf16_t* WrT, const float* brg, const float* bre,
                                                int* cnt, int* list, float* gate, int wg, int nwg, int wave_s) {
    typedef Core<2, 1> C;
    const int tid = opaque_tid(wave_s), wid = __builtin_amdgcn_readfirstlane(tid >> 6), lane = tid & 63, wr = wid >> 2, wc = wid & 3, fr = lane & 15, fq = lane >> 4;
    unsigned aoff[1], boff[1];
    { int r, c; C::apiece(tid, 0, r, c); aoff[0] = (unsigned)(r * 2048 + c) * 2u; C::bpiece(tid, 0, r, c); boff[0] = (unsigned)(r * 2048 + c) * 2u; }
    LAS float* lg = (LAS float*)lds;
    for (int u = wg; u < T_ / 64; u += nwg) {
        if constexpr (true) {
            const float* xf = (const float*)x1; f32x4 gv[8], xa[8]; u32x4 xh[4];
#pragma unroll
            for (int i = 0; i < 4; ++i) { const int e0 = 8 * (lane + 64 * i); gv[2 * i] = *(const f32x4*)(g + e0); gv[2 * i + 1] = *(const f32x4*)(g + e0 + 4); }
#define RT_LOAD(row_) do { const size_t rb_ = (size_t)(row_) * D_; _Pragma("unroll") for (int i = 0; i < 4; ++i) { const int e0 = 8 * (lane + 64 * i); \
        if (XIN16) xh[i] = *(const u32x4*)((const bf16_t*)x1 + rb_ + e0); else { xa[2 * i] = *(const f32x4*)(xf + rb_ + e0); xa[2 * i + 1] = *(const f32x4*)(xf + rb_ + e0 + 4); } } } while (0)
            RT_LOAD(u * 64 + wid * 8);
            for (int rr = 0; rr < 8; ++rr) { const int row = u * 64 + wid * 8 + rr;
                f32x4 v[8]; float ss = 0.f;
#pragma unroll
                for (int i = 0; i < 8; ++i) { if (XIN16) { const u32x4 w = xh[i >> 1]; v[i] = (i & 1) ? (f32x4){bflo(w.z), bfhi(w.z), bflo(w.w), bfhi(w.w)} : (f32x4){bflo(w.x), bfhi(w.x), bflo(w.y), bfhi(w.y)}; } else v[i] = xa[i];
                    ss += v[i][0] * v[i][0] + v[i][1] * v[i][1] + v[i][2] * v[i][2] + v[i][3] * v[i][3]; }
                asm volatile("" ::: "memory");
                if (rr < 7) RT_LOAD(row + 1);
                asm volatile("" ::: "memory");
                ss = wave_sum(ss);
                const float r = rsqrtf(ss * (1.f / D_) + 1e-6f);
#pragma unroll
                for (int i = 0; i < 4; ++i) { const int e0 = 8 * (lane + 64 * i); const f32x4 ga = gv[2 * i], gb = gv[2 * i + 1], a = v[2 * i], b = v[2 * i + 1];
                    const float h8[8] = {a[0] * r * ga[0], a[1] * r * ga[1], a[2] * r * ga[2], a[3] * r * ga[3], b[0] * r * gb[0], b[1] * r * gb[1], b[2] * r * gb[2], b[3] * r * gb[3]};
                    u32x4 o; o.x = cvt_pk_bf16(h8[0], h8[1]); o.y = cvt_pk_bf16(h8[2], h8[3]); o.z = cvt_pk_bf16(h8[4], h8[5]); o.w = cvt_pk_bf16(h8[6], h8[7]);
                    *(u32x4*)(hb + (size_t)row * D_ + e0) = o;
                    if (hb8) { u32x2 w; w.x = pk4_fp8(4.f * h8[0], 4.f * h8[1], 4.f * h8[2], 4.f * h8[3]); w.y = pk4_fp8(4.f * h8[4], 4.f * h8[5], 4.f * h8[6], 4.f * h8[7]); *(u32x2*)(hb8 + (size_t)row * D_ + e0) = w; } } }
#undef RT_LOAD
        } else
        for (int rr = 0; rr < 8; ++rr) { const int row = u * 64 + wid * 8 + rr;
            float4 v[8]; float ss = 0.f;
#pragma unroll
            for (int i = 0; i < 8; ++i) { v[i] = ld_x4<XIN16>(x1, (size_t)row * (D_ / 4) + 2 * (lane + 64 * (i >> 1)) + (i & 1)); ss += v[i].x * v[i].x + v[i].y * v[i].y + v[i].z * v[i].z + v[i].w * v[i].w; }
            ss = wave_sum(ss);
            const float r = rsqrtf(ss * (1.f / D_) + 1e-6f);
#pragma unroll
            for (int i = 0; i < 4; ++i) { const int e0 = 8 * (lane + 64 * i); const float4 ga = *(const float4*)(g + e0), gb = *(const float4*)(g + e0 + 4); const float4 a = v[2 * i], b = v[2 * i + 1];
                const float h8[8] = {a.x * r * ga.x, a.y * r * ga.y, a.z * r * ga.z, a.w * r * ga.w, b.x * r * gb.x, b.y * r * gb.y, b.z * r * gb.z, b.w * r * gb.w};
                u32x4 o; o.x = cvt_pk_bf16(h8[0], h8[1]); o.y = cvt_pk_bf16(h8[2], h8[3]); o.z = cvt_pk_bf16(h8[4], h8[5]); o.w = cvt_pk_bf16(h8[6], h8[7]);
                *(u32x4*)(hb + (size_t)row * D_ + e0) = o;
                if (hb8) { u32x2 w; w.x = pk4_fp8(4.f * h8[0], 4.f * h8[1], 4.f * h8[2], 4.f * h8[3]); w.y = pk4_fp8(4.f * h8[4], 4.f * h8[5], 4.f * h8[6], 4.f * h8[7]); *(u32x2*)(hb8 + (size_t)row * D_ + e0) = w; } } }
        WAIT_V0(); __syncthreads();
        f32x4 acc[2][1]; C::zero(acc);
        for (int kb = 0; kb < 4; ++kb) {
            C::burst_gg(lds, lds + 65536, (const char*)(hb + (size_t)u * 64 * D_) + kb * 1024, aoff, (const char*)WrT + kb * 1024, boff, 8, acc, wid, wr, wc, fr, fq);
            __syncthreads(); }
#pragma unroll
        for (int m = 0; m < 2; ++m) { const int row = wr * 32 + m * 16 + fr;
#pragma unroll
            for (int j = 0; j < 4; ++j) { const int col = wc * 16 + 4 * fq + j; if (col < 36) lg[row * 40 + col] = acc[m][0][j] + (col < 4 ? brg[col] : bre[col - 4]); } }
        __syncthreads();
        if (tid < 64) {
            const int t = u * 64 + tid; const LAS float* L = lg + tid * 40;
            float l4[4], le[32];
#pragma unroll
            for (int i = 0; i < 4; ++i) l4[i] = L[i];
#pragma unroll
            for (int i = 0; i < 32; ++i) le[i] = L[4 + i];
            int gs = 0; float gm = l4[0];
#pragma unroll
            for (int i = 1; i < 4; ++i) if (l4[i] > gm) { gm = l4[i]; gs = i; }
            float den = 0.f;
#pragma unroll
            for (int i = 0; i < 4; ++i) den += __expf(l4[i] - gm);
            const float psel = 1.f / den;
            float l8[8];
#pragma unroll
            for (int i = 0; i < 8; ++i) l8[i] = gs == 0 ? le[i] : gs == 1 ? le[8 + i] : gs == 2 ? le[16 + i] : le[24 + i];
            int e1 = 0; float m1 = l8[0];
#pragma unroll
            for (int i = 1; i < 8; ++i) if (l8[i] > m1) { m1 = l8[i]; e1 = i; }
            int e2 = -1; float m2 = -3.0e38f;
#pragma unroll
            for (int i = 0; i < 8; ++i) if (i != e1 && l8[i] > m2) { m2 = l8[i]; e2 = i; }
            const float z = __expf(m2 - m1);
            const int ex1 = gs * 8 + e1, ex2 = gs * 8 + e2;
            LAS int* hist = (LAS int*)(lg + 64 * 40);
            if (tid < 32) hist[tid] = 0;
            const int r1 = __hip_atomic_fetch_add(hist + ex1, 1, __ATOMIC_RELAXED, __HIP_MEMORY_SCOPE_WORKGROUP);
            const int r2 = __hip_atomic_fetch_add(hist + ex2, 1, __ATOMIC_RELAXED, __HIP_MEMORY_SCOPE_WORKGROUP);
            if (tid < 32) { const int c = hist[tid]; hist[32 + tid] = c ? atomicAdd(&cnt[tid], c) : 0; }
            const int p1 = hist[32 + ex1] + r1, p2 = hist[32 + ex2] + r2;
            list[ex1 * CAPF + p1] = t * 2; list[ex2 * CAPF + p2] = t * 2 + 1;
            gate[ex1 * CAPF + p1] = psel / (1.f + z); gate[ex2 * CAPF + p2] = psel * z / (1.f + z);
        }
        __syncthreads();
    }
}
__device__ __forceinline__ void moe_prefix(LAS int* tp, LAS int* cn, LAS int* tab, const int* cnt, int tid) {
    if (tid == 0) { int s = 0; for (int e = 0; e < 32; ++e) { const int c = cnt[e]; cn[e] = c; tp[e] = s; s += (c + 255) >> 8; } tp[32] = s; }
    __syncthreads();
    if (tid < 32) { const int nf = (cn[tid] + 255) >> 8, k0 = tp[tid]; for (int r = 0; r < nf; ++r) tab[k0 + r] = (tid << 8) | r; }
    __syncthreads();
}
struct MoeU { int R, pn, e, rt, ne, tpe; };
__device__ __forceinline__ bool moe_unit(int idx, int total, const LAS int* tp, const LAS int* cn, const LAS int* tab, MoeU& u) {
    if (idx >= total) return false;
    u.pn = idx & 7;
    const int t = __builtin_amdgcn_readfirstlane(tab[idx >> 3]);
    u.e = t >> 8; u.rt = t & 255; u.tpe = __builtin_amdgcn_readfirstlane(tp[u.e]); u.R = u.tpe + u.rt; u.ne = __builtin_amdgcn_readfirstlane(cn[u.e]); return true;
}
struct GuSched {
    typedef MoeU U; static constexpr bool GATHER = true;
    static constexpr bool RAGGED = true;
    const char* hb; const char* Wgu; const int* list; const LAS int* tp; const LAS int* cn; const LAS int* tab; int wg, nwg, total, rb;
    __device__ __forceinline__ bool next(int i, U& u) const { return moe_unit(i * nwg + wg, total, tp, cn, tab, u); }
    __device__ __forceinline__ int nvalid(const U& u) const { const int r = u.ne - u.rt * 256; return r < 256 ? r : 256; }
    __device__ __forceinline__ const char* abase(const U&) const { return hb; }
    __device__ __forceinline__ const char* bbase(const U& u) const { return Wgu + ((size_t)u.e * 2048 + u.pn * 256) * rb; }
    __device__ __forceinline__ void gather(const U& u, int R0, unsigned (&pk)[2]) const {
        int l[4];
#pragma unroll
        for (int q = 0; q < 4; ++q) { int gr = u.rt * 256 + (q >> 1) * 128 + R0 + 64 * (q & 1); gr = gr < u.ne ? gr : u.ne - 1; l[q] = list[u.e * CAPF + gr]; }
        asm volatile("" : "+v"(l[0]), "+v"(l[1]), "+v"(l[2]), "+v"(l[3]));
        pk[0] = (unsigned)(l[0] >> 1) | ((unsigned)(l[1] >> 1) << 16); pk[1] = (unsigned)(l[2] >> 1) | ((unsigned)(l[3] >> 1) << 16); }
};
template <bool FP8> struct EpiGu { void* hid;
    __device__ __forceinline__ void operator()(const f32x4 (&acc)[8][4], const MoeU& u, int wr, int wc, int fr, int fq) const {
        const float si = FP8 ? (1.f / 256.f) : 1.f, so = FP8 ? 8.f : 1.f;
#pragma unroll
        for (int m = 0; m < 8; ++m) { int gr = u.rt * 256 + arow_of<8>(wr, m, fr); asm volatile("" : "+v"(gr));
            if (gr < u.ne) {
                float o[8];
#pragma unroll
                for (int e = 0; e < 8; ++e) { const float a = acc[m][e >> 2][e & 3] * si, b = acc[m][2 + (e >> 2)][e & 3] * si; o[e] = silu_fast(a) * b * so; if (FP8) o[e] = __builtin_amdgcn_fmed3f(o[e], -448.f, 448.f); }
                const size_t off = ((size_t)u.tpe * 256 + gr) * 1024 + u.pn * 128 + wc * 32 + 8 * fq;
                if (FP8) { u32x2 w; w.x = pk4_fp8(o[0], o[1], o[2], o[3]); w.y = pk4_fp8(o[4], o[5], o[6], o[7]); *(u32x2*)((unsigned char*)hid + off) = w; }
                else { u32x4 w; w.x = cvt_pk_bf16(o[0], o[1]); w.y = cvt_pk_bf16(o[2], o[3]); w.z = cvt_pk_bf16(o[4], o[5]); w.w = cvt_pk_bf16(o[6], o[7]); *(u32x4*)((bf16_t*)hid + off) = w; } }
            asm volatile("" ::: "memory"); }
    }
};
template <bool FP8>
__device__ __forceinline__ void moe_gu_phase(LAS unsigned char* lds, const void* h, const void* Wgu, const int* cnt, const int* list, void* hid, int wg, int nwg, int wave_s) {
    const int tid = opaque_tid(wave_s);
    LAS int* tp = (LAS int*)(lds + 143360); LAS int* cn = tp + 40; LAS int* tab = tp + 80;
    moe_prefix(tp, cn, tab, cnt, tid);
    const int rb = FP8 ? 2048 : 4096;
    GuSched S{(const char*)h, (const char*)Wgu, list, tp, cn, tab, wg, nwg, __builtin_amdgcn_readfirstlane(tp[32]) * 8, rb}; EpiGu<FP8> E{hid};
    gemm8_phase<FP8>(lds, rb, S, E, wave_s);
    __syncthreads();
}
struct DownSched {
    typedef MoeU U; static constexpr bool GATHER = false;
    static constexpr bool RAGGED = true;
    const char* hid; const char* Wdn; const LAS int* tp; const LAS int* cn; const LAS int* tab; int wg, nwg, total, rb;
    __device__ __forceinline__ bool next(int i, U& u) const { return moe_unit(i * nwg + wg, total, tp, cn, tab, u); }
    __device__ __forceinline__ int nvalid(const U& u) const { const int r = u.ne - u.rt * 256; return r < 256 ? r : 256; }
    __device__ __forceinline__ const char* abase(const U& u) const { return hid + (size_t)u.R * 256 * rb; }
    __device__ __forceinline__ const char* bbase(const U& u) const { return Wdn + ((size_t)u.e * 2048 + u.pn * 256) * rb; }
    __device__ __forceinline__ void gather(const U&, int, unsigned (&)[2]) const {}
};
template <bool Y8> struct EpiDown { const int* list; const float* gate; void* y; float sc;
    __device__ __forceinline__ void operator()(const f32x4 (&acc)[8][4], const MoeU& u, int wr, int wc, int fr, int fq) const {
        int slot[8]; float gt[8];
#pragma unroll
        for (int m = 0; m < 8; ++m) { int gr = u.rt * 256 + arow_of<8>(wr, m, fr); gr = gr < u.ne ? gr : u.ne - 1; slot[m] = list[u.e * CAPF + gr]; gt[m] = gate[u.e * CAPF + gr] * sc; }
        { float dep = 0.f;
#pragma unroll
          for (int m = 0; m < 8; ++m) dep += gt[m] + (float)slot[m];
          asm volatile("" :: "v"(dep)); }
#pragma unroll
        for (int m = 0; m < 8; ++m) { const int gr = u.rt * 256 + arow_of<8>(wr, m, fr);
            if (gr < u.ne) { const float g = gt[m];
                const size_t yo = (size_t)slot[m] * 2048 + u.pn * 256 + wc * 32 + 8 * fq;
#pragma unroll
                for (int hf = 0; hf < 2; ++hf) { const f32x4 a = acc[m][2 * hf], b = acc[m][2 * hf + 1];
                    if (Y8) { float o[8] = {g * a[0], g * a[1], g * a[2], g * a[3], g * b[0], g * b[1], g * b[2], g * b[3]};
#pragma unroll
                        for (int e = 0; e < 8; ++e) o[e] = __builtin_amdgcn_fmed3f(o[e], -448.f, 448.f);
                        u32x2 w; w.x = pk4_fp8(o[0], o[1], o[2], o[3]); w.y = pk4_fp8(o[4], o[5], o[6], o[7]); *(u32x2*)((unsigned char*)y + yo + hf * 128) = w; }
                    else { u32x4 w; w.x = cvt_pk_bf16(g * a[0], g * a[1]); w.y = cvt_pk_bf16(g * a[2], g * a[3]); w.z = cvt_pk_bf16(g * b[0], g * b[1]); w.w = cvt_pk_bf16(g * b[2], g * b[3]);
                        *(u32x4*)((bf16_t*)y + yo + hf * 128) = w; } } } }
    }
};
template <bool FP8, bool Y8>
__device__ __forceinline__ void moe_down_phase(LAS unsigned char* lds, const void* hid, const void* Wdn, const int* cnt, const int* list, const float* gate, void* y, int wg, int nwg, int wave_s) {
    const int tid = opaque_tid(wave_s);
    LAS int* tp = (LAS int*)(lds + 143360); LAS int* cn = tp + 40; LAS int* tab = tp + 80;
    moe_prefix(tp, cn, tab, cnt, tid);
    const int rb = FP8 ? 1024 : 2048;
    DownSched S{(const char*)hid, (const char*)Wdn, tp, cn, tab, wg, nwg, __builtin_amdgcn_readfirstlane(tp[32]) * 8, rb}; EpiDown<Y8> E{list, gate, y, (FP8 ? (1.f / 256.f) : 1.f) * (Y8 ? 64.f : 1.f)};
    gemm8_phase<FP8>(lds, rb, S, E, wave_s);
    __syncthreads();
}
template <bool WRITE_X, bool Y8, bool XIN16, bool XOUT16, bool HB8 = false>
__device__ __forceinline__ void moe_combine_phase_gen(const void* xin, void* xout, const void* y, const float* g, bf16_t* hb, float* outf, int wg, int nwg, int wave_s) {
    const int tid = opaque_tid(wave_s), lane = tid & 63, wv = tid >> 6;
    for (int row = wg * 8 + wv; row < T_; row += nwg * 8) {
        const size_t r4 = (size_t)row * (D_ / 4);
        float4 v[8]; float ss = 0.f;
#pragma unroll
        for (int i = 0; i < 4; ++i) { const int e0 = 8 * (lane + 64 * i);
            float4 a = ld_x4<XIN16>(xin, r4 + e0 / 4), b = ld_x4<XIN16>(xin, r4 + e0 / 4 + 1);
            if (Y8) { const u32x2 p = *(const u32x2*)((const unsigned char*)y + (size_t)(2 * row) * D_ + e0), q2 = *(const u32x2*)((const unsigned char*)y + (size_t)(2 * row + 1) * D_ + e0);
                const f32x2 p0 = __builtin_amdgcn_cvt_pk_f32_fp8((int)p.x, false), p1 = __builtin_amdgcn_cvt_pk_f32_fp8((int)p.x, true), p2 = __builtin_amdgcn_cvt_pk_f32_fp8((int)p.y, false), p3 = __builtin_amdgcn_cvt_pk_f32_fp8((int)p.y, true);
                const f32x2 s0 = __builtin_amdgcn_cvt_pk_f32_fp8((int)q2.x, false), s1 = __builtin_amdgcn_cvt_pk_f32_fp8((int)q2.x, true), s2 = __builtin_amdgcn_cvt_pk_f32_fp8((int)q2.y, false), s3 = __builtin_amdgcn_cvt_pk_f32_fp8((int)q2.y, true);
                a.x += (p0[0] + s0[0]) * (1.f / 64.f); a.y += (p0[1] + s0[1]) * (1.f / 64.f); a.z += (p1[0] + s1[0]) * (1.f / 64.f); a.w += (p1[1] + s1[1]) * (1.f / 64.f);
                b.x += (p2[0] + s2[0]) * (1.f / 64.f); b.y += (p2[1] + s2[1]) * (1.f / 64.f); b.z += (p3[0] + s3[0]) * (1.f / 64.f); b.w += (p3[1] + s3[1]) * (1.f / 64.f); }
            else { const u32x4 p = *(const u32x4*)((const bf16_t*)y + (size_t)(2 * row) * D_ + e0), q2 = *(const u32x4*)((const bf16_t*)y + (size_t)(2 * row + 1) * D_ + e0);
                a.x += bflo(p.x) + bflo(q2.x); a.y += bfhi(p.x) + bfhi(q2.x); a.z += bflo(p.y) + bflo(q2.y); a.w += bfhi(p.y) + bfhi(q2.y);
                b.x += bflo(p.z) + bflo(q2.z); b.y += bfhi(p.z) + bfhi(q2.z); b.z += bflo(p.w) + bflo(q2.w); b.w += bfhi(p.w) + bfhi(q2.w); }
            v[2 * i] = a; v[2 * i + 1] = b;
            ss += a.x * a.x + a.y * a.y + a.z * a.z + a.w * a.w + b.x * b.x + b.y * b.y + b.z * b.z + b.w * b.w; }
        ss = wave_sum(ss);
        const float r = rsqrtf(ss * (1.f / D_) + 1e-6f);
#pragma unroll
        for (int i = 0; i < 4; ++i) { const int e0 = 8 * (lane + 64 * i); const float4 ga = *(const float4*)(g + e0), gb = *(const float4*)(g + e0 + 4); const float4 a = v[2 * i], b = v[2 * i + 1];
            if (hb) { if (WRITE_X) { st_x4<XOUT16>(xout, r4 + e0 / 4, a); st_x4<XOUT16>(xout, r4 + e0 / 4 + 1, b); }
                if (HB8) { const float r4s = 4.f * r; u32x2 o; o.x = pk4_fp8(a.x * r4s * ga.x, a.y * r4s * ga.y, a.z * r4s * ga.z, a.w * r4s * ga.w); o.y = pk4_fp8(b.x * r4s * gb.x, b.y * r4s * gb.y, b.z * r4s * gb.z, b.w * r4s * gb.w);
                    *(u32x2*)((unsigned char*)hb + (size_t)row * D_ + e0) = o; }
                else { u32x4 o; o.x = cvt_pk_bf16(a.x * r * ga.x, a.y * r * ga.y); o.y = cvt_pk_bf16(a.z * r * ga.z, a.w * r * ga.w); o.z = cvt_pk_bf16(b.x * r * gb.x, b.y * r * gb.y); o.w = cvt_pk_bf16(b.z * r * gb.z, b.w * r * gb.w);
                *(u32x4*)(hb + (size_t)row * D_ + e0) = o; } }
            else { float4 oa, ob; oa.x = a.x * r * ga.x; oa.y = a.y * r * ga.y; oa.z = a.z * r * ga.z; oa.w = a.w * r * ga.w; ob.x = b.x * r * gb.x; ob.y = b.y * r * gb.y; ob.z = b.z * r * gb.z; ob.w = b.w * r * gb.w;
                *(float4*)(outf + (size_t)row * D_ + e0) = oa; *(float4*)(outf + (size_t)row * D_ + e0 + 4) = ob; } }
    }
}
__device__ __forceinline__ void moe_combine_phase2(const float* x1, const bf16_t* y, const float* g, bf16_t* hb, float* xd, int wg, int nwg, int wave_s) {
    const int tid = opaque_tid(wave_s), lane = tid & 63, wv = tid >> 6;
    for (int row = wg * 8 + wv; row < T_; row += nwg * 8) {
        const float4* xr = (const float4*)(x1 + (size_t)row * D_); float4* xo = (float4*)(xd + (size_t)row * D_);
        const u32x2* y0 = (const u32x2*)(y + (size_t)(2 * row) * D_); const u32x2* y1 = (const u32x2*)(y + (size_t)(2 * row + 1) * D_);
        float4 v[8]; float ss = 0.f;
#pragma unroll
        for (int i = 0; i < 8; ++i) { v[i] = xr[lane + 64 * i]; const u32x2 a = y0[lane + 64 * i], b = y1[lane + 64 * i];
            v[i].x += bflo(a.x) + bflo(b.x); v[i].y += bfhi(a.x) + bfhi(b.x); v[i].z += bflo(a.y) + bflo(b.y); v[i].w += bfhi(a.y) + bfhi(b.y);
            ss += v[i].x * v[i].x + v[i].y * v[i].y + v[i].z * v[i].z + v[i].w * v[i].w; }
        ss = wave_sum(ss);
        const float r = rsqrtf(ss * (1.f / D_) + 1e-6f);
#pragma unroll
        for (int i = 0; i < 8; ++i) { const float4 gg = ((const float4*)g)[lane + 64 * i]; xo[lane + 64 * i] = v[i];
            u32x2 o; o.x = cvt_pk_bf16(v[i].x * r * gg.x, v[i].y * r * gg.y); o.y = cvt_pk_bf16(v[i].z * r * gg.z, v[i].w * r * gg.w);
            *(u32x2*)(hb + (size_t)row * D_ + (lane + 64 * i) * 4) = o; }
    }
}

template <bool WRITE_X, bool HB8, bool XIN16 = false, bool XOUT16 = false>
__device__ __forceinline__ void moe_combine_phase_pipe(const float* xin, float* xout, const unsigned char* y, const float* g, bf16_t* hb, float* outf, int wg, int nwg, int wave_s) {
    const int tid = opaque_tid(wave_s), lane = tid & 63, wv = tid >> 6;
    f32x4 gv[8];
#pragma unroll
    for (int i = 0; i < 4; ++i) { const int e0 = 8 * (lane + 64 * i); gv[2 * i] = *(const f32x4*)(g + e0); gv[2 * i + 1] = *(const f32x4*)(g + e0 + 4); }
    f32x4 xa[8]; u32x4 xh[4]; u32x2 yp[4], yq[4];
#define MC_LOAD(row_) do { const size_t rb_ = (size_t)(row_) * D_; _Pragma("unroll") for (int i = 0; i < 4; ++i) { const int e0 = 8 * (lane + 64 * i); \
        if (XIN16) xh[i] = *(const u32x4*)((const bf16_t*)xin + rb_ + e0); else { xa[2 * i] = *(const f32x4*)(xin + rb_ + e0); xa[2 * i + 1] = *(const f32x4*)(xin + rb_ + e0 + 4); } \
        yp[i] = *(const u32x2*)(y + 2 * rb_ + e0); yq[i] = *(const u32x2*)(y + 2 * rb_ + D_ + e0); } } while (0)
    int row = wg * 8 + wv;
    if (row < T_) MC_LOAD(row);
    for (; row < T_; row += nwg * 8) {
        f32x4 v[8]; float ss = 0.f;
#pragma unroll
        for (int i = 0; i < 4; ++i) { f32x4 a, b; const u32x2 p = yp[i], q2 = yq[i];
            if (XIN16) { const u32x4 w = xh[i]; a = (f32x4){bflo(w.x), bfhi(w.x), bflo(w.y), bfhi(w.y)}; b = (f32x4){bflo(w.z), bfhi(w.z), bflo(w.w), bfhi(w.w)}; } else { a = xa[2 * i]; b = xa[2 * i + 1]; }
            const f32x2 p0 = __builtin_amdgcn_cvt_pk_f32_fp8((int)p.x, false), p1 = __builtin_amdgcn_cvt_pk_f32_fp8((int)p.x, true), p2 = __builtin_amdgcn_cvt_pk_f32_fp8((int)p.y, false), p3 = __builtin_amdgcn_cvt_pk_f32_fp8((int)p.y, true);
            const f32x2 s0 = __builtin_amdgcn_cvt_pk_f32_fp8((int)q2.x, false), s1 = __builtin_amdgcn_cvt_pk_f32_fp8((int)q2.x, true), s2 = __builtin_amdgcn_cvt_pk_f32_fp8((int)q2.y, false), s3 = __builtin_amdgcn_cvt_pk_f32_fp8((int)q2.y, true);
            a[0] += (p0[0] + s0[0]) * (1.f / 64.f); a[1] += (p0[1] + s0[1]) * (1.f / 64.f); a[2] += (p1[0] + s1[0]) * (1.f / 64.f); a[3] += (p1[1] + s1[1]) * (1.f / 64.f);
            b[0] += (p2[0] + s2[0]) * (1.f / 64.f); b[1] += (p2[1] + s2[1]) * (1.f / 64.f); b[2] += (p3[0] + s3[0]) * (1.f / 64.f); b[3] += (p3[1] + s3[1]) * (1.f / 64.f);
            v[2 * i] = a; v[2 * i + 1] = b;
            ss += a[0] * a[0] + a[1] * a[1] + a[2] * a[2] + a[3] * a[3] + b[0] * b[0] + b[1] * b[1] + b[2] * b[2] + b[3] * b[3]; }
        asm volatile("" ::: "memory");
        if (row + nwg * 8 < T_) MC_LOAD(row + nwg * 8);
        asm volatile("" ::: "memory");
        ss = wave_sum(ss);
        const float r = rsqrtf(ss * (1.f / D_) + 1e-6f);
        const size_t rb = (size_t)row * D_;
#pragma unroll
        for (int i = 0; i < 4; ++i) { const int e0 = 8 * (lane + 64 * i); const f32x4 ga = gv[2 * i], gb = gv[2 * i + 1], a = v[2 * i], b = v[2 * i + 1];
            if (hb) { if (WRITE_X) { if (XOUT16) { u32x4 o; o.x = cvt_pk_bf16(a[0], a[1]); o.y = cvt_pk_bf16(a[2], a[3]); o.z = cvt_pk_bf16(b[0], b[1]); o.w = cvt_pk_bf16(b[2], b[3]); *(u32x4*)((bf16_t*)xout + rb + e0) = o; }
                                      else { *(f32x4*)(xout + rb + e0) = a; *(f32x4*)(xout + rb + e0 + 4) = b; } }
                if (HB8) { const float r4s = 4.f * r; u32x2 o; o.x = pk4_fp8(a[0] * r4s * ga[0], a[1] * r4s * ga[1], a[2] * r4s * ga[2], a[3] * r4s * ga[3]); o.y = pk4_fp8(b[0] * r4s * gb[0], b[1] * r4s * gb[1], b[2] * r4s * gb[2], b[3] * r4s * gb[3]);
                    *(u32x2*)((unsigned char*)hb + rb + e0) = o; }
                else { u32x4 o; o.x = cvt_pk_bf16(a[0] * r * ga[0], a[1] * r * ga[1]); o.y = cvt_pk_bf16(a[2] * r * ga[2], a[3] * r * ga[3]); o.z = cvt_pk_bf16(b[0] * r * gb[0], b[1] * r * gb[1]); o.w = cvt_pk_bf16(b[2] * r * gb[2], b[3] * r * gb[3]);
                    *(u32x4*)(hb + rb + e0) = o; } }
            else { f32x4 oa, ob;
#pragma unroll
                for (int e = 0; e < 4; ++e) { oa[e] = a[e] * r * ga[e]; ob[e] = b[e] * r * gb[e]; }
                *(f32x4*)(outf + rb + e0) = oa; *(f32x4*)(outf + rb + e0 + 4) = ob; } }
    }
#undef MC_LOAD
}
template <bool WRITE_X, bool Y8, bool XIN16, bool XOUT16, bool HB8 = false>
__device__ __forceinline__ void moe_combine_phase(const void* xin, void* xout, const void* y, const float* g, bf16_t* hb, float* outf, int wg, int nwg, int wave_s) {
    if constexpr (Y8) moe_combine_phase_pipe<WRITE_X, HB8, XIN16, XOUT16>((const float*)xin, (float*)xout, (const unsigned char*)y, g, hb, outf, wg, nwg, wave_s);
    else moe_combine_phase_gen<WRITE_X, Y8, XIN16, XOUT16, HB8>(xin, xout, y, g, hb, outf, wg, nwg, wave_s);
}
__device__ __forceinline__ void lb_phase(const float* lbp, float* lbv, int wg, int nwg, int wave_s) {
    const int tid = opaque_tid(wave_s);
    for (int i = wg * NTHR + tid; i < 2048; i += nwg * NTHR) lbv[i] = 1.f / (1.f + __expf(lbp[i] - lbp[2048 + i]));
}
template <bool S8> struct EpiInC {
    bf16_t *qs, *vT, *sg, *lf; const float* lbv;
    static constexpr float SC = S8 ? (1.f / 256.f) : 1.f;
    __device__ __forceinline__ bool swapped(int pn) const { return pn >= 16 && pn < 24; }
    __device__ __forceinline__ int brow0(int pn) const { return pn * 256; }
    __device__ __forceinline__ void operator()(const f32x4 (&acc)[8][4], int pm, int pn, int wr, int wc, int fr, int fq) const {
        if (pn < 8 || pn >= 24) {
            bf16_t* dst = (pn < 8 ? qs : sg) + (size_t)((pn & 7) * 2) * T_ * 128;
#pragma unroll
            for (int m = 0; m < 8; ++m) { int row = pm * 256 + arow_of<8>(wr, m, fr); asm volatile("" : "+v"(row));
#pragma unroll
                for (int hf = 0; hf < 2; ++hf) { u32x4 w; const f32x4 a = acc[m][2 * hf], b = acc[m][2 * hf + 1];
                    w.x = cvt_pk_bf16(silu_fast(SC * a[0]), silu_fast(SC * a[1])); w.y = cvt_pk_bf16(silu_fast(SC * a[2]), silu_fast(SC * a[3]));
                    w.z = cvt_pk_bf16(silu_fast(SC * b[0]), silu_fast(SC * b[1])); w.w = cvt_pk_bf16(silu_fast(SC * b[2]), silu_fast(SC * b[3]));
                    *(u32x4*)(dst + ((size_t)hf * T_ + row) * 128 + wc * 32 + 8 * fq) = w; } }
        } else if (pn < 16) {
            const int cb = (pn - 8) * 256; f32x4 lb[4];
#pragma unroll
            for (int n = 0; n < 4; ++n) lb[n] = *(const f32x4*)(lbv + cb + bcol_of<4>(wc, n, fq, 0));
#pragma unroll
            for (int m = 0; m < 8; ++m) { int row = pm * 256 + arow_of<8>(wr, m, fr); asm volatile("" : "+v"(row));
#pragma unroll
                for (int hf = 0; hf < 2; ++hf) { float o[8];
#pragma unroll
                    for (int e = 0; e < 8; ++e) { const float z = acc[m][2 * hf + (e >> 2)][e & 3], l = lb[2 * hf + (e >> 2)][e & 3]; o[e] = 0.6931471805599453f * __builtin_amdgcn_logf(l + (1.f - l) * __builtin_amdgcn_rcpf(1.f + __builtin_amdgcn_exp2f((-1.4426950408889634f * SC) * z))); }
                    u32x4 w; w.x = cvt_pk_bf16(o[0], o[1]); w.y = cvt_pk_bf16(o[2], o[3]); w.z = cvt_pk_bf16(o[4], o[5]); w.w = cvt_pk_bf16(o[6], o[7]);
                    *(u32x4*)(lf + ((size_t)((pn - 8) * 2 + hf) * T_ + row) * 128 + wc * 32 + 8 * fq) = w; } }
        } else {
            bf16_t* dst = vT + ((size_t)((pn - 16) * 2) * 128 + pm * 2) * 16384;
#pragma unroll
            for (int m = 0; m < 8; ++m) { int f = arow_of<8>(wr, m, fr); asm volatile("" : "+v"(f));
#pragma unroll
                for (int hf = 0; hf < 2; ++hf) { u32x4 w; const f32x4 a = acc[m][2 * hf], b = acc[m][2 * hf + 1];
                    w.x = cvt_pk_bf16(SC * a[0], SC * a[1]); w.y = cvt_pk_bf16(SC * a[2], SC * a[3]); w.z = cvt_pk_bf16(SC * b[0], SC * b[1]); w.w = cvt_pk_bf16(SC * b[2], SC * b[3]);
                    *(u32x4*)(dst + ((size_t)(m >> 2) * 128 + hf) * 16384 + (f & 127) * 128 + wc * 32 + 8 * fq) = w; } }
        }
    }
};
__device__ __forceinline__ int bcol_to_slot2(int c) { const int c5 = c & 31; return (c & ~31) + ((c5 >> 2) & 1) * 16 + (c5 >> 3) * 4 + (c5 & 3); }
template <bool BG>
__device__ __forceinline__ void hgrn_kv_phase(LAS unsigned char* lds, const bf16_t* lf, const bf16_t* vT, float* dec, bf16_t* KVT2, const float* bw0, const float* bw1, const float* bw2, unsigned char* bgu, unsigned char* bdn, int tile0, int wg, int nwg, int wave_s) {
    typedef Core<4, 2> C;
    const int tid = opaque_tid(wave_s), wid = __builtin_amdgcn_readfirstlane(tid >> 6), lane = tid & 63, wr = wid >> 2, wc = wid & 3, fr = lane & 15, fq = lane >> 4;
    LAS unsigned char* ldsB = lds + 65536;
    LAS float* tot = (LAS float*)(lds + 131072);
    unsigned aoff[2];
#pragma unroll
    for (int i = 0; i < 2; ++i) { int r, c; C::apiece(tid, i, r, c); aoff[i] = (unsigned)(r * 128 + c) * 2u; }
    const int q4 = lane & 31, s = wid * 2 + (lane >> 5), dk0 = 4 * q4;
    for (int u = wg; u < 2048; u += nwg) {
        const int n = u >> 4, h = u & 15;
        const size_t t0 = (size_t)n * 128 + s * 8; const size_t col = (size_t)h * T_ * 128 + dk0;
        float4 bg[3][8];
        if (BG) {
#pragma unroll
            for (int b3 = 0; b3 < 3; ++b3) bg_issue(bw0, bw1, bw2, tile0 + 3 * u + b3, bg[b3], tid); }
        float l[8][4]; float sm[4] = {0.f, 0.f, 0.f, 0.f};
#pragma unroll
        for (int j = 0; j < 8; ++j) { const u32x2 w = *(const u32x2*)(lf + (t0 + j) * 128 + col); l[j][0] = bflo(w.x); l[j][1] = bfhi(w.x); l[j][2] = bflo(w.y); l[j][3] = bfhi(w.y);
#pragma unroll
            for (int d = 0; d < 4; ++d) sm[d] += l[j][d]; }
        *(LAS f32x4*)(tot + s * 128 + dk0) = (f32x4){sm[0], sm[1], sm[2], sm[3]};
        __syncthreads();
        { const char* Vb = (const char*)(vT + (size_t)(h * 128 + n) * 16384); C::stage_a(lds, Vb, aoff, 0u, wid); C::stage_a(lds + 16384, Vb, aoff, 128u, wid); }
        float pre[4] = {0.f, 0.f, 0.f, 0.f}, tt[4] = {0.f, 0.f, 0.f, 0.f};
#pragma unroll
        for (int q = 0; q < 16; ++q) { const f32x4 v = *(const LAS f32x4*)(tot + q * 128 + dk0);
#pragma unroll
            for (int d = 0; d < 4; ++d) { tt[d] += v[d]; pre[d] += (q < s) ? v[d] : 0.f; } }
        if (s == 0) *(f32x4*)(dec + (size_t)n * 2048 + col) = (f32x4){__expf(tt[0]), __expf(tt[1]), __expf(tt[2]), __expf(tt[3])};
        float kh[4][8];
#pragma unroll
        for (int j = 0; j < 8; ++j)
#pragma unroll
            for (int d = 0; d < 4; ++d) { pre[d] += l[j][d]; kh[d][j] = (1.f - __expf(l[j][d])) * __expf(tt[d] - pre[d]); }
        const int jj = s * 8;
#pragma unroll
        for (int d = 0; d < 4; ++d) { u32x4 w; w.x = cvt_pk_bf16(kh[d][0], kh[d][1]); w.y = cvt_pk_bf16(kh[d][2], kh[d][3]); w.z = cvt_pk_bf16(kh[d][4], kh[d][5]); w.w = cvt_pk_bf16(kh[d][6], kh[d][7]);
            *(LAS u32x4*)(ldsB + (jj >> 6) * 16384 + lds_byte(bcol_to_slot2(dk0 + d), jj & 63)) = w; }
        WAIT_V0(); __syncthreads();
        f32x4 acc[4][2]; C::zero(acc);
        C::compute(lds, ldsB, acc, wr, wc, fr, fq); C::compute(lds + 16384, ldsB + 16384, acc, wr, wc, fr, fq);
        __syncthreads();
        bf16_t* dst = KVT2 + (size_t)u * 16384;
#pragma unroll
        for (int m = 0; m < 4; ++m) { const f32x4 a = acc[m][0], b = acc[m][1]; u32x4 w;
            w.x = cvt_pk_bf16(a[0], a[1]); w.y = cvt_pk_bf16(a[2], a[3]); w.z = cvt_pk_bf16(b[0], b[1]); w.w = cvt_pk_bf16(b[2], b[3]);
            *(u32x4*)(dst + (wr * 64 + m * 16 + fr) * 128 + wc * 32 + 8 * fq) = w; }
        if (BG) {
#pragma unroll
            for (int b3 = 0; b3 < 3; ++b3) bg_write(lds + b3 * 18432, bg[b3], (tile0 + 3 * u + b3) >= 8192 ? 32.f : 64.f, tid);
            __syncthreads();
#pragma unroll
            for (int b3 = 0; b3 < 3; ++b3) bg_store(lds + b3 * 18432, bgu, bdn, tile0 + 3 * u + b3, tid);
            __syncthreads(); }
    }
}
__device__ __forceinline__ void hgrn_scan_phase(const bf16_t* KVT2, const float* dec, bf16_t* STb2, int wg, int nwg, int wave_s) {
    const int tid = opaque_tid(wave_s);
    for (int e = (wg * NTHR + tid) * 2; e < 262144; e += nwg * NTHR * 2) {
        const int c = (e >> 14) * 128 + (e & 127);
        float s0 = 0.f, s1 = 0.f;
        for (int n0 = 0; n0 < 128; n0 += 8) {
            unsigned kv[8]; float2 d[8];
#pragma unroll
            for (int i = 0; i < 8; ++i) { kv[i] = *(const unsigned*)(KVT2 + (size_t)(n0 + i) * 262144 + e); d[i] = *(const float2*)(dec + (size_t)(n0 + i) * 2048 + c); }
#pragma unroll
            for (int i = 0; i < 8; ++i) { *(unsigned*)(STb2 + (size_t)(n0 + i) * 262144 + e) = cvt_pk_bf16(s0, s1); s0 = d[i].x * s0 + bflo(kv[i]); s1 = d[i].y * s1 + bfhi(kv[i]); }
        }
    }
}
template <bool BG, bool MIX8 = false>
__device__ __forceinline__ void hgrn_out_phase(LAS unsigned char* lds, const bf16_t* qs, const bf16_t* lf, const bf16_t* vT, const bf16_t* STb2, const bf16_t* sg,
                                               const float* gain, bf16_t* mixb, const float* bw0, const float* bw1, const float* bw2, unsigned char* bgu, unsigned char* bdn, int tile0, int wg, int nwg, int wave_s) {
    typedef Core<4, 2> C;
    const int tid = opaque_tid(wave_s), wid = __builtin_amdgcn_readfirstlane(tid >> 6), lane = tid & 63, wr = wid >> 2, wc = wid & 3, fr = lane & 15, fq = lane >> 4;
    LAS unsigned char* lQ = lds; LAS unsigned char* lK = lds + 32768; LAS unsigned char* lS = lds + 65536; LAS unsigned char* lV = lds + 98304;
    LAS float* stat = (LAS float*)(lds + 131072);
    LAS float* tot = (LAS float*)(lds + 133120);
    unsigned soff[2], voff[2];
#pragma unroll
    for (int i = 0; i < 2; ++i) { int r, c; C::bpiece(tid, i, r, c); soff[i] = (unsigned)(r * 128 + c) * 2u; voff[i] = (unsigned)(r * 128 + c) * 2u; }
    const int q4 = lane & 31, s = wid * 2 + (lane >> 5), dk0 = 4 * q4;
    u32x2 lw[8], qw8[8];
    if (wg < 2048) { const size_t t0 = (size_t)(wg >> 4) * 128 + s * 8; const size_t col = (size_t)(wg & 15) * T_ * 128 + dk0;
#pragma unroll
        for (int j = 0; j < 8; ++j) { lw[j] = *(const u32x2*)(lf + (t0 + j) * 128 + col); qw8[j] = *(const u32x2*)(qs + (t0 + j) * 128 + col); } }
    for (int u = wg; u < 2048; u += nwg) {
        const int n = u >> 4, h = u & 15;
        const char* Sb = (const char*)(STb2 + (size_t)u * 16384); const char* Vb = (const char*)(vT + (size_t)(h * 128 + n) * 16384);
        float4 bg[3][8];
        if (BG) {
#pragma unroll
            for (int b3 = 0; b3 < 3; ++b3) bg_issue(bw0, bw1, bw2, tile0 + 3 * u + b3, bg[b3], tid); }
        {
            const size_t t0 = (size_t)n * 128 + s * 8; const int col = h * 128 + dk0;
            float l[8][4]; float sm[4] = {0.f, 0.f, 0.f, 0.f};
#pragma unroll
            for (int j = 0; j < 8; ++j) { const u32x2 w = lw[j]; l[j][0] = bflo(w.x); l[j][1] = bfhi(w.x); l[j][2] = bflo(w.y); l[j][3] = bfhi(w.y);
#pragma unroll
                for (int d = 0; d < 4; ++d) sm[d] += l[j][d]; }
            *(LAS f32x4*)(tot + s * 128 + dk0) = (f32x4){sm[0], sm[1], sm[2], sm[3]};
            __syncthreads();
#pragma unroll
            for (int t = 0; t < 2; ++t) { C::stage_b(lS + t * 16384, Sb, soff, t * 128u, wid); C::stage_b(lV + t * 16384, Vb, voff, t * 128u, wid); }
            float pre[4] = {0.f, 0.f, 0.f, 0.f};
#pragma unroll
            for (int q = 0; q < 16; ++q) { const f32x4 v = *(const LAS f32x4*)(tot + q * 128 + dk0);
#pragma unroll
                for (int d = 0; d < 4; ++d) pre[d] += (q < s) ? v[d] : 0.f; }
#pragma unroll
            for (int j = 0; j < 8; ++j) { const u32x2 qw = qw8[j];
                const float qv[4] = {bflo(qw.x), bfhi(qw.x), bflo(qw.y), bfhi(qw.y)}; float oq[4], ok[4];
#pragma unroll
                for (int d = 0; d < 4; ++d) { pre[d] += l[j][d]; oq[d] = qv[d] * __expf(pre[d]); ok[d] = (1.f - __expf(l[j][d])) * __expf(-pre[d]); }
                const int tk = s * 8 + j;
                u32x2 w; w.x = cvt_pk_bf16(oq[0], oq[1]); w.y = cvt_pk_bf16(oq[2], oq[3]); *(LAS u32x2*)(lQ + (dk0 >> 6) * 16384 + lds_byte(tk, dk0 & 63)) = w;
                w.x = cvt_pk_bf16(ok[0], ok[1]); w.y = cvt_pk_bf16(ok[2], ok[3]); *(LAS u32x2*)(lK + (dk0 >> 6) * 16384 + lds_byte(bcol_to_slot2(tk), dk0 & 63)) = w; }
        }
        WAIT_V0(); __syncthreads();
        if (u + nwg < 2048) { const int un = u + nwg; const size_t t0n = (size_t)(un >> 4) * 128 + s * 8; const size_t coln = (size_t)(un & 15) * T_ * 128 + dk0;
#pragma unroll
            for (int j = 0; j < 8; ++j) { lw[j] = *(const u32x2*)(lf + (t0n + j) * 128 + coln); qw8[j] = *(const u32x2*)(qs + (t0n + j) * 128 + coln); } }
        {
            f32x4 sa[4][2]; C::zero(sa);
            C::compute(lQ, lK, sa, wr, wc, fr, fq); C::compute(lQ + 16384, lK + 16384, sa, wr, wc, fr, fq);
            __syncthreads();
#pragma unroll
            for (int m = 0; m < 4; ++m) { const int i = wr * 64 + m * 16 + fr; const int j0 = wc * 32 + 8 * fq;
                float p[8];
#pragma unroll
                for (int e = 0; e < 8; ++e) { const float sv = e < 4 ? sa[m][0][e] : sa[m][1][e - 4]; p[e] = (j0 + e <= i) ? sv : 0.f; }
                u32x4 w; w.x = cvt_pk_bf16(p[0], p[1]); w.y = cvt_pk_bf16(p[2], p[3]); w.z = cvt_pk_bf16(p[4], p[5]); w.w = cvt_pk_bf16(p[6], p[7]);
                *(LAS u32x4*)(lK + (wc >> 1) * 16384 + lds_byte(i, j0 & 63)) = w; }
            __syncthreads();
        }
        f32x4 acc[4][2]; C::zero(acc);
        C::compute(lQ, lS, acc, wr, wc, fr, fq); C::compute(lQ + 16384, lS + 16384, acc, wr, wc, fr, fq);
        C::compute(lK, lV, acc, wr, wc, fr, fq); C::compute(lK + 16384, lV + 16384, acc, wr, wc, fr, fq);
#pragma unroll
        for (int m = 0; m < 4; ++m) { float ss = 0.f;
#pragma unroll
            for (int nn = 0; nn < 2; ++nn)
#pragma unroll
                for (int e = 0; e < 4; ++e) { const float v = acc[m][nn][e]; ss += v * v; }
            ss += __shfl_xor(ss, 16); ss += __shfl_xor(ss, 32);
            if (fq == 0) stat[(wr * 64 + m * 16 + fr) * 4 + wc] = ss; }
        __syncthreads();
        u32x4 g8v[4]; f32x4 gn0, gn1;
        { const int c0 = h * 128 + wc * 32 + 8 * fq; gn0 = *(const f32x4*)(gain + c0); gn1 = *(const f32x4*)(gain + c0 + 4);
#pragma unroll
          for (int m = 0; m < 4; ++m) g8v[m] = *(const u32x4*)(sg + ((size_t)h * T_ + (size_t)n * 128 + wr * 64 + m * 16 + fr) * 128 + wc * 32 + 8 * fq); }
        asm volatile("" ::: "memory");
#pragma unroll
        for (int m = 0; m < 4; ++m) { const int i = wr * 64 + m * 16 + fr;
            const float ss = stat[i * 4] + stat[i * 4 + 1] + stat[i * 4 + 2] + stat[i * 4 + 3];
            const float rstd = rsqrtf(ss * (1.f / 128.f) + 1e-6f);
            const size_t t = (size_t)n * 128 + i; const int c0 = h * 128 + wc * 32 + 8 * fq;
            const u32x4 g8 = g8v[m];
            const f32x4 g0 = gn0, g1 = gn1;
            const f32x4 a = acc[m][0], b = acc[m][1];
            u32x4 w; w.x = cvt_pk_bf16(a[0] * rstd * g0[0] * bflo(g8.x), a[1] * rstd * g0[1] * bfhi(g8.x)); w.y = cvt_pk_bf16(a[2] * rstd * g0[2] * bflo(g8.y), a[3] * rstd * g0[3] * bfhi(g8.y));
            w.z = cvt_pk_bf16(b[0] * rstd * g1[0] * bflo(g8.z), b[1] * rstd * g1[1] * bfhi(g8.z)); w.w = cvt_pk_bf16(b[2] * rstd * g1[2] * bflo(g8.w), b[3] * rstd * g1[3] * bfhi(g8.w));
            if (MIX8) { float o8[8] = {a[0] * rstd * g0[0] * bflo(g8.x), a[1] * rstd * g0[1] * bfhi(g8.x), a[2] * rstd * g0[2] * bflo(g8.y), a[3] * rstd * g0[3] * bfhi(g8.y),
                                       b[0] * rstd * g1[0] * bflo(g8.z), b[1] * rstd * g1[1] * bfhi(g8.z), b[2] * rstd * g1[2] * bflo(g8.w), b[3] * rstd * g1[3] * bfhi(g8.w)};
#pragma unroll
                for (int e = 0; e < 8; ++e) o8[e] = __builtin_amdgcn_fmed3f(8.f * o8[e], -448.f, 448.f);
                u32x2 w8; w8.x = pk4_fp8(o8[0], o8[1], o8[2], o8[3]); w8.y = pk4_fp8(o8[4], o8[5], o8[6], o8[7]);
                *(u32x2*)((unsigned char*)mixb + t * 2048 + c0) = w8; }
            else *(u32x4*)(mixb + t * 2048 + c0) = w; }
        __syncthreads();
        if (BG) {
#pragma unroll
            for (int b3 = 0; b3 < 3; ++b3) bg_write(lds + b3 * 18432, bg[b3], (tile0 + 3 * u + b3) >= 8192 ? 32.f : 64.f, tid);
            __syncthreads();
#pragma unroll
            for (int b3 = 0; b3 < 3; ++b3) bg_store(lds + b3 * 18432, bgu, bdn, tile0 + 3 * u + b3, tid);
            __syncthreads(); }
    }
}
#define LDS_BYTES 147456
#define MiB(x) ((size_t)(x) << 20)
#define WS_CTL     ((size_t)0)
#define CTL_BYTES  65536
#define CTL_CNT    1024
#define CTL_BAR    4096
#define WS_X1      MiB(1)
#define WS_HB      MiB(129)
#define WS_ROPE    MiB(193)
#define WS_WSM     MiB(225)
#define WS_WR      MiB(226)
#define WS_WINAB   MiB(228)
#define WS_WOUTAB  MiB(252)
#define WS_WINC    MiB(260)
#define WS_WOUTC   MiB(292)
#define WS_WGU     MiB(300)
#define WS_WDN     MiB(812)
#define WS_SCR     MiB(1068)
#define WS_QB      (WS_SCR)
#define WS_KVT     (WS_SCR + MiB(224))
#define WS_STB     (WS_SCR + MiB(352))
#define WS_MIXB    (WS_SCR + MiB(416))
#define WS_VNT     (WS_SCR + MiB(480))
#define WS_HID     (WS_SCR)
#define WS_Y       (WS_SCR + MiB(80))
#define WS_LIST    (WS_SCR + MiB(208))
#define WS_GATE    (WS_SCR + MiB(212))
struct FArgs { const float* in[21]; float* out; unsigned char* ws; int ph_lo, ph_hi; };
#define WS1_QS     (WS_SCR)
#define WS1_VT     (WS_SCR + MiB(64))
#define WS1_SG     (WS_SCR + MiB(128))
#define WS1_LF     (WS_SCR + MiB(192))
#define WS1_QH     (WS_SCR + MiB(320))
#define WS1_KT     (WS_SCR + MiB(480))
#define WS1_KVT    (WS_SCR + MiB(544))
#define WS1_STB    (WS_SCR + MiB(672))
#define WS1_DEC    (WS_SCR + MiB(736))
#define WS_Y0      (WS_SCR + MiB(740))
#define WS_LBV     (WS_WR + MiB(1))
#define N_PHASES 20
#ifndef FP8_L0
#define FP8_L0 1
#endif
#ifndef FP8_L1
#define FP8_L1 1
#endif
#ifndef BGCONV_L1
#define BGCONV_L1 0
#endif
#ifndef F8_INC
#define F8_INC 1
#endif
#ifndef F8_INAB
#define F8_INAB 0
#endif
#ifndef BG_T2
#define BG_T2 18432
#endif
#ifndef NCONV2
#define NCONV2 85
#endif
#ifndef BG_T11
#define BG_T11 6144
#endif
#ifndef NCONV11
#define NCONV11 51
#endif
static_assert(BG_T11 == 0 || BG_T2 >= 12288, "layer-0 tiles must be converted before P8");
static_assert(BG_T2 + BG_T11 <= 24576, "tile ranges");
#ifndef F8_OUTC
#define F8_OUTC 1
#endif
#ifndef XB16
#define XB16 1
#endif
#ifndef Y8_L0
#define Y8_L0 1
#endif
#ifndef Y8_L1
#define Y8_L1 1
#endif
__global__ void __launch_bounds__(NTHR, 2) fwd(FArgs a) {
    extern __shared__ __attribute__((aligned(16))) unsigned char lds_raw[];
    LAS unsigned char* lds = (LAS unsigned char*)lds_raw;
    const int lo = a.ph_lo, hi = a.ph_hi;
    const int wave_s = __builtin_amdgcn_readfirstlane(threadIdx.x >> 6);
    const int wg = blockIdx.x, nwg = gridDim.x;
    if (threadIdx.x == 0) *(LAS u32x4*)(lds + LDS_BYTES - 16) = (u32x4){0u, 0u, 0u, 0u};
    __syncthreads();
    XcdBarrier bar; bar.bar = (unsigned*)(a.ws + WS_CTL + CTL_BAR); bar.x = 0; bar.st = (volatile LAS unsigned*)(lds + LDS_BYTES - 16);
    if (hi - lo > 1) bar = xcd_barrier_post((unsigned*)(a.ws + WS_CTL + CTL_BAR), (volatile LAS unsigned*)(lds + LDS_BYTES - 16));
#define GRID_BAR() xcd_barrier(bar)
#define IN(k) (lo <= (k) && (k) < hi)
#define BOTH(k) (IN(k) && IN((k) + 1))
#ifndef DUP_MASK
#define DUP_MASK 0
#endif
#define DUP(k) ((DUP_MASK >> (k)) & 1)
#define PH(k, ...) if (IN(k)) { __VA_ARGS__ if (DUP(k)) { GRID_BAR(); __VA_ARGS__ } if (BOTH(k)) GRID_BAR(); }
    unsigned char* ws = a.ws;
    float* x1 = (float*)(ws + WS_X1); bf16_t* xb = (bf16_t*)(ws + WS1_QH);     bf16_t* hb = (bf16_t*)(ws + WS_HB);
    bf16_t* WsM = (bf16_t*)(ws + WS_WSM); bf16_t* WrT = (bf16_t*)(ws + WS_WR); float* lbv = (float*)(ws + WS_LBV);
    bf16_t* winab = (bf16_t*)(ws + WS_WINAB); bf16_t* woutab = (bf16_t*)(ws + WS_WOUTAB); bf16_t* winc = (bf16_t*)(ws + WS_WINC); bf16_t* woutc = (bf16_t*)(ws + WS_WOUTC);
    bf16_t* wgu = (bf16_t*)(ws + WS_WGU); bf16_t* wdn = (bf16_t*)(ws + WS_WDN);
    bf16_t* qb = (bf16_t*)(ws + WS_QB); bf16_t* KVT = (bf16_t*)(ws + WS_KVT); bf16_t* STb = (bf16_t*)(ws + WS_STB); bf16_t* mixb = (bf16_t*)(ws + WS_MIXB); bf16_t* vnT = (bf16_t*)(ws + WS_VNT);
    unsigned char* hb8 = ws + WS_ROPE;
    bf16_t* hid = (bf16_t*)(ws + WS_HID); bf16_t* yb = (bf16_t*)(ws + WS_Y); bf16_t* yb0 = (bf16_t*)(ws + WS_Y0); int* list = (int*)(ws + WS_LIST); float* gate = (float*)(ws + WS_GATE);
    int* cnt = (int*)(ws + WS_CTL + CTL_CNT);
    const size_t TS = (size_t)T_ * 1024; const size_t WGU_L = (size_t)32 * 2048 * 2048, WDN_L = (size_t)32 * 2048 * 1024;
    PH(0, {
        { ConvJob J{a.in[4], winab, 2048, 6144, 1, 6144, 6144, 6144, 0, 0}; if (F8_INAB) conv8_phase(lds, J, 64.f, wg, nwg, wave_s); else conv_phase(lds, J, wg, nwg, wave_s); }
        { ConvJob J{a.in[9], woutab, 2048, 2048, 1, 2048, 2048, 2048, 0, 0}; conv_phase(lds, J, wg, nwg, wave_s); }
        { ConvJob J{a.in[10], winc, 2048, 8192, 1, 8192, 8192, 8192, 0, 0}; if (F8_INC) conv8_phase(lds, J, 64.f, wg, nwg, wave_s); else conv_phase(lds, J, wg, nwg, wave_s); }
        { ConvJob J{a.in[13], woutc, 2048, 2048, 1, 2048, 2048, 2048, 0, 0}; if (F8_OUTC) conv8_phase(lds, J, 64.f, wg, nwg, wave_s); else conv_phase(lds, J, wg, nwg, wave_s); }
        if (FP8_L0 && FP8_L1 && !BGCONV_L1) { if (BG_T2 + BG_T11 < 24576) conv_stream(lds, a.in[18], a.in[19], a.in[20], (unsigned char*)wgu, (unsigned char*)wdn, BG_T2 + BG_T11, 24576, wg, nwg, wave_s); }
        else for (int L = 0; L < 2; ++L) {
            const bool f8 = L ? (FP8_L1 != 0) : (FP8_L0 != 0);
            if (L == 1 && BGCONV_L1 && FP8_L1) continue;
            const float* sg_ = a.in[18] + (size_t)L * 32 * 2048 * 1024; const float* su_ = a.in[19] + (size_t)L * 32 * 2048 * 1024; const float* sd_ = a.in[20] + (size_t)L * 32 * 2048 * 1024;
            ConvJob Jg{sg_, wgu + L * WGU_L, 2048, 1024, 32, 2048, 128, 256, 0, 0}, Ju{su_, wgu + L * WGU_L, 2048, 1024, 32, 2048, 128, 256, 128, 0}, Jd{sd_, wdn + L * WDN_L, 1024, 2048, 32, 2048, 2048, 2048, 0, 0};
            if (f8) { conv8_phase(lds, Jg, 64.f, wg, nwg, wave_s); conv8_phase(lds, Ju, 64.f, wg, nwg, wave_s); conv8_phase(lds, Jd, 32.f, wg, nwg, wave_s); }
            else { conv_phase(lds, Jg, wg, nwg, wave_s); conv_phase(lds, Ju, wg, nwg, wave_s); conv_phase(lds, Jd, wg, nwg, wave_s); }
        }
        wr_phase(a.in[14], a.in[16], WrT, wg, nwg, wave_s);
        wr_phase(a.in[14] + 2048 * 4, a.in[16] + 2048 * 32, WrT + 64 * 2048, wg, nwg, wave_s);
        wsm_phase(a.in[7], WsM, wg, nwg, wave_s);
        lb_phase(a.in[11], lbv, wg, nwg, wave_s);
        norm_rows_bf16<F8_INAB != 0>(a.in[0], a.in[1], hb, wg, nwg, wave_s);
    })

    PH(2, { const bool split = FP8_L0 && FP8_L1 && !BGCONV_L1 && BG_T2 > 0 && nwg > 2 * NCONV2; const int ng = split ? nwg - NCONV2 : nwg;
            if (wg < ng) { EpiInAB<F8_INAB != 0> E{qb, qb + TS, qb + 3 * TS, qb + 4 * TS, qb + 5 * TS, qb + 6 * TS};
                if (F8_INAB) gemm_phase_f8(lds, (const unsigned char*)hb, (const unsigned char*)winab, 64, 24, 2048, E, wave_s, wg, ng); else gemm_phase(lds, hb, winab, 64, 24, 2048, E, wave_s, wg, ng); }
            else conv_stream(lds, a.in[18], a.in[19], a.in[20], (unsigned char*)wgu, (unsigned char*)wdn, 0, BG_T2, wg - ng, nwg - ng, wave_s); })
    PH(3, { gmlp_norm_phase(lds, qb + 6 * TS, vnT, a.in[6], wg, nwg, wave_s); ret_kv_phase(lds, qb + 3 * TS, qb + TS, KVT, wg, nwg, wave_s); })
    PH(4, { ret_scan_phase(KVT, STb, wg, nwg, wave_s); })
    PH(5, { ret_out_phase(lds, qb, qb + TS, qb + 3 * TS, STb, qb + 4 * TS, a.in[5], mixb, wg, nwg, wave_s);
                 gmlp_mix_phase(lds, WsM, vnT, qb + 5 * TS, a.in[8], mixb, wg, nwg, wave_s); })
    PH(6, { if (XB16) { EpiResidualT<true> E{a.in[0], (float*)xb}; gemm_phase(lds, mixb, woutab, 64, 8, 2048, E, wave_s); } else { EpiResidual E{a.in[0], x1}; gemm_phase(lds, mixb, woutab, 64, 8, 2048, E, wave_s); } })
    PH(7, { moe_route_phase<XB16 != 0>(lds, XB16 ? (const void*)xb : (const void*)x1, a.in[2], hb, FP8_L0 ? hb8 : nullptr, WrT, a.in[15], a.in[17], cnt, list, gate, wg, nwg, wave_s); })
    PH(8, { moe_gu_phase<FP8_L0 != 0>(lds, FP8_L0 ? (const void*)hb8 : (const void*)hb, wgu, cnt, list, hid, wg, nwg, wave_s); })
    PH(9, { moe_down_phase<FP8_L0 != 0, Y8_L0 != 0>(lds, hid, wdn, cnt, list, gate, yb, wg, nwg, wave_s); })
    PH(10, { moe_combine_phase<true, Y8_L0 != 0, XB16 != 0, XB16 != 0, F8_INC != 0>(XB16 ? (const void*)xb : (const void*)x1, XB16 ? (void*)xb : (void*)x1, yb, a.in[1] + D_, hb, nullptr, wg, nwg, wave_s); })
    bf16_t* qs = (bf16_t*)(ws + WS1_QS); bf16_t* vT1 = (bf16_t*)(ws + WS1_VT); bf16_t* sg1 = (bf16_t*)(ws + WS1_SG); bf16_t* lf = (bf16_t*)(ws + WS1_LF);
    bf16_t* qh = (bf16_t*)(ws + WS1_QH); bf16_t* kt = (bf16_t*)(ws + WS1_KT); bf16_t* KVT2 = (bf16_t*)(ws + WS1_KVT); bf16_t* STb2 = (bf16_t*)(ws + WS1_STB); float* dec = (float*)(ws + WS1_DEC);
    PH(11, { const bool split = FP8_L0 && FP8_L1 && !BGCONV_L1 && BG_T11 > 0 && nwg > 2 * NCONV11; const int ng = split ? nwg - NCONV11 : nwg;
            if (wg < ng) { EpiInC<F8_INC != 0> E{qs, vT1, sg1, lf, lbv};
                if (F8_INC) gemm_phase_f8(lds, (const unsigned char*)hb, (const unsigned char*)winc, 64, 32, 2048, E, wave_s, wg, ng); else gemm_phase(lds, hb, winc, 64, 32, 2048, E, wave_s, wg, ng); }
            else conv_stream(lds, a.in[18], a.in[19], a.in[20], (unsigned char*)wgu, (unsigned char*)wdn, BG_T2, BG_T2 + BG_T11, wg - ng, nwg - ng, wave_s); })
    PH(12, { hgrn_kv_phase<(BGCONV_L1 && FP8_L1)>(lds, lf, vT1, dec, KVT2, a.in[18] + (size_t)32 * 2048 * 1024, a.in[19] + (size_t)32 * 2048 * 1024, a.in[20] + (size_t)32 * 2048 * 1024, (unsigned char*)(wgu + WGU_L), (unsigned char*)(wdn + WDN_L), 0, wg, nwg, wave_s); })
    PH(13, { hgrn_scan_phase(KVT2, dec, STb2, wg, nwg, wave_s); })
    PH(14, { hgrn_out_phase<(BGCONV_L1 && FP8_L1), (F8_OUTC != 0)>(lds, qs, lf, vT1, STb2, sg1, a.in[12], mixb, a.in[18] + (size_t)32 * 2048 * 1024, a.in[19] + (size_t)32 * 2048 * 1024, a.in[20] + (size_t)32 * 2048 * 1024, (unsigned char*)(wgu + WGU_L), (unsigned char*)(wdn + WDN_L), 6144, wg, nwg, wave_s); })
    PH(15, { if (XB16) { EpiResidual16 E{xb, F8_OUTC ? (1.f / 512.f) : 1.f}; if (F8_OUTC) gemm_phase_f8(lds, (const unsigned char*)mixb, (const unsigned char*)woutc, 64, 8, 2048, E, wave_s); else gemm_phase(lds, mixb, woutc, 64, 8, 2048, E, wave_s); } else { EpiResidual E{x1, x1, F8_OUTC ? (1.f / 512.f) : 1.f}; if (F8_OUTC) gemm_phase_f8(lds, (const unsigned char*)mixb, (const unsigned char*)woutc, 64, 8, 2048, E, wave_s); else gemm_phase(lds, mixb, woutc, 64, 8, 2048, E, wave_s); } })
    PH(16, { moe_route_phase<XB16 != 0>(lds, XB16 ? (const void*)xb : (const void*)x1, a.in[2] + D_, hb, FP8_L1 ? hb8 : nullptr, WrT + 64 * 2048, a.in[15] + 4, a.in[17] + 32, cnt + 32, list, gate, wg, nwg, wave_s); })
    PH(17, { moe_gu_phase<FP8_L1 != 0>(lds, FP8_L1 ? (const void*)hb8 : (const void*)hb, wgu + WGU_L, cnt + 32, list, hid, wg, nwg, wave_s); })
    PH(18, { moe_down_phase<FP8_L1 != 0, Y8_L1 != 0>(lds, hid, wdn + WDN_L, cnt + 32, list, gate, yb, wg, nwg, wave_s); })
    PH(19, { moe_combine_phase<true, Y8_L1 != 0, XB16 != 0, false>(XB16 ? (const void*)xb : (const void*)x1, nullptr, yb, a.in[3], nullptr, a.out, wg, nwg, wave_s); })
#undef IN
#undef BOTH
#undef GRID_BAR
}
#ifndef N_LAUNCH_PER_PHASE
#define N_LAUNCH_PER_PHASE 0
#endif
extern "C" void kernel_launch(void* const* d_in, const int* in_sizes, int n_in, void* d_out, int out_size, void* d_ws, size_t ws_size, hipStream_t stream) {
    static int grid = 0;
    if (!grid) {
        int dev = 0, cus = 0, per_cu = 0;
        (void)hipGetDevice(&dev); (void)hipDeviceGetAttribute(&cus, hipDeviceAttributeMultiprocessorCount, dev);
        (void)hipFuncSetAttribute((const void*)fwd, hipFuncAttributeMaxDynamicSharedMemorySize, LDS_BYTES);
        if (hipOccupancyMaxActiveBlocksPerMultiprocessor(&per_cu, (const void*)fwd, NTHR, LDS_BYTES) != hipSuccess || per_cu < 1) per_cu = 1;
        (void)hipGetLastError();
        grid = cus > 0 ? cus : 256;
    }
    FArgs fa{}; for (int i = 0; i < 21; ++i) fa.in[i] = (const float*)d_in[i];
    fa.out = (float*)d_out; fa.ws = (unsigned char*)d_ws;
    (void)hipMemsetAsync((char*)d_ws + WS_CTL, 0, CTL_BYTES, stream);
#if N_LAUNCH_PER_PHASE
    for (int p = 0; p < N_PHASES; ++p) { fa.ph_lo = p; fa.ph_hi = p + 1; hipLaunchKernelGGL(fwd, dim3(grid), dim3(NTHR), LDS_BYTES, stream, fa); }
#else
    fa.ph_lo = 0; fa.ph_hi = N_PHASES; hipLaunchKernelGGL(fwd, dim3(grid), dim3(NTHR), LDS_BYTES, stream, fa);
#endif
}
```

```cpp
#include <hip/hip_runtime.h>
#include <stdint.h>
#define T_ 16384
#define D_ 2048
__device__ __forceinline__ float wave_sum(float v) {
#pragma unroll
    for (int o = 32; o > 0; o >>= 1) v += __shfl_xor(v, o);
    return v;
}
typedef unsigned short bf16_t;
typedef short bf16x8 __attribute__((ext_vector_type(8)));
typedef float f32x4 __attribute__((ext_vector_type(4)));
typedef unsigned u32x4 __attribute__((ext_vector_type(4)));
typedef unsigned u32x2 __attribute__((ext_vector_type(2)));
#define LAS __attribute__((address_space(3)))
#define NTHR 512

__device__ __forceinline__ unsigned cvt_pk_bf16(float lo, float hi) { unsigned r; asm volatile("v_cvt_pk_bf16_f32 %0, %1, %2" : "=v"(r) : "v"(lo), "v"(hi)); return r; }
__device__ __forceinline__ float bf2f(bf16_t b) { return __uint_as_float(((unsigned)b) << 16); }
__device__ __forceinline__ float bflo(unsigned w) { return __uint_as_float(w << 16); }
__device__ __forceinline__ float bfhi(unsigned w) { return __uint_as_float(w & 0xffff0000u); }

__device__ __forceinline__ int lds_byte(int r, int c) { const int st = (r >> 4) * 2 + (c >> 5), ob = (r & 15) * 64 + (c & 31) * 2; return st * 1024 + (ob ^ (((ob >> 9) & 1) << 5)); }
__device__ __forceinline__ void stage_rc(int b, int& R, int& C) { const int st = b >> 10, sb = b & 1023, swz = sb ^ (((sb >> 9) & 1) << 5); R = (st >> 1) * 16 + swz / 64; C = (st & 1) * 32 + (swz % 64) / 2; }

#define WAIT_V0() asm volatile("s_waitcnt vmcnt(0)" ::: "memory")
__device__ __forceinline__ int opaque_tid(int wave_s) { int l; asm volatile("v_mbcnt_lo_u32_b32 %0, -1, 0\n\tv_mbcnt_hi_u32_b32 %0, -1, %0" : "=v"(l)); return wave_s * 64 + l; }

template <int MF> __device__ __forceinline__ int arow_of(int wr, int m, int fr) { if (MF == 8) return (m >> 2) * 128 + wr * 64 + (m & 3) * 16 + fr; return wr * (MF * 16) + m * 16 + fr; }
template <int NF> __device__ __forceinline__ int bcol_of(int wc, int n, int fq, int j) {
    if (NF == 4) return (n >> 1) * 128 + wc * 32 + 8 * fq + 4 * (n & 1) + j;
    if (NF == 2) return wc * 32 + 8 * fq + 4 * n + j;
    return wc * 16 + 4 * fq + j; }
template <int MF> __device__ __forceinline__ int aslot_to_row(int s) { const int wr = s / (MF * 16), m = (s >> 4) % MF, fr = s & 15; return arow_of<MF>(wr, m, fr); }
template <int NF> __device__ __forceinline__ int bslot_to_col(int s) { const int wc = s / (NF * 16), n = (s >> 4) % NF, i = s & 15; return bcol_of<NF>(wc, n, i >> 2, i & 3); }

template <int MF, int NF> struct Core {
    static constexpr int BM = 32 * MF, BN = 64 * NF;
    static constexpr int GA = BM / 64, GB = BN / 64;
    static constexpr int TA = BM * 128, TB = BN * 128;
    static __device__ __forceinline__ void apiece(int tid, int i, int& row, int& c) { int R, C; stage_rc((tid >> 6) * 1024 + i * 8192 + (tid & 63) * 16, R, C); row = aslot_to_row<MF>(R); c = C; }
    static __device__ __forceinline__ void bpiece(int tid, int i, int& col, int& c) { int R, C; stage_rc((tid >> 6) * 1024 + i * 8192 + (tid & 63) * 16, R, C); col = bslot_to_col<NF>(R); c = C; }
    static __device__ __forceinline__ void zero(f32x4 (&acc)[MF][NF]) {
#pragma unroll
        for (int m = 0; m < MF; ++m)
#pragma unroll
            for (int n = 0; n < NF; ++n) acc[m][n] = (f32x4){0.f, 0.f, 0.f, 0.f}; }
    static __device__ __forceinline__ void compute(LAS unsigned char* la, LAS unsigned char* lb, f32x4 (&acc)[MF][NF], int wr, int wc, int fr, int fq) {
        const int ao = lds_byte(wr * MF * 16 + fr, fq * 8), bo = lds_byte(wc * NF * 16 + fr, fq * 8);
#pragma unroll
        for (int ks = 0; ks < 2; ++ks) {
            bf16x8 At[MF], Bf[NF];
#pragma unroll
            for (int m = 0; m < MF; ++m) At[m] = *(const LAS bf16x8*)(la + ao + m * 2048 + ks * 1024);
#pragma unroll
            for (int n = 0; n < NF; ++n) Bf[n] = *(const LAS bf16x8*)(lb + bo + n * 2048 + ks * 1024);
#pragma unroll
            for (int m = 0; m < MF; ++m)
#pragma unroll
                for (int n = 0; n < NF; ++n) acc[m][n] = __builtin_amdgcn_mfma_f32_16x16x32_bf16(Bf[n], At[m], acc[m][n], 0, 0, 0);
            __builtin_amdgcn_sched_barrier(0);
        }
    }
    static __device__ __forceinline__ void stage_a(LAS unsigned char* dst, const char* base, const unsigned (&off)[GA], unsigned kbyte, int wid) {
        const __amdgpu_buffer_rsrc_t r = __builtin_amdgcn_make_buffer_rsrc((void*)base, 0, 0x7ffffff0, 0x00020000);
#pragma unroll
        for (int i = 0; i < GA; ++i) __builtin_amdgcn_raw_ptr_buffer_load_lds(r, (LAS void*)(dst + wid * 1024 + i * 8192), 16, (int)off[i], (int)kbyte, 0, 0); }
    static __device__ __forceinline__ void stage_b(LAS unsigned char* dst, const char* base, const unsigned (&off)[GB], unsigned kbyte, int wid) {
        const __amdgpu_buffer_rsrc_t r = __builtin_amdgcn_make_buffer_rsrc((void*)base, 0, 0x7ffffff0, 0x00020000);
#pragma unroll
        for (int i = 0; i < GB; ++i) __builtin_amdgcn_raw_ptr_buffer_load_lds(r, (LAS void*)(dst + wid * 1024 + i * 8192), 16, (int)off[i], (int)kbyte, 0, 0); }
    static __device__ __forceinline__ void loop_gg(LAS unsigned char* lds, const char* Ab, const unsigned (&aoff)[GA], const char* Bb, const unsigned (&boff)[GB], int nt,
                                                   f32x4 (&acc)[MF][NF], int wid, int wr, int wc, int fr, int fq) {
        constexpr int STG = TA + TB;
        stage_a(lds, Ab, aoff, 0, wid); stage_b(lds + TA, Bb, boff, 0, wid);
        WAIT_V0(); __syncthreads();
        for (int t = 0; t < nt; ++t) {
            const int cur = t & 1;
            if (t + 1 < nt) { stage_a(lds + (cur ^ 1) * STG, Ab, aoff, (unsigned)(t + 1) * 128u, wid); stage_b(lds + (cur ^ 1) * STG + TA, Bb, boff, (unsigned)(t + 1) * 128u, wid); }
            compute(lds + cur * STG, lds + cur * STG + TA, acc, wr, wc, fr, fq);
            WAIT_V0(); __syncthreads();
        }
    }
    static __device__ __forceinline__ void burst_gg(LAS unsigned char* la, LAS unsigned char* lb, const char* Ab, const unsigned (&aoff)[GA], const char* Bb, const unsigned (&boff)[GB], int nt,
                                                    f32x4 (&acc)[MF][NF], int wid, int wr, int wc, int fr, int fq) {
        for (int t = 0; t < nt; ++t) { stage_a(la + t * TA, Ab, aoff, (unsigned)t * 128u, wid); stage_b(lb + t * TB, Bb, boff, (unsigned)t * 128u, wid); }
        WAIT_V0(); __syncthreads();
        for (int t = 0; t < nt; ++t) compute(la + t * TA, lb + t * TB, acc, wr, wc, fr, fq);
    }
    static __device__ __forceinline__ void loop_lg(LAS unsigned char* la, LAS unsigned char* lb, const char* Bb, const unsigned (&boff)[GB], int nt,
                                                   f32x4 (&acc)[MF][NF], int wid, int wr, int wc, int fr, int fq) {
        stage_b(lb, Bb, boff, 0, wid);
        WAIT_V0(); __syncthreads();
        for (int t = 0; t < nt; ++t) {
            const int cur = t & 1;
            if (t + 1 < nt) stage_b(lb + (cur ^ 1) * TB, Bb, boff, (unsigned)(t + 1) * 128u, wid);
            compute(la + t * TA, lb + cur * TB, acc, wr, wc, fr, fq);
            WAIT_V0(); __syncthreads();
        }
    }
    static __device__ __forceinline__ void loop_gl(LAS unsigned char* la, const char* Ab, const unsigned (&aoff)[GA], LAS unsigned char* lb, int nt,
                                                   f32x4 (&acc)[MF][NF], int wid, int wr, int wc, int fr, int fq) {
        stage_a(la, Ab, aoff, 0, wid);
        WAIT_V0(); __syncthreads();
        for (int t = 0; t < nt; ++t) {
            const int cur = t & 1;
            if (t + 1 < nt) stage_a(la + (cur ^ 1) * TA, Ab, aoff, (unsigned)(t + 1) * 128u, wid);
            compute(la + cur * TA, lb + t * TB, acc, wr, wc, fr, fq);
            WAIT_V0(); __syncthreads();
        }
    }
};
#define XB_TMO      128
#define XB_XCNT(j)  (256  + 64 * (j))
#define XB_XSUB(j)  (1280 + 64 * (j))
#define XB_XGEN(j)  (2304 + 64 * (j))
#define XB_TOP      3328
#define XB_TOPGEN   3392
#define XCD_BAR_WORDS 3456
#define XB_SPIN_CAP (1u << 18)
#define LAS __attribute__((address_space(3)))

__device__ __forceinline__ unsigned xb_ld(unsigned* p)              { return __hip_atomic_load(p, __ATOMIC_RELAXED, __HIP_MEMORY_SCOPE_AGENT); }
__device__ __forceinline__ unsigned xb_add(unsigned* p, unsigned v) { return __hip_atomic_fetch_add(p, v, __ATOMIC_RELAXED, __HIP_MEMORY_SCOPE_AGENT); }
__device__ __forceinline__ unsigned xb_xcc_id() { return (unsigned)__builtin_amdgcn_s_getreg((3 << 11) | 20) & 0xFu; }
#define XB_SPIN(cond, bar) do { unsigned _sp = 0; while (cond) { __builtin_amdgcn_s_sleep(1); \
    if ((++_sp & 255u) == 0u) { if (xb_ld(&(bar)[XB_TMO])) break; if (_sp > XB_SPIN_CAP) { atomicAdd(&(bar)[XB_TMO], 1u); break; } } } } while (0)

struct XcdBarrier {
    unsigned* bar; unsigned x;
    volatile LAS unsigned* st;
};

__device__ __forceinline__ XcdBarrier xcd_barrier_post(unsigned* bar, volatile LAS unsigned* st) {
    XcdBarrier b; b.bar = bar; b.x = xb_xcc_id(); b.st = st;
    if (threadIdx.x == 0) (void)xb_add(&bar[XB_XCNT(b.x)], 1u);
    return b;
}
__device__ __forceinline__ void xcd_barrier_complete(unsigned* bar, unsigned x, unsigned& nloc, unsigned& nx) {
    const unsigned G = gridDim.x * gridDim.y * gridDim.z;
    unsigned sum, cnt, mine, sp = 0u;
    for (;;) {
        sum = 0u; cnt = 0u; mine = 0u;
#pragma unroll
        for (unsigned j = 0; j < 16; ++j) { const unsigned c = xb_ld(&bar[XB_XCNT(j)]); sum += c; cnt += (c > 0u) ? 1u : 0u; mine = (j == x) ? c : mine; }
        if (sum == G) break;
        __builtin_amdgcn_s_sleep(1);
        if ((++sp & 255u) == 0u) { if (xb_ld(&bar[XB_TMO])) break; if (sp > XB_SPIN_CAP) { atomicAdd(&bar[XB_TMO], 1u); break; } }
    }
    nloc = mine > 0u ? mine : 1u; nx = cnt > 0u ? cnt : 1u;
}

__device__ __forceinline__ void xcd_barrier(const XcdBarrier& b) {
    asm volatile("s_waitcnt vmcnt(0)" ::: "memory");
    __syncthreads();
    if (threadIdx.x == 0) {
        unsigned* bar = b.bar;
        __builtin_amdgcn_s_waitcnt(0);
        unsigned nloc = b.st[0], nx = b.st[1];
        if (nloc == 0u) { xcd_barrier_complete(bar, b.x, nloc, nx); b.st[0] = nloc; b.st[1] = nx; }
        const unsigned old = xb_add(&bar[XB_XSUB(b.x)], 1u);
        const unsigned gen = old / nloc;
        if (old + 1u == (gen + 1u) * nloc) {
            __builtin_amdgcn_fence(__ATOMIC_RELEASE, "agent");
            asm volatile("s_waitcnt vmcnt(0)" ::: "memory");
            const unsigned og = xb_add(&bar[XB_TOP], 1u);
            const unsigned tg = og / nx;
            if (og + 1u == (tg + 1u) * nx) xb_add(&bar[XB_TOPGEN], 1u);
            else XB_SPIN(xb_ld(&bar[XB_TOPGEN]) == tg, bar);
            __builtin_amdgcn_fence(__ATOMIC_ACQUIRE, "agent");
            xb_add(&bar[XB_XGEN(b.x)], 1u);
            asm volatile("s_waitcnt vmcnt(0)" ::: "memory");
        } else {
            XB_SPIN(xb_ld(&bar[XB_XGEN(b.x)]) == gen, bar);
            __builtin_amdgcn_fence(__ATOMIC_ACQUIRE, "agent");
            asm volatile("s_waitcnt vmcnt(0)" ::: "memory");
        }
    }
    __syncthreads();
}

__device__ __forceinline__ bool unit_of(long L, int nM, int nN, int& pm, int& pn) {
    const int nwg = nM * nN; if (L >= nwg) return false;
    int wgid = (int)L; { const int q = nwg / 8, r = nwg % 8, xcd = wgid % 8, off = wgid / 8; wgid = (xcd < r ? xcd * (q + 1) : r * (q + 1) + (xcd - r) * q) + off; }
    const int nig = 8 * nN, gid = wgid / nig, fm = gid * 8, gsz = (nM - fm) < 8 ? (nM - fm) : 8;
    pm = fm + ((wgid % nig) % gsz); pn = (wgid % nig) / gsz; return true;
}

struct EpiPlainF32 {
    float* Cout; int ldc;
    __device__ __forceinline__ bool swapped(int) const { return false; }
    __device__ __forceinline__ int brow0(int pn) const { return pn * 256; }
    __device__ __forceinline__ void operator()(const f32x4 (&acc)[8][4], int pm, int pn, int wr, int wc, int fr, int fq) const {
#pragma unroll
        for (int m = 0; m < 8; ++m) { float* rp = Cout + (size_t)(pm * 256 + arow_of<8>(wr, m, fr)) * ldc + pn * 256;
#pragma unroll
            for (int n = 0; n < 4; ++n) *(f32x4*)(rp + bcol_of<4>(wc, n, fq, 0)) = acc[m][n]; }
    }
};

__device__ __forceinline__ unsigned pk4_fp8(float a, float b, float c, float d) { int w = 0; w = __builtin_amdgcn_cvt_pk_fp8_f32(a, b, w, false); w = __builtin_amdgcn_cvt_pk_fp8_f32(c, d, w, true); return (unsigned)w; }
struct ConvJob { const float* W; bf16_t* dst; int K, N, batch, rows_per_batch, grp, grp_stride, add, pad; };
template <bool FP8>
__device__ __forceinline__ void conv_tiles(LAS unsigned char* lds, const ConvJob& J, float sc, int wg, int nwg, int wave_s) {
    const int tid = opaque_tid(wave_s), n4 = tid & 31, kg = tid >> 5;
    const int tk = J.K / 128, tn = J.N / 128, per = tk * tn, total = per * J.batch;
    constexpr int RS = FP8 ? 144 : 272;
    unsigned char* dst8 = (unsigned char*)J.dst;
    for (int u = wg; u < total; u += nwg) {
        const int b = u / per, r = u % per, kt = r / tn, nt = r % tn;
        const float* src = J.W + ((size_t)b * J.K + (size_t)kt * 128 + kg * 8) * J.N + nt * 128 + 4 * n4;
        float4 v[8];
#pragma unroll
        for (int j = 0; j < 8; ++j) v[j] = *(const float4*)(src + (size_t)j * J.N);
#pragma unroll
        for (int i = 0; i < 4; ++i) { float e[8];
#pragma unroll
            for (int j = 0; j < 8; ++j) e[j] = (i == 0 ? v[j].x : i == 1 ? v[j].y : i == 2 ? v[j].z : v[j].w) * (FP8 ? sc : 1.f);
            if (FP8) { u32x2 w; w.x = pk4_fp8(e[0], e[1], e[2], e[3]); w.y = pk4_fp8(e[4], e[5], e[6], e[7]); *(LAS u32x2*)(lds + (4 * n4 + i) * RS + kg * 8) = w; }
            else { u32x4 w; w.x = cvt_pk_bf16(e[0], e[1]); w.y = cvt_pk_bf16(e[2], e[3]); w.z = cvt_pk_bf16(e[4], e[5]); w.w = cvt_pk_bf16(e[6], e[7]); *(LAS u32x4*)(lds + (4 * n4 + i) * RS + kg * 16) = w; } }
        __syncthreads();
        const int nn0 = nt * 128;
        const size_t drow0 = (size_t)b * J.rows_per_batch + (size_t)(nn0 / J.grp) * J.grp_stride + (nn0 % J.grp) + J.add;
#pragma unroll
        for (int p = 0; p < (FP8 ? 2 : 4); ++p) { const int q = tid + 512 * p, row = FP8 ? (q >> 3) : (q >> 4), pc = FP8 ? (q & 7) : (q & 15);
            const u32x4 w = *(const LAS u32x4*)(lds + row * RS + pc * 16);
            if (FP8) *(u32x4*)(dst8 + (drow0 + row) * J.K + kt * 128 + pc * 16) = w;
            else *(u32x4*)(J.dst + (drow0 + row) * J.K + kt * 128 + pc * 8) = w; }
        __syncthreads();
    }
}
__device__ __forceinline__ void conv_phase(LAS unsigned char* lds, const ConvJob& J, int wg, int nwg, int wave_s) { conv_tiles<false>(lds, J, 1.f, wg, nwg, wave_s); }
__device__ __forceinline__ void conv8_phase(LAS unsigned char* lds, const ConvJob& J, float sc, int wg, int nwg, int wave_s) { conv_tiles<true>(lds, J, sc, wg, nwg, wave_s); }

template <bool HB8>
__device__ __forceinline__ void norm_rows_bf16(const float* __restrict__ x, const float* __restrict__ g, bf16_t* __restrict__ out, int wg, int nwg, int wave_s) {
    const int tid = opaque_tid(wave_s), lane = tid & 63, wv = tid >> 6;
    f32x4 gv[8], xa[8];
#pragma unroll
    for (int i = 0; i < 4; ++i) { const int e0 = 8 * (lane + 64 * i); gv[2 * i] = *(const f32x4*)(g + e0); gv[2 * i + 1] = *(const f32x4*)(g + e0 + 4); }
#define NR_LOAD(row_) do { const size_t rb_ = (size_t)(row_) * D_; _Pragma("unroll") for (int i = 0; i < 4; ++i) { const int e0 = 8 * (lane + 64 * i); xa[2 * i] = *(const f32x4*)(x + rb_ + e0); xa[2 * i + 1] = *(const f32x4*)(x + rb_ + e0 + 4); } } while (0)
    int row = wg * 8 + wv;
    if (row < T_) NR_LOAD(row);
    for (; row < T_; row += nwg * 8) {
        f32x4 v[8]; float ss = 0.f;
#pragma unroll
        for (int i = 0; i < 8; ++i) { v[i] = xa[i]; ss += v[i][0] * v[i][0] + v[i][1] * v[i][1] + v[i][2] * v[i][2] + v[i][3] * v[i][3]; }
        asm volatile("" ::: "memory");
        if (row + nwg * 8 < T_) NR_LOAD(row + nwg * 8);
        asm volatile("" ::: "memory");
        ss = wave_sum(ss);
        const float r = rsqrtf(ss * (1.f / D_) + 1e-6f);
#pragma unroll
        for (int i = 0; i < 4; ++i) { const int e0 = 8 * (lane + 64 * i); const f32x4 ga = gv[2 * i], gb = gv[2 * i + 1], a = v[2 * i], b = v[2 * i + 1];
            if (HB8) { const float r4s = 4.f * r; u32x2 o; o.x = pk4_fp8(a[0] * r4s * ga[0], a[1] * r4s * ga[1], a[2] * r4s * ga[2], a[3] * r4s * ga[3]); o.y = pk4_fp8(b[0] * r4s * gb[0], b[1] * r4s * gb[1], b[2] * r4s * gb[2], b[3] * r4s * gb[3]);
                *(u32x2*)((unsigned char*)out + (size_t)row * D_ + e0) = o; }
            else { u32x4 o; o.x = cvt_pk_bf16(a[0] * r * ga[0], a[1] * r * ga[1]); o.y = cvt_pk_bf16(a[2] * r * ga[2], a[3] * r * ga[3]); o.z = cvt_pk_bf16(b[0] * r * gb[0], b[1] * r * gb[1]); o.w = cvt_pk_bf16(b[2] * r * gb[2], b[3] * r * gb[3]);
                *(u32x4*)(out + (size_t)row * D_ + e0) = o; } }
    }
#undef NR_LOAD
}

__device__ __forceinline__ void bg_issue(const float* wg_, const float* wu_, const float* wd_, int t, float4 (&v)[8], int tid) {
    const int n4 = tid & 31, kg = tid >> 5, m = t >> 12, r = t & 4095, b = r >> 7, q = r & 127;
    const int N = m == 2 ? 2048 : 1024, K = m == 2 ? 1024 : 2048, tn = N >> 7, kt = q / tn, nt = q % tn;
    const float* W = m == 0 ? wg_ : (m == 1 ? wu_ : wd_);
    const float* src = W + ((size_t)b * K + (size_t)kt * 128 + kg * 8) * N + nt * 128 + 4 * n4;
#pragma unroll
    for (int j = 0; j < 8; ++j) v[j] = *(const float4*)(src + (size_t)j * N);
}
__device__ __forceinline__ void bg_write(LAS unsigned char* img, const float4 (&v)[8], float sc, int tid) {
    const int n4 = tid & 31, kg = tid >> 5;
#pragma unroll
    for (int i = 0; i < 4; ++i) { float e[8];
#pragma unroll
        for (int j = 0; j < 8; ++j) e[j] = (i == 0 ? v[j].x : i == 1 ? v[j].y : i == 2 ? v[j].z : v[j].w) * sc;
        u32x2 w; w.x = pk4_fp8(e[0], e[1], e[2], e[3]); w.y = pk4_fp8(e[4], e[5], e[6], e[7]); *(LAS u32x2*)(img + (4 * n4 + i) * 144 + kg * 8) = w; }
}
__device__ __forceinline__ void bg_store(const LAS unsigned char* img, unsigned char* gu8, unsigned char* dn8, int t, int tid) {
    const int m = t >> 12, r = t & 4095, b = r >> 7, q = r & 127;
    const int N = m == 2 ? 2048 : 1024, K = m == 2 ? 1024 : 2048, tn = N >> 7, kt = q / tn, nt = q % tn;
    const size_t drow0 = (size_t)b * 2048 + (m == 2 ? (size_t)nt * 128 : (size_t)nt * 256 + (m == 1 ? 128 : 0));
    unsigned char* dst = m == 2 ? dn8 : gu8;
#pragma unroll
    for (int p = 0; p < 2; ++p) { const int qq = tid + 512 * p, row = qq >> 3, pc = qq & 7;
        *(u32x4*)(dst + (drow0 + row) * K + kt * 128 + pc * 16) = *(const LAS u32x4*)(img + row * 144 + pc * 16); }
}

#ifndef CS_NS
#define CS_NS 4
#endif
#define CS_STR2(x) #x
#define CS_STR(x) CS_STR2(x)
__device__ __forceinline__ void conv_stream(LAS unsigned char* lds, const float* sg, const float* su, const float* sd, unsigned char* gu8, unsigned char* dn8, int t_lo, int t_hi, int c, int nc, int wave_s) {
    const int tid = opaque_tid(wave_s), n4 = tid & 31, kg = tid >> 5;
    const size_t LSRC = (size_t)32 * 2048 * 1024, LGU = (size_t)2 * 32 * 2048 * 2048, LDN = (size_t)2 * 32 * 2048 * 1024;
    f32x4 v[CS_NS][8];
    const int tmax = t_hi - 1;
    const unsigned wofs = (unsigned)((4 * n4) * 144 + ((kg ^ (2 * ((n4 >> 2) & 7))) * 8));
#define CS_ISSUE(s, ts) do { const int tc_ = (ts) < tmax ? (ts) : tmax, L_ = tc_ >= 12288 ? 1 : 0, t_ = tc_ - L_ * 12288, m_ = t_ >> 12, r_ = t_ & 4095, b_ = r_ >> 7, q_ = r_ & 127; \
        const int N_ = m_ == 2 ? 2048 : 1024, K_ = m_ == 2 ? 1024 : 2048, tn_ = N_ >> 7, kt_ = q_ / tn_, nt_ = q_ % tn_; \
        const float* W_ = (m_ == 0 ? sg : (m_ == 1 ? su : sd)) + L_ * LSRC + ((size_t)b_ * K_ + (size_t)kt_ * 128) * N_ + nt_ * 128; \
        const unsigned vo_ = (unsigned)(kg * 8 * N_ + 4 * n4) * 4u; \
        _Pragma("unroll") for (int j_ = 0; j_ < 8; ++j_) { const float* rb_ = W_ + (size_t)j_ * N_; asm volatile("global_load_dwordx4 %0, %1, %2 nt" : "=v"(v[s][j_]) : "v"(vo_), "s"(rb_) : "memory"); } } while (0)
#define CS_WAIT(s, n) asm volatile("s_waitcnt vmcnt(" CS_STR(n) ")" : "+v"(v[s][0]), "+v"(v[s][1]), "+v"(v[s][2]), "+v"(v[s][3]), "+v"(v[s][4]), "+v"(v[s][5]), "+v"(v[s][6]), "+v"(v[s][7]) :: "memory")
#pragma unroll
    for (int s = 0; s < CS_NS; ++s) CS_ISSUE(s, t_lo + c + s * nc);
    for (int t = t_lo + c; t < t_hi; t += CS_NS * nc) {
#pragma unroll
        for (int s = 0; s < CS_NS; ++s) { const int ts0 = t + s * nc, ts = ts0 < tmax ? ts0 : tmax;
            const int tt = ts >= 12288 ? ts - 12288 : ts; const float sc = tt >= 8192 ? 32.f : 64.f;
            CS_WAIT(s, 8 * (CS_NS - 1));
#pragma unroll
            for (int i = 0; i < 4; ++i) { float e[8];
#pragma unroll
                for (int j = 0; j < 8; ++j) e[j] = v[s][j][i] * sc;
                u32x2 w; w.x = pk4_fp8(e[0], e[1], e[2], e[3]); w.y = pk4_fp8(e[4], e[5], e[6], e[7]); *(LAS u32x2*)(lds + s * 18432 + wofs + i * 144) = w; }
            CS_ISSUE(s, ts0 + CS_NS * nc); }
        asm volatile("s_waitcnt lgkmcnt(0)" ::: "memory"); __builtin_amdgcn_s_barrier();
#pragma unroll
        for (int s = 0; s < CS_NS; ++s) { const int ts0 = t + s * nc, ts = ts0 < tmax ? ts0 : tmax;
            const int L_ = ts >= 12288 ? 1 : 0, t_ = ts - L_ * 12288, m = t_ >> 12, r = t_ & 4095, b = r >> 7, q = r & 127;
            const int N = m == 2 ? 2048 : 1024, K = m == 2 ? 1024 : 2048, tn = N >> 7, kt = q / tn, nt = q % tn;
            const size_t drow0 = (size_t)b * 2048 + (m == 2 ? (size_t)nt * 128 : (size_t)nt * 256 + (m == 1 ? 128 : 0));
            unsigned char* dst = (m == 2 ? dn8 + L_ * LDN : gu8 + L_ * LGU) + drow0 * K + kt * 128;
#pragma unroll
            for (int p = 0; p < 2; ++p) { const int qq = tid + 512 * p, row = qq >> 3, pc = qq & 7;
                const u32x4 w = *(const LAS u32x4*)(lds + s * 18432 + row * 144 + ((pc ^ ((row >> 4) & 7)) * 16));
                asm volatile("global_store_dwordx4 %0, %1, %2 nt" :: "v"((unsigned)(row * K + pc * 16)), "v"(w), "s"(dst) : "memory"); } }
        asm volatile("s_waitcnt lgkmcnt(0)" ::: "memory"); __builtin_amdgcn_s_barrier();
    }
    asm volatile("s_waitcnt vmcnt(0)" ::: "memory");
#undef CS_ISSUE
#undef CS_WAIT
}
__device__ __forceinline__ int perm32(int rho) { const int n = rho >> 4, i = rho & 15; return 8 * (i >> 2) + 4 * n + (i & 3); }
#define HTB 16384
typedef int i32x4 __attribute__((ext_vector_type(4)));
typedef int i32x8 __attribute__((ext_vector_type(8)));
#ifndef G8_ABLATE
#define G8_ABLATE 0
#endif
template <bool FP8, class Sched, class Epi, int ABL = 0>
__device__ __forceinline__ void gemm8_phase(LAS unsigned char* lds, int RB, const Sched& S, const Epi& E, int wave_s) {
    typedef typename Sched::U U;
    const int tid = opaque_tid(wave_s), wid = __builtin_amdgcn_readfirstlane(tid >> 6), lane = tid & 63, wr = wid >> 2, wc = wid & 3, fr = lane & 15, fq = lane >> 4;
    const int nt = RB / 128;
    int R0, C0; stage_rc(tid * 16, R0, C0);
    const unsigned c2 = (unsigned)C0 * 2u, r64 = (unsigned)64 * RB;
    const unsigned voffB0 = (unsigned)(((R0 & ~31) + perm32(R0 & 31)) * RB) + c2, voffA0 = (unsigned)(R0 * RB) + c2;
    const unsigned hstep = (unsigned)128 * RB;
    const unsigned ldsw = (unsigned)wid * 1024u;
    const int aoff = lds_byte(wr * 64 + fr, fq * 8), boff = lds_byte(wc * 32 + fr, fq * 8);
#define G8_SA(b, h) (((b) * 2 + (h)) * HTB)
#define G8_SB(b, h) ((4 + (b) * 2 + (h)) * HTB)
#define G8_STAGE2(bufoff, rs, v0, s0, v1, s1) do { __builtin_amdgcn_raw_ptr_buffer_load_lds(rs, (LAS void*)(lds + (bufoff) + ldsw), 16, (int)(v0), (int)(s0), 0, 0); \
        __builtin_amdgcn_raw_ptr_buffer_load_lds(rs, (LAS void*)(lds + (bufoff) + ldsw + 8192), 16, (int)(v1), (int)(s1), 0, 0); } while (0)
#define G8_STB(bufoff, rs, so) G8_STAGE2(bufoff, rs, voffB0, (so), voffB0, (so) + r64)
#define G8_STA(bufoff, rs, pk, h, so) do { if (Sched::GATHER) { const unsigned _p = (pk)[h]; G8_STAGE2(bufoff, rs, (_p & 0xffffu) * (unsigned)RB + c2, (so), (_p >> 16) * (unsigned)RB + c2, (so)); } \
        else G8_STAGE2(bufoff, rs, voffA0, (so) + (h) * hstep, voffA0, (so) + (h) * hstep + r64); } while (0)
#define G8_LDA(dst, b, h) do { _Pragma("unroll") for (int m = 0; m < 4; ++m) dst[m] = __builtin_shufflevector(*(const LAS i32x4*)(lds + G8_SA(b, h) + aoff + m * 2048), *(const LAS i32x4*)(lds + G8_SA(b, h) + aoff + m * 2048 + 1024), 0, 1, 2, 3, 4, 5, 6, 7); } while (0)
#define G8_LDB(dst, b, h) do { _Pragma("unroll") for (int n = 0; n < 2; ++n) dst[n] = __builtin_shufflevector(*(const LAS i32x4*)(lds + G8_SB(b, h) + boff + n * 2048), *(const LAS i32x4*)(lds + G8_SB(b, h) + boff + n * 2048 + 1024), 0, 1, 2, 3, 4, 5, 6, 7); } while (0)
#define G8_MMA1(ai, bj, At, Bt, m, n) do { \
        if constexpr (FP8) asm volatile("v_mfma_scale_f32_16x16x128_f8f6f4 %0, %1, %2, %0, %3, %3 op_sel_hi:[0,0,0]" : "+v"(acc[(ai) * 4 + m][(bj) * 2 + n]) : "v"(Bt[n]), "v"(At[m]), "v"(one_scale)); \
        else { acc[(ai) * 4 + m][(bj) * 2 + n] = __builtin_amdgcn_mfma_f32_16x16x32_bf16(__builtin_bit_cast(bf16x8, __builtin_shufflevector(Bt[n], Bt[n], 0, 1, 2, 3)), __builtin_bit_cast(bf16x8, __builtin_shufflevector(At[m], At[m], 0, 1, 2, 3)), acc[(ai) * 4 + m][(bj) * 2 + n], 0, 0, 0); \
               acc[(ai) * 4 + m][(bj) * 2 + n] = __builtin_amdgcn_mfma_f32_16x16x32_bf16(__builtin_bit_cast(bf16x8, __builtin_shufflevector(Bt[n], Bt[n], 4, 5, 6, 7)), __builtin_bit_cast(bf16x8, __builtin_shufflevector(At[m], At[m], 4, 5, 6, 7)), acc[(ai) * 4 + m][(bj) * 2 + n], 0, 0, 0); } } while (0)
#define G8_MMA(ai, bj, At, Bt) do { if (ABL == 1) { _Pragma("unroll") for (int m = 0; m < 4; ++m) asm volatile("" :: "v"(At[m])); _Pragma("unroll") for (int n = 0; n < 2; ++n) asm volatile("" :: "v"(Bt[n])); break; } \
        __builtin_amdgcn_s_setprio(1); _Pragma("unroll") for (int m = 0; m < 4; ++m) _Pragma("unroll") for (int n = 0; n < 2; ++n) G8_MMA1(ai, bj, At, Bt, m, n); __builtin_amdgcn_s_setprio(0); } while (0)
#define G8_WAIT_V(n) asm volatile("s_waitcnt vmcnt(" #n ")" ::: "memory")
#define G8_WAIT_L(n) asm volatile("s_waitcnt lgkmcnt(" #n ")" ::: "memory")
#define G8_BAR __builtin_amdgcn_s_barrier()
#define G8_SCHED __builtin_amdgcn_sched_barrier(0)
#define G8_RSRC(p) __builtin_amdgcn_make_buffer_rsrc((void*)(p), 0, 0x7ffffff0, 0x00020000)
    U cur, nxt; int ui = 0;
    if (!S.next(0, cur)) return;
    f32x4 acc[8][4];
#pragma unroll
    for (int m = 0; m < 8; ++m)
#pragma unroll
        for (int n = 0; n < 4; ++n) acc[m][n] = (f32x4){0.f, 0.f, 0.f, 0.f};
    i32x8 At[4], B0[2], B1[2];
    const int one_scale = 0x7F7F7F7F;
    unsigned pkc[2] = {0u, 0u}, pkn[2] = {0u, 0u};
    if (Sched::GATHER) S.gather(cur, R0, pkc);
    pkn[0] = pkc[0]; pkn[1] = pkc[1];
    const char* cA = S.abase(cur); const char* cB = S.bbase(cur);
    {
        const __amdgpu_buffer_rsrc_t rA = G8_RSRC(cA), rB = G8_RSRC(cB);
        G8_STB(G8_SB(0, 0), rB, 0u); G8_STA(G8_SA(0, 0), rA, pkc, 0, 0u); G8_STB(G8_SB(0, 1), rB, hstep); G8_STA(G8_SA(0, 1), rA, pkc, 1, 0u);
        if (wr == 1) G8_BAR;
        G8_WAIT_V(4); G8_BAR;
        G8_STB(G8_SB(1, 0), rB, 128u); G8_STA(G8_SA(1, 0), rA, pkc, 0, 128u); G8_STB(G8_SB(1, 1), rB, hstep + 128u);
        G8_WAIT_V(6); G8_BAR;
    }
    for (;;) {
        const bool has_next = S.next(ui + 1, nxt);
        if (Sched::GATHER && has_next) { const int tz = opaque_tid(wave_s); int R2, C2; stage_rc(tz * 16, R2, C2); S.gather(nxt, R2, pkn); }
        const char* nA = has_next ? S.abase(nxt) : cA; const char* nB = has_next ? S.bbase(nxt) : cB;
        const __amdgpu_buffer_rsrc_t rA = G8_RSRC(cA);
#pragma unroll 1
        for (int t = 0; t < nt; t += 2) {
            int lastv = __builtin_amdgcn_readfirstlane((t == nt - 2) ? 1 : 0); asm volatile("" : "+s"(lastv)); const bool last = lastv != 0;
            const unsigned k1 = (unsigned)(t + 1) * 128u;
            const unsigned k2 = last ? 0u : (unsigned)(t + 2) * 128u, k3 = k2 + 128u;
            const __amdgpu_buffer_rsrc_t rA2 = G8_RSRC(last ? nA : cA), rB2 = G8_RSRC(last ? nB : cB);
            const unsigned px[2] = {last ? pkn[0] : pkc[0], last ? pkn[1] : pkc[1]};
            G8_LDB(B0, 0, 0); G8_SCHED; G8_LDA(At, 0, 0); G8_STA(G8_SA(1, 1), rA, pkc, 1, k1);
            G8_WAIT_L(8); G8_BAR; G8_WAIT_L(0); G8_MMA(0, 0, At, B0); G8_BAR; G8_SCHED;
            G8_LDB(B1, 0, 1); G8_STB(G8_SB(0, 0), rB2, k2);
            G8_BAR; G8_WAIT_L(0); G8_MMA(0, 1, At, B1); G8_BAR;
            G8_LDA(At, 0, 1); G8_STA(G8_SA(0, 0), rA2, px, 0, k2);
            G8_BAR; G8_WAIT_L(0); G8_MMA(1, 0, At, B0); G8_BAR; G8_SCHED;
            G8_STB(G8_SB(0, 1), rB2, k2 + hstep);
            G8_WAIT_V(6); G8_BAR; G8_MMA(1, 1, At, B1); G8_BAR;
            G8_LDB(B0, 1, 0); G8_SCHED; G8_LDA(At, 1, 0); G8_STA(G8_SA(0, 1), rA2, px, 1, k2);
            G8_WAIT_L(8); G8_BAR; G8_WAIT_L(0); G8_MMA(0, 0, At, B0); G8_BAR; G8_SCHED;
            G8_LDB(B1, 1, 1); G8_STB(G8_SB(1, 0), rB2, k3);
            G8_BAR; G8_WAIT_L(0); G8_MMA(0, 1, At, B1); G8_BAR;
            G8_LDA(At, 1, 1); G8_STA(G8_SA(1, 0), rA2, px, 0, k3);
            G8_BAR; G8_WAIT_L(0); G8_MMA(1, 0, At, B0); G8_BAR; G8_SCHED;
            G8_STB(G8_SB(1, 1), rB2, k3 + hstep);
            G8_WAIT_V(6); G8_BAR; G8_MMA(1, 1, At, B1); G8_BAR;
        }
        if (FP8) asm volatile("s_nop 15\n\ts_nop 15" ::: "memory");
        {
            const int tz = opaque_tid(wave_s), lz = tz & 63, wz = __builtin_amdgcn_readfirstlane(tz >> 6);
            E(acc, cur, wz >> 2, wz & 3, lz & 15, lz >> 4); }
        if (!has_next) break;
#pragma unroll
        for (int m = 0; m < 8; ++m)
#pragma unroll
            for (int n = 0; n < 4; ++n) acc[m][n] = (f32x4){0.f, 0.f, 0.f, 0.f};
        cur = nxt; cA = nA; cB = nB; ++ui;
        pkc[0] = pkn[0]; pkc[1] = pkn[1];
    }
    G8_WAIT_V(0);
    if (wr == 0) G8_BAR;
    G8_BAR;
#undef G8_SA
#undef G8_SB
#undef G8_STAGE2
#undef G8_STB
#undef G8_STA
#undef G8_LDA
#undef G8_LDB
#undef G8_MMA
#undef G8_MMA1
#undef G8_WAIT_V
#undef G8_WAIT_L
#undef G8_BAR
#undef G8_SCHED
#undef G8_RSRC
}

struct DenseU { int pm, pn; };
template <class Epi> struct DenseSched {
    typedef DenseU U; static constexpr bool GATHER = false; static constexpr bool RAGGED = false;
    __device__ __forceinline__ int nvalid(const U&) const { return 256; }
    const char* A; const char* Bt; int nM, nN, RB; const Epi* E; int wg, nwg;
    __device__ __forceinline__ bool next(int i, U& u) const { return unit_of((long)i * nwg + wg, nM, nN, u.pm, u.pn); }
    __device__ __forceinline__ const char* abase(const U& u) const { return E->swapped(u.pn) ? (Bt + (size_t)E->brow0(u.pn) * RB) : (A + (size_t)u.pm * 256 * RB); }
    __device__ __forceinline__ const char* bbase(const U& u) const { return E->swapped(u.pn) ? (A + (size_t)u.pm * 256 * RB) : (Bt + (size_t)E->brow0(u.pn) * RB); }
    __device__ __forceinline__ void gather(const U&, int, unsigned (&)[2]) const {}
};
template <class Epi> struct DenseEpi { const Epi* E;
    __device__ __forceinline__ void operator()(const f32x4 (&acc)[8][4], const DenseU& u, int wr, int wc, int fr, int fq) const { (*E)(acc, u.pm, u.pn, wr, wc, fr, fq); } };
template <class Epi>
__device__ __forceinline__ void gemm_phase(LAS unsigned char* lds, const bf16_t* A, const bf16_t* Bt, int nM, int nN, int K, const Epi& E, int wave_s, int wg = (int)blockIdx.x, int nwg = (int)gridDim.x) {
    DenseSched<Epi> S{(const char*)A, (const char*)Bt, nM, nN, K * 2, &E, wg, nwg}; DenseEpi<Epi> DE{&E};
    gemm8_phase<false>(lds, K * 2, S, DE, wave_s);
}
template <class Epi>
__device__ __forceinline__ void gemm_phase_f8(LAS unsigned char* lds, const unsigned char* A, const unsigned char* Bt, int nM, int nN, int K, const Epi& E, int wave_s, int wg = (int)blockIdx.x, int nwg = (int)gridDim.x) {
    DenseSched<Epi> S{(const char*)A, (const char*)Bt, nM, nN, K, &E, wg, nwg}; DenseEpi<Epi> DE{&E};
    gemm8_phase<true>(lds, K, S, DE, wave_s);
}
__device__ __forceinline__ void rope_freq(int j, float& fhi, float& flo) {
    const double f = exp2(-(double)j * (13.287712379549449 / 128.0)) * 0.15915494309189535;
    fhi = (float)f; flo = (float)(f - (double)fhi);
}
__device__ __forceinline__ void rope_cs(float pos, float fhi, float flo, float& c, float& s) {
    const float p = pos * fhi; const float e = __builtin_fmaf(pos, fhi, -p);
    float r = p - __builtin_rintf(p); r += e + pos * flo;
    c = __builtin_amdgcn_cosf(r); s = __builtin_amdgcn_sinf(r);
}
__device__ __forceinline__ float gelu_fast(float x) { const float u = x * (-2.3022081981971123f - 0.10294324276067f * x * x); return x * __builtin_amdgcn_rcpf(1.f + __builtin_amdgcn_exp2f(u)); }
__device__ __forceinline__ float silu_fast(float x) { return x * __builtin_amdgcn_rcpf(1.f + __builtin_amdgcn_exp2f(-1.4426950408889634f * x)); }

template <bool S8> struct EpiInAB {
    bf16_t *qb, *kb, *vT, *sgb, *ugb, *gvT;
    static constexpr float SC = S8 ? (1.f / 256.f) : 1.f;
    __device__ __forceinline__ bool swapped(int pn) const { return (pn >= 8 && pn < 12) || pn >= 20; }
    __device__ __forceinline__ int brow0(int pn) const { return pn * 256; }
    __device__ __forceinline__ void operator()(const f32x4 (&acc)[8][4], int pm, int pn, int wr, int wc, int fr, int fq) const {
        if (pn < 8) {
            bf16_t* dst = (pn < 4 ? qb : kb) + (pn & 3) * 256; const float sc = (pn < 4 ? 1.f : 0.0625f) * SC;
            float fh[8], fl[8];
#pragma unroll
            for (int e = 0; e < 8; ++e) rope_freq(wc * 32 + 8 * fq + e, fh[e], fl[e]);
#pragma unroll
            for (int m = 0; m < 8; ++m) { int row = pm * 256 + arow_of<8>(wr, m, fr); asm volatile("" : "+v"(row));
                const float pos = (float)row; float o1[8], o2[8];
#pragma unroll
                for (int e = 0; e < 8; ++e) { float c, s; rope_cs(pos, fh[e], fl[e], c, s);
                    const float x1 = acc[m][e >> 2][e & 3], x2 = acc[m][(e >> 2) + 2][e & 3];
                    o1[e] = (x1 * c - x2 * s) * sc; o2[e] = (x2 * c + x1 * s) * sc; }
                u32x4 lo, hi;
                lo.x = cvt_pk_bf16(o1[0], o1[1]); lo.y = cvt_pk_bf16(o1[2], o1[3]); lo.z = cvt_pk_bf16(o1[4], o1[5]); lo.w = cvt_pk_bf16(o1[6], o1[7]);
                hi.x = cvt_pk_bf16(o2[0], o2[1]); hi.y = cvt_pk_bf16(o2[2], o2[3]); hi.z = cvt_pk_bf16(o2[4], o2[5]); hi.w = cvt_pk_bf16(o2[6], o2[7]);
                bf16_t* rp = dst + (size_t)row * 1024 + wc * 32 + 8 * fq;
                *(u32x4*)rp = lo; *(u32x4*)(rp + 128) = hi; }
        } else if (pn >= 12 && pn < 20) {
            const bool isg = pn < 16; bf16_t* dst = (isg ? sgb : ugb) + (pn & 3) * 256;
#pragma unroll
            for (int m = 0; m < 8; ++m) { int row = pm * 256 + arow_of<8>(wr, m, fr); asm volatile("" : "+v"(row));
#pragma unroll
                for (int hf = 0; hf < 2; ++hf) { u32x4 w; const f32x4 a = acc[m][2 * hf], b = acc[m][2 * hf + 1];
                    float v[8] = {SC * a[0], SC * a[1], SC * a[2], SC * a[3], SC * b[0], SC * b[1], SC * b[2], SC * b[3]};
#pragma unroll
                    for (int e = 0; e < 8; ++e) v[e] = isg ? silu_fast(v[e]) : gelu_fast(v[e]);
                    w.x = cvt_pk_bf16(v[0], v[1]); w.y = cvt_pk_bf16(v[2], v[3]); w.z = cvt_pk_bf16(v[4], v[5]); w.w = cvt_pk_bf16(v[6], v[7]);
                    *(u32x4*)(dst + (size_t)row * 1024 + hf * 128 + wc * 32 + 8 * fq) = w; } }
        } else {
            const bool isv = pn < 12; bf16_t* dst = (isv ? vT : gvT) + (size_t)((pn & 3) * 256) * T_ + pm * 256;
#pragma unroll
            for (int m = 0; m < 8; ++m) { int f = arow_of<8>(wr, m, fr); asm volatile("" : "+v"(f));
#pragma unroll
                for (int hf = 0; hf < 2; ++hf) { u32x4 w; const f32x4 a = acc[m][2 * hf], b = acc[m][2 * hf + 1];
                    float v[8] = {SC * a[0], SC * a[1], SC * a[2], SC * a[3], SC * b[0], SC * b[1], SC * b[2], SC * b[3]};
                    if (!isv) {
#pragma unroll
                        for (int e = 0; e < 8; ++e) v[e] = gelu_fast(v[e]); }
                    w.x = cvt_pk_bf16(v[0], v[1]); w.y = cvt_pk_bf16(v[2], v[3]); w.z = cvt_pk_bf16(v[4], v[5]); w.w = cvt_pk_bf16(v[6], v[7]);
                    *(u32x4*)(dst + (size_t)f * T_ + hf * 128 + wc * 32 + 8 * fq) = w; } }
        }
    }
};

struct EpiKhat {
    bf16_t* khatT;
    __device__ __forceinline__ bool swapped(int) const { return true; }
    __device__ __forceinline__ int brow0(int pn) const { return (4 + pn) * 256; }
    __device__ __forceinline__ void operator()(const f32x4 (&acc)[8][4], int pm, int pn, int wr, int wc, int fr, int fq) const {
        const int h = pn; const float l2g = log2f(1.f - exp2f(-5.f - (float)h));
        bf16_t* dst = khatT + (size_t)(h * 256) * T_ + pm * 256;
#pragma unroll
        for (int m = 0; m < 4; ++m) { int f = wr * 64 + m * 16 + fr; asm volatile("" : "+v"(f));
            float fh, fl; rope_freq(f, fh, fl);
#pragma unroll
            for (int hf = 0; hf < 2; ++hf) { float o1[8], o2[8]; const int t0 = hf * 128 + wc * 32 + 8 * fq;
#pragma unroll
                for (int e = 0; e < 8; ++e) { float c, s; rope_cs((float)(pm * 256 + t0 + e), fh, fl, c, s);
                    const float x1 = acc[m][2 * hf + (e >> 2)][e & 3], x2 = acc[m + 4][2 * hf + (e >> 2)][e & 3];
                    const float d = 0.0625f * exp2f((float)(127 - ((t0 + e) & 127)) * l2g);
                    o1[e] = (x1 * c - x2 * s) * d; o2[e] = (x2 * c + x1 * s) * d; }
                u32x4 w1, w2;
                w1.x = cvt_pk_bf16(o1[0], o1[1]); w1.y = cvt_pk_bf16(o1[2], o1[3]); w1.z = cvt_pk_bf16(o1[4], o1[5]); w1.w = cvt_pk_bf16(o1[6], o1[7]);
                w2.x = cvt_pk_bf16(o2[0], o2[1]); w2.y = cvt_pk_bf16(o2[2], o2[3]); w2.z = cvt_pk_bf16(o2[4], o2[5]); w2.w = cvt_pk_bf16(o2[6], o2[7]);
                *(u32x4*)(dst + (size_t)f * T_ + t0) = w1;
                *(u32x4*)(dst + (size_t)(f + 128) * T_ + t0) = w2; } }
    }
};
typedef short s16x4 __attribute__((ext_vector_type(4)));
__device__ __forceinline__ void ret_kv_phase(LAS unsigned char* lds, const bf16_t* vT, const bf16_t* kb, bf16_t* KVT, int wg, int nwg, int wave_s) {
    typedef Core<8, 4> C;
    constexpr int RS = 576;
    const int tid = opaque_tid(wave_s), wid = __builtin_amdgcn_readfirstlane(tid >> 6), lane = tid & 63, wr = wid >> 2, wc = wid & 3, fr = lane & 15, fq = lane >> 4;
    LAS unsigned char* ldsT = lds + 65536;
    unsigned aoff[4];
#pragma unroll
    for (int i = 0; i < 4; ++i) { int r, c; C::apiece(tid, i, r, c); aoff[i] = (unsigned)(r * T_ + c) * 2u; }
    const int ao = lds_byte(wr * 128 + fr, fq * 8);
    LAS unsigned char* trb = ldsT + (8 * fq + (fr >> 2)) * RS + 2 * (wc * 32 + 8 * (fr & 3));
    for (int u = wg; u < 512; u += nwg) {
        const int n = u >> 2, h = u & 3; const float l2g = log2f(1.f - exp2f(-5.f - (float)h));
        const bf16_t* kt = kb + (size_t)(n * 128) * 1024 + h * 256;
        { const char* Vb = (const char*)(vT + (size_t)(h * 256) * T_ + n * 128); C::stage_a(lds, Vb, aoff, 0u, wid); C::stage_a(lds + 32768, Vb, aoff, 128u, wid); }
        u32x4 wk[8];
#pragma unroll
        for (int p = 0; p < 8; ++p) { int idx = tid + 512 * p; asm volatile("" : "+v"(idx)); const int j = idx >> 5, d0 = (idx & 31) * 8; wk[p] = *(const u32x4*)(kt + (size_t)j * 1024 + d0); }
#pragma unroll
        for (int p = 0; p < 8; ++p) { int idx = tid + 512 * p; asm volatile("" : "+v"(idx)); const int j = idx >> 5, d0 = (idx & 31) * 8;
            const u32x4 w = wk[p];
            const float d = exp2f((float)(127 - j) * l2g);
            u32x4 o; o.x = cvt_pk_bf16(bflo(w.x) * d, bfhi(w.x) * d); o.y = cvt_pk_bf16(bflo(w.y) * d, bfhi(w.y) * d); o.z = cvt_pk_bf16(bflo(w.z) * d, bfhi(w.z) * d); o.w = cvt_pk_bf16(bflo(w.w) * d, bfhi(w.w) * d);
            *(LAS u32x4*)(ldsT + j * RS + d0 * 2) = o; }
        WAIT_V0(); __syncthreads();
        f32x4 acc[8][4]; C::zero(acc);
#pragma unroll
        for (int kk = 0; kk < 4; ++kk) {
            bf16x8 At[8], Bf[4];
#pragma unroll
            for (int m = 0; m < 8; ++m) At[m] = *(const LAS bf16x8*)(lds + (kk >> 1) * 32768 + ao + m * 2048 + (kk & 1) * 1024);
#pragma unroll
            for (int nn = 0; nn < 4; ++nn) { LAS unsigned char* a = trb + (kk * 32) * RS + 2 * ((nn >> 1) * 128 + 4 * (nn & 1));
                const s16x4 lo = __builtin_amdgcn_ds_read_tr16_b64_v4i16((LAS s16x4*)a), hi = __builtin_amdgcn_ds_read_tr16_b64_v4i16((LAS s16x4*)(a + 4 * RS));
                Bf[nn] = __builtin_shufflevector(lo, hi, 0, 1, 2, 3, 4, 5, 6, 7); }
#pragma unroll
            for (int m = 0; m < 8; ++m)
#pragma unroll
                for (int nn = 0; nn < 4; ++nn) acc[m][nn] = __builtin_amdgcn_mfma_f32_16x16x32_bf16(Bf[nn], At[m], acc[m][nn], 0, 0, 0);
            __builtin_amdgcn_sched_barrier(0);
        }
        __syncthreads();
        bf16_t* dst = KVT + (size_t)u * 65536;
#pragma unroll
        for (int m = 0; m < 8; ++m) { bf16_t* rp = dst + arow_of<8>(wr, m, fr) * 256 + wc * 32 + 8 * fq;
#pragma unroll
            for (int hf = 0; hf < 2; ++hf) { const f32x4 a = acc[m][2 * hf], b = acc[m][2 * hf + 1]; u32x4 w;
                w.x = cvt_pk_bf16(a[0], a[1]); w.y = cvt_pk_bf16(a[2], a[3]); w.z = cvt_pk_bf16(b[0], b[1]); w.w = cvt_pk_bf16(b[2], b[3]); *(u32x4*)(rp + hf * 128) = w; } }
    }
}
__device__ __forceinline__ void ret_scan_phase(const bf16_t* KVT, bf16_t* STb, int wg, int nwg, int wave_s) {
    const int tid = opaque_tid(wave_s);
    for (int e = (wg * NTHR + tid) * 2; e < 4 * 65536; e += nwg * NTHR * 2) {
        const int h = e >> 16; const float g = exp2f(128.f * log2f(1.f - exp2f(-5.f - (float)h)));
        float s0 = 0.f, s1 = 0.f;
        for (int n0 = 0; n0 < 128; n0 += 8) {
            unsigned kv[8];
#pragma unroll
            for (int i = 0; i < 8; ++i) kv[i] = *(const unsigned*)(KVT + (size_t)(n0 + i) * 262144 + e);
#pragma unroll
            for (int i = 0; i < 8; ++i) { *(unsigned*)(STb + (size_t)(n0 + i) * 262144 + e) = cvt_pk_bf16(s0, s1); s0 = g * s0 + bflo(kv[i]); s1 = g * s1 + bfhi(kv[i]); }
        }
    }
}
__device__ __forceinline__ void ret_out_phase(LAS unsigned char* lds, const bf16_t* qb, const bf16_t* kb, const bf16_t* vT, const bf16_t* STb, const bf16_t* sgb,
                                              const float* gain, bf16_t* mixb, int wg, int nwg, int wave_s) {
    typedef Core<4, 2> CA; typedef Core<4, 4> CB;
    const int tid = opaque_tid(wave_s), wid = __builtin_amdgcn_readfirstlane(tid >> 6), lane = tid & 63, wr = wid >> 2, wc = wid & 3, fr = lane & 15, fq = lane >> 4;
    LAS unsigned char* ldsP = lds + 98304;
    LAS float* stat = (LAS float*)lds;
    unsigned qoff[2], koff[2], soff[4], voff[4];
#pragma unroll
    for (int i = 0; i < 2; ++i) { int r, c; CA::apiece(tid, i, r, c); qoff[i] = (unsigned)(r * 1024 + c) * 2u; CA::bpiece(tid, i, r, c); koff[i] = (unsigned)(r * 1024 + c) * 2u; }
#pragma unroll
    for (int i = 0; i < 4; ++i) { int r, c; CB::bpiece(tid, i, r, c); soff[i] = (unsigned)(r * 256 + c) * 2u; voff[i] = (unsigned)(r * T_ + c) * 2u; }
    for (int u = wg; u < 512; u += nwg) {
        const int n = u >> 2, h = u & 3; const float l2g = log2f(1.f - exp2f(-5.f - (float)h));
        const char* Qb = (const char*)(qb + (size_t)(n * 128) * 1024 + h * 256); const char* Kb = (const char*)(kb + (size_t)(n * 128) * 1024 + h * 256);
        {
            f32x4 sa[4][2]; CA::zero(sa);
            CA::loop_gg(lds, Qb, qoff, Kb, koff, 4, sa, wid, wr, wc, fr, fq);
#pragma unroll
            for (int m = 0; m < 4; ++m) { const int i = wr * 64 + m * 16 + fr; const int j0 = wc * 32 + 8 * fq;
                float p[8];
#pragma unroll
                for (int e = 0; e < 8; ++e) { const int j = j0 + e; const float s = e < 4 ? sa[m][0][e] : sa[m][1][e - 4]; p[e] = (j <= i) ? s * exp2f((float)(i - j) * l2g) : 0.f; }
                u32x4 w; w.x = cvt_pk_bf16(p[0], p[1]); w.y = cvt_pk_bf16(p[2], p[3]); w.z = cvt_pk_bf16(p[4], p[5]); w.w = cvt_pk_bf16(p[6], p[7]);
                *(LAS u32x4*)(ldsP + (wc >> 1) * 16384 + lds_byte(i, j0 & 63)) = w; }
        }
        f32x4 acc[4][4]; CB::zero(acc);
        CB::loop_gg(lds, Qb, qoff, (const char*)(STb + (size_t)u * 65536), soff, 4, acc, wid, wr, wc, fr, fq);
#pragma unroll
        for (int m = 0; m < 4; ++m) { const float sc = exp2f((float)(wr * 64 + m * 16 + fr + 1) * l2g);
#pragma unroll
            for (int nn = 0; nn < 4; ++nn) acc[m][nn] *= sc; }
        CB::loop_lg(ldsP, lds, (const char*)(vT + (size_t)(h * 256) * T_ + n * 128), voff, 2, acc, wid, wr, wc, fr, fq);
#pragma unroll
        for (int m = 0; m < 4; ++m) { float s = 0.f, ss = 0.f;
#pragma unroll
            for (int nn = 0; nn < 4; ++nn)
#pragma unroll
                for (int e = 0; e < 4; ++e) { const float v = acc[m][nn][e]; s += v; ss += v * v; }
            s += __shfl_xor(s, 16); ss += __shfl_xor(ss, 16); s += __shfl_xor(s, 32); ss += __shfl_xor(ss, 32);
            if (fq == 0) { const int i = wr * 64 + m * 16 + fr; stat[(i * 4 + wc) * 2] = s; stat[(i * 4 + wc) * 2 + 1] = ss; } }
        __syncthreads();
        u32x4 sgv[4][2]; f32x4 gnv[2][2];
#pragma unroll
        for (int hf = 0; hf < 2; ++hf) { const int c0 = h * 256 + hf * 128 + wc * 32 + 8 * fq; gnv[hf][0] = *(const f32x4*)(gain + c0); gnv[hf][1] = *(const f32x4*)(gain + c0 + 4);
#pragma unroll
            for (int m = 0; m < 4; ++m) sgv[m][hf] = *(const u32x4*)(sgb + ((size_t)n * 128 + wr * 64 + m * 16 + fr) * 1024 + c0); }
        asm volatile("" ::: "memory");
#pragma unroll
        for (int m = 0; m < 4; ++m) { const int i = wr * 64 + m * 16 + fr; float s = 0.f, ss = 0.f;
#pragma unroll
            for (int w4 = 0; w4 < 4; ++w4) { s += stat[(i * 4 + w4) * 2]; ss += stat[(i * 4 + w4) * 2 + 1]; }
            const float mean = s * (1.f / 256.f); const float var = ss * (1.f / 256.f) - mean * mean; const float rstd = rsqrtf(var + 1e-6f);
            const size_t t = (size_t)n * 128 + i;
#pragma unroll
            for (int hf = 0; hf < 2; ++hf) { const int c0 = h * 256 + hf * 128 + wc * 32 + 8 * fq;
                const u32x4 sg = sgv[m][hf];
                const f32x4 g0 = gnv[hf][0], g1 = gnv[hf][1];
                const f32x4 a = acc[m][2 * hf], b = acc[m][2 * hf + 1];
                float o[8];
                o[0] = (a[0] - mean) * rstd * g0[0] * bflo(sg.x); o[1] = (a[1] - mean) * rstd * g0[1] * bfhi(sg.x);
                o[2] = (a[2] - mean) * rstd * g0[2] * bflo(sg.y); o[3] = (a[3] - mean) * rstd * g0[3] * bfhi(sg.y);
                o[4] = (b[0] - mean) * rstd * g1[0] * bflo(sg.z); o[5] = (b[1] - mean) * rstd * g1[1] * bfhi(sg.z);
                o[6] = (b[2] - mean) * rstd * g1[2] * bflo(sg.w); o[7] = (b[3] - mean) * rstd * g1[3] * bfhi(sg.w);
                u32x4 w; w.x = cvt_pk_bf16(o[0], o[1]); w.y = cvt_pk_bf16(o[2], o[3]); w.z = cvt_pk_bf16(o[4], o[5]); w.w = cvt_pk_bf16(o[6], o[7]);
                *(u32x4*)(mixb + t * 2048 + c0) = w; } }
        __syncthreads();
    }
}
typedef float f32x2 __attribute__((ext_vector_type(2)));
__device__ __forceinline__ void wsm_phase(const float* ws, bf16_t* WsM, int wg, int nwg, int wave_s) {
    const int tid = opaque_tid(wave_s);
    for (int i = wg * NTHR + tid; i < 4 * 128 * 128; i += nwg * NTHR) { const int t = (i >> 7) & 127, s = i & 127; WsM[i] = (bf16_t)(cvt_pk_bf16(s <= t ? ws[i] : 0.f, 0.f) & 0xffffu); }
}
__device__ __forceinline__ void gmlp_norm_phase(LAS unsigned char* lds, const bf16_t* gvT, bf16_t* vnT, const float* gain, int wg, int nwg, int wave_s) {
    const int tid = opaque_tid(wave_s), tg = tid & 15, c0 = tid >> 4;
    LAS float* red = (LAS float*)lds;
    for (int u = wg; u < 512; u += nwg) {
        const int n = u >> 2, g = u & 3;
        const size_t boff = (size_t)(g * 256 + c0) * T_ + n * 128 + tg * 8;
        u32x4 w[8]; float s[8], q[8], gn8[8];
#pragma unroll
        for (int i = 0; i < 8; ++i) gn8[i] = gain[g * 256 + c0 + 32 * i];
#pragma unroll
        for (int e = 0; e < 8; ++e) { s[e] = 0.f; q[e] = 0.f; }
#pragma unroll
        for (int i = 0; i < 8; ++i) { w[i] = *(const u32x4*)(gvT + boff + (size_t)(32 * i) * T_);
            const float v[8] = {bflo(w[i].x), bfhi(w[i].x), bflo(w[i].y), bfhi(w[i].y), bflo(w[i].z), bfhi(w[i].z), bflo(w[i].w), bfhi(w[i].w)};
#pragma unroll
            for (int e = 0; e < 8; ++e) { s[e] += v[e]; q[e] += v[e] * v[e]; } }
#pragma unroll
        for (int e = 0; e < 8; ++e) { s[e] += __shfl_xor(s[e], 16); q[e] += __shfl_xor(q[e], 16); s[e] += __shfl_xor(s[e], 32); q[e] += __shfl_xor(q[e], 32); }
        { const int wv = tid >> 6;
          if ((tid & 48) == 0) {
#pragma unroll
            for (int e = 0; e < 8; ++e) *(LAS f32x2*)(red + ((e * 8 + wv) * 16 + tg) * 2) = (f32x2){s[e], q[e]}; } }
        __syncthreads();
        float mean[8], rstd[8];
#pragma unroll
        for (int e = 0; e < 8; ++e) { float a = 0.f, b = 0.f;
#pragma unroll
            for (int k = 0; k < 8; ++k) { const f32x2 t2 = *(const LAS f32x2*)(red + ((e * 8 + k) * 16 + tg) * 2); a += t2[0]; b += t2[1]; }
            mean[e] = a * (1.f / 256.f); rstd[e] = rsqrtf(b * (1.f / 256.f) - mean[e] * mean[e] + 1e-6f); }
#pragma unroll
        for (int i = 0; i < 8; ++i) { const float gn = gn8[i];
            const float v[8] = {bflo(w[i].x), bfhi(w[i].x), bflo(w[i].y), bfhi(w[i].y), bflo(w[i].z), bfhi(w[i].z), bflo(w[i].w), bfhi(w[i].w)};
            u32x4 o; o.x = cvt_pk_bf16((v[0] - mean[0]) * rstd[0] * gn, (v[1] - mean[1]) * rstd[1] * gn); o.y = cvt_pk_bf16((v[2] - mean[2]) * rstd[2] * gn, (v[3] - mean[3]) * rstd[3] * gn);
            o.z = cvt_pk_bf16((v[4] - mean[4]) * rstd[4] * gn, (v[5] - mean[5]) * rstd[5] * gn); o.w = cvt_pk_bf16((v[6] - mean[6]) * rstd[6] * gn, (v[7] - mean[7]) * rstd[7] * gn);
            *(u32x4*)(vnT + boff + (size_t)(32 * i) * T_) = o; }
        __syncthreads();
    }
}
__device__ __forceinline__ void gmlp_mix_phase(LAS unsigned char* lds, const bf16_t* WsM, const bf16_t* vnT, const bf16_t* ugb, const float* bs, bf16_t* mixb, int wg, int nwg, int wave_s) {
    typedef Core<4, 4> C;
    const int tid = opaque_tid(wave_s), wid = __builtin_amdgcn_readfirstlane(tid >> 6), lane = tid & 63, wr = wid >> 2, wc = wid & 3, fr = lane & 15, fq = lane >> 4;
    unsigned aoff[2], boff[4];
#pragma unroll
    for (int i = 0; i < 2; ++i) { int r, c; C::apiece(tid, i, r, c); aoff[i] = (unsigned)(r * 128 + c) * 2u; }
#pragma unroll
    for (int i = 0; i < 4; ++i) { int r, c; C::bpiece(tid, i, r, c); boff[i] = (unsigned)(r * T_ + c) * 2u; }
    for (int u = wg; u < 512; u += nwg) {
        const int n = u >> 2, g = u & 3;
        f32x4 acc[4][4]; C::zero(acc);
        C::burst_gg(lds, lds + 32768, (const char*)(WsM + g * 16384), aoff, (const char*)(vnT + (size_t)(g * 256) * T_ + n * 128), boff, 2, acc, wid, wr, wc, fr, fq);
        u32x4 ugv[4][2]; float bsv[4];
#pragma unroll
        for (int m = 0; m < 4; ++m) { const int i = wr * 64 + m * 16 + fr; bsv[m] = bs[g * 128 + i];
#pragma unroll
            for (int hf = 0; hf < 2; ++hf) ugv[m][hf] = *(const u32x4*)(ugb + ((size_t)n * 128 + i) * 1024 + g * 256 + hf * 128 + wc * 32 + 8 * fq); }
        asm volatile("" ::: "memory");
#pragma unroll
        for (int m = 0; m < 4; ++m) { const int i = wr * 64 + m * 16 + fr; const float bias = bsv[m]; const size_t t = (size_t)n * 128 + i;
#pragma unroll
            for (int hf = 0; hf < 2; ++hf) { const int c0 = g * 256 + hf * 128 + wc * 32 + 8 * fq;
                const u32x4 ug = ugv[m][hf];
                const f32x4 a = acc[m][2 * hf], b = acc[m][2 * hf + 1];
                u32x4 w; w.x = cvt_pk_bf16((a[0] + bias) * bflo(ug.x), (a[1] + bias) * bfhi(ug.x)); w.y = cvt_pk_bf16((a[2] + bias) * bflo(ug.y), (a[3] + bias) * bfhi(ug.y));
                w.z = cvt_pk_bf16((b[0] + bias) * bflo(ug.z), (b[1] + bias) * bfhi(ug.z)); w.w = cvt_pk_bf16((b[2] + bias) * bflo(ug.w), (b[3] + bias) * bfhi(ug.w));
                *(u32x4*)(mixb + t * 2048 + 1024 + c0) = w; } }
        __syncthreads();
    }
}
template <bool B16> __device__ __forceinline__ float4 ld_x4(const void* base, size_t i4) {
    if (B16) { const u32x2 w = ((const u32x2*)base)[i4]; return make_float4(bflo(w.x), bfhi(w.x), bflo(w.y), bfhi(w.y)); }
    return ((const float4*)base)[i4]; }
template <bool B16> __device__ __forceinline__ void st_x4(void* base, size_t i4, float4 v) {
    if (B16) { u32x2 w; w.x = cvt_pk_bf16(v.x, v.y); w.y = cvt_pk_bf16(v.z, v.w); ((u32x2*)base)[i4] = w; }
    else ((float4*)base)[i4] = v; }
template <bool OUT16 = false> struct EpiResidualT {
    const float* xin; float* xout; float sc = 1.f;
    __device__ __forceinline__ bool swapped(int) const { return false; }
    __device__ __forceinline__ int brow0(int pn) const { return pn * 256; }
    __device__ __forceinline__ void operator()(const f32x4 (&acc)[8][4], int pm, int pn, int wr, int wc, int fr, int fq) const {
        f32x4 xa[2][4], xb[2][4];
#define ER_ROW(m2) (pm * 256 + arow_of<8>(wr, 2 * (m2), fr))
#define ER_LD(buf, m2) do { int row0_ = ER_ROW(m2); asm volatile("" : "+v"(row0_)); const float* ip0_ = xin + (size_t)row0_ * D_ + pn * 256; \
        _Pragma("unroll") for (int r = 0; r < 2; ++r) _Pragma("unroll") for (int n = 0; n < 4; ++n) buf[r][n] = *(const f32x4*)(ip0_ + (size_t)r * 16 * D_ + bcol_of<4>(wc, n, fq, 0)); } while (0)
#define ER_ST(buf, m2) do { int row0_ = ER_ROW(m2); asm volatile("" : "+v"(row0_)); \
        if (OUT16) { bf16_t* op0_ = (bf16_t*)xout + (size_t)row0_ * D_ + pn * 256; \
            _Pragma("unroll") for (int r = 0; r < 2; ++r) _Pragma("unroll") for (int hf = 0; hf < 2; ++hf) { const f32x4 a_ = buf[r][2 * hf] + acc[2 * (m2) + r][2 * hf] * sc, b_ = buf[r][2 * hf + 1] + acc[2 * (m2) + r][2 * hf + 1] * sc; \
                u32x4 o_; o_.x = cvt_pk_bf16(a_[0], a_[1]); o_.y = cvt_pk_bf16(a_[2], a_[3]); o_.z = cvt_pk_bf16(b_[0], b_[1]); o_.w = cvt_pk_bf16(b_[2], b_[3]); *(u32x4*)(op0_ + (size_t)r * 16 * D_ + hf * 128 + wc * 32 + 8 * fq) = o_; } } \
        else { float* op0_ = xout + (size_t)row0_ * D_ + pn * 256; \
        _Pragma("unroll") for (int r = 0; r < 2; ++r) _Pragma("unroll") for (int n = 0; n < 4; ++n) *(f32x4*)(op0_ + (size_t)r * 16 * D_ + bcol_of<4>(wc, n, fq, 0)) = buf[r][n] + acc[2 * (m2) + r][n] * sc; } } while (0)
        ER_LD(xa, 0); ER_LD(xb, 1); asm volatile("" ::: "memory");
        ER_ST(xa, 0); asm volatile("" ::: "memory"); ER_LD(xa, 2); asm volatile("" ::: "memory");
        ER_ST(xb, 1); asm volatile("" ::: "memory"); ER_LD(xb, 3); asm volatile("" ::: "memory");
        ER_ST(xa, 2); ER_ST(xb, 3); asm volatile("" ::: "memory");
#undef ER_ROW
#undef ER_LD
#undef ER_ST
    }
};
typedef EpiResidualT<false> EpiResidual;
struct EpiResidual16 {
    bf16_t* x; float sc = 1.f;
    __device__ __forceinline__ bool swapped(int) const { return false; }
    __device__ __forceinline__ int brow0(int pn) const { return pn * 256; }
    __device__ __forceinline__ void operator()(const f32x4 (&acc)[8][4], int pm, int pn, int wr, int wc, int fr, int fq) const {
#pragma unroll
        for (int mb = 0; mb < 8; mb += 4) {
            u32x4 w[4][2];
#pragma unroll
            for (int m = 0; m < 4; ++m) { int row = pm * 256 + arow_of<8>(wr, mb + m, fr); asm volatile("" : "+v"(row)); const bf16_t* p = x + (size_t)row * D_ + pn * 256 + wc * 32 + 8 * fq;
                w[m][0] = *(const u32x4*)p; w[m][1] = *(const u32x4*)(p + 128); }
            asm volatile("" ::: "memory");
#pragma unroll
            for (int m = 0; m < 4; ++m) { int row = pm * 256 + arow_of<8>(wr, mb + m, fr); asm volatile("" : "+v"(row)); bf16_t* p = x + (size_t)row * D_ + pn * 256 + wc * 32 + 8 * fq;
#pragma unroll
                for (int hf = 0; hf < 2; ++hf) { const u32x4 ww = w[m][hf]; const f32x4 a = acc[mb + m][2 * hf] * sc, b = acc[mb + m][2 * hf + 1] * sc; u32x4 o;
                    o.x = cvt_pk_bf16(bflo(ww.x) + a[0], bfhi(ww.x) + a[1]); o.y = cvt_pk_bf16(bflo(ww.y) + a[2], bfhi(ww.y) + a[3]);
                    o.z = cvt_pk_bf16(bflo(ww.z) + b[0], bfhi(ww.z) + b[1]); o.w = cvt_pk_bf16(bflo(ww.w) + b[2], bfhi(ww.w) + b[3]);
                    *(u32x4*)(p + hf * 128) = o; } }
            asm volatile("" ::: "memory"); }
    }
};
struct EpiResidualY {
    const float* xin; const bf16_t* y; float* xout;
    __device__ __forceinline__ bool swapped(int) const { return false; }
    __device__ __forceinline__ int brow0(int pn) const { return pn * 256; }
    __device__ __forceinline__ void operator()(const f32x4 (&acc)[8][4], int pm, int pn, int wr, int wc, int fr, int fq) const {
#pragma unroll
        for (int m = 0; m < 8; ++m) { int row = pm * 256 + arow_of<8>(wr, m, fr); asm volatile("" : "+v"(row));
            const float* ip = xin + (size_t)row * D_ + pn * 256; float* op = xout + (size_t)row * D_ + pn * 256;
            const bf16_t* y0 = y + (size_t)(2 * row) * D_ + pn * 256; const bf16_t* y1 = y0 + D_;
#pragma unroll
            for (int hf = 0; hf < 2; ++hf) { const int c = hf * 128 + wc * 32 + 8 * fq;
                const u32x4 a = *(const u32x4*)(y0 + c), b = *(const u32x4*)(y1 + c);
                f32x4 x0 = *(const f32x4*)(ip + c) + acc[m][2 * hf], x1v = *(const f32x4*)(ip + c + 4) + acc[m][2 * hf + 1];
                x0[0] += bflo(a.x) + bflo(b.x); x0[1] += bfhi(a.x) + bfhi(b.x); x0[2] += bflo(a.y) + bflo(b.y); x0[3] += bfhi(a.y) + bfhi(b.y);
                x1v[0] += bflo(a.z) + bflo(b.z); x1v[1] += bfhi(a.z) + bfhi(b.z); x1v[2] += bflo(a.w) + bflo(b.w); x1v[3] += bfhi(a.w) + bfhi(b.w);
                *(f32x4*)(op + c) = x0; *(f32x4*)(op + c + 4) = x1v; }
            asm volatile("" ::: "memory"); }
    }
};

#define CAPF 16384
typedef float f32x2 __attribute__((ext_vector_type(2)));
__device__ __forceinline__ void wr_phase(const float* wrg, const float* wre, bf16_t* WrT, int wg, int nwg, int wave_s) {
    const int tid = opaque_tid(wave_s);
    for (int i = wg * NTHR + tid; i < 64 * 2048; i += nwg * NTHR) { const int r = i >> 11, k = i & 2047;
        const float v = r < 4 ? wrg[k * 4 + r] : (r < 36 ? wre[k * 32 + (r - 4)] : 0.f);
        WrT[i] = (bf16_t)(cvt_pk_bf16(v, 0.f) & 0xffffu); }
}
template <bool XIN16>
__device__ __forceinline__ void moe_route_phase(LAS unsigned char* lds, const void* x1, const float* g, bf16_t* hb, unsigned char* hb8, const bf16_t* WrT, const float* brg, const float* bre,
                                                int* cnt, int* list, float* gate, int wg, int nwg, int wave_s) {
    typedef Core<2, 1> C;
    const int tid = opaque_tid(wave_s), wid = __builtin_amdgcn_readfirstlane(tid >> 6), lane = tid & 63, wr = wid >> 2, wc = wid & 3, fr = lane & 15, fq = lane >> 4;
    unsigned aoff[1], boff[1];
    { int r, c; C::apiece(tid, 0, r, c); aoff[0] = (unsigned)(r * 2048 + c) * 2u; C::bpiece(tid, 0, r, c); boff[0] = (unsigned)(r * 2048 + c) * 2u; }
    LAS float* lg = (LAS float*)lds;
    for (int u = wg; u < T_ / 64; u += nwg) {
        if constexpr (true) {
            const float* xf = (const float*)x1; f32x4 gv[8], xa[8]; u32x4 xh[4];
#pragma unroll
            for (int i = 0; i < 4; ++i) { const int e0 = 8 * (lane + 64 * i); gv[2 * i] = *(const f32x4*)(g + e0); gv[2 * i + 1] = *(const f32x4*)(g + e0 + 4); }
#define RT_LOAD(row_) do { const size_t rb_ = (size_t)(row_) * D_; _Pragma("unroll") for (int i = 0; i < 4; ++i) { const int e0 = 8 * (lane + 64 * i); \
        if (XIN16) xh[i] = *(const u32x4*)((const bf16_t*)x1 + rb_ + e0); else { xa[2 * i] = *(const f32x4*)(xf + rb_ + e0); xa[2 * i + 1] = *(const f32x4*)(xf + rb_ + e0 + 4); } } } while (0)
            RT_LOAD(u * 64 + wid * 8);
            for (int rr = 0; rr < 8; ++rr) { const int row = u * 64 + wid * 8 + rr;
                f32x4 v[8]; float ss = 0.f;
#pragma unroll
                for (int i = 0; i < 8; ++i) { if (XIN16) { const u32x4 w = xh[i >> 1]; v[i] = (i & 1) ? (f32x4){bflo(w.z), bfhi(w.z), bflo(w.w), bfhi(w.w)} : (f32x4){bflo(w.x), bfhi(w.x), bflo(w.y), bfhi(w.y)}; } else v[i] = xa[i];
                    ss += v[i][0] * v[i][0] + v[i][1] * v[i][1] + v[i][2] * v[i][2] + v[i][3] * v[i][3]; }
                asm volatile("" ::: "memory");
                if (rr < 7) RT_LOAD(row + 1);
                asm volatile("" ::: "memory");
                ss = wave_sum(ss);
                const float r = rsqrtf(ss * (1.f / D_) + 1e-6f);
#pragma unroll
                for (int i = 0; i < 4; ++i) { const int e0 = 8 * (lane + 64 * i); const f32x4 ga = gv[2 * i], gb = gv[2 * i + 1], a = v[2 * i], b = v[2 * i + 1];
                    const float h8[8] = {a[0] * r * ga[0], a[1] * r * ga[1], a[2] * r * ga[2], a[3] * r * ga[3], b[0] * r * gb[0], b[1] * r * gb[1], b[2] * r * gb[2], b[3] * r * gb[3]};
                    u32x4 o; o.x = cvt_pk_bf16(h8[0], h8[1]); o.y = cvt_pk_bf16(h8[2], h8[3]); o.z = cvt_pk_bf16(h8[4], h8[5]); o.w = cvt_pk_bf16(h8[6], h8[7]);
                    *(u32x4*)(hb + (size_t)row * D_ + e0) = o;
                    if (hb8) { u32x2 w; w.x = pk4_fp8(4.f * h8[0], 4.f * h8[1], 4.f * h8[2], 4.f * h8[3]); w.y = pk4_fp8(4.f * h8[4], 4.f * h8[5], 4.f * h8[6], 4.f * h8[7]); *(u32x2*)(hb8 + (size_t)row * D_ + e0) = w; } } }
#undef RT_LOAD
        } else
        for (int rr = 0; rr < 8; ++rr) { const int row = u * 64 + wid * 8 + rr;
            float4 v[8]; float ss = 0.f;
#pragma unroll
            for (int i = 0; i < 8; ++i) { v[i] = ld_x4<XIN16>(x1, (size_t)row * (D_ / 4) + 2 * (lane + 64 * (i >> 1)) + (i & 1)); ss += v[i].x * v[i].x + v[i].y * v[i].y + v[i].z * v[i].z + v[i].w * v[i].w; }
            ss = wave_sum(ss);
            const float r = rsqrtf(ss * (1.f / D_) + 1e-6f);
#pragma unroll
            for (int i = 0; i < 4; ++i) { const int e0 = 8 * (lane + 64 * i); const float4 ga = *(const float4*)(g + e0), gb = *(const float4*)(g + e0 + 4); const float4 a = v[2 * i], b = v[2 * i + 1];
                const float h8[8] = {a.x * r * ga.x, a.y * r * ga.y, a.z * r * ga.z, a.w * r * ga.w, b.x * r * gb.x, b.y * r * gb.y, b.z * r * gb.z, b.w * r * gb.w};
                u32x4 o; o.x = cvt_pk_bf16(h8[0], h8[1]); o.y = cvt_pk_bf16(h8[2], h8[3]); o.z = cvt_pk_bf16(h8[4], h8[5]); o.w = cvt_pk_bf16(h8[6], h8[7]);
                *(u32x4*)(hb + (size_t)row * D_ + e0) = o;
                if (hb8) { u32x2 w; w.x = pk4_fp8(4.f * h8[0], 4.f * h8[1], 4.f * h8[2], 4.f * h8[3]); w.y = pk4_fp8(4.f * h8[4], 4.f * h8[5], 4.f * h8[6], 4.f * h8[7]); *(u32x2*)(hb8 + (size_t)row * D_ + e0) = w; } } }
        WAIT_V0(); __syncthreads();
        f32x4 acc[2][1]; C::zero(acc);
        for (int kb = 0; kb < 4; ++kb) {
            C::burst_gg(lds, lds + 65536, (const char*)(hb + (size_t)u * 64 * D_) + kb * 1024, aoff, (const char*)WrT + kb * 1024, boff, 8, acc, wid, wr, wc, fr, fq);
            __syncthreads(); }
#pragma unroll
        for (int m = 0; m < 2; ++m) { const int row = wr * 32 + m * 16 + fr;
#pragma unroll
            for (int j = 0; j < 4; ++j) { const int col = wc * 16 + 4 * fq + j; if (col < 36) lg[row * 40 + col] = acc[m][0][j] + (col < 4 ? brg[col] : bre[col - 4]); } }
        __syncthreads();
        if (tid < 64) {
            const int t = u * 64 + tid; const LAS float* L = lg + tid * 40;
            float l4[4], le[32];
#pragma unroll
            for (int i = 0; i < 4; ++i) l4[i] = L[i];
#pragma unroll
            for (int i = 0; i < 32; ++i) le[i] = L[4 + i];
            int gs = 0; float gm = l4[0];
#pragma unroll
            for (int i = 1; i < 4; ++i) if (l4[i] > gm) { gm = l4[i]; gs = i; }
            float den = 0.f;
#pragma unroll
            for (int i = 0; i < 4; ++i) den += __expf(l4[i] - gm);
            const float psel = 1.f / den;
            float l8[8];
#pragma unroll
            for (int i = 0; i < 8; ++i) l8[i] = gs == 0 ? le[i] : gs == 1 ? le[8 + i] : gs == 2 ? le[16 + i] : le[24 + i];
            int e1 = 0; float m1 = l8[0];
#pragma unroll
            for (int i = 1; i < 8; ++i) if (l8[i] > m1) { m1 = l8[i]; e1 = i; }
            int e2 = -1; float m2 = -3.0e38f;
#pragma unroll
            for (int i = 0; i < 8; ++i) if (i != e1 && l8[i] > m2) { m2 = l8[i]; e2 = i; }
            const float z = __expf(m2 - m1);
            const int ex1 = gs * 8 + e1, ex2 = gs * 8 + e2;
            LAS int* hist = (LAS int*)(lg + 64 * 40);
            if (tid < 32) hist[tid] = 0;
            const int r1 = __hip_atomic_fetch_add(hist + ex1, 1, __ATOMIC_RELAXED, __HIP_MEMORY_SCOPE_WORKGROUP);
            const int r2 = __hip_atomic_fetch_add(hist + ex2, 1, __ATOMIC_RELAXED, __HIP_MEMORY_SCOPE_WORKGROUP);
            if (tid < 32) { const int c = hist[tid]; hist[32 + tid] = c ? atomicAdd(&cnt[tid], c) : 0; }
            const int p1 = hist[32 + ex1] + r1, p2 = hist[32 + ex2] + r2;
            list[ex1 * CAPF + p1] = t * 2; list[ex2 * CAPF + p2] = t * 2 + 1;
            gate[ex1 * CAPF + p1] = psel / (1.f + z); gate[ex2 * CAPF + p2] = psel * z / (1.f + z);
        }
        __syncthreads();
    }
}
__device__ __forceinline__ void moe_prefix(LAS int* tp, LAS int* cn, LAS int* tab, const int* cnt, int tid) {
    if (tid == 0) { int s = 0; for (int e = 0; e < 32; ++e) { const int c = cnt[e]; cn[e] = c; tp[e] = s; s += (c + 255) >> 8; } tp[32] = s; }
    __syncthreads();
    if (tid < 32) { const int nf = (cn[tid] + 255) >> 8, k0 = tp[tid]; for (int r = 0; r < nf; ++r) tab[k0 + r] = (tid << 8) | r; }
    __syncthreads();
}
struct MoeU { int R, pn, e, rt, ne, tpe; };
__device__ __forceinline__ bool moe_unit(int idx, int total, const LAS int* tp, const LAS int* cn, const LAS int* tab, MoeU& u) {
    if (idx >= total) return false;
    u.pn = idx & 7;
    const int t = __builtin_amdgcn_readfirstlane(tab[idx >> 3]);
    u.e = t >> 8; u.rt = t & 255; u.tpe = __builtin_amdgcn_readfirstlane(tp[u.e]); u.R = u.tpe + u.rt; u.ne = __builtin_amdgcn_readfirstlane(cn[u.e]); return true;
}
struct GuSched {
    typedef MoeU U; static constexpr bool GATHER = true;
    static constexpr bool RAGGED = true;
    const char* hb; const char* Wgu; const int* list; const LAS int* tp; const LAS int* cn; const LAS int* tab; int wg, nwg, total, rb;
    __device__ __forceinline__ bool next(int i, U& u) const { return moe_unit(i * nwg + wg, total, tp, cn, tab, u); }
    __device__ __forceinline__ int nvalid(const U& u) const { const int r = u.ne - u.rt * 256; return r < 256 ? r : 256; }
    __device__ __forceinline__ const char* abase(const U&) const { return hb; }
    __device__ __forceinline__ const char* bbase(const U& u) const { return Wgu + ((size_t)u.e * 2048 + u.pn * 256) * rb; }
    __device__ __forceinline__ void gather(const U& u, int R0, unsigned (&pk)[2]) const {
        int l[4];
#pragma unroll
        for (int q = 0; q < 4; ++q) { int gr = u.rt * 256 + (q >> 1) * 128 + R0 + 64 * (q & 1); gr = gr < u.ne ? gr : u.ne - 1; l[q] = list[u.e * CAPF + gr]; }
        asm volatile("" : "+v"(l[0]), "+v"(l[1]), "+v"(l[2]), "+v"(l[3]));
        pk[0] = (unsigned)(l[0] >> 1) | ((unsigned)(l[1] >> 1) << 16); pk[1] = (unsigned)(l[2] >> 1) | ((unsigned)(l[3] >> 1) << 16); }
};
template <bool FP8> struct EpiGu { void* hid;
    __device__ __forceinline__ void operator()(const f32x4 (&acc)[8][4], const MoeU& u, int wr, int wc, int fr, int fq) const {
        const float si = FP8 ? (1.f / 256.f) : 1.f, so = FP8 ? 8.f : 1.f;
#pragma unroll
        for (int m = 0; m < 8; ++m) { int gr = u.rt * 256 + arow_of<8>(wr, m, fr); asm volatile("" : "+v"(gr));
            if (gr < u.ne) {
                float o[8];
#pragma unroll
                for (int e = 0; e < 8; ++e) { const float a = acc[m][e >> 2][e & 3] * si, b = acc[m][2 + (e >> 2)][e & 3] * si; o[e] = silu_fast(a) * b * so; if (FP8) o[e] = __builtin_amdgcn_fmed3f(o[e], -448.f, 448.f); }
                const size_t off = ((size_t)u.tpe * 256 + gr) * 1024 + u.pn * 128 + wc * 32 + 8 * fq;
                if (FP8) { u32x2 w; w.x = pk4_fp8(o[0], o[1], o[2], o[3]); w.y = pk4_fp8(o[4], o[5], o[6], o[7]); *(u32x2*)((unsigned char*)hid + off) = w; }
                else { u32x4 w; w.x = cvt_pk_bf16(o[0], o[1]); w.y = cvt_pk_bf16(o[2], o[3]); w.z = cvt_pk_bf16(o[4], o[5]); w.w = cvt_pk_bf16(o[6], o[7]); *(u32x4*)((bf16_t*)hid + off) = w; } }
            asm volatile("" ::: "memory"); }
    }
};
template <bool FP8>
__device__ __forceinline__ void moe_gu_phase(LAS unsigned char* lds, const void* h, const void* Wgu, const int* cnt, const int* list, void* hid, int wg, int nwg, int wave_s) {
    const int tid = opaque_tid(wave_s);
    LAS int* tp = (LAS int*)(lds + 143360); LAS int* cn = tp + 40; LAS int* tab = tp + 80;
    moe_prefix(tp, cn, tab, cnt, tid);
    const int rb = FP8 ? 2048 : 4096;
    GuSched S{(const char*)h, (const char*)Wgu, list, tp, cn, tab, wg, nwg, __builtin_amdgcn_readfirstlane(tp[32]) * 8, rb}; EpiGu<FP8> E{hid};
    gemm8_phase<FP8>(lds, rb, S, E, wave_s);
    __syncthreads();
}
struct DownSched {
    typedef MoeU U; static constexpr bool GATHER = false;
    static constexpr bool RAGGED = true;
    const char* hid; const char* Wdn; const LAS int* tp; const LAS int* cn; const LAS int* tab; int wg, nwg, total, rb;
    __device__ __forceinline__ bool next(int i, U& u) const { return moe_unit(i * nwg + wg, total, tp, cn, tab, u); }
    __device__ __forceinline__ int nvalid(const U& u) const { const int r = u.ne - u.rt * 256; return r < 256 ? r : 256; }
    __device__ __forceinline__ const char* abase(const U& u) const { return hid + (size_t)u.R * 256 * rb; }
    __device__ __forceinline__ const char* bbase(const U& u) const { return Wdn + ((size_t)u.e * 2048 + u.pn * 256) * rb; }
    __device__ __forceinline__ void gather(const U&, int, unsigned (&)[2]) const {}
};
template <bool Y8> struct EpiDown { const int* list; const float* gate; void* y; float sc;
    __device__ __forceinline__ void operator()(const f32x4 (&acc)[8][4], const MoeU& u, int wr, int wc, int fr, int fq) const {
        int slot[8]; float gt[8];
#pragma unroll
        for (int m = 0; m < 8; ++m) { int gr = u.rt * 256 + arow_of<8>(wr, m, fr); gr = gr < u.ne ? gr : u.ne - 1; slot[m] = list[u.e * CAPF + gr]; gt[m] = gate[u.e * CAPF + gr] * sc; }
        { float dep = 0.f;
#pragma unroll
          for (int m = 0; m < 8; ++m) dep += gt[m] + (float)slot[m];
          asm volatile("" :: "v"(dep)); }
#pragma unroll
        for (int m = 0; m < 8; ++m) { const int gr = u.rt * 256 + arow_of<8>(wr, m, fr);
            if (gr < u.ne) { const float g = gt[m];
                const size_t yo = (size_t)slot[m] * 2048 + u.pn * 256 + wc * 32 + 8 * fq;
#pragma unroll
                for (int hf = 0; hf < 2; ++hf) { const f32x4 a = acc[m][2 * hf], b = acc[m][2 * hf + 1];
                    if (Y8) { float o[8] = {g * a[0], g * a[1], g * a[2], g * a[3], g * b[0], g * b[1], g * b[2], g * b[3]};
#pragma unroll
                        for (int e = 0; e < 8; ++e) o[e] = __builtin_amdgcn_fmed3f(o[e], -448.f, 448.f);
                        u32x2 w; w.x = pk4_fp8(o[0], o[1], o[2], o[3]); w.y = pk4_fp8(o[4], o[5], o[6], o[7]); *(u32x2*)((unsigned char*)y + yo + hf * 128) = w; }
                    else { u32x4 w; w.x = cvt_pk_bf16(g * a[0], g * a[1]); w.y = cvt_pk_bf16(g * a[2], g * a[3]); w.z = cvt_pk_bf16(g * b[0], g * b[1]); w.w = cvt_pk_bf16(g * b[2], g * b[3]);
                        *(u32x4*)((bf16_t*)y + yo + hf * 128) = w; } } } }
    }
};
template <bool FP8, bool Y8>
__device__ __forceinline__ void moe_down_phase(LAS unsigned char* lds, const void* hid, const void* Wdn, const int* cnt, const int* list, const float* gate, void* y, int wg, int nwg, int wave_s) {
    const int tid = opaque_tid(wave_s);
    LAS int* tp = (LAS int*)(lds + 143360); LAS int* cn = tp + 40; LAS int* tab = tp + 80;
    moe_prefix(tp, cn, tab, cnt, tid);
    const int rb = FP8 ? 1024 : 2048;
    DownSched S{(const char*)hid, (const char*)Wdn, tp, cn, tab, wg, nwg, __builtin_amdgcn_readfirstlane(tp[32]) * 8, rb}; EpiDown<Y8> E{list, gate, y, (FP8 ? (1.f / 256.f) : 1.f) * (Y8 ? 64.f : 1.f)};
    gemm8_phase<FP8>(lds, rb, S, E, wave_s);
    __syncthreads();
}
template <bool WRITE_X, bool Y8, bool XIN16, bool XOUT16, bool HB8 = false>
__device__ __forceinline__ void moe_combine_phase_gen(const void* xin, void* xout, const void* y, const float* g, bf16_t* hb, float* outf, int wg, int nwg, int wave_s) {
    const int tid = opaque_tid(wave_s), lane = tid & 63, wv = tid >> 6;
    for (int row = wg * 8 + wv; row < T_; row += nwg * 8) {
        const size_t r4 = (size_t)row * (D_ / 4);
        float4 v[8]; float ss = 0.f;
#pragma unroll
        for (int i = 0; i < 4; ++i) { const int e0 = 8 * (lane + 64 * i);
            float4 a = ld_x4<XIN16>(xin, r4 + e0 / 4), b = ld_x4<XIN16>(xin, r4 + e0 / 4 + 1);
            if (Y8) { const u32x2 p = *(const u32x2*)((const unsigned char*)y + (size_t)(2 * row) * D_ + e0), q2 = *(const u32x2*)((const unsigned char*)y + (size_t)(2 * row + 1) * D_ + e0);
                const f32x2 p0 = __builtin_amdgcn_cvt_pk_f32_fp8((int)p.x, false), p1 = __builtin_amdgcn_cvt_pk_f32_fp8((int)p.x, true), p2 = __builtin_amdgcn_cvt_pk_f32_fp8((int)p.y, false), p3 = __builtin_amdgcn_cvt_pk_f32_fp8((int)p.y, true);
                const f32x2 s0 = __builtin_amdgcn_cvt_pk_f32_fp8((int)q2.x, false), s1 = __builtin_amdgcn_cvt_pk_f32_fp8((int)q2.x, true), s2 = __builtin_amdgcn_cvt_pk_f32_fp8((int)q2.y, false), s3 = __builtin_amdgcn_cvt_pk_f32_fp8((int)q2.y, true);
                a.x += (p0[0] + s0[0]) * (1.f / 64.f); a.y += (p0[1] + s0[1]) * (1.f / 64.f); a.z += (p1[0] + s1[0]) * (1.f / 64.f); a.w += (p1[1] + s1[1]) * (1.f / 64.f);
                b.x += (p2[0] + s2[0]) * (1.f / 64.f); b.y += (p2[1] + s2[1]) * (1.f / 64.f); b.z += (p3[0] + s3[0]) * (1.f / 64.f); b.w += (p3[1] + s3[1]) * (1.f / 64.f); }
            else { const u32x4 p = *(const u32x4*)((const bf16_t*)y + (size_t)(2 * row) * D_ + e0), q2 = *(const u32x4*)((const bf16_t*)y + (size_t)(2 * row + 1) * D_ + e0);
                a.x += bflo(p.x) + bflo(q2.x); a.y += bfhi(p.x) + bfhi(q2.x); a.z += bflo(p.y) + bflo(q2.y); a.w += bfhi(p.y) + bfhi(q2.y);
                b.x += bflo(p.z) + bflo(q2.z); b.y += bfhi(p.z) + bfhi(q2.z); b.z += bflo(p.w) + bflo(q2.w); b.w += bfhi(p.w) + bfhi(q2.w); }
            v[2 * i] = a; v[2 * i + 1] = b;
            ss += a.x * a.x + a.y * a.y + a.z * a.z + a.w * a.w + b.x * b.x + b.y * b.y + b.z * b.z + b.w * b.w; }
        ss = wave_sum(ss);
        const float r = rsqrtf(ss * (1.f / D_) + 1e-6f);
#pragma unroll
        for (int i = 0; i < 4; ++i) { const int e0 = 8 * (lane + 64 * i); const float4 ga = *(const float4*)(g + e0), gb = *(const float4*)(g + e0 + 4); const float4 a = v[2 * i], b = v[2 * i + 1];
            if (hb) { if (WRITE_X) { st_x4<XOUT16>(xout, r4 + e0 / 4, a); st_x4<XOUT16>(xout, r4 + e0 / 4 + 1, b); }
                if (HB8) { const float r4s = 4.f * r; u32x2 o; o.x = pk4_fp8(a.x * r4s * ga.x, a.y * r4s * ga.y, a.z * r4s * ga.z, a.w * r4s * ga.w); o.y = pk4_fp8(b.x * r4s * gb.x, b.y * r4s * gb.y, b.z * r4s * gb.z, b.w * r4s * gb.w);
                    *(u32x2*)((unsigned char*)hb + (size_t)row * D_ + e0) = o; }
                else { u32x4 o; o.x = cvt_pk_bf16(a.x * r * ga.x, a.y * r * ga.y); o.y = cvt_pk_bf16(a.z * r * ga.z, a.w * r * ga.w); o.z = cvt_pk_bf16(b.x * r * gb.x, b.y * r * gb.y); o.w = cvt_pk_bf16(b.z * r * gb.z, b.w * r * gb.w);
                *(u32x4*)(hb + (size_t)row * D_ + e0) = o; } }
            else { float4 oa, ob; oa.x = a.x * r * ga.x; oa.y = a.y * r * ga.y; oa.z = a.z * r * ga.z; oa.w = a.w * r * ga.w; ob.x = b.x * r * gb.x; ob.y = b.y * r * gb.y; ob.z = b.z * r * gb.z; ob.w = b.w * r * gb.w;
                *(float4*)(outf + (size_t)row * D_ + e0) = oa; *(float4*)(outf + (size_t)row * D_ + e0 + 4) = ob; } }
    }
}
__device__ __forceinline__ void moe_combine_phase2(const float* x1, const bf16_t* y, const float* g, bf16_t* hb, float* xd, int wg, int nwg, int wave_s) {
    const int tid = opaque_tid(wave_s), lane = tid & 63, wv = tid >> 6;
    for (int row = wg * 8 + wv; row < T_; row += nwg * 8) {
        const float4* xr = (const float4*)(x1 + (size_t)row * D_); float4* xo = (float4*)(xd + (size_t)row * D_);
        const u32x2* y0 = (const u32x2*)(y + (size_t)(2 * row) * D_); const u32x2* y1 = (const u32x2*)(y + (size_t)(2 * row + 1) * D_);
        float4 v[8]; float ss = 0.f;
#pragma unroll
        for (int i = 0; i < 8; ++i) { v[i] = xr[lane + 64 * i]; const u32x2 a = y0[lane + 64 * i], b = y1[lane + 64 * i];
            v[i].x += bflo(a.x) + bflo(b.x); v[i].y += bfhi(a.x) + bfhi(b.x); v[i].z += bflo(a.y) + bflo(b.y); v[i].w += bfhi(a.y) + bfhi(b.y);
            ss += v[i].x * v[i].x + v[i].y * v[i].y + v[i].z * v[i].z + v[i].w * v[i].w; }
        ss = wave_sum(ss);
        const float r = rsqrtf(ss * (1.f / D_) + 1e-6f);
#pragma unroll
        for (int i = 0; i < 8; ++i) { const float4 gg = ((const float4*)g)[lane + 64 * i]; xo[lane + 64 * i] = v[i];
            u32x2 o; o.x = cvt_pk_bf16(v[i].x * r * gg.x, v[i].y * r * gg.y); o.y = cvt_pk_bf16(v[i].z * r * gg.z, v[i].w * r * gg.w);
            *(u32x2*)(hb + (size_t)row * D_ + (lane + 64 * i) * 4) = o; }
    }
}

template <bool WRITE_X, bool HB8, bool XIN16 = false, bool XOUT16 = false>
__device__ __forceinline__ void moe_combine_phase_pipe(const float* xin, float* xout, const unsigned char* y, const float* g, bf16_t* hb, float* outf, int wg, int nwg, int wave_s) {
    const int tid = opaque_tid(wave_s), lane = tid & 63, wv = tid >> 6;
    f32x4 gv[8];
#pragma unroll
    for (int i = 0; i < 4; ++i) { const int e0 = 8 * (lane + 64 * i); gv[2 * i] = *(const f32x4*)(g + e0); gv[2 * i + 1] = *(const f32x4*)(g + e0 + 4); }
    f32x4 xa[8]; u32x4 xh[4]; u32x2 yp[4], yq[4];
#define MC_LOAD(row_) do { const size_t rb_ = (size_t)(row_) * D_; _Pragma("unroll") for (int i = 0; i < 4; ++i) { const int e0 = 8 * (lane + 64 * i); \
        if (XIN16) xh[i] = *(const u32x4*)((const bf16_t*)xin + rb_ + e0); else { xa[2 * i] = *(const f32x4*)(xin + rb_ + e0); xa[2 * i + 1] = *(const f32x4*)(xin + rb_ + e0 + 4); } \
        yp[i] = *(const u32x2*)(y + 2 * rb_ + e0); yq[i] = *(const u32x2*)(y + 2 * rb_ + D_ + e0); } } while (0)
    int row = wg * 8 + wv;
    if (row < T_) MC_LOAD(row);
    for (; row < T_; row += nwg * 8) {
        f32x4 v[8]; float ss = 0.f;
#pragma unroll
        for (int i = 0; i < 4; ++i) { f32x4 a, b; const u32x2 p = yp[i], q2 = yq[i];
            if (XIN16) { const u32x4 w = xh[i]; a = (f32x4){bflo(w.x), bfhi(w.x), bflo(w.y), bfhi(w.y)}; b = (f32x4){bflo(w.z), bfhi(w.z), bflo(w.w), bfhi(w.w)}; } else { a = xa[2 * i]; b = xa[2 * i + 1]; }
            const f32x2 p0 = __builtin_amdgcn_cvt_pk_f32_fp8((int)p.x, false), p1 = __builtin_amdgcn_cvt_pk_f32_fp8((int)p.x, true), p2 = __builtin_amdgcn_cvt_pk_f32_fp8((int)p.y, false), p3 = __builtin_amdgcn_cvt_pk_f32_fp8((int)p.y, true);
            const f32x2 s0 = __builtin_amdgcn_cvt_pk_f32_fp8((int)q2.x, false), s1 = __builtin_amdgcn_cvt_pk_f32_fp8((int)q2.x, true), s2 = __builtin_amdgcn_cvt_pk_f32_fp8((int)q2.y, false), s3 = __builtin_amdgcn_cvt_pk_f32_fp8((int)q2.y, true);
            a[0] += (p0[0] + s0[0]) * (1.f / 64.f); a[1] += (p0[1] + s0[1]) * (1.f / 64.f); a[2] += (p1[0] + s1[0]) * (1.f / 64.f); a[3] += (p1[1] + s1[1]) * (1.f / 64.f);
            b[0] += (p2[0] + s2[0]) * (1.f / 64.f); b[1] += (p2[1] + s2[1]) * (1.f / 64.f); b[2] += (p3[0] + s3[0]) * (1.f / 64.f); b[3] += (p3[1] + s3[1]) * (1.f / 64.f);
            v[2 * i] = a; v[2 * i + 1] = b;
            ss += a[0] * a[0] + a[1] * a[1] + a[2] * a[2] + a[3] * a[3] + b[0] * b[0] + b[1] * b[1] + b[2] * b[2] + b[3] * b[3]; }
        asm volatile("" ::: "memory");
        if (row + nwg * 8 < T_) MC_LOAD(row + nwg * 8);
        asm volatile("" ::: "memory");
        ss = wave_sum(ss);
        const float r = rsqrtf(ss * (1.f / D_) + 1e-6f);
        const size_t rb = (size_t)row * D_;
#pragma unroll
        for (int i = 0; i < 4; ++i) { const int e0 = 8 * (lane + 64 * i); const f32x4 ga = gv[2 * i], gb = gv[2 * i + 1], a = v[2 * i], b = v[2 * i + 1];
            if (hb) { if (WRITE_X) { if (XOUT16) { u32x4 o; o.x = cvt_pk_bf16(a[0], a[1]); o.y = cvt_pk_bf16(a[2], a[3]); o.z = cvt_pk_bf16(b[0], b[1]); o.w = cvt_pk_bf16(b[2], b[3]); *(u32x4*)((bf16_t*)xout + rb + e0) = o; }
                                      else { *(f32x4*)(xout + rb + e0) = a; *(f32x4*)(xout + rb + e0 + 4) = b; } }
                if (HB8) { const float r4s = 4.f * r; u32x2 o; o.x = pk4_fp8(a[0] * r4s * ga[0], a[1] * r4s * ga[1], a[2] * r4s * ga[2], a[3] * r4s * ga[3]); o.y = pk4_fp8(b[0] * r4s * gb[0], b[1] * r4s * gb[1], b[2] * r4s * gb[2], b[3] * r4s * gb[3]);
                    *(u32x2*)((unsigned char*)hb + rb + e0) = o; }
                else { u32x4 o; o.x = cvt_pk_bf16(a[0] * r * ga[0], a[1] * r * ga[1]); o.y = cvt_pk_bf16(a[2] * r * ga[2], a[3] * r * ga[3]); o.z = cvt_pk_bf16(b[0] * r * gb[0], b[1] * r * gb[1]); o.w = cvt_pk_bf16(b[2] * r * gb[2], b[3] * r * gb[3]);
                    *(u32x4*)(hb + rb + e0) = o; } }
            else { f32x4 oa, ob;
#pragma unroll
                for (int e = 0; e < 4; ++e) { oa[e] = a[e] * r * ga[e]; ob[e] = b[e] * r * gb[e]; }
                *(f32x4*)(outf + rb + e0) = oa; *(f32x4*)(outf + rb + e0 + 4) = ob; } }
    }
#undef MC_LOAD
}
template <bool WRITE_X, bool Y8, bool XIN16, bool XOUT16, bool HB8 = false>
__device__ __forceinline__ void moe_combine_phase(const void* xin, void* xout, const void* y, const float* g, bf16_t* hb, float* outf, int wg, int nwg, int wave_s) {
    if constexpr (Y8) moe_combine_phase_pipe<WRITE_X, HB8, XIN16, XOUT16>((const float*)xin, (float*)xout, (const unsigned char*)y, g, hb, outf, wg, nwg, wave_s);
    else moe_combine_phase_gen<WRITE_X, Y8, XIN16, XOUT16, HB8>(xin, xout, y, g, hb, outf, wg, nwg, wave_s);
}
__device__ __forceinline__ void lb_phase(const float* lbp, float* lbv, int wg, int nwg, int wave_s) {
    const int tid = opaque_tid(wave_s);
    for (int i = wg * NTHR + tid; i < 2048; i += nwg * NTHR) lbv[i] = 1.f / (1.f + __expf(lbp[i] - lbp[2048 + i]));
}
template <bool S8> struct EpiInC {
    bf16_t *qs, *vT, *sg, *lf; const float* lbv;
    static constexpr float SC = S8 ? (1.f / 256.f) : 1.f;
    __device__ __forceinline__ bool swapped(int pn) const { return pn >= 16 && pn < 24; }
    __device__ __forceinline__ int brow0(int pn) const { return pn * 256; }
    __device__ __forceinline__ void operator()(const f32x4 (&acc)[8][4], int pm, int pn, int wr, int wc, int fr, int fq) const {
        if (pn < 8 || pn >= 24) {
            bf16_t* dst = (pn < 8 ? qs : sg) + (size_t)((pn & 7) * 2) * T_ * 128;
#pragma unroll
            for (int m = 0; m < 8; ++m) { int row = pm * 256 + arow_of<8>(wr, m, fr); asm volatile("" : "+v"(row));
#pragma unroll
                for (int hf = 0; hf < 2; ++hf) { u32x4 w; const f32x4 a = acc[m][2 * hf], b = acc[m][2 * hf + 1];
                    w.x = cvt_pk_bf16(silu_fast(SC * a[0]), silu_fast(SC * a[1])); w.y = cvt_pk_bf16(silu_fast(SC * a[2]), silu_fast(SC * a[3]));
                    w.z = cvt_pk_bf16(silu_fast(SC * b[0]), silu_fast(SC * b[1])); w.w = cvt_pk_bf16(silu_fast(SC * b[2]), silu_fast(SC * b[3]));
                    *(u32x4*)(dst + ((size_t)hf * T_ + row) * 128 + wc * 32 + 8 * fq) = w; } }
        } else if (pn < 16) {
            const int cb = (pn - 8) * 256; f32x4 lb[4];
#pragma unroll
            for (int n = 0; n < 4; ++n) lb[n] = *(const f32x4*)(lbv + cb + bcol_of<4>(wc, n, fq, 0));
#pragma unroll
            for (int m = 0; m < 8; ++m) { int row = pm * 256 + arow_of<8>(wr, m, fr); asm volatile("" : "+v"(row));
#pragma unroll
                for (int hf = 0; hf < 2; ++hf) { float o[8];
#pragma unroll
                    for (int e = 0; e < 8; ++e) { const float z = acc[m][2 * hf + (e >> 2)][e & 3], l = lb[2 * hf + (e >> 2)][e & 3]; o[e] = 0.6931471805599453f * __builtin_amdgcn_logf(l + (1.f - l) * __builtin_amdgcn_rcpf(1.f + __builtin_amdgcn_exp2f((-1.4426950408889634f * SC) * z))); }
                    u32x4 w; w.x = cvt_pk_bf16(o[0], o[1]); w.y = cvt_pk_bf16(o[2], o[3]); w.z = cvt_pk_bf16(o[4], o[5]); w.w = cvt_pk_bf16(o[6], o[7]);
                    *(u32x4*)(lf + ((size_t)((pn - 8) * 2 + hf) * T_ + row) * 128 + wc * 32 + 8 * fq) = w; } }
        } else {
            bf16_t* dst = vT + ((size_t)((pn - 16) * 2) * 128 + pm * 2) * 16384;
#pragma unroll
            for (int m = 0; m < 8; ++m) { int f = arow_of<8>(wr, m, fr); asm volatile("" : "+v"(f));
#pragma unroll
                for (int hf = 0; hf < 2; ++hf) { u32x4 w; const f32x4 a = acc[m][2 * hf], b = acc[m][2 * hf + 1];
                    w.x = cvt_pk_bf16(SC * a[0], SC * a[1]); w.y = cvt_pk_bf16(SC * a[2], SC * a[3]); w.z = cvt_pk_bf16(SC * b[0], SC * b[1]); w.w = cvt_pk_bf16(SC * b[2], SC * b[3]);
                    *(u32x4*)(dst + ((size_t)(m >> 2) * 128 + hf) * 16384 + (f & 127) * 128 + wc * 32 + 8 * fq) = w; } }
        }
    }
};
__device__ __forceinline__ int bcol_to_slot2(int c) { const int c5 = c & 31; return (c & ~31) + ((c5 >> 2) & 1) * 16 + (c5 >> 3) * 4 + (c5 & 3); }
template <bool BG>
__device__ __forceinline__ void hgrn_kv_phase(LAS unsigned char* lds, const bf16_t* lf, const bf16_t* vT, float* dec, bf16_t* KVT2, const float* bw0, const float* bw1, const float* bw2, unsigned char* bgu, unsigned char* bdn, int tile0, int wg, int nwg, int wave_s) {
    typedef Core<4, 2> C;
    const int tid = opaque_tid(wave_s), wid = __builtin_amdgcn_readfirstlane(tid >> 6), lane = tid & 63, wr = wid >> 2, wc = wid & 3, fr = lane & 15, fq = lane >> 4;
    LAS unsigned char* ldsB = lds + 65536;
    LAS float* tot = (LAS float*)(lds + 131072);
    unsigned aoff[2];
#pragma unroll
    for (int i = 0; i < 2; ++i) { int r, c; C::apiece(tid, i, r, c); aoff[i] = (unsigned)(r * 128 + c) * 2u; }
    const int q4 = lane & 31, s = wid * 2 + (lane >> 5), dk0 = 4 * q4;
    for (int u = wg; u < 2048; u += nwg) {
        const int n = u >> 4, h = u & 15;
        const size_t t0 = (size_t)n * 128 + s * 8; const size_t col = (size_t)h * T_ * 128 + dk0;
        float4 bg[3][8];
        if (BG) {
#pragma unroll
            for (int b3 = 0; b3 < 3; ++b3) bg_issue(bw0, bw1, bw2, tile0 + 3 * u + b3, bg[b3], tid); }
        float l[8][4]; float sm[4] = {0.f, 0.f, 0.f, 0.f};
#pragma unroll
        for (int j = 0; j < 8; ++j) { const u32x2 w = *(const u32x2*)(lf + (t0 + j) * 128 + col); l[j][0] = bflo(w.x); l[j][1] = bfhi(w.x); l[j][2] = bflo(w.y); l[j][3] = bfhi(w.y);
#pragma unroll
            for (int d = 0; d < 4; ++d) sm[d] += l[j][d]; }
        *(LAS f32x4*)(tot + s * 128 + dk0) = (f32x4){sm[0], sm[1], sm[2], sm[3]};
        __syncthreads();
        { const char* Vb = (const char*)(vT + (size_t)(h * 128 + n) * 16384); C::stage_a(lds, Vb, aoff, 0u, wid); C::stage_a(lds + 16384, Vb, aoff, 128u, wid); }
        float pre[4] = {0.f, 0.f, 0.f, 0.f}, tt[4] = {0.f, 0.f, 0.f, 0.f};
#pragma unroll
        for (int q = 0; q < 16; ++q) { const f32x4 v = *(const LAS f32x4*)(tot + q * 128 + dk0);
#pragma unroll
            for (int d = 0; d < 4; ++d) { tt[d] += v[d]; pre[d] += (q < s) ? v[d] : 0.f; } }
        if (s == 0) *(f32x4*)(dec + (size_t)n * 2048 + col) = (f32x4){__expf(tt[0]), __expf(tt[1]), __expf(tt[2]), __expf(tt[3])};
        float kh[4][8];
#pragma unroll
        for (int j = 0; j < 8; ++j)
#pragma unroll
            for (int d = 0; d < 4; ++d) { pre[d] += l[j][d]; kh[d][j] = (1.f - __expf(l[j][d])) * __expf(tt[d] - pre[d]); }
        const int jj = s * 8;
#pragma unroll
        for (int d = 0; d < 4; ++d) { u32x4 w; w.x = cvt_pk_bf16(kh[d][0], kh[d][1]); w.y = cvt_pk_bf16(kh[d][2], kh[d][3]); w.z = cvt_pk_bf16(kh[d][4], kh[d][5]); w.w = cvt_pk_bf16(kh[d][6], kh[d][7]);
            *(LAS u32x4*)(ldsB + (jj >> 6) * 16384 + lds_byte(bcol_to_slot2(dk0 + d), jj & 63)) = w; }
        WAIT_V0(); __syncthreads();
        f32x4 acc[4][2]; C::zero(acc);
        C::compute(lds, ldsB, acc, wr, wc, fr, fq); C::compute(lds + 16384, ldsB + 16384, acc, wr, wc, fr, fq);
        __syncthreads();
        bf16_t* dst = KVT2 + (size_t)u * 16384;
#pragma unroll
        for (int m = 0; m < 4; ++m) { const f32x4 a = acc[m][0], b = acc[m][1]; u32x4 w;
            w.x = cvt_pk_bf16(a[0], a[1]); w.y = cvt_pk_bf16(a[2], a[3]); w.z = cvt_pk_bf16(b[0], b[1]); w.w = cvt_pk_bf16(b[2], b[3]);
            *(u32x4*)(dst + (wr * 64 + m * 16 + fr) * 128 + wc * 32 + 8 * fq) = w; }
        if (BG) {
#pragma unroll
            for (int b3 = 0; b3 < 3; ++b3) bg_write(lds + b3 * 18432, bg[b3], (tile0 + 3 * u + b3) >= 8192 ? 32.f : 64.f, tid);
            __syncthreads();
#pragma unroll
            for (int b3 = 0; b3 < 3; ++b3) bg_store(lds + b3 * 18432, bgu, bdn, tile0 + 3 * u + b3, tid);
            __syncthreads(); }
    }
}
__device__ __forceinline__ void hgrn_scan_phase(const bf16_t* KVT2, const float* dec, bf16_t* STb2, int wg, int nwg, int wave_s) {
    const int tid = opaque_tid(wave_s);
    for (int e = (wg * NTHR + tid) * 2; e < 262144; e += nwg * NTHR * 2) {
        const int c = (e >> 14) * 128 + (e & 127);
        float s0 = 0.f, s1 = 0.f;
        for (int n0 = 0; n0 < 128; n0 += 8) {
            unsigned kv[8]; float2 d[8];
#pragma unroll
            for (int i = 0; i < 8; ++i) { kv[i] = *(const unsigned*)(KVT2 + (size_t)(n0 + i) * 262144 + e); d[i] = *(const float2*)(dec + (size_t)(n0 + i) * 2048 + c); }
#pragma unroll
            for (int i = 0; i < 8; ++i) { *(unsigned*)(STb2 + (size_t)(n0 + i) * 262144 + e) = cvt_pk_bf16(s0, s1); s0 = d[i].x * s0 + bflo(kv[i]); s1 = d[i].y * s1 + bfhi(kv[i]); }
        }
    }
}
template <bool BG, bool MIX8 = false>
__device__ __forceinline__ void hgrn_out_phase(LAS unsigned char* lds, const bf16_t* qs, const bf16_t* lf, const bf16_t* vT, const bf16_t* STb2, const bf16_t* sg,
                                               const float* gain, bf16_t* mixb, const float* bw0, const float* bw1, const float* bw2, unsigned char* bgu, unsigned char* bdn, int tile0, int wg, int nwg, int wave_s) {
    typedef Core<4, 2> C;
    const int tid = opaque_tid(wave_s), wid = __builtin_amdgcn_readfirstlane(tid >> 6), lane = tid & 63, wr = wid >> 2, wc = wid & 3, fr = lane & 15, fq = lane >> 4;
    LAS unsigned char* lQ = lds; LAS unsigned char* lK = lds + 32768; LAS unsigned char* lS = lds + 65536; LAS unsigned char* lV = lds + 98304;
    LAS float* stat = (LAS float*)(lds + 131072);
    LAS float* tot = (LAS float*)(lds + 133120);
    unsigned soff[2], voff[2];
#pragma unroll
    for (int i = 0; i < 2; ++i) { int r, c; C::bpiece(tid, i, r, c); soff[i] = (unsigned)(r * 128 + c) * 2u; voff[i] = (unsigned)(r * 128 + c) * 2u; }
    const int q4 = lane & 31, s = wid * 2 + (lane >> 5), dk0 = 4 * q4;
    u32x2 lw[8], qw8[8];
    if (wg < 2048) { const size_t t0 = (size_t)(wg >> 4) * 128 + s * 8; const size_t col = (size_t)(wg & 15) * T_ * 128 + dk0;
#pragma unroll
        for (int j = 0; j < 8; ++j) { lw[j] = *(const u32x2*)(lf + (t0 + j) * 128 + col); qw8[j] = *(const u32x2*)(qs + (t0 + j) * 128 + col); } }
    for (int u = wg; u < 2048; u += nwg) {
        const int n = u >> 4, h = u & 15;
        const char* Sb = (const char*)(STb2 + (size_t)u * 16384); const char* Vb = (const char*)(vT + (size_t)(h * 128 + n) * 16384);
        float4 bg[3][8];
        if (BG) {
#pragma unroll
            for (int b3 = 0; b3 < 3; ++b3) bg_issue(bw0, bw1, bw2, tile0 + 3 * u + b3, bg[b3], tid); }
        {
            const size_t t0 = (size_t)n * 128 + s * 8; const int col = h * 128 + dk0;
            float l[8][4]; float sm[4] = {0.f, 0.f, 0.f, 0.f};
#pragma unroll
            for (int j = 0; j < 8; ++j) { const u32x2 w = lw[j]; l[j][0] = bflo(w.x); l[j][1] = bfhi(w.x); l[j][2] = bflo(w.y); l[j][3] = bfhi(w.y);
#pragma unroll
                for (int d = 0; d < 4; ++d) sm[d] += l[j][d]; }
            *(LAS f32x4*)(tot + s * 128 + dk0) = (f32x4){sm[0], sm[1], sm[2], sm[3]};
            __syncthreads();
#pragma unroll
            for (int t = 0; t < 2; ++t) { C::stage_b(lS + t * 16384, Sb, soff, t * 128u, wid); C::stage_b(lV + t * 16384, Vb, voff, t * 128u, wid); }
            float pre[4] = {0.f, 0.f, 0.f, 0.f};
#pragma unroll
            for (int q = 0; q < 16; ++q) { const f32x4 v = *(const LAS f32x4*)(tot + q * 128 + dk0);
#pragma unroll
                for (int d = 0; d < 4; ++d) pre[d] += (q < s) ? v[d] : 0.f; }
#pragma unroll
            for (int j = 0; j < 8; ++j) { const u32x2 qw = qw8[j];
                const float qv[4] = {bflo(qw.x), bfhi(qw.x), bflo(qw.y), bfhi(qw.y)}; float oq[4], ok[4];
#pragma unroll
                for (int d = 0; d < 4; ++d) { pre[d] += l[j][d]; oq[d] = qv[d] * __expf(pre[d]); ok[d] = (1.f - __expf(l[j][d])) * __expf(-pre[d]); }
                const int tk = s * 8 + j;
                u32x2 w; w.x = cvt_pk_bf16(oq[0], oq[1]); w.y = cvt_pk_bf16(oq[2], oq[3]); *(LAS u32x2*)(lQ + (dk0 >> 6) * 16384 + lds_byte(tk, dk0 & 63)) = w;
                w.x = cvt_pk_bf16(ok[0], ok[1]); w.y = cvt_pk_bf16(ok[2], ok[3]); *(LAS u32x2*)(lK + (dk0 >> 6) * 16384 + lds_byte(bcol_to_slot2(tk), dk0 & 63)) = w; }
        }
        WAIT_V0(); __syncthreads();
        if (u + nwg < 2048) { const int un = u + nwg; const size_t t0n = (size_t)(un >> 4) * 128 + s * 8; const size_t coln = (size_t)(un & 15) * T_ * 128 + dk0;
#pragma unroll
            for (int j = 0; j < 8; ++j) { lw[j] = *(const u32x2*)(lf + (t0n + j) * 128 + coln); qw8[j] = *(const u32x2*)(qs + (t0n + j) * 128 + coln); } }
        {
            f32x4 sa[4][2]; C::zero(sa);
            C::compute(lQ, lK, sa, wr, wc, fr, fq); C::compute(lQ + 16384, lK + 16384, sa, wr, wc, fr, fq);
            __syncthreads();
#pragma unroll
            for (int m = 0; m < 4; ++m) { const int i = wr * 64 + m * 16 + fr; const int j0 = wc * 32 + 8 * fq;
                float p[8];
#pragma unroll
                for (int e = 0; e < 8; ++e) { const float sv = e < 4 ? sa[m][0][e] : sa[m][1][e - 4]; p[e] = (j0 + e <= i) ? sv : 0.f; }
                u32x4 w; w.x = cvt_pk_bf16(p[0], p[1]); w.y = cvt_pk_bf16(p[2], p[3]); w.z = cvt_pk_bf16(p[4], p[5]); w.w = cvt_pk_bf16(p[6], p[7]);
                *(LAS u32x4*)(lK + (wc >> 1) * 16384 + lds_byte(i, j0 & 63)) = w; }
            __syncthreads();
        }
        f32x4 acc[4][2]; C::zero(acc);
        C::compute(lQ, lS, acc, wr, wc, fr, fq); C::compute(lQ + 16384, lS + 16384, acc, wr, wc, fr, fq);
        C::compute(lK, lV, acc, wr, wc, fr, fq); C::compute(lK + 16384, lV + 16384, acc, wr, wc, fr, fq);
#pragma unroll
        for (int m = 0; m < 4; ++m) { float ss = 0.f;
#pragma unroll
            for (int nn = 0; nn < 2; ++nn)
#pragma unroll
                for (int e = 0; e < 4; ++e) { const float v = acc[m][nn][e]; ss += v * v; }
            ss += __shfl_xor(ss, 16); ss += __shfl_xor(ss, 32);
            if (fq == 0) stat[(wr * 64 + m * 16 + fr) * 4 + wc] = ss; }
        __syncthreads();
        u32x4 g8v[4]; f32x4 gn0, gn1;
        { const int c0 = h * 128 + wc * 32 + 8 * fq; gn0 = *(const f32x4*)(gain + c0); gn1 = *(const f32x4*)(gain + c0 + 4);
#pragma unroll
          for (int m = 0; m < 4; ++m) g8v[m] = *(const u32x4*)(sg + ((size_t)h * T_ + (size_t)n * 128 + wr * 64 + m * 16 + fr) * 128 + wc * 32 + 8 * fq); }
        asm volatile("" ::: "memory");
#pragma unroll
        for (int m = 0; m < 4; ++m) { const int i = wr * 64 + m * 16 + fr;
            const float ss = stat[i * 4] + stat[i * 4 + 1] + stat[i * 4 + 2] + stat[i * 4 + 3];
            const float rstd = rsqrtf(ss * (1.f / 128.f) + 1e-6f);
            const size_t t = (size_t)n * 128 + i; const int c0 = h * 128 + wc * 32 + 8 * fq;
            const u32x4 g8 = g8v[m];
            const f32x4 g0 = gn0, g1 = gn1;
            const f32x4 a = acc[m][0], b = acc[m][1];
            u32x4 w; w.x = cvt_pk_bf16(a[0] * rstd * g0[0] * bflo(g8.x), a[1] * rstd * g0[1] * bfhi(g8.x)); w.y = cvt_pk_bf16(a[2] * rstd * g0[2] * bflo(g8.y), a[3] * rstd * g0[3] * bfhi(g8.y));
            w.z = cvt_pk_bf16(b[0] * rstd * g1[0] * bflo(g8.z), b[1] * rstd * g1[1] * bfhi(g8.z)); w.w = cvt_pk_bf16(b[2] * rstd * g1[2] * bflo(g8.w), b[3] * rstd * g1[3] * bfhi(g8.w));
            if (MIX8) { float o8[8] = {a[0] * rstd * g0[0] * bflo(g8.x), a[1] * rstd * g0[1] * bfhi(g8.x), a[2] * rstd * g0[2] * bflo(g8.y), a[3] * rstd * g0[3] * bfhi(g8.y),
                                       b[0] * rstd * g1[0] * bflo(g8.z), b[1] * rstd * g1[1] * bfhi(g8.z), b[2] * rstd * g1[2] * bflo(g8.w), b[3] * rstd * g1[3] * bfhi(g8.w)};
#pragma unroll
                for (int e = 0; e < 8; ++e) o8[e] = __builtin_amdgcn_fmed3f(8.f * o8[e], -448.f, 448.f);
                u32x2 w8; w8.x = pk4_fp8(o8[0], o8[1], o8[2], o8[3]); w8.y = pk4_fp8(o8[4], o8[5], o8[6], o8[7]);
                *(u32x2*)((unsigned char*)mixb + t * 2048 + c0) = w8; }
            else *(u32x4*)(mixb + t * 2048 + c0) = w; }
        __syncthreads();
        if (BG) {
#pragma unroll
            for (int b3 = 0; b3 < 3; ++b3) bg_write(lds + b3 * 18432, bg[b3], (tile0 + 3 * u + b3) >= 8192 ? 32.f : 64.f, tid);
            __syncthreads();
#pragma unroll
            for (int b3 = 0; b3 < 3; ++b3) bg_store(lds + b3 * 18432, bgu, bdn, tile0 + 3 * u + b3, tid);
            __syncthreads(); }
    }
}
#define LDS_BYTES 147456
#define MiB(x) ((size_t)(x) << 20)
#define WS_CTL     ((size_t)0)
#define CTL_BYTES  65536
#define CTL_CNT    1024
#define CTL_BAR    4096
#define WS_X1      MiB(1)
#define WS_HB      MiB(129)
#define WS_ROPE    MiB(193)
#define WS_WSM     MiB(225)
#define WS_WR      MiB(226)
#define WS_WINAB   MiB(228)
#define WS_WOUTAB  MiB(252)
#define WS_WINC    MiB(260)
#define WS_WOUTC   MiB(292)
#define WS_WGU     MiB(300)
#define WS_WDN     MiB(812)
#define WS_SCR     MiB(1068)
#define WS_QB      (WS_SCR)
#define WS_KVT     (WS_SCR + MiB(224))
#define WS_STB     (WS_SCR + MiB(352))
#define WS_MIXB    (WS_SCR + MiB(416))
#define WS_VNT     (WS_SCR + MiB(480))
#define WS_HID     (WS_SCR)
#define WS_Y       (WS_SCR + MiB(80))
#define WS_LIST    (WS_SCR + MiB(208))
#define WS_GATE    (WS_SCR + MiB(212))
struct FArgs { const float* in[21]; float* out; unsigned char* ws; int ph_lo, ph_hi; };
#define WS1_QS     (WS_SCR)
#define WS1_VT     (WS_SCR + MiB(64))
#define WS1_SG     (WS_SCR + MiB(128))
#define WS1_LF     (WS_SCR + MiB(192))
#define WS1_QH     (WS_SCR + MiB(320))
#define WS1_KT     (WS_SCR + MiB(480))
#define WS1_KVT    (WS_SCR + MiB(544))
#define WS1_STB    (WS_SCR + MiB(672))
#define WS1_DEC    (WS_SCR + MiB(736))
#define WS_Y0      (WS_SCR + MiB(740))
#define WS_LBV     (WS_WR + MiB(1))
#define N_PHASES 20
#ifndef FP8_L0
#define FP8_L0 1
#endif
#ifndef FP8_L1
#define FP8_L1 1
#endif
#ifndef BGCONV_L1
#define BGCONV_L1 0
#endif
#ifndef F8_INC
#define F8_INC 1
#endif
#ifndef F8_INAB
#define F8_INAB 0
#endif
#ifndef BG_T2
#define BG_T2 18432
#endif
#ifndef NCONV2
#define NCONV2 85
#endif
#ifndef BG_T11
#define BG_T11 6144
#endif
#ifndef NCONV11
#define NCONV11 51
#endif
static_assert(BG_T11 == 0 || BG_T2 >= 12288, "layer-0 tiles must be converted before P8");
static_assert(BG_T2 + BG_T11 <= 24576, "tile ranges");
#ifndef F8_OUTC
#define F8_OUTC 1
#endif
#ifndef XB16
#define XB16 1
#endif
#ifndef Y8_L0
#define Y8_L0 1
#endif
#ifndef Y8_L1
#define Y8_L1 1
#endif
__global__ void __launch_bounds__(NTHR, 2) fwd(FArgs a) {
    extern __shared__ __attribute__((aligned(16))) unsigned char lds_raw[];
    LAS unsigned char* lds = (LAS unsigned char*)lds_raw;
    const int lo = a.ph_lo, hi = a.ph_hi;
    const int wave_s = __builtin_amdgcn_readfirstlane(threadIdx.x >> 6);
    const int wg = blockIdx.x, nwg = gridDim.x;
    if (threadIdx.x == 0) *(LAS u32x4*)(lds + LDS_BYTES - 16) = (u32x4){0u, 0u, 0u, 0u};
    __syncthreads();
    XcdBarrier bar; bar.bar = (unsigned*)(a.ws + WS_CTL + CTL_BAR); bar.x = 0; bar.st = (volatile LAS unsigned*)(lds + LDS_BYTES - 16);
    if (hi - lo > 1) bar = xcd_barrier_post((unsigned*)(a.ws + WS_CTL + CTL_BAR), (volatile LAS unsigned*)(lds + LDS_BYTES - 16));
#define GRID_BAR() xcd_barrier(bar)
#define IN(k) (lo <= (k) && (k) < hi)
#define BOTH(k) (IN(k) && IN((k) + 1))
#ifndef DUP_MASK
#define DUP_MASK 0
#endif
#define DUP(k) ((DUP_MASK >> (k)) & 1)
#define PH(k, ...) if (IN(k)) { __VA_ARGS__ if (DUP(k)) { GRID_BAR(); __VA_ARGS__ } if (BOTH(k)) GRID_BAR(); }
    unsigned char* ws = a.ws;
    float* x1 = (float*)(ws + WS_X1); bf16_t* xb = (bf16_t*)(ws + WS1_QH);     bf16_t* hb = (bf16_t*)(ws + WS_HB);
    bf16_t* WsM = (bf16_t*)(ws + WS_WSM); bf16_t* WrT = (bf16_t*)(ws + WS_WR); float* lbv = (float*)(ws + WS_LBV);
    bf16_t* winab = (bf16_t*)(ws + WS_WINAB); bf16_t* woutab = (bf16_t*)(ws + WS_WOUTAB); bf16_t* winc = (bf16_t*)(ws + WS_WINC); bf16_t* woutc = (bf16_t*)(ws + WS_WOUTC);
    bf16_t* wgu = (bf16_t*)(ws + WS_WGU); bf16_t* wdn = (bf16_t*)(ws + WS_WDN);
    bf16_t* qb = (bf16_t*)(ws + WS_QB); bf16_t* KVT = (bf16_t*)(ws + WS_KVT); bf16_t* STb = (bf16_t*)(ws + WS_STB); bf16_t* mixb = (bf16_t*)(ws + WS_MIXB); bf16_t* vnT = (bf16_t*)(ws + WS_VNT);
    unsigned char* hb8 = ws + WS_ROPE;
    bf16_t* hid = (bf16_t*)(ws + WS_HID); bf16_t* yb = (bf16_t*)(ws + WS_Y); bf16_t* yb0 = (bf16_t*)(ws + WS_Y0); int* list = (int*)(ws + WS_LIST); float* gate = (float*)(ws + WS_GATE);
    int* cnt = (int*)(ws + WS_CTL + CTL_CNT);
    const size_t TS = (size_t)T_ * 1024; const size_t WGU_L = (size_t)32 * 2048 * 2048, WDN_L = (size_t)32 * 2048 * 1024;
    PH(0, {
        { ConvJob J{a.in[4], winab, 2048, 6144, 1, 6144, 6144, 6144, 0, 0}; if (F8_INAB) conv8_phase(lds, J, 64.f, wg, nwg, wave_s); else conv_phase(lds, J, wg, nwg, wave_s); }
        { ConvJob J{a.in[9], woutab, 2048, 2048, 1, 2048, 2048, 2048, 0, 0}; conv_phase(lds, J, wg, nwg, wave_s); }
        { ConvJob J{a.in[10], winc, 2048, 8192, 1, 8192, 8192, 8192, 0, 0}; if (F8_INC) conv8_phase(lds, J, 64.f, wg, nwg, wave_s); else conv_phase(lds, J, wg, nwg, wave_s); }
        { ConvJob J{a.in[13], woutc, 2048, 2048, 1, 2048, 2048, 2048, 0, 0}; if (F8_OUTC) conv8_phase(lds, J, 64.f, wg, nwg, wave_s); else conv_phase(lds, J, wg, nwg, wave_s); }
        if (FP8_L0 && FP8_L1 && !BGCONV_L1) { if (BG_T2 + BG_T11 < 24576) conv_stream(lds, a.in[18], a.in[19], a.in[20], (unsigned char*)wgu, (unsigned char*)wdn, BG_T2 + BG_T11, 24576, wg, nwg, wave_s); }
        else for (int L = 0; L < 2; ++L) {
            const bool f8 = L ? (FP8_L1 != 0) : (FP8_L0 != 0);
            if (L == 1 && BGCONV_L1 && FP8_L1) continue;
            const float* sg_ = a.in[18] + (size_t)L * 32 * 2048 * 1024; const float* su_ = a.in[19] + (size_t)L * 32 * 2048 * 1024; const float* sd_ = a.in[20] + (size_t)L * 32 * 2048 * 1024;
            ConvJob Jg{sg_, wgu + L * WGU_L, 2048, 1024, 32, 2048, 128, 256, 0, 0}, Ju{su_, wgu + L * WGU_L, 2048, 1024, 32, 2048, 128, 256, 128, 0}, Jd{sd_, wdn + L * WDN_L, 1024, 2048, 32, 2048, 2048, 2048, 0, 0};
            if (f8) { conv8_phase(lds, Jg, 64.f, wg, nwg, wave_s); conv8_phase(lds, Ju, 64.f, wg, nwg, wave_s); conv8_phase(lds, Jd, 32.f, wg, nwg, wave_s); }
            else { conv_phase(lds, Jg, wg, nwg, wave_s); conv_phase(lds, Ju, wg, nwg, wave_s); conv_phase(lds, Jd, wg, nwg, wave_s); }
        }
        wr_phase(a.in[14], a.in[16], WrT, wg, nwg, wave_s);
        wr_phase(a.in[14] + 2048 * 4, a.in[16] + 2048 * 32, WrT + 64 * 2048, wg, nwg, wave_s);
        wsm_phase(a.in[7], WsM, wg, nwg, wave_s);
        lb_phase(a.in[11], lbv, wg, nwg, wave_s);
        norm_rows_bf16<F8_INAB != 0>(a.in[0], a.in[1], hb, wg, nwg, wave_s);
    })

    PH(2, { const bool split = FP8_L0 && FP8_L1 && !BGCONV_L1 && BG_T2 > 0 && nwg > 2 * NCONV2; const int ng = split ? nwg - NCONV2 : nwg;
            if (wg < ng) { EpiInAB<F8_INAB != 0> E{qb, qb + TS, qb + 3 * TS, qb + 4 * TS, qb + 5 * TS, qb + 6 * TS};
                if (F8_INAB) gemm_phase_f8(lds, (const unsigned char*)hb, (const unsigned char*)winab, 64, 24, 2048, E, wave_s, wg, ng); else gemm_phase(lds, hb, winab, 64, 24, 2048, E, wave_s, wg, ng); }
            else conv_stream(lds, a.in[18], a.in[19], a.in[20], (unsigned char*)wgu, (unsigned char*)wdn, 0, BG_T2, wg - ng, nwg - ng, wave_s); })
    PH(3, { gmlp_norm_phase(lds, qb + 6 * TS, vnT, a.in[6], wg, nwg, wave_s); ret_kv_phase(lds, qb + 3 * TS, qb + TS, KVT, wg, nwg, wave_s); })
    PH(4, { ret_scan_phase(KVT, STb, wg, nwg, wave_s); })
    PH(5, { ret_out_phase(lds, qb, qb + TS, qb + 3 * TS, STb, qb + 4 * TS, a.in[5], mixb, wg, nwg, wave_s);
                 gmlp_mix_phase(lds, WsM, vnT, qb + 5 * TS, a.in[8], mixb, wg, nwg, wave_s); })
    PH(6, { if (XB16) { EpiResidualT<true> E{a.in[0], (float*)xb}; gemm_phase(lds, mixb, woutab, 64, 8, 2048, E, wave_s); } else { EpiResidual E{a.in[0], x1}; gemm_phase(lds, mixb, woutab, 64, 8, 2048, E, wave_s); } })
    PH(7, { moe_route_phase<XB16 != 0>(lds, XB16 ? (const void*)xb : (const void*)x1, a.in[2], hb, FP8_L0 ? hb8 : nullptr, WrT, a.in[15], a.in[17], cnt, list, gate, wg, nwg, wave_s); })
    PH(8, { moe_gu_phase<FP8_L0 != 0>(lds, FP8_L0 ? (const void*)hb8 : (const void*)hb, wgu, cnt, list, hid, wg, nwg, wave_s); })
    PH(9, { moe_down_phase<FP8_L0 != 0, Y8_L0 != 0>(lds, hid, wdn, cnt, list, gate, yb, wg, nwg, wave_s); })
    PH(10, { moe_combine_phase<true, Y8_L0 != 0, XB16 != 0, XB16 != 0, F8_INC != 0>(XB16 ? (const void*)xb : (const void*)x1, XB16 ? (void*)xb : (void*)x1, yb, a.in[1] + D_, hb, nullptr, wg, nwg, wave_s); })
    bf16_t* qs = (bf16_t*)(ws + WS1_QS); bf16_t* vT1 = (bf16_t*)(ws + WS1_VT); bf16_t* sg1 = (bf16_t*)(ws + WS1_SG); bf16_t* lf = (bf16_t*)(ws + WS1_LF);
    bf16_t* qh = (bf16_t*)(ws + WS1_QH); bf16_t* kt = (bf16_t*)(ws + WS1_KT); bf16_t* KVT2 = (bf16_t*)(ws + WS1_KVT); bf16_t* STb2 = (bf16_t*)(ws + WS1_STB); float* dec = (float*)(ws + WS1_DEC);
    PH(11, { const bool split = FP8_L0 && FP8_L1 && !BGCONV_L1 && BG_T11 > 0 && nwg > 2 * NCONV11; const int ng = split ? nwg - NCONV11 : nwg;
            if (wg < ng) { EpiInC<F8_INC != 0> E{qs, vT1, sg1, lf, lbv};
                if (F8_INC) gemm_phase_f8(lds, (const unsigned char*)hb, (const unsigned char*)winc, 64, 32, 2048, E, wave_s, wg, ng); else gemm_phase(lds, hb, winc, 64, 32, 2048, E, wave_s, wg, ng); }
            else conv_stream(lds, a.in[18], a.in[19], a.in[20], (unsigned char*)wgu, (unsigned char*)wdn, BG_T2, BG_T2 + BG_T11, wg - ng, nwg - ng, wave_s); })
    PH(12, { hgrn_kv_phase<(BGCONV_L1 && FP8_L1)>(lds, lf, vT1, dec, KVT2, a.in[18] + (size_t)32 * 2048 * 1024, a.in[19] + (size_t)32 * 2048 * 1024, a.in[20] + (size_t)32 * 2048 * 1024, (unsigned char*)(wgu + WGU_L), (unsigned char*)(wdn + WDN_L), 0, wg, nwg, wave_s); })
    PH(13, { hgrn_scan_phase(KVT2, dec, STb2, wg, nwg, wave_s); })
    PH(14, { hgrn_out_phase<(BGCONV_L1 && FP8_L1), (F8_OUTC != 0)>(lds, qs, lf, vT1, STb2, sg1, a.in[12], mixb, a.in[18] + (size_t)32 * 2048 * 1024, a.in[19] + (size_t)32 * 2048 * 1024, a.in[20] + (size_t)32 * 2048 * 1024, (unsigned char*)(wgu + WGU_L), (unsigned char*)(wdn + WDN_L), 6144, wg, nwg, wave_s); })
    PH(15, { if (XB16) { EpiResidual16 E{xb, F8_OUTC ? (1.f / 512.f) : 1.f}; if (F8_OUTC) gemm_phase_f8(lds, (const unsigned char*)mixb, (const unsigned char*)woutc, 64, 8, 2048, E, wave_s); else gemm_phase(lds, mixb, woutc, 64, 8, 2048, E, wave_s); } else { EpiResidual E{x1, x1, F8_OUTC ? (1.f / 512.f) : 1.f}; if (F8_OUTC) gemm_phase_f8(lds, (const unsigned char*)mixb, (const unsigned char*)woutc, 64, 8, 2048, E, wave_s); else gemm_phase(lds, mixb, woutc, 64, 8, 2048, E, wave_s); } })
    PH(16, { moe_route_phase<XB16 != 0>(lds, XB16 ? (const void*)xb : (const void*)x1, a.in[2] + D_, hb, FP8_L1 ? hb8 : nullptr, WrT + 64 * 2048, a.in[15] + 4, a.in[17] + 32, cnt + 32, list, gate, wg, nwg, wave_s); })
    PH(17, { moe_gu_phase<FP8_L1 != 0>(lds, FP8_L1 ? (const void*)hb8 : (const void*)hb, wgu + WGU_L, cnt + 32, list, hid, wg, nwg, wave_s); })
    PH(18, { moe_down_phase<FP8_L1 != 0, Y8_L1 != 0>(lds, hid, wdn + WDN_L, cnt + 32, list, gate, yb, wg, nwg, wave_s); })
    PH(19, { moe_combine_phase<true, Y8_L1 != 0, XB16 != 0, false>(XB16 ? (const void*)xb : (const void*)x1, nullptr, yb, a.in[3], nullptr, a.out, wg, nwg, wave_s); })
#undef IN
#undef BOTH
#undef GRID_BAR
}
#ifndef N_LAUNCH_PER_PHASE
#define N_LAUNCH_PER_PHASE 0
#endif
extern "C" void kernel_launch(void* const* d_in, const int* in_sizes, int n_in, void* d_out, int out_size, void* d_ws, size_t ws_size, hipStream_t stream) {
    static int grid = 0;
    if (!grid) {
        int dev = 0, cus = 0, per_cu = 0;
        (void)hipGetDevice(&dev); (void)hipDeviceGetAttribute(&cus, hipDeviceAttributeMultiprocessorCount, dev);
        (void)hipFuncSetAttribute((const void*)fwd, hipFuncAttributeMaxDynamicSharedMemorySize, LDS_BYTES);
        if (hipOccupancyMaxActiveBlocksPerMultiprocessor(&per_cu, (const void*)fwd, NTHR, LDS_BYTES) != hipSuccess || per_cu < 1) per_cu = 1;
        (void)hipGetLastError();
        grid = cus > 0 ? cus : 256;
    }
    FArgs fa{}; for (int i = 0; i < 21; ++i) fa.in[i] = (const float*)d_in[i];
    fa.out = (float*)d_out; fa.ws = (unsigned char*)d_ws;
    (void)hipMemsetAsync((char*)d_ws + WS_CTL, 0, CTL_BYTES, stream);
#if N_LAUNCH_PER_PHASE
    for (int p = 0; p < N_PHASES; ++p) { fa.ph_lo = p; fa.ph_hi = p + 1; hipLaunchKernelGGL(fwd, dim3(grid), dim3(NTHR), LDS_BYTES, stream, fa); }
#else
    fa.ph_lo = 0; fa.ph_hi = N_PHASES; hipLaunchKernelGGL(fwd, dim3(grid), dim3(NTHR), LDS_BYTES, stream, fa);
#endif
}
```

```cpp
#include <hip/hip_runtime.h>
#include <stdint.h>
#define T_ 16384
#define D_ 2048
__device__ __forceinline__ float wave_sum(float v) {
#pragma unroll
    for (int o = 32; o > 0; o >>= 1) v += __shfl_xor(v, o);
    return v;
}
typedef unsigned short bf16_t;
typedef short bf16x8 __attribute__((ext_vector_type(8)));
typedef float f32x4 __attribute__((ext_vector_type(4)));
typedef unsigned u32x4 __attribute__((ext_vector_type(4)));
typedef unsigned u32x2 __attribute__((ext_vector_type(2)));
#define LAS __attribute__((address_space(3)))
#define NTHR 512

__device__ __forceinline__ unsigned cvt_pk_bf16(float lo, float hi) { unsigned r; asm volatile("v_cvt_pk_bf16_f32 %0, %1, %2" : "=v"(r) : "v"(lo), "v"(hi)); return r; }
__device__ __forceinline__ float bf2f(bf16_t b) { return __uint_as_float(((unsigned)b) << 16); }
__device__ __forceinline__ float bflo(unsigned w) { return __uint_as_float(w << 16); }
__device__ __forceinline__ float bfhi(unsigned w) { return __uint_as_float(w & 0xffff0000u); }

__device__ __forceinline__ int lds_byte(int r, int c) { const int st = (r >> 4) * 2 + (c >> 5), ob = (r & 15) * 64 + (c & 31) * 2; return st * 1024 + (ob ^ (((ob >> 9) & 1) << 5)); }
__device__ __forceinline__ void stage_rc(int b, int& R, int& C) { const int st = b >> 10, sb = b & 1023, swz = sb ^ (((sb >> 9) & 1) << 5); R = (st >> 1) * 16 + swz / 64; C = (st & 1) * 32 + (swz % 64) / 2; }

#define WAIT_V0() asm volatile("s_waitcnt vmcnt(0)" ::: "memory")
__device__ __forceinline__ int opaque_tid(int wave_s) { int l; asm volatile("v_mbcnt_lo_u32_b32 %0, -1, 0\n\tv_mbcnt_hi_u32_b32 %0, -1, %0" : "=v"(l)); return wave_s * 64 + l; }

template <int MF> __device__ __forceinline__ int arow_of(int wr, int m, int fr) { if (MF == 8) return (m >> 2) * 128 + wr * 64 + (m & 3) * 16 + fr; return wr * (MF * 16) + m * 16 + fr; }
template <int NF> __device__ __forceinline__ int bcol_of(int wc, int n, int fq, int j) {
    if (NF == 4) return (n >> 1) * 128 + wc * 32 + 8 * fq + 4 * (n & 1) + j;
    if (NF == 2) return wc * 32 + 8 * fq + 4 * n + j;
    return wc * 16 + 4 * fq + j; }
template <int MF> __device__ __forceinline__ int aslot_to_row(int s) { const int wr = s / (MF * 16), m = (s >> 4) % MF, fr = s & 15; return arow_of<MF>(wr, m, fr); }
template <int NF> __device__ __forceinline__ int bslot_to_col(int s) { const int wc = s / (NF * 16), n = (s >> 4) % NF, i = s & 15; return bcol_of<NF>(wc, n, i >> 2, i & 3); }

template <int MF, int NF> struct Core {
    static constexpr int BM = 32 * MF, BN = 64 * NF;
    static constexpr int GA = BM / 64, GB = BN / 64;
    static constexpr int TA = BM * 128, TB = BN * 128;
    static __device__ __forceinline__ void apiece(int tid, int i, int& row, int& c) { int R, C; stage_rc((tid >> 6) * 1024 + i * 8192 + (tid & 63) * 16, R, C); row = aslot_to_row<MF>(R); c = C; }
    static __device__ __forceinline__ void bpiece(int tid, int i, int& col, int& c) { int R, C; stage_rc((tid >> 6) * 1024 + i * 8192 + (tid & 63) * 16, R, C); col = bslot_to_col<NF>(R); c = C; }
    static __device__ __forceinline__ void zero(f32x4 (&acc)[MF][NF]) {
#pragma unroll
        for (int m = 0; m < MF; ++m)
#pragma unroll
            for (int n = 0; n < NF; ++n) acc[m][n] = (f32x4){0.f, 0.f, 0.f, 0.f}; }
    static __device__ __forceinline__ void compute(LAS unsigned char* la, LAS unsigned char* lb, f32x4 (&acc)[MF][NF], int wr, int wc, int fr, int fq) {
        const int ao = lds_byte(wr * MF * 16 + fr, fq * 8), bo = lds_byte(wc * NF * 16 + fr, fq * 8);
#pragma unroll
        for (int ks = 0; ks < 2; ++ks) {
            bf16x8 At[MF], Bf[NF];
#pragma unroll
            for (int m = 0; m < MF; ++m) At[m] = *(const LAS bf16x8*)(la + ao + m * 2048 + ks * 1024);
#pragma unroll
            for (int n = 0; n < NF; ++n) Bf[n] = *(const LAS bf16x8*)(lb + bo + n * 2048 + ks * 1024);
#pragma unroll
            for (int m = 0; m < MF; ++m)
#pragma unroll
                for (int n = 0; n < NF; ++n) acc[m][n] = __builtin_amdgcn_mfma_f32_16x16x32_bf16(Bf[n], At[m], acc[m][n], 0, 0, 0);
            __builtin_amdgcn_sched_barrier(0);
        }
    }
    static __device__ __forceinline__ void stage_a(LAS unsigned char* dst, const char* base, const unsigned (&off)[GA], unsigned kbyte, int wid) {
        const __amdgpu_buffer_rsrc_t r = __builtin_amdgcn_make_buffer_rsrc((void*)base, 0, 0x7ffffff0, 0x00020000);
#pragma unroll
        for (int i = 0; i < GA; ++i) __builtin_amdgcn_raw_ptr_buffer_load_lds(r, (LAS void*)(dst + wid * 1024 + i * 8192), 16, (int)off[i], (int)kbyte, 0, 0); }
    static __device__ __forceinline__ void stage_b(LAS unsigned char* dst, const char* base, const unsigned (&off)[GB], unsigned kbyte, int wid) {
        const __amdgpu_buffer_rsrc_t r = __builtin_amdgcn_make_buffer_rsrc((void*)base, 0, 0x7ffffff0, 0x00020000);
#pragma unroll
        for (int i = 0; i < GB; ++i) __builtin_amdgcn_raw_ptr_buffer_load_lds(r, (LAS void*)(dst + wid * 1024 + i * 8192), 16, (int)off[i], (int)kbyte, 0, 0); }
    static __device__ __forceinline__ void loop_gg(LAS unsigned char* lds, const char* Ab, const unsigned (&aoff)[GA], const char* Bb, const unsigned (&boff)[GB], int nt,
                                                   f32x4 (&acc)[MF][NF], int wid, int wr, int wc, int fr, int fq) {
        constexpr int STG = TA + TB;
        stage_a(lds, Ab, aoff, 0, wid); stage_b(lds + TA, Bb, boff, 0, wid);
        WAIT_V0(); __syncthreads();
        for (int t = 0; t < nt; ++t) {
            const int cur = t & 1;
            if (t + 1 < nt) { stage_a(lds + (cur ^ 1) * STG, Ab, aoff, (unsigned)(t + 1) * 128u, wid); stage_b(lds + (cur ^ 1) * STG + TA, Bb, boff, (unsigned)(t + 1) * 128u, wid); }
            compute(lds + cur * STG, lds + cur * STG + TA, acc, wr, wc, fr, fq);
            WAIT_V0(); __syncthreads();
        }
    }
    static __device__ __forceinline__ void burst_gg(LAS unsigned char* la, LAS unsigned char* lb, const char* Ab, const unsigned (&aoff)[GA], const char* Bb, const unsigned (&boff)[GB], int nt,
                                                    f32x4 (&acc)[MF][NF], int wid, int wr, int wc, int fr, int fq) {
        for (int t = 0; t < nt; ++t) { stage_a(la + t * TA, Ab, aoff, (unsigned)t * 128u, wid); stage_b(lb + t * TB, Bb, boff, (unsigned)t * 128u, wid); }
        WAIT_V0(); __syncthreads();
        for (int t = 0; t < nt; ++t) compute(la + t * TA, lb + t * TB, acc, wr, wc, fr, fq);
    }
    static __device__ __forceinline__ void loop_lg(LAS unsigned char* la, LAS unsigned char* lb, const char* Bb, const unsigned (&boff)[GB], int nt,
                                                   f32x4 (&acc)[MF][NF], int wid, int wr, int wc, int fr, int fq) {
        stage_b(lb, Bb, boff, 0, wid);
        WAIT_V0(); __syncthreads();
        for (int t = 0; t < nt; ++t) {
            const int cur = t & 1;
            if (t + 1 < nt) stage_b(lb + (cur ^ 1) * TB, Bb, boff, (unsigned)(t + 1) * 128u, wid);
            compute(la + t * TA, lb + cur * TB, acc, wr, wc, fr, fq);
            WAIT_V0(); __syncthreads();
        }
    }
    static __device__ __forceinline__ void loop_gl(LAS unsigned char* la, const char* Ab, const unsigned (&aoff)[GA], LAS unsigned char* lb, int nt,
                                                   f32x4 (&acc)[MF][NF], int wid, int wr, int wc, int fr, int fq) {
        stage_a(la, Ab, aoff, 0, wid);
        WAIT_V0(); __syncthreads();
        for (int t = 0; t < nt; ++t) {
            const int cur = t & 1;
            if (t + 1 < nt) stage_a(la + (cur ^ 1) * TA, Ab, aoff, (unsigned)(t + 1) * 128u, wid);
            compute(la + cur * TA, lb + t * TB, acc, wr, wc, fr, fq);
            WAIT_V0(); __syncthreads();
        }
    }
};
#define XB_TMO      128
#define XB_XCNT(j)  (256  + 64 * (j))
#define XB_XSUB(j)  (1280 + 64 * (j))
#define XB_XGEN(j)  (2304 + 64 * (j))
#define XB_TOP      3328
#define XB_TOPGEN   3392
#define XCD_BAR_WORDS 3456
#define XB_SPIN_CAP (1u << 18)
#define LAS __attribute__((address_space(3)))

__device__ __forceinline__ unsigned xb_ld(unsigned* p)              { return __hip_atomic_load(p, __ATOMIC_RELAXED, __HIP_MEMORY_SCOPE_AGENT); }
__device__ __forceinline__ unsigned xb_add(unsigned* p, unsigned v) { return __hip_atomic_fetch_add(p, v, __ATOMIC_RELAXED, __HIP_MEMORY_SCOPE_AGENT); }
__device__ __forceinline__ unsigned xb_xcc_id() { return (unsigned)__builtin_amdgcn_s_getreg((3 << 11) | 20) & 0xFu; }
#define XB_SPIN(cond, bar) do { unsigned _sp = 0; while (cond) { __builtin_amdgcn_s_sleep(1); \
    if ((++_sp & 255u) == 0u) { if (xb_ld(&(bar)[XB_TMO])) break; if (_sp > XB_SPIN_CAP) { atomicAdd(&(bar)[XB_TMO], 1u); break; } } } } while (0)

struct XcdBarrier {
    unsigned* bar; unsigned x;
    volatile LAS unsigned* st;
};

__device__ __forceinline__ XcdBarrier xcd_barrier_post(unsigned* bar, volatile LAS unsigned* st) {
    XcdBarrier b; b.bar = bar; b.x = xb_xcc_id(); b.st = st;
    if (threadIdx.x == 0) (void)xb_add(&bar[XB_XCNT(b.x)], 1u);
    return b;
}
__device__ __forceinline__ void xcd_barrier_complete(unsigned* bar, unsigned x, unsigned& nloc, unsigned& nx) {
    const unsigned G = gridDim.x * gridDim.y * gridDim.z;
    unsigned sum, cnt, mine, sp = 0u;
    for (;;) {
        sum = 0u; cnt = 0u; mine = 0u;
#pragma unroll
        for (unsigned j = 0; j < 16; ++j) { const unsigned c = xb_ld(&bar[XB_XCNT(j)]); sum += c; cnt += (c > 0u) ? 1u : 0u; mine = (j == x) ? c : mine; }
        if (sum == G) break;
        __builtin_amdgcn_s_sleep(1);
        if ((++sp & 255u) == 0u) { if (xb_ld(&bar[XB_TMO])) break; if (sp > XB_SPIN_CAP) { atomicAdd(&bar[XB_TMO], 1u); break; } }
    }
    nloc = mine > 0u ? mine : 1u; nx = cnt > 0u ? cnt : 1u;
}

__device__ __forceinline__ void xcd_barrier(const XcdBarrier& b) {
    asm volatile("s_waitcnt vmcnt(0)" ::: "memory");
    __syncthreads();
    if (threadIdx.x == 0) {
        unsigned* bar = b.bar;
        __builtin_amdgcn_s_waitcnt(0);
        unsigned nloc = b.st[0], nx = b.st[1];
        if (nloc == 0u) { xcd_barrier_complete(bar, b.x, nloc, nx); b.st[0] = nloc; b.st[1] = nx; }
        const unsigned old = xb_add(&bar[XB_XSUB(b.x)], 1u);
        const unsigned gen = old / nloc;
        if (old + 1u == (gen + 1u) * nloc) {
            __builtin_amdgcn_fence(__ATOMIC_RELEASE, "agent");
            asm volatile("s_waitcnt vmcnt(0)" ::: "memory");
            const unsigned og = xb_add(&bar[XB_TOP], 1u);
            const unsigned tg = og / nx;
            if (og + 1u == (tg + 1u) * nx) xb_add(&bar[XB_TOPGEN], 1u);
            else XB_SPIN(xb_ld(&bar[XB_TOPGEN]) == tg, bar);
            __builtin_amdgcn_fence(__ATOMIC_ACQUIRE, "agent");
            xb_add(&bar[XB_XGEN(b.x)], 1u);
            asm volatile("s_waitcnt vmcnt(0)" ::: "memory");
        } else {
            XB_SPIN(xb_ld(&bar[XB_XGEN(b.x)]) == gen, bar);
            __builtin_amdgcn_fence(__ATOMIC_ACQUIRE, "agent");
            asm volatile("s_waitcnt vmcnt(0)" ::: "memory");
        }
    }
    __syncthreads();
}

__device__ __forceinline__ bool unit_of(long L, int nM, int nN, int& pm, int& pn) {
    const int nwg = nM * nN; if (L >= nwg) return false;
    int wgid = (int)L; { const int q = nwg / 8, r = nwg % 8, xcd = wgid % 8, off = wgid / 8; wgid = (xcd < r ? xcd * (q + 1) : r * (q + 1) + (xcd - r) * q) + off; }
    const int nig = 8 * nN, gid = wgid / nig, fm = gid * 8, gsz = (nM - fm) < 8 ? (nM - fm) : 8;
    pm = fm + ((wgid % nig) % gsz); pn = (wgid % nig) / gsz; return true;
}

struct EpiPlainF32 {
    float* Cout; int ldc;
    __device__ __forceinline__ bool swapped(int) const { return false; }
    __device__ __forceinline__ int brow0(int pn) const { return pn * 256; }
    __device__ __forceinline__ void operator()(const f32x4 (&acc)[8][4], int pm, int pn, int wr, int wc, int fr, int fq) const {
#pragma unroll
        for (int m = 0; m < 8; ++m) { float* rp = Cout + (size_t)(pm * 256 + arow_of<8>(wr, m, fr)) * ldc + pn * 256;
#pragma unroll
            for (int n = 0; n < 4; ++n) *(f32x4*)(rp + bcol_of<4>(wc, n, fq, 0)) = acc[m][n]; }
    }
};

__device__ __forceinline__ unsigned pk4_fp8(float a, float b, float c, float d) { int w = 0; w = __builtin_amdgcn_cvt_pk_fp8_f32(a, b, w, false); w = __builtin_amdgcn_cvt_pk_fp8_f32(c, d, w, true); return (unsigned)w; }
struct ConvJob { const float* W; bf16_t* dst; int K, N, batch, rows_per_batch, grp, grp_stride, add, pad; };
template <bool FP8>
__device__ __forceinline__ void conv_tiles(LAS unsigned char* lds, const ConvJob& J, float sc, int wg, int nwg, int wave_s) {
    const int tid = opaque_tid(wave_s), n4 = tid & 31, kg = tid >> 5;
    const int tk = J.K / 128, tn = J.N / 128, per = tk * tn, total = per * J.batch;
    constexpr int RS = FP8 ? 144 : 272;
    unsigned char* dst8 = (unsigned char*)J.dst;
    for (int u = wg; u < total; u += nwg) {
        const int b = u / per, r = u % per, kt = r / tn, nt = r % tn;
        const float* src = J.W + ((size_t)b * J.K + (size_t)kt * 128 + kg * 8) * J.N + nt * 128 + 4 * n4;
        float4 v[8];
#pragma unroll
        for (int j = 0; j < 8; ++j) v[j] = *(const float4*)(src + (size_t)j * J.N);
#pragma unroll
        for (int i = 0; i < 4; ++i) { float e[8];
#pragma unroll
            for (int j = 0; j < 8; ++j) e[j] = (i == 0 ? v[j].x : i == 1 ? v[j].y : i == 2 ? v[j].z : v[j].w) * (FP8 ? sc : 1.f);
            if (FP8) { u32x2 w; w.x = pk4_fp8(e[0], e[1], e[2], e[3]); w.y = pk4_fp8(e[4], e[5], e[6], e[7]); *(LAS u32x2*)(lds + (4 * n4 + i) * RS + kg * 8) = w; }
            else { u32x4 w; w.x = cvt_pk_bf16(e[0], e[1]); w.y = cvt_pk_bf16(e[2], e[3]); w.z = cvt_pk_bf16(e[4], e[5]); w.w = cvt_pk_bf16(e[6], e[7]); *(LAS u32x4*)(lds + (4 * n4 + i) * RS + kg * 16) = w; } }
        __syncthreads();
        const int nn0 = nt * 128;
        const size_t drow0 = (size_t)b * J.rows_per_batch + (size_t)(nn0 / J.grp) * J.grp_stride + (nn0 % J.grp) + J.add;
#pragma unroll
        for (int p = 0; p < (FP8 ? 2 : 4); ++p) { const int q = tid + 512 * p, row = FP8 ? (q >> 3) : (q >> 4), pc = FP8 ? (q & 7) : (q & 15);
            const u32x4 w = *(const LAS u32x4*)(lds + row * RS + pc * 16);
            if (FP8) *(u32x4*)(dst8 + (drow0 + row) * J.K + kt * 128 + pc * 16) = w;
            else *(u32x4*)(J.dst + (drow0 + row) * J.K + kt * 128 + pc * 8) = w; }
        __syncthreads();
    }
}
__device__ __forceinline__ void conv_phase(LAS unsigned char* lds, const ConvJob& J, int wg, int nwg, int wave_s) { conv_tiles<false>(lds, J, 1.f, wg, nwg, wave_s); }
__device__ __forceinline__ void conv8_phase(LAS unsigned char* lds, const ConvJob& J, float sc, int wg, int nwg, int wave_s) { conv_tiles<true>(lds, J, sc, wg, nwg, wave_s); }

template <bool HB8>
__device__ __forceinline__ void norm_rows_bf16(const float* __restrict__ x, const float* __restrict__ g, bf16_t* __restrict__ out, int wg, int nwg, int wave_s) {
    const int tid = opaque_tid(wave_s), lane = tid & 63, wv = tid >> 6;
    f32x4 gv[8], xa[8];
#pragma unroll
    for (int i = 0; i < 4; ++i) { const int e0 = 8 * (lane + 64 * i); gv[2 * i] = *(const f32x4*)(g + e0); gv[2 * i + 1] = *(const f32x4*)(g + e0 + 4); }
#define NR_LOAD(row_) do { const size_t rb_ = (size_t)(row_) * D_; _Pragma("unroll") for (int i = 0; i < 4; ++i) { const int e0 = 8 * (lane + 64 * i); xa[2 * i] = *(const f32x4*)(x + rb_ + e0); xa[2 * i + 1] = *(const f32x4*)(x + rb_ + e0 + 4); } } while (0)
    int row = wg * 8 + wv;
    if (row < T_) NR_LOAD(row);
    for (; row < T_; row += nwg * 8) {
        f32x4 v[8]; float ss = 0.f;
#pragma unroll
        for (int i = 0; i < 8; ++i) { v[i] = xa[i]; ss += v[i][0] * v[i][0] + v[i][1] * v[i][1] + v[i][2] * v[i][2] + v[i][3] * v[i][3]; }
        asm volatile("" ::: "memory");
        if (row + nwg * 8 < T_) NR_LOAD(row + nwg * 8);
        asm volatile("" ::: "memory");
        ss = wave_sum(ss);
        const float r = rsqrtf(ss * (1.f / D_) + 1e-6f);
#pragma unroll
        for (int i = 0; i < 4; ++i) { const int e0 = 8 * (lane + 64 * i); const f32x4 ga = gv[2 * i], gb = gv[2 * i + 1], a = v[2 * i], b = v[2 * i + 1];
            if (HB8) { const float r4s = 4.f * r; u32x2 o; o.x = pk4_fp8(a[0] * r4s * ga[0], a[1] * r4s * ga[1], a[2] * r4s * ga[2], a[3] * r4s * ga[3]); o.y = pk4_fp8(b[0] * r4s * gb[0], b[1] * r4s * gb[1], b[2] * r4s * gb[2], b[3] * r4s * gb[3]);
                *(u32x2*)((unsigned char*)out + (size_t)row * D_ + e0) = o; }
            else { u32x4 o; o.x = cvt_pk_bf16(a[0] * r * ga[0], a[1] * r * ga[1]); o.y = cvt_pk_bf16(a[2] * r * ga[2], a[3] * r * ga[3]); o.z = cvt_pk_bf16(b[0] * r * gb[0], b[1] * r * gb[1]); o.w = cvt_pk_bf16(b[2] * r * gb[2], b[3] * r * gb[3]);
                *(u32x4*)(out + (size_t)row * D_ + e0) = o; } }
    }
#undef NR_LOAD
}

__device__ __forceinline__ void bg_issue(const float* wg_, const float* wu_, const float* wd_, int t, float4 (&v)[8], int tid) {
    const int n4 = tid & 31, kg = tid >> 5, m = t >> 12, r = t & 4095, b = r >> 7, q = r & 127;
    const int N = m == 2 ? 2048 : 1024, K = m == 2 ? 1024 : 2048, tn = N >> 7, kt = q / tn, nt = q % tn;
    const float* W = m == 0 ? wg_ : (m == 1 ? wu_ : wd_);
    const float* src = W + ((size_t)b * K + (size_t)kt * 128 + kg * 8) * N + nt * 128 + 4 * n4;
#pragma unroll
    for (int j = 0; j < 8; ++j) v[j] = *(const float4*)(src + (size_t)j * N);
}
__device__ __forceinline__ void bg_write(LAS unsigned char* img, const float4 (&v)[8], float sc, int tid) {
    const int n4 = tid & 31, kg = tid >> 5;
#pragma unroll
    for (int i = 0; i < 4; ++i) { float e[8];
#pragma unroll
        for (int j = 0; j < 8; ++j) e[j] = (i == 0 ? v[j].x : i == 1 ? v[j].y : i == 2 ? v[j].z : v[j].w) * sc;
        u32x2 w; w.x = pk4_fp8(e[0], e[1], e[2], e[3]); w.y = pk4_fp8(e[4], e[5], e[6], e[7]); *(LAS u32x2*)(img + (4 * n4 + i) * 144 + kg * 8) = w; }
}
__device__ __forceinline__ void bg_store(const LAS unsigned char* img, unsigned char* gu8, unsigned char* dn8, int t, int tid) {
    const int m = t >> 12, r = t & 4095, b = r >> 7, q = r & 127;
    const int N = m == 2 ? 2048 : 1024, K = m == 2 ? 1024 : 2048, tn = N >> 7, kt = q / tn, nt = q % tn;
    const size_t drow0 = (size_t)b * 2048 + (m == 2 ? (size_t)nt * 128 : (size_t)nt * 256 + (m == 1 ? 128 : 0));
    unsigned char* dst = m == 2 ? dn8 : gu8;
#pragma unroll
    for (int p = 0; p < 2; ++p) { const int qq = tid + 512 * p, row = qq >> 3, pc = qq & 7;
        *(u32x4*)(dst + (drow0 + row) * K + kt * 128 + pc * 16) = *(const LAS u32x4*)(img + row * 144 + pc * 16); }
}

#ifndef CS_NS
#define CS_NS 4
#endif
#define CS_STR2(x) #x
#define CS_STR(x) CS_STR2(x)
__device__ __forceinline__ void conv_stream(LAS unsigned char* lds, const float* sg, const float* su, const float* sd, unsigned char* gu8, unsigned char* dn8, int t_lo, int t_hi, int c, int nc, int wave_s) {
    const int tid = opaque_tid(wave_s), n4 = tid & 31, kg = tid >> 5;
    const size_t LSRC = (size_t)32 * 2048 * 1024, LGU = (size_t)2 * 32 * 2048 * 2048, LDN = (size_t)2 * 32 * 2048 * 1024;
    f32x4 v[CS_NS][8];
    const int tmax = t_hi - 1;
    const unsigned wofs = (unsigned)((4 * n4) * 144 + ((kg ^ (2 * ((n4 >> 2) & 7))) * 8));
#define CS_ISSUE(s, ts) do { const int tc_ = (ts) < tmax ? (ts) : tmax, L_ = tc_ >= 12288 ? 1 : 0, t_ = tc_ - L_ * 12288, m_ = t_ >> 12, r_ = t_ & 4095, b_ = r_ >> 7, q_ = r_ & 127; \
        const int N_ = m_ == 2 ? 2048 : 1024, K_ = m_ == 2 ? 1024 : 2048, tn_ = N_ >> 7, kt_ = q_ / tn_, nt_ = q_ % tn_; \
        const float* W_ = (m_ == 0 ? sg : (m_ == 1 ? su : sd)) + L_ * LSRC + ((size_t)b_ * K_ + (size_t)kt_ * 128) * N_ + nt_ * 128; \
        const unsigned vo_ = (unsigned)(kg * 8 * N_ + 4 * n4) * 4u; \
        _Pragma("unroll") for (int j_ = 0; j_ < 8; ++j_) { const float* rb_ = W_ + (size_t)j_ * N_; asm volatile("global_load_dwordx4 %0, %1, %2 nt" : "=v"(v[s][j_]) : "v"(vo_), "s"(rb_) : "memory"); } } while (0)
#define CS_WAIT(s, n) asm volatile("s_waitcnt vmcnt(" CS_STR(n) ")" : "+v"(v[s][0]), "+v"(v[s][1]), "+v"(v[s][2]), "+v"(v[s][3]), "+v"(v[s][4]), "+v"(v[s][5]), "+v"(v[s][6]), "+v"(v[s][7]) :: "memory")
#pragma unroll
    for (int s = 0; s < CS_NS; ++s) CS_ISSUE(s, t_lo + c + s * nc);
    for (int t = t_lo + c; t < t_hi; t += CS_NS * nc) {
#pragma unroll
        for (int s = 0; s < CS_NS; ++s) { const int ts0 = t + s * nc, ts = ts0 < tmax ? ts0 : tmax;
            const int tt = ts >= 12288 ? ts - 12288 : ts; const float sc = tt >= 8192 ? 32.f : 64.f;
            CS_WAIT(s, 8 * (CS_NS - 1));
#pragma unroll
            for (int i = 0; i < 4; ++i) { float e[8];
#pragma unroll
                for (int j = 0; j < 8; ++j) e[j] = v[s][j][i] * sc;
                u32x2 w; w.x = pk4_fp8(e[0], e[1], e[2], e[3]); w.y = pk4_fp8(e[4], e[5], e[6], e[7]); *(LAS u32x2*)(lds + s * 18432 + wofs + i * 144) = w; }
            CS_ISSUE(s, ts0 + CS_NS * nc); }
        asm volatile("s_waitcnt lgkmcnt(0)" ::: "memory"); __builtin_amdgcn_s_barrier();
#pragma unroll
        for (int s = 0; s < CS_NS; ++s) { const int ts0 = t + s * nc, ts = ts0 < tmax ? ts0 : tmax;
            const int L_ = ts >= 12288 ? 1 : 0, t_ = ts - L_ * 12288, m = t_ >> 12, r = t_ & 4095, b = r >> 7, q = r & 127;
            const int N = m == 2 ? 2048 : 1024, K = m == 2 ? 1024 : 2048, tn = N >> 7, kt = q / tn, nt = q % tn;
            const size_t drow0 = (size_t)b * 2048 + (m == 2 ? (size_t)nt * 128 : (size_t)nt * 256 + (m == 1 ? 128 : 0));
            unsigned char* dst = (m == 2 ? dn8 + L_ * LDN : gu8 + L_ * LGU) + drow0 * K + kt * 128;
#pragma unroll
            for (int p = 0; p < 2; ++p) { const int qq = tid + 512 * p, row = qq >> 3, pc = qq & 7;
                const u32x4 w = *(const LAS u32x4*)(lds + s * 18432 + row * 144 + ((pc ^ ((row >> 4) & 7)) * 16));
                asm volatile("global_store_dwordx4 %0, %1, %2 nt" :: "v"((unsigned)(row * K + pc * 16)), "v"(w), "s"(dst) : "memory"); } }
        asm volatile("s_waitcnt lgkmcnt(0)" ::: "memory"); __builtin_amdgcn_s_barrier();
    }
    asm volatile("s_waitcnt vmcnt(0)" ::: "memory");
#undef CS_ISSUE
#undef CS_WAIT
}
__device__ __forceinline__ int perm32(int rho) { const int n = rho >> 4, i = rho & 15; return 8 * (i >> 2) + 4 * n + (i & 3); }
#define HTB 16384
typedef int i32x4 __attribute__((ext_vector_type(4)));
typedef int i32x8 __attribute__((ext_vector_type(8)));
#ifndef G8_ABLATE
#define G8_ABLATE 0
#endif
template <bool FP8, class Sched, class Epi, int ABL = 0>
__device__ __forceinline__ void gemm8_phase(LAS unsigned char* lds, int RB, const Sched& S, const Epi& E, int wave_s) {
    typedef typename Sched::U U;
    const int tid = opaque_tid(wave_s), wid = __builtin_amdgcn_readfirstlane(tid >> 6), lane = tid & 63, wr = wid >> 2, wc = wid & 3, fr = lane & 15, fq = lane >> 4;
    const int nt = RB / 128;
    int R0, C0; stage_rc(tid * 16, R0, C0);
    const unsigned c2 = (unsigned)C0 * 2u, r64 = (unsigned)64 * RB;
    const unsigned voffB0 = (unsigned)(((R0 & ~31) + perm32(R0 & 31)) * RB) + c2, voffA0 = (unsigned)(R0 * RB) + c2;
    const unsigned hstep = (unsigned)128 * RB;
    const unsigned ldsw = (unsigned)wid * 1024u;
    const int aoff = lds_byte(wr * 64 + fr, fq * 8), boff = lds_byte(wc * 32 + fr, fq * 8);
#define G8_SA(b, h) (((b) * 2 + (h)) * HTB)
#define G8_SB(b, h) ((4 + (b) * 2 + (h)) * HTB)
#define G8_STAGE2(bufoff, rs, v0, s0, v1, s1) do { __builtin_amdgcn_raw_ptr_buffer_load_lds(rs, (LAS void*)(lds + (bufoff) + ldsw), 16, (int)(v0), (int)(s0), 0, 0); \
        __builtin_amdgcn_raw_ptr_buffer_load_lds(rs, (LAS void*)(lds + (bufoff) + ldsw + 8192), 16, (int)(v1), (int)(s1), 0, 0); } while (0)
#define G8_STB(bufoff, rs, so) G8_STAGE2(bufoff, rs, voffB0, (so), voffB0, (so) + r64)
#define G8_STA(bufoff, rs, pk, h, so) do { if (Sched::GATHER) { const unsigned _p = (pk)[h]; G8_STAGE2(bufoff, rs, (_p & 0xffffu) * (unsigned)RB + c2, (so), (_p >> 16) * (unsigned)RB + c2, (so)); } \
        else G8_STAGE2(bufoff, rs, voffA0, (so) + (h) * hstep, voffA0, (so) + (h) * hstep + r64); } while (0)
#define G8_LDA(dst, b, h) do { _Pragma("unroll") for (int m = 0; m < 4; ++m) dst[m] = __builtin_shufflevector(*(const LAS i32x4*)(lds + G8_SA(b, h) + aoff + m * 2048), *(const LAS i32x4*)(lds + G8_SA(b, h) + aoff + m * 2048 + 1024), 0, 1, 2, 3, 4, 5, 6, 7); } while (0)
#define G8_LDB(dst, b, h) do { _Pragma("unroll") for (int n = 0; n < 2; ++n) dst[n] = __builtin_shufflevector(*(const LAS i32x4*)(lds + G8_SB(b, h) + boff + n * 2048), *(const LAS i32x4*)(lds + G8_SB(b, h) + boff + n * 2048 + 1024), 0, 1, 2, 3, 4, 5, 6, 7); } while (0)
#define G8_MMA1(ai, bj, At, Bt, m, n) do { \
        if constexpr (FP8) asm volatile("v_mfma_scale_f32_16x16x128_f8f6f4 %0, %1, %2, %0, %3, %3 op_sel_hi:[0,0,0]" : "+v"(acc[(ai) * 4 + m][(bj) * 2 + n]) : "v"(Bt[n]), "v"(At[m]), "v"(one_scale)); \
        else { acc[(ai) * 4 + m][(bj) * 2 + n] = __builtin_amdgcn_mfma_f32_16x16x32_bf16(__builtin_bit_cast(bf16x8, __builtin_shufflevector(Bt[n], Bt[n], 0, 1, 2, 3)), __builtin_bit_cast(bf16x8, __builtin_shufflevector(At[m], At[m], 0, 1, 2, 3)), acc[(ai) * 4 + m][(bj) * 2 + n], 0, 0, 0); \
               acc[(ai) * 4 + m][(bj) * 2 + n] = __builtin_amdgcn_mfma_f32_16x16x32_bf16(__builtin_bit_cast(bf16x8, __builtin_shufflevector(Bt[n], Bt[n], 4, 5, 6, 7)), __builtin_bit_cast(bf16x8, __builtin_shufflevector(At[m], At[m], 4, 5, 6, 7)), acc[(ai) * 4 + m][(bj) * 2 + n], 0, 0, 0); } } while (0)
#define G8_MMA(ai, bj, At, Bt) do { if (ABL == 1) { _Pragma("unroll") for (int m = 0; m < 4; ++m) asm volatile("" :: "v"(At[m])); _Pragma("unroll") for (int n = 0; n < 2; ++n) asm volatile("" :: "v"(Bt[n])); break; } \
        __builtin_amdgcn_s_setprio(1); _Pragma("unroll") for (int m = 0; m < 4; ++m) _Pragma("unroll") for (int n = 0; n < 2; ++n) G8_MMA1(ai, bj, At, Bt, m, n); __builtin_amdgcn_s_setprio(0); } while (0)
#define G8_WAIT_V(n) asm volatile("s_waitcnt vmcnt(" #n ")" ::: "memory")
#define G8_WAIT_L(n) asm volatile("s_waitcnt lgkmcnt(" #n ")" ::: "memory")
#define G8_BAR __builtin_amdgcn_s_barrier()
#define G8_SCHED __builtin_amdgcn_sched_barrier(0)
#define G8_RSRC(p) __builtin_amdgcn_make_buffer_rsrc((void*)(p), 0, 0x7ffffff0, 0x00020000)
    U cur, nxt; int ui = 0;
    if (!S.next(0, cur)) return;
    f32x4 acc[8][4];
#pragma unroll
    for (int m = 0; m < 8; ++m)
#pragma unroll
        for (int n = 0; n < 4; ++n) acc[m][n] = (f32x4){0.f, 0.f, 0.f, 0.f};
    i32x8 At[4], B0[2], B1[2];
    const int one_scale = 0x7F7F7F7F;
    unsigned pkc[2] = {0u, 0u}, pkn[2] = {0u, 0u};
    if (Sched::GATHER) S.gather(cur, R0, pkc);
    pkn[0] = pkc[0]; pkn[1] = pkc[1];
    const char* cA = S.abase(cur); const char* cB = S.bbase(cur);
    {
        const __amdgpu_buffer_rsrc_t rA = G8_RSRC(cA), rB = G8_RSRC(cB);
        G8_STB(G8_SB(0, 0), rB, 0u); G8_STA(G8_SA(0, 0), rA, pkc, 0, 0u); G8_STB(G8_SB(0, 1), rB, hstep); G8_STA(G8_SA(0, 1), rA, pkc, 1, 0u);
        if (wr == 1) G8_BAR;
        G8_WAIT_V(4); G8_BAR;
        G8_STB(G8_SB(1, 0), rB, 128u); G8_STA(G8_SA(1, 0), rA, pkc, 0, 128u); G8_STB(G8_SB(1, 1), rB, hstep + 128u);
        G8_WAIT_V(6); G8_BAR;
    }
    for (;;) {
        const bool has_next = S.next(ui + 1, nxt);
        if (Sched::GATHER && has_next) { const int tz = opaque_tid(wave_s); int R2, C2; stage_rc(tz * 16, R2, C2); S.gather(nxt, R2, pkn); }
        const char* nA = has_next ? S.abase(nxt) : cA; const char* nB = has_next ? S.bbase(nxt) : cB;
        const __amdgpu_buffer_rsrc_t rA = G8_RSRC(cA);
#pragma unroll 1
        for (int t = 0; t < nt; t += 2) {
            int lastv = __builtin_amdgcn_readfirstlane((t == nt - 2) ? 1 : 0); asm volatile("" : "+s"(lastv)); const bool last = lastv != 0;
            const unsigned k1 = (unsigned)(t + 1) * 128u;
            const unsigned k2 = last ? 0u : (unsigned)(t + 2) * 128u, k3 = k2 + 128u;
            const __amdgpu_buffer_rsrc_t rA2 = G8_RSRC(last ? nA : cA), rB2 = G8_RSRC(last ? nB : cB);
            const unsigned px[2] = {last ? pkn[0] : pkc[0], last ? pkn[1] : pkc[1]};
            G8_LDB(B0, 0, 0); G8_SCHED; G8_LDA(At, 0, 0); G8_STA(G8_SA(1, 1), rA, pkc, 1, k1);
            G8_WAIT_L(8); G8_BAR; G8_WAIT_L(0); G8_MMA(0, 0, At, B0); G8_BAR; G8_SCHED;
            G8_LDB(B1, 0, 1); G8_STB(G8_SB(0, 0), rB2, k2);
            G8_BAR; G8_WAIT_L(0); G8_MMA(0, 1, At, B1); G8_BAR;
            G8_LDA(At, 0, 1); G8_STA(G8_SA(0, 0), rA2, px, 0, k2);
            G8_BAR; G8_WAIT_L(0); G8_MMA(1, 0, At, B0); G8_BAR; G8_SCHED;
            G8_STB(G8_SB(0, 1), rB2, k2 + hstep);
            G8_WAIT_V(6); G8_BAR; G8_MMA(1, 1, At, B1); G8_BAR;
            G8_LDB(B0, 1, 0); G8_SCHED; G8_LDA(At, 1, 0); G8_STA(G8_SA(0, 1), rA2, px, 1, k2);
            G8_WAIT_L(8); G8_BAR; G8_WAIT_L(0); G8_MMA(0, 0, At, B0); G8_BAR; G8_SCHED;
            G8_LDB(B1, 1, 1); G8_STB(G8_SB(1, 0), rB2, k3);
            G8_BAR; G8_WAIT_L(0); G8_MMA(0, 1, At, B1); G8_BAR;
            G8_LDA(At, 1, 1); G8_STA(G8_SA(1, 0), rA2, px, 0, k3);
            G8_BAR; G8_WAIT_L(0); G8_MMA(1, 0, At, B0); G8_BAR; G8_SCHED;
            G8_STB(G8_SB(1, 1), rB2, k3 + hstep);
            G8_WAIT_V(6); G8_BAR; G8_MMA(1, 1, At, B1); G8_BAR;
        }
        if (FP8) asm volatile("s_nop 15\n\ts_nop 15" ::: "memory");
        {
            const int tz = opaque_tid(wave_s), lz = tz & 63, wz = __builtin_amdgcn_readfirstlane(tz >> 6);
            E(acc, cur, wz >> 2, wz & 3, lz & 15, lz >> 4); }
        if (!has_next) break;
#pragma unroll
        for (int m = 0; m < 8; ++m)
#pragma unroll
            for (int n = 0; n < 4; ++n) acc[m][n] = (f32x4){0.f, 0.f, 0.f, 0.f};
        cur = nxt; cA = nA; cB = nB; ++ui;
        pkc[0] = pkn[0]; pkc[1] = pkn[1];
    }
    G8_WAIT_V(0);
    if (wr == 0) G8_BAR;
    G8_BAR;
#undef G8_SA
#undef G8_SB
#undef G8_STAGE2
#undef G8_STB
#undef G8_STA
#undef G8_LDA
#undef G8_LDB
#undef G8_MMA
#undef G8_MMA1
#undef G8_WAIT_V
#undef G8_WAIT_L
#undef G8_BAR
#undef G8_SCHED
#undef G8_RSRC
}

struct DenseU { int pm, pn; };
template <class Epi> struct DenseSched {
    typedef DenseU U; static constexpr bool GATHER = false; static constexpr bool RAGGED = false;
    __device__ __forceinline__ int nvalid(const U&) const { return 256; }
    const char* A; const char* Bt; int nM, nN, RB; const Epi* E; int wg, nwg;
    __device__ __forceinline__ bool next(int i, U& u) const { return unit_of((long)i * nwg + wg, nM, nN, u.pm, u.pn); }
    __device__ __forceinline__ const char* abase(const U& u) const { return E->swapped(u.pn) ? (Bt + (size_t)E->brow0(u.pn) * RB) : (A + (size_t)u.pm * 256 * RB); }
    __device__ __forceinline__ const char* bbase(const U& u) const { return E->swapped(u.pn) ? (A + (size_t)u.pm * 256 * RB) : (Bt + (size_t)E->brow0(u.pn) * RB); }
    __device__ __forceinline__ void gather(const U&, int, unsigned (&)[2]) const {}
};
template <class Epi> struct DenseEpi { const Epi* E;
    __device__ __forceinline__ void operator()(const f32x4 (&acc)[8][4], const DenseU& u, int wr, int wc, int fr, int fq) const { (*E)(acc, u.pm, u.pn, wr, wc, fr, fq); } };
template <class Epi>
__device__ __forceinline__ void gemm_phase(LAS unsigned char* lds, const bf16_t* A, const bf16_t* Bt, int nM, int nN, int K, const Epi& E, int wave_s, int wg = (int)blockIdx.x, int nwg = (int)gridDim.x) {
    DenseSched<Epi> S{(const char*)A, (const char*)Bt, nM, nN, K * 2, &E, wg, nwg}; DenseEpi<Epi> DE{&E};
    gemm8_phase<false>(lds, K * 2, S, DE, wave_s);
}
template <class Epi>
__device__ __forceinline__ void gemm_phase_f8(LAS unsigned char* lds, const unsigned char* A, const unsigned char* Bt, int nM, int nN, int K, const Epi& E, int wave_s, int wg = (int)blockIdx.x, int nwg = (int)gridDim.x) {
    DenseSched<Epi> S{(const char*)A, (const char*)Bt, nM, nN, K, &E, wg, nwg}; DenseEpi<Epi> DE{&E};
    gemm8_phase<true>(lds, K, S, DE, wave_s);
}
__device__ __forceinline__ void rope_freq(int j, float& fhi, float& flo) {
    const double f = exp2(-(double)j * (13.287712379549449 / 128.0)) * 0.15915494309189535;
    fhi = (float)f; flo = (float)(f - (double)fhi);
}
__device__ __forceinline__ void rope_cs(float pos, float fhi, float flo, float& c, float& s) {
    const float p = pos * fhi; const float e = __builtin_fmaf(pos, fhi, -p);
    float r = p - __builtin_rintf(p); r += e + pos * flo;
    c = __builtin_amdgcn_cosf(r); s = __builtin_amdgcn_sinf(r);
}
__device__ __forceinline__ float gelu_fast(float x) { const float u = x * (-2.3022081981971123f - 0.10294324276067f * x * x); return x * __builtin_amdgcn_rcpf(1.f + __builtin_amdgcn_exp2f(u)); }
__device__ __forceinline__ float silu_fast(float x) { return x * __builtin_amdgcn_rcpf(1.f + __builtin_amdgcn_exp2f(-1.4426950408889634f * x)); }

template <bool S8> struct EpiInAB {
    bf16_t *qb, *kb, *vT, *sgb, *ugb, *gvT;
    static constexpr float SC = S8 ? (1.f / 256.f) : 1.f;
    __device__ __forceinline__ bool swapped(int pn) const { return (pn >= 8 && pn < 12) || pn >= 20; }
    __device__ __forceinline__ int brow0(int pn) const { return pn * 256; }
    __device__ __forceinline__ void operator()(const f32x4 (&acc)[8][4], int pm, int pn, int wr, int wc, int fr, int fq) const {
        if (pn < 8) {
            bf16_t* dst = (pn < 4 ? qb : kb) + (pn & 3) * 256; const float sc = (pn < 4 ? 1.f : 0.0625f) * SC;
            float fh[8], fl[8];
#pragma unroll
            for (int e = 0; e < 8; ++e) rope_freq(wc * 32 + 8 * fq + e, fh[e], fl[e]);
#pragma unroll
            for (int m = 0; m < 8; ++m) { int row = pm * 256 + arow_of<8>(wr, m, fr); asm volatile("" : "+v"(row));
                const float pos = (float)row; float o1[8], o2[8];
#pragma unroll
                for (int e = 0; e < 8; ++e) { float c, s; rope_cs(pos, fh[e], fl[e], c, s);
                    const float x1 = acc[m][e >> 2][e & 3], x2 = acc[m][(e >> 2) + 2][e & 3];
                    o1[e] = (x1 * c - x2 * s) * sc; o2[e] = (x2 * c + x1 * s) * sc; }
                u32x4 lo, hi;
                lo.x = cvt_pk_bf16(o1[0], o1[1]); lo.y = cvt_pk_bf16(o1[2], o1[3]); lo.z = cvt_pk_bf16(o1[4], o1[5]); lo.w = cvt_pk_bf16(o1[6], o1[7]);
                hi.x = cvt_pk_bf16(o2[0], o2[1]); hi.y = cvt_pk_bf16(o2[2], o2[3]); hi.z = cvt_pk_bf16(o2[4], o2[5]); hi.w = cvt_pk_bf16(o2[6], o2[7]);
                bf16_t* rp = dst + (size_t)row * 1024 + wc * 32 + 8 * fq;
                *(u32x4*)rp = lo; *(u32x4*)(rp + 128) = hi; }
        } else if (pn >= 12 && pn < 20) {
            const bool isg = pn < 16; bf16_t* dst = (isg ? sgb : ugb) + (pn & 3) * 256;
#pragma unroll
            for (int m = 0; m < 8; ++m) { int row = pm * 256 + arow_of<8>(wr, m, fr); asm volatile("" : "+v"(row));
#pragma unroll
                for (int hf = 0; hf < 2; ++hf) { u32x4 w; const f32x4 a = acc[m][2 * hf], b = acc[m][2 * hf + 1];
                    float v[8] = {SC * a[0], SC * a[1], SC * a[2], SC * a[3], SC * b[0], SC * b[1], SC * b[2], SC * b[3]};
#pragma unroll
                    for (int e = 0; e < 8; ++e) v[e] = isg ? silu_fast(v[e]) : gelu_fast(v[e]);
                    w.x = cvt_pk_bf16(v[0], v[1]); w.y = cvt_pk_bf16(v[2], v[3]); w.z = cvt_pk_bf16(v[4], v[5]); w.w = cvt_pk_bf16(v[6], v[7]);
                    *(u32x4*)(dst + (size_t)row * 1024 + hf * 128 + wc * 32 + 8 * fq) = w; } }
        } else {
            const bool isv = pn < 12; bf16_t* dst = (isv ? vT : gvT) + (size_t)((pn & 3) * 256) * T_ + pm * 256;
#pragma unroll
            for (int m = 0; m < 8; ++m) { int f = arow_of<8>(wr, m, fr); asm volatile("" : "+v"(f));
#pragma unroll
                for (int hf = 0; hf < 2; ++hf) { u32x4 w; const f32x4 a = acc[m][2 * hf], b = acc[m][2 * hf + 1];
                    float v[8] = {SC * a[0], SC * a[1], SC * a[2], SC * a[3], SC * b[0], SC * b[1], SC * b[2], SC * b[3]};
                    if (!isv) {
#pragma unroll
                        for (int e = 0; e < 8; ++e) v[e] = gelu_fast(v[e]); }
                    w.x = cvt_pk_bf16(v[0], v[1]); w.y = cvt_pk_bf16(v[2], v[3]); w.z = cvt_pk_bf16(v[4], v[5]); w.w = cvt_pk_bf16(v[6], v[7]);
                    *(u32x4*)(dst + (size_t)f * T_ + hf * 128 + wc * 32 + 8 * fq) = w; } }
        }
    }
};

struct EpiKhat {
    bf16_t* khatT;
    __device__ __forceinline__ bool swapped(int) const { return true; }
    __device__ __forceinline__ int brow0(int pn) const { return (4 + pn) * 256; }
    __device__ __forceinline__ void operator()(const f32x4 (&acc)[8][4], int pm, int pn, int wr, int wc, int fr, int fq) const {
        const int h = pn; const float l2g = log2f(1.f - exp2f(-5.f - (float)h));
        bf16_t* dst = khatT + (size_t)(h * 256) * T_ + pm * 256;
#pragma unroll
        for (int m = 0; m < 4; ++m) { int f = wr * 64 + m * 16 + fr; asm volatile("" : "+v"(f));
            float fh, fl; rope_freq(f, fh, fl);
#pragma unroll
            for (int hf = 0; hf < 2; ++hf) { float o1[8], o2[8]; const int t0 = hf * 128 + wc * 32 + 8 * fq;
#pragma unroll
                for (int e = 0; e < 8; ++e) { float c, s; rope_cs((float)(pm * 256 + t0 + e), fh, fl, c, s);
                    const float x1 = acc[m][2 * hf + (e >> 2)][e & 3], x2 = acc[m + 4][2 * hf + (e >> 2)][e & 3];
                    const float d = 0.0625f * exp2f((float)(127 - ((t0 + e) & 127)) * l2g);
                    o1[e] = (x1 * c - x2 * s) * d; o2[e] = (x2 * c + x1 * s) * d; }
                u32x4 w1, w2;
                w1.x = cvt_pk_bf16(o1[0], o1[1]); w1.y = cvt_pk_bf16(o1[2], o1[3]); w1.z = cvt_pk_bf16(o1[4], o1[5]); w1.w = cvt_pk_bf16(o1[6], o1[7]);
                w2.x = cvt_pk_bf16(o2[0], o2[1]); w2.y = cvt_pk_bf16(o2[2], o2[3]); w2.z = cvt_pk_bf16(o2[4], o2[5]); w2.w = cvt_pk_bf16(o2[6], o2[7]);
                *(u32x4*)(dst + (size_t)f * T_ + t0) = w1;
                *(u32x4*)(dst + (size_t)(f + 128) * T_ + t0) = w2; } }
    }
};
typedef short s16x4 __attribute__((ext_vector_type(4)));
__device__ __forceinline__ void ret_kv_phase(LAS unsigned char* lds, const bf16_t* vT, const bf16_t* kb, bf16_t* KVT, int wg, int nwg, int wave_s) {
    typedef Core<8, 4> C;
    constexpr int RS = 576;
    const int tid = opaque_tid(wave_s), wid = __builtin_amdgcn_readfirstlane(tid >> 6), lane = tid & 63, wr = wid >> 2, wc = wid & 3, fr = lane & 15, fq = lane >> 4;
    LAS unsigned char* ldsT = lds + 65536;
    unsigned aoff[4];
#pragma unroll
    for (int i = 0; i < 4; ++i) { int r, c; C::apiece(tid, i, r, c); aoff[i] = (unsigned)(r * T_ + c) * 2u; }
    const int ao = lds_byte(wr * 128 + fr, fq * 8);
    LAS unsigned char* trb = ldsT + (8 * fq + (fr >> 2)) * RS + 2 * (wc * 32 + 8 * (fr & 3));
    for (int u = wg; u < 512; u += nwg) {
        const int n = u >> 2, h = u & 3; const float l2g = log2f(1.f - exp2f(-5.f - (float)h));
        const bf16_t* kt = kb + (size_t)(n * 128) * 1024 + h * 256;
        { const char* Vb = (const char*)(vT + (size_t)(h * 256) * T_ + n * 128); C::stage_a(lds, Vb, aoff, 0u, wid); C::stage_a(lds + 32768, Vb, aoff, 128u, wid); }
        u32x4 wk[8];
#pragma unroll
        for (int p = 0; p < 8; ++p) { int idx = tid + 512 * p; asm volatile("" : "+v"(idx)); const int j = idx >> 5, d0 = (idx & 31) * 8; wk[p] = *(const u32x4*)(kt + (size_t)j * 1024 + d0); }
#pragma unroll
        for (int p = 0; p < 8; ++p) { int idx = tid + 512 * p; asm volatile("" : "+v"(idx)); const int j = idx >> 5, d0 = (idx & 31) * 8;
            const u32x4 w = wk[p];
            const float d = exp2f((float)(127 - j) * l2g);
            u32x4 o; o.x = cvt_pk_bf16(bflo(w.x) * d, bfhi(w.x) * d); o.y = cvt_pk_bf16(bflo(w.y) * d, bfhi(w.y) * d); o.z = cvt_pk_bf16(bflo(w.z) * d, bfhi(w.z) * d); o.w = cvt_pk_bf16(bflo(w.w) * d, bfhi(w.w) * d);
            *(LAS u32x4*)(ldsT + j * RS + d0 * 2) = o; }
        WAIT_V0(); __syncthreads();
        f32x4 acc[8][4]; C::zero(acc);
#pragma unroll
        for (int kk = 0; kk < 4; ++kk) {
            bf16x8 At[8], Bf[4];
#pragma unroll
            for (int m = 0; m < 8; ++m) At[m] = *(const LAS bf16x8*)(lds + (kk >> 1) * 32768 + ao + m * 2048 + (kk & 1) * 1024);
#pragma unroll
            for (int nn = 0; nn < 4; ++nn) { LAS unsigned char* a = trb + (kk * 32) * RS + 2 * ((nn >> 1) * 128 + 4 * (nn & 1));
                const s16x4 lo = __builtin_amdgcn_ds_read_tr16_b64_v4i16((LAS s16x4*)a), hi = __builtin_amdgcn_ds_read_tr16_b64_v4i16((LAS s16x4*)(a + 4 * RS));
                Bf[nn] = __builtin_shufflevector(lo, hi, 0, 1, 2, 3, 4, 5, 6, 7); }
#pragma unroll
            for (int m = 0; m < 8; ++m)
#pragma unroll
                for (int nn = 0; nn < 4; ++nn) acc[m][nn] = __builtin_amdgcn_mfma_f32_16x16x32_bf16(Bf[nn], At[m], acc[m][nn], 0, 0, 0);
            __builtin_amdgcn_sched_barrier(0);
        }
        __syncthreads();
        bf16_t* dst = KVT + (size_t)u * 65536;
#pragma unroll
        for (int m = 0; m < 8; ++m) { bf16_t* rp = dst + arow_of<8>(wr, m, fr) * 256 + wc * 32 + 8 * fq;
#pragma unroll
            for (int hf = 0; hf < 2; ++hf) { const f32x4 a = acc[m][2 * hf], b = acc[m][2 * hf + 1]; u32x4 w;
                w.x = cvt_pk_bf16(a[0], a[1]); w.y = cvt_pk_bf16(a[2], a[3]); w.z = cvt_pk_bf16(b[0], b[1]); w.w = cvt_pk_bf16(b[2], b[3]); *(u32x4*)(rp + hf * 128) = w; } }
    }
}
__device__ __forceinline__ void ret_scan_phase(const bf16_t* KVT, bf16_t* STb, int wg, int nwg, int wave_s) {
    const int tid = opaque_tid(wave_s);
    for (int e = (wg * NTHR + tid) * 2; e < 4 * 65536; e += nwg * NTHR * 2) {
        const int h = e >> 16; const float g = exp2f(128.f * log2f(1.f - exp2f(-5.f - (float)h)));
        float s0 = 0.f, s1 = 0.f;
        for (int n0 = 0; n0 < 128; n0 += 8) {
            unsigned kv[8];
#pragma unroll
            for (int i = 0; i < 8; ++i) kv[i] = *(const unsigned*)(KVT + (size_t)(n0 + i) * 262144 + e);
#pragma unroll
            for (int i = 0; i < 8; ++i) { *(unsigned*)(STb + (size_t)(n0 + i) * 262144 + e) = cvt_pk_bf16(s0, s1); s0 = g * s0 + bflo(kv[i]); s1 = g * s1 + bfhi(kv[i]); }
        }
    }
}
__device__ __forceinline__ void ret_out_phase(LAS unsigned char* lds, const bf16_t* qb, const bf16_t* kb, const bf16_t* vT, const bf16_t* STb, const bf16_t* sgb,
                                              const float* gain, bf16_t* mixb, int wg, int nwg, int wave_s) {
    typedef Core<4, 2> CA; typedef Core<4, 4> CB;
    const int tid = opaque_tid(wave_s), wid = __builtin_amdgcn_readfirstlane(tid >> 6), lane = tid & 63, wr = wid >> 2, wc = wid & 3, fr = lane & 15, fq = lane >> 4;
    LAS unsigned char* ldsP = lds + 98304;
    LAS float* stat = (LAS float*)lds;
    unsigned qoff[2], koff[2], soff[4], voff[4];
#pragma unroll
    for (int i = 0; i < 2; ++i) { int r, c; CA::apiece(tid, i, r, c); qoff[i] = (unsigned)(r * 1024 + c) * 2u; CA::bpiece(tid, i, r, c); koff[i] = (unsigned)(r * 1024 + c) * 2u; }
#pragma unroll
    for (int i = 0; i < 4; ++i) { int r, c; CB::bpiece(tid, i, r, c); soff[i] = (unsigned)(r * 256 + c) * 2u; voff[i] = (unsigned)(r * T_ + c) * 2u; }
    for (int u = wg; u < 512; u += nwg) {
        const int n = u >> 2, h = u & 3; const float l2g = log2f(1.f - exp2f(-5.f - (float)h));
        const char* Qb = (const char*)(qb + (size_t)(n * 128) * 1024 + h * 256); const char* Kb = (const char*)(kb + (size_t)(n * 128) * 1024 + h * 256);
        {
            f32x4 sa[4][2]; CA::zero(sa);
            CA::loop_gg(lds, Qb, qoff, Kb, koff, 4, sa, wid, wr, wc, fr, fq);
#pragma unroll
            for (int m = 0; m < 4; ++m) { const int i = wr * 64 + m * 16 + fr; const int j0 = wc * 32 + 8 * fq;
                float p[8];
#pragma unroll
                for (int e = 0; e < 8; ++e) { const int j = j0 + e; const float s = e < 4 ? sa[m][0][e] : sa[m][1][e - 4]; p[e] = (j <= i) ? s * exp2f((float)(i - j) * l2g) : 0.f; }
                u32x4 w; w.x = cvt_pk_bf16(p[0], p[1]); w.y = cvt_pk_bf16(p[2], p[3]); w.z = cvt_pk_bf16(p[4], p[5]); w.w = cvt_pk_bf16(p[6], p[7]);
                *(LAS u32x4*)(ldsP + (wc >> 1) * 16384 + lds_byte(i, j0 & 63)) = w; }
        }
        f32x4 acc[4][4]; CB::zero(acc);
        CB::loop_gg(lds, Qb, qoff, (const char*)(STb + (size_t)u * 65536), soff, 4, acc, wid, wr, wc, fr, fq);
#pragma unroll
        for (int m = 0; m < 4; ++m) { const float sc = exp2f((float)(wr * 64 + m * 16 + fr + 1) * l2g);
#pragma unroll
            for (int nn = 0; nn < 4; ++nn) acc[m][nn] *= sc; }
        CB::loop_lg(ldsP, lds, (const char*)(vT + (size_t)(h * 256) * T_ + n * 128), voff, 2, acc, wid, wr, wc, fr, fq);
#pragma unroll
        for (int m = 0; m < 4; ++m) { float s = 0.f, ss = 0.f;
#pragma unroll
            for (int nn = 0; nn < 4; ++nn)
#pragma unroll
                for (int e = 0; e < 4; ++e) { const float v = acc[m][nn][e]; s += v; ss += v * v; }
            s += __shfl_xor(s, 16); ss += __shfl_xor(ss, 16); s += __shfl_xor(s, 32); ss += __shfl_xor(ss, 32);
            if (fq == 0) { const int i = wr * 64 + m * 16 + fr; stat[(i * 4 + wc) * 2] = s; stat[(i * 4 + wc) * 2 + 1] = ss; } }
        __syncthreads();
        u32x4 sgv[4][2]; f32x4 gnv[2][2];
#pragma unroll
        for (int hf = 0; hf < 2; ++hf) { const int c0 = h * 256 + hf * 128 + wc * 32 + 8 * fq; gnv[hf][0] = *(const f32x4*)(gain + c0); gnv[hf][1] = *(const f32x4*)(gain + c0 + 4);
#pragma unroll
            for (int m = 0; m < 4; ++m) sgv[m][hf] = *(const u32x4*)(sgb + ((size_t)n * 128 + wr * 64 + m * 16 + fr) * 1024 + c0); }
        asm volatile("" ::: "memory");
#pragma unroll
        for (int m = 0; m < 4; ++m) { const int i = wr * 64 + m * 16 + fr; float s = 0.f, ss = 0.f;
#pragma unroll
            for (int w4 = 0; w4 < 4; ++w4) { s += stat[(i * 4 + w4) * 2]; ss += stat[(i * 4 + w4) * 2 + 1]; }
            const float mean = s * (1.f / 256.f); const float var = ss * (1.f / 256.f) - mean * mean; const float rstd = rsqrtf(var + 1e-6f);
            const size_t t = (size_t)n * 128 + i;
#pragma unroll
            for (int hf = 0; hf < 2; ++hf) { const int c0 = h * 256 + hf * 128 + wc * 32 + 8 * fq;
                const u32x4 sg = sgv[m][hf];
                const f32x4 g0 = gnv[hf][0], g1 = gnv[hf][1];
                const f32x4 a = acc[m][2 * hf], b = acc[m][2 * hf + 1];
                float o[8];
                o[0] = (a[0] - mean) * rstd * g0[0] * bflo(sg.x); o[1] = (a[1] - mean) * rstd * g0[1] * bfhi(sg.x);
                o[2] = (a[2] - mean) * rstd * g0[2] * bflo(sg.y); o[3] = (a[3] - mean) * rstd * g0[3] * bfhi(sg.y);
                o[4] = (b[0] - mean) * rstd * g1[0] * bflo(sg.z); o[5] = (b[1] - mean) * rstd * g1[1] * bfhi(sg.z);
                o[6] = (b[2] - mean) * rstd * g1[2] * bflo(sg.w); o[7] = (b[3] - mean) * rstd * g1[3] * bfhi(sg.w);
                u32x4 w; w.x = cvt_pk_bf16(o[0], o[1]); w.y = cvt_pk_bf16(o[2], o[3]); w.z = cvt_pk_bf16(o[4], o[5]); w.w = cvt_pk_bf16(o[6], o[7]);
                *(u32x4*)(mixb + t * 2048 + c0) = w; } }
        __syncthreads();
    }
}
typedef float f32x2 __attribute__((ext_vector_type(2)));
__device__ __forceinline__ void wsm_phase(const float* ws, bf16_t* WsM, int wg, int nwg, int wave_s) {
    const int tid = opaque_tid(wave_s);
    for (int i = wg * NTHR + tid; i < 4 * 128 * 128; i += nwg * NTHR) { const int t = (i >> 7) & 127, s = i & 127; WsM[i] = (bf16_t)(cvt_pk_bf16(s <= t ? ws[i] : 0.f, 0.f) & 0xffffu); }
}
__device__ __forceinline__ void gmlp_norm_phase(LAS unsigned char* lds, const bf16_t* gvT, bf16_t* vnT, const float* gain, int wg, int nwg, int wave_s) {
    const int tid = opaque_tid(wave_s), tg = tid & 15, c0 = tid >> 4;
    LAS float* red = (LAS float*)lds;
    for (int u = wg; u < 512; u += nwg) {
        const int n = u >> 2, g = u & 3;
        const size_t boff = (size_t)(g * 256 + c0) * T_ + n * 128 + tg * 8;
        u32x4 w[8]; float s[8], q[8], gn8[8];
#pragma unroll
        for (int i = 0; i < 8; ++i) gn8[i] = gain[g * 256 + c0 + 32 * i];
#pragma unroll
        for (int e = 0; e < 8; ++e) { s[e] = 0.f; q[e] = 0.f; }
#pragma unroll
        for (int i = 0; i < 8; ++i) { w[i] = *(const u32x4*)(gvT + boff + (size_t)(32 * i) * T_);
            const float v[8] = {bflo(w[i].x), bfhi(w[i].x), bflo(w[i].y), bfhi(w[i].y), bflo(w[i].z), bfhi(w[i].z), bflo(w[i].w), bfhi(w[i].w)};
#pragma unroll
            for (int e = 0; e < 8; ++e) { s[e] += v[e]; q[e] += v[e] * v[e]; } }
#pragma unroll
        for (int e = 0; e < 8; ++e) { s[e] += __shfl_xor(s[e], 16); q[e] += __shfl_xor(q[e], 16); s[e] += __shfl_xor(s[e], 32); q[e] += __shfl_xor(q[e], 32); }
        { const int wv = tid >> 6;
          if ((tid & 48) == 0) {
#pragma unroll
            for (int e = 0; e < 8; ++e) *(LAS f32x2*)(red + ((e * 8 + wv) * 16 + tg) * 2) = (f32x2){s[e], q[e]}; } }
        __syncthreads();
        float mean[8], rstd[8];
#pragma unroll
        for (int e = 0; e < 8; ++e) { float a = 0.f, b = 0.f;
#pragma unroll
            for (int k = 0; k < 8; ++k) { const f32x2 t2 = *(const LAS f32x2*)(red + ((e * 8 + k) * 16 + tg) * 2); a += t2[0]; b += t2[1]; }
            mean[e] = a * (1.f / 256.f); rstd[e] = rsqrtf(b * (1.f / 256.f) - mean[e] * mean[e] + 1e-6f); }
#pragma unroll
        for (int i = 0; i < 8; ++i) { const float gn = gn8[i];
            const float v[8] = {bflo(w[i].x), bfhi(w[i].x), bflo(w[i].y), bfhi(w[i].y), bflo(w[i].z), bfhi(w[i].z), bflo(w[i].w), bfhi(w[i].w)};
            u32x4 o; o.x = cvt_pk_bf16((v[0] - mean[0]) * rstd[0] * gn, (v[1] - mean[1]) * rstd[1] * gn); o.y = cvt_pk_bf16((v[2] - mean[2]) * rstd[2] * gn, (v[3] - mean[3]) * rstd[3] * gn);
            o.z = cvt_pk_bf16((v[4] - mean[4]) * rstd[4] * gn, (v[5] - mean[5]) * rstd[5] * gn); o.w = cvt_pk_bf16((v[6] - mean[6]) * rstd[6] * gn, (v[7] - mean[7]) * rstd[7] * gn);
            *(u32x4*)(vnT + boff + (size_t)(32 * i) * T_) = o; }
        __syncthreads();
    }
}
__device__ __forceinline__ void gmlp_mix_phase(LAS unsigned char* lds, const bf16_t* WsM, const bf16_t* vnT, const bf16_t* ugb, const float* bs, bf16_t* mixb, int wg, int nwg, int wave_s) {
    typedef Core<4, 4> C;
    const int tid = opaque_tid(wave_s), wid = __builtin_amdgcn_readfirstlane(tid >> 6), lane = tid & 63, wr = wid >> 2, wc = wid & 3, fr = lane & 15, fq = lane >> 4;
    unsigned aoff[2], boff[4];
#pragma unroll
    for (int i = 0; i < 2; ++i) { int r, c; C::apiece(tid, i, r, c); aoff[i] = (unsigned)(r * 128 + c) * 2u; }
#pragma unroll
    for (int i = 0; i < 4; ++i) { int r, c; C::bpiece(tid, i, r, c); boff[i] = (unsigned)(r * T_ + c) * 2u; }
    for (int u = wg; u < 512; u += nwg) {
        const int n = u >> 2, g = u & 3;
        f32x4 acc[4][4]; C::zero(acc);
        C::burst_gg(lds, lds + 32768, (const char*)(WsM + g * 16384), aoff, (const char*)(vnT + (size_t)(g * 256) * T_ + n * 128), boff, 2, acc, wid, wr, wc, fr, fq);
        u32x4 ugv[4][2]; float bsv[4];
#pragma unroll
        for (int m = 0; m < 4; ++m) { const int i = wr * 64 + m * 16 + fr; bsv[m] = bs[g * 128 + i];
#pragma unroll
            for (int hf = 0; hf < 2; ++hf) ugv[m][hf] = *(const u32x4*)(ugb + ((size_t)n * 128 + i) * 1024 + g * 256 + hf * 128 + wc * 32 + 8 * fq); }
        asm volatile("" ::: "memory");
#pragma unroll
        for (int m = 0; m < 4; ++m) { const int i = wr * 64 + m * 16 + fr; const float bias = bsv[m]; const size_t t = (size_t)n * 128 + i;
#pragma unroll
            for (int hf = 0; hf < 2; ++hf) { const int c0 = g * 256 + hf * 128 + wc * 32 + 8 * fq;
                const u32x4 ug = ugv[m][hf];
                const f32x4 a = acc[m][2 * hf], b = acc[m][2 * hf + 1];
                u32x4 w; w.x = cvt_pk_bf16((a[0] + bias) * bflo(ug.x), (a[1] + bias) * bfhi(ug.x)); w.y = cvt_pk_bf16((a[2] + bias) * bflo(ug.y), (a[3] + bias) * bfhi(ug.y));
                w.z = cvt_pk_bf16((b[0] + bias) * bflo(ug.z), (b[1] + bias) * bfhi(ug.z)); w.w = cvt_pk_bf16((b[2] + bias) * bflo(ug.w), (b[3] + bias) * bfhi(ug.w));
                *(u32x4*)(mixb + t * 2048 + 1024 + c0) = w; } }
        __syncthreads();
    }
}
template <bool B16> __device__ __forceinline__ float4 ld_x4(const void* base, size_t i4) {
    if (B16) { const u32x2 w = ((const u32x2*)base)[i4]; return make_float4(bflo(w.x), bfhi(w.x), bflo(w.y), bfhi(w.y)); }
    return ((const float4*)base)[i4]; }
template <bool B16> __device__ __forceinline__ void st_x4(void* base, size_t i4, float4 v) {
    if (B16) { u32x2 w; w.x = cvt_pk_bf16(v.x, v.y); w.y = cvt_pk_bf16(v.z, v.w); ((u32x2*)base)[i4] = w; }
    else ((float4*)base)[i4] = v; }
template <bool OUT16 = false> struct EpiResidualT {
    const float* xin; float* xout; float sc = 1.f;
    __device__ __forceinline__ bool swapped(int) const { return false; }
    __device__ __forceinline__ int brow0(int pn) const { return pn * 256; }
    __device__ __forceinline__ void operator()(const f32x4 (&acc)[8][4], int pm, int pn, int wr, int wc, int fr, int fq) const {
        f32x4 xa[2][4], xb[2][4];
#define ER_ROW(m2) (pm * 256 + arow_of<8>(wr, 2 * (m2), fr))
#define ER_LD(buf, m2) do { int row0_ = ER_ROW(m2); asm volatile("" : "+v"(row0_)); const float* ip0_ = xin + (size_t)row0_ * D_ + pn * 256; \
        _Pragma("unroll") for (int r = 0; r < 2; ++r) _Pragma("unroll") for (int n = 0; n < 4; ++n) buf[r][n] = *(const f32x4*)(ip0_ + (size_t)r * 16 * D_ + bcol_of<4>(wc, n, fq, 0)); } while (0)
#define ER_ST(buf, m2) do { int row0_ = ER_ROW(m2); asm volatile("" : "+v"(row0_)); \
        if (OUT16) { bf16_t* op0_ = (bf16_t*)xout + (size_t)row0_ * D_ + pn * 256; \
            _Pragma("unroll") for (int r = 0; r < 2; ++r) _Pragma("unroll") for (int hf = 0; hf < 2; ++hf) { const f32x4 a_ = buf[r][2 * hf] + acc[2 * (m2) + r][2 * hf] * sc, b_ = buf[r][2 * hf + 1] + acc[2 * (m2) + r][2 * hf + 1] * sc; \
                u32x4 o_; o_.x = cvt_pk_bf16(a_[0], a_[1]); o_.y = cvt_pk_bf16(a_[2], a_[3]); o_.z = cvt_pk_bf16(b_[0], b_[1]); o_.w = cvt_pk_bf16(b_[2], b_[3]); *(u32x4*)(op0_ + (size_t)r * 16 * D_ + hf * 128 + wc * 32 + 8 * fq) = o_; } } \
        else { float* op0_ = xout + (size_t)row0_ * D_ + pn * 256; \
        _Pragma("unroll") for (int r = 0; r < 2; ++r) _Pragma("unroll") for (int n = 0; n < 4; ++n) *(f32x4*)(op0_ + (size_t)r * 16 * D_ + bcol_of<4>(wc, n, fq, 0)) = buf[r][n] + acc[2 * (m2) + r][n] * sc; } } while (0)
        ER_LD(xa, 0); ER_LD(xb, 1); asm volatile("" ::: "memory");
        ER_ST(xa, 0); asm volatile("" ::: "memory"); ER_LD(xa, 2); asm volatile("" ::: "memory");
        ER_ST(xb, 1); asm volatile("" ::: "memory"); ER_LD(xb, 3); asm volatile("" ::: "memory");
        ER_ST(xa, 2); ER_ST(xb, 3); asm volatile("" ::: "memory");
#undef ER_ROW
#undef ER_LD
#undef ER_ST
    }
};
typedef EpiResidualT<false> EpiResidual;
struct EpiResidual16 {
    bf16_t* x; float sc = 1.f;
    __device__ __forceinline__ bool swapped(int) const { return false; }
    __device__ __forceinline__ int brow0(int pn) const { return pn * 256; }
    __device__ __forceinline__ void operator()(const f32x4 (&acc)[8][4], int pm, int pn, int wr, int wc, int fr, int fq) const {
#pragma unroll
        for (int mb = 0; mb < 8; mb += 4) {
            u32x4 w[4][2];
#pragma unroll
            for (int m = 0; m < 4; ++m) { int row = pm * 256 + arow_of<8>(wr, mb + m, fr); asm volatile("" : "+v"(row)); const bf16_t* p = x + (size_t)row * D_ + pn * 256 + wc * 32 + 8 * fq;
                w[m][0] = *(const u32x4*)p; w[m][1] = *(const u32x4*)(p + 128); }
            asm volatile("" ::: "memory");
#pragma unroll
            for (int m = 0; m < 4; ++m) { int row = pm * 256 + arow_of<8>(wr, mb + m, fr); asm volatile("" : "+v"(row)); bf16_t* p = x + (size_t)row * D_ + pn * 256 + wc * 32 + 8 * fq;
#pragma unroll
                for (int hf = 0; hf < 2; ++hf) { const u32x4 ww = w[m][hf]; const f32x4 a = acc[mb + m][2 * hf] * sc, b = acc[mb + m][2 * hf + 1] * sc; u32x4 o;
                    o.x = cvt_pk_bf16(bflo(ww.x) + a[0], bfhi(ww.x) + a[1]); o.y = cvt_pk_bf16(bflo(ww.y) + a[2], bfhi(ww.y) + a[3]);
                    o.z = cvt_pk_bf16(bflo(ww.z) + b[0], bfhi(ww.z) + b[1]); o.w = cvt_pk_bf16(bflo(ww.w) + b[2], bfhi(ww.w) + b[3]);
                    *(u32x4*)(p + hf * 128) = o; } }
            asm volatile("" ::: "memory"); }
    }
};
struct EpiResidualY {
    const float* xin; const bf16_t* y; float* xout;
    __device__ __forceinline__ bool swapped(int) const { return false; }
    __device__ __forceinline__ int brow0(int pn) const { return pn * 256; }
    __device__ __forceinline__ void operator()(const f32x4 (&acc)[8][4], int pm, int pn, int wr, int wc, int fr, int fq) const {
#pragma unroll
        for (int m = 0; m < 8; ++m) { int row = pm * 256 + arow_of<8>(wr, m, fr); asm volatile("" : "+v"(row));
            const float* ip = xin + (size_t)row * D_ + pn * 256; float* op = xout + (size_t)row * D_ + pn * 256;
            const bf16_t* y0 = y + (size_t)(2 * row) * D_ + pn * 256; const bf16_t* y1 = y0 + D_;
#pragma unroll
            for (int hf = 0; hf < 2; ++hf) { const int c = hf * 128 + wc * 32 + 8 * fq;
                const u32x4 a = *(const u32x4*)(y0 + c), b = *(const u32x4*)(y1 + c);
                f32x4 x0 = *(const f32x4*)(ip + c) + acc[m][2 * hf], x1v = *(const f32x4*)(ip + c + 4) + acc[m][2 * hf + 1];
                x0[0] += bflo(a.x) + bflo(b.x); x0[1] += bfhi(a.x) + bfhi(b.x); x0[2] += bflo(a.y) + bflo(b.y); x0[3] += bfhi(a.y) + bfhi(b.y);
                x1v[0] += bflo(a.z) + bflo(b.z); x1v[1] += bfhi(a.z) + bfhi(b.z); x1v[2] += bflo(a.w) + bflo(b.w); x1v[3] += bfhi(a.w) + bfhi(b.w);
                *(f32x4*)(op + c) = x0; *(f32x4*)(op + c + 4) = x1v; }
            asm volatile("" ::: "memory"); }
    }
};

#define CAPF 16384
typedef float f32x2 __attribute__((ext_vector_type(2)));
__device__ __forceinline__ void wr_phase(const float* wrg, const float* wre, bf16_t* WrT, int wg, int nwg, int wave_s) {
    const int tid = opaque_tid(wave_s);
    for (int i = wg * NTHR + tid; i < 64 * 2048; i += nwg * NTHR) { const int r = i >> 11, k = i & 2047;
        const float v = r < 4 ? wrg[k * 4 + r] : (r < 36 ? wre[k * 32 + (r - 4)] : 0.f);
        WrT[i] = (bf16_t)(cvt_pk_bf16(v, 0.f) & 0xffffu); }
}
template <bool XIN16>
__device__ __forceinline__ void moe_route_phase(LAS unsigned char* lds, const void* x1, const float* g, bf16_t* hb, unsigned char* hb8, const bf16_t* WrT, const float* brg, const float* bre,
                                                int* cnt, int* list, float* gate, int wg, int nwg, int wave_s) {
    typedef Core<2, 1> C;
    const int tid = opaque_tid(wave_s), wid = __builtin_amdgcn_readfirstlane(tid >> 6), lane = tid & 63, wr = wid >> 2, wc = wid & 3, fr = lane & 15, fq = lane >> 4;
    unsigned aoff[1], boff[1];
    { int r, c; C::apiece(tid, 0, r, c); aoff[0] = (unsigned)(r * 2048 + c) * 2u; C::bpiece(tid, 0, r, c); boff[0] = (unsigned)(r * 2048 + c) * 2u; }
    LAS float* lg = (LAS float*)lds;
    for (int u = wg; u < T_ / 64; u += nwg) {
        if constexpr (true) {
            const float* xf = (const float*)x1; f32x4 gv[8], xa[8]; u32x4 xh[4];
#pragma unroll
            for (int i = 0; i < 4; ++i) { const int e0 = 8 * (lane + 64 * i); gv[2 * i] = *(const f32x4*)(g + e0); gv[2 * i + 1] = *(const f32x4*)(g + e0 + 4); }
#define RT_LOAD(row_) do { const size_t rb_ = (size_t)(row_) * D_; _Pragma("unroll") for (int i = 0; i < 4; ++i) { const int e0 = 8 * (lane + 64 * i); \
        if (XIN16) xh[i] = *(const u32x4*)((const bf16_t*)x1 + rb_ + e0); else { xa[2 * i] = *(const f32x4*)(xf + rb_ + e0); xa[2 * i + 1] = *(const f32x4*)(xf + rb_ + e0 + 4); } } } while (0)
            RT_LOAD(u * 64 + wid * 8);
            for (int rr = 0; rr < 8; ++rr) { const int row = u * 64 + wid * 8 + rr;
                f32x4 v[8]; float ss = 0.f;
#pragma unroll
                for (int i = 0; i < 8; ++i) { if (XIN16) { const u32x4 w = xh[i >> 1]; v[i] = (i & 1) ? (f32x4){bflo(w.z), bfhi(w.z), bflo(w.w), bfhi(w.w)} : (f32x4){bflo(w.x), bfhi(w.x), bflo(w.y), bfhi(w.y)}; } else v[i] = xa[i];
                    ss += v[i][0] * v[i][0] + v[i][1] * v[i][1] + v[i][2] * v[i][2] + v[i][3] * v[i][3]; }
                asm volatile("" ::: "memory");
                if (rr < 7) RT_LOAD(row + 1);
                asm volatile("" ::: "memory");
                ss = wave_sum(ss);
                const float r = rsqrtf(ss * (1.f / D_) + 1e-6f);
#pragma unroll
                for (int i = 0; i < 4; ++i) { const int e0 = 8 * (lane + 64 * i); const f32x4 ga = gv[2 * i], gb = gv[2 * i + 1], a = v[2 * i], b = v[2 * i + 1];
                    const float h8[8] = {a[0] * r * ga[0], a[1] * r * ga[1], a[2] * r * ga[2], a[3] * r * ga[3], b[0] * r * gb[0], b[1] * r * gb[1], b[2] * r * gb[2], b[3] * r * gb[3]};
                    u32x4 o; o.x = cvt_pk_bf16(h8[0], h8[1]); o.y = cvt_pk_bf16(h8[2], h8[3]); o.z = cvt_pk_bf16(h8[4], h8[5]); o.w = cvt_pk_bf16(h8[6], h8[7]);
                    *(u32x4*)(hb + (size_t)row * D_ + e0) = o;
                    if (hb8) { u32x2 w; w.x = pk4_fp8(4.f * h8[0], 4.f * h8[1], 4.f * h8[2], 4.f * h8[3]); w.y = pk4_fp8(4.f * h8[4], 4.f * h8[5], 4.f * h8[6], 4.f * h8[7]); *(u32x2*)(hb8 + (size_t)row * D_ + e0) = w; } } }
#undef RT_LOAD
        } else
        for (int rr = 0; rr < 8; ++rr) { const int row = u * 64 + wid * 8 + rr;
            float4 v[8]; float ss = 0.f;
#pragma unroll
            for (int i = 0; i < 8; ++i) { v[i] = ld_x4<XIN16>(x1, (size_t)row * (D_ / 4) + 2 * (lane + 64 * (i >> 1)) + (i & 1)); ss += v[i].x * v[i].x + v[i].y * v[i].y + v[i].z * v[i].z + v[i].w * v[i].w; }
            ss = wave_sum(ss);
            const float r = rsqrtf(ss * (1.f / D_) + 1e-6f);
#pragma unroll
            for (int i = 0; i < 4; ++i) { const int e0 = 8 * (lane + 64 * i); const float4 ga = *(const float4*)(g + e0), gb = *(const float4*)(g + e0 + 4); const float4 a = v[2 * i], b = v[2 * i + 1];
                const float h8[8] = {a.x * r * ga.x, a.y * r * ga.y, a.z * r * ga.z, a.w * r * ga.w, b.x * r * gb.x, b.y * r * gb.y, b.z * r * gb.z, b.w * r * gb.w};
                u32x4 o; o.x = cvt_pk_bf16(h8[0], h8[1]); o.y = cvt_pk_bf16(h8[2], h8[3]); o.z = cvt_pk_bf16(h8[4], h8[5]); o.w = cvt_pk_bf16(h8[6], h8[7]);
                *(u32x4*)(hb + (size_t)row * D_ + e0) = o;
                if (hb8) { u32x2 w; w.x = pk4_fp8(4.f * h8[0], 4.f * h8[1], 4.f * h8[2], 4.f * h8[3]); w.y = pk4_fp8(4.f * h8[4], 4.f * h8[5], 4.f * h8[6], 4.f * h8[7]); *(u32x2*)(hb8 + (size_t)row * D_ + e0) = w; } } }
        WAIT_V0(); __syncthreads();
        f32x4 acc[2][1]; C::zero(acc);
        for (int kb = 0; kb < 4; ++kb) {
            C::burst_gg(lds, lds + 65536, (const char*)(hb + (size_t)u * 64 * D_) + kb * 1024, aoff, (const char*)WrT + kb * 1024, boff, 8, acc, wid, wr, wc, fr, fq);
            __syncthreads(); }
#pragma unroll
        for (int m = 0; m < 2; ++m) { const int row = wr * 32 + m * 16 + fr;
#pragma unroll
            for (int j = 0; j < 4; ++j) { const int col = wc * 16 + 4 * fq + j; if (col < 36) lg[row * 40 + col] = acc[m][0][j] + (col < 4 ? brg[col] : bre[col - 4]); } }
        __syncthreads();
        if (tid < 64) {
            const int t = u * 64 + tid; const LAS float* L = lg + tid * 40;
            float l4[4], le[32];
#pragma unroll
            for (int i = 0; i < 4; ++i) l4[i] = L[i];
#pragma unroll
            for (int i = 0; i < 32; ++i) le[i] = L[4 + i];
            int gs = 0; float gm = l4[0];
#pragma unroll
            for (int i = 1; i < 4; ++i) if (l4[i] > gm) { gm = l4[i]; gs = i; }
            float den = 0.f;
#pragma unroll
            for (int i = 0; i < 4; ++i) den += __expf(l4[i] - gm);
            const float psel = 1.f / den;
            float l8[8];
#pragma unroll
            for (int i = 0; i < 8; ++i) l8[i] = gs == 0 ? le[i] : gs == 1 ? le[8 + i] : gs == 2 ? le[16 + i] : le[24 + i];
            int e1 = 0; float m1 = l8[0];
#pragma unroll
            for (int i = 1; i < 8; ++i) if (l8[i] > m1) { m1 = l8[i]; e1 = i; }
            int e2 = -1; float m2 = -3.0e38f;
#pragma unroll
            for (int i = 0; i < 8; ++i) if (i != e1 && l8[i] > m2) { m2 = l8[i]; e2 = i; }
            const float z = __expf(m2 - m1);
            const int ex1 = gs * 8 + e1, ex2 = gs * 8 + e2;
            LAS int* hist = (LAS int*)(lg + 64 * 40);
            if (tid < 32) hist[tid] = 0;
            const int r1 = __hip_atomic_fetch_add(hist + ex1, 1, __ATOMIC_RELAXED, __HIP_MEMORY_SCOPE_WORKGROUP);
            const int r2 = __hip_atomic_fetch_add(hist + ex2, 1, __ATOMIC_RELAXED, __HIP_MEMORY_SCOPE_WORKGROUP);
            if (tid < 32) { const int c = hist[tid]; hist[32 + tid] = c ? atomicAdd(&cnt[tid], c) : 0; }
            const int p1 = hist[32 + ex1] + r1, p2 = hist[32 + ex2] + r2;
            list[ex1 * CAPF + p1] = t * 2; list[ex2 * CAPF + p2] = t * 2 + 1;
            gate[ex1 * CAPF + p1] = psel / (1.f + z); gate[ex2 * CAPF + p2] = psel * z / (1.f + z);
        }
        __syncthreads();
    }
}
__device__ __forceinline__ void moe_prefix(LAS int* tp, LAS int* cn, LAS int* tab, const int* cnt, int tid) {
    if (tid == 0) { int s = 0; for (int e = 0; e < 32; ++e) { const int c = cnt[e]; cn[e] = c; tp[e] = s; s += (c + 255) >> 8; } tp[32] = s; }
    __syncthreads();
    if (tid < 32) { const int nf = (cn[tid] + 255) >> 8, k0 = tp[tid]; for (int r = 0; r < nf; ++r) tab[k0 + r] = (tid << 8) | r; }
    __syncthreads();
}
struct MoeU { int R, pn, e, rt, ne, tpe; };
__device__ __forceinline__ bool moe_unit(int idx, int total, const LAS int* tp, const LAS int* cn, const LAS int* tab, MoeU& u) {
    if (idx >= total) return false;
    u.pn = idx & 7;
    const int t = __builtin_amdgcn_readfirstlane(tab[idx >> 3]);
    u.e = t >> 8; u.rt = t & 255; u.tpe = __builtin_amdgcn_readfirstlane(tp[u.e]); u.R = u.tpe + u.rt; u.ne = __builtin_amdgcn_readfirstlane(cn[u.e]); return true;
}
struct GuSched {
    typedef MoeU U; static constexpr bool GATHER = true;
    static constexpr bool RAGGED = true;
    const char* hb; const char* Wgu; const int* list; const LAS int* tp; const LAS int* cn; const LAS int* tab; int wg, nwg, total, rb;
    __device__ __forceinline__ bool next(int i, U& u) const { return moe_unit(i * nwg + wg, total, tp, cn, tab, u); }
    __device__ __forceinline__ int nvalid(const U& u) const { const int r = u.ne - u.rt * 256; return r < 256 ? r : 256; }
    __device__ __forceinline__ const char* abase(const U&) const { return hb; }
    __device__ __forceinline__ const char* bbase(const U& u) const { return Wgu + ((size_t)u.e * 2048 + u.pn * 256) * rb; }
    __device__ __forceinline__ void gather(const U& u, int R0, unsigned (&pk)[2]) const {
        int l[4];
#pragma unroll
        for (int q = 0; q < 4; ++q) { int gr = u.rt * 256 + (q >> 1) * 128 + R0 + 64 * (q & 1); gr = gr < u.ne ? gr : u.ne - 1; l[q] = list[u.e * CAPF + gr]; }
        asm volatile("" : "+v"(l[0]), "+v"(l[1]), "+v"(l[2]), "+v"(l[3]));
        pk[0] = (unsigned)(l[0] >> 1) | ((unsigned)(l[1] >> 1) << 16); pk[1] = (unsigned)(l[2] >> 1) | ((unsigned)(l[3] >> 1) << 16); }
};
template <bool FP8> struct EpiGu { void* hid;
    __device__ __forceinline__ void operator()(const f32x4 (&acc)[8][4], const MoeU& u, int wr, int wc, int fr, int fq) const {
        const float si = FP8 ? (1.f / 256.f) : 1.f, so = FP8 ? 8.f : 1.f;
#pragma unroll
        for (int m = 0; m < 8; ++m) { int gr = u.rt * 256 + arow_of<8>(wr, m, fr); asm volatile("" : "+v"(gr));
            if (gr < u.ne) {
                float o[8];
#pragma unroll
                for (int e = 0; e < 8; ++e) { const float a = acc[m][e >> 2][e & 3] * si, b = acc[m][2 + (e >> 2)][e & 3] * si; o[e] = silu_fast(a) * b * so; if (FP8) o[e] = __builtin_amdgcn_fmed3f(o[e], -448.f, 448.f); }
                const size_t off = ((size_t)u.tpe * 256 + gr) * 1024 + u.pn * 128 + wc * 32 + 8 * fq;
                if (FP8) { u32x2 w; w.x = pk4_fp8(o[0], o[1], o[2], o[3]); w.y = pk4_fp8(o[4], o[5], o[6], o[7]); *(u32x2*)((unsigned char*)hid + off) = w; }
                else { u32x4 w; w.x = cvt_pk_bf16(o[0], o[1]); w.y = cvt_pk_bf16(o[2], o[3]); w.z = cvt_pk_bf16(o[4], o[5]); w.w = cvt_pk_bf16(o[6], o[7]); *(u32x4*)((bf16_t*)hid + off) = w; } }
            asm volatile("" ::: "memory"); }
    }
};
template <bool FP8>
__device__ __forceinline__ void moe_gu_phase(LAS unsigned char* lds, const void* h, const void* Wgu, const int* cnt, const int* list, void* hid, int wg, int nwg, int wave_s) {
    const int tid = opaque_tid(wave_s);
    LAS int* tp = (LAS int*)(lds + 143360); LAS int* cn = tp + 40; LAS int* tab = tp + 80;
    moe_prefix(tp, cn, tab, cnt, tid);
    const int rb = FP8 ? 2048 : 4096;
    GuSched S{(const char*)h, (const char*)Wgu, list, tp, cn, tab, wg, nwg, __builtin_amdgcn_readfirstlane(tp[32]) * 8, rb}; EpiGu<FP8> E{hid};
    gemm8_phase<FP8>(lds, rb, S, E, wave_s);
    __syncthreads();
}
struct DownSched {
    typedef MoeU U; static constexpr bool GATHER = false;
    static constexpr bool RAGGED = true;
    const char* hid; const char* Wdn; const LAS int* tp; const LAS int* cn; const LAS int* tab; int wg, nwg, total, rb;
    __device__ __forceinline__ bool next(int i, U& u) const { return moe_unit(i * nwg + wg, total, tp, cn, tab, u); }
    __device__ __forceinline__ int nvalid(const U& u) const { const int r = u.ne - u.rt * 256; return r < 256 ? r : 256; }
    __device__ __forceinline__ const char* abase(const U& u) const { return hid + (size_t)u.R * 256 * rb; }
    __device__ __forceinline__ const char* bbase(const U& u) const { return Wdn + ((size_t)u.e * 2048 + u.pn * 256) * rb; }
    __device__ __forceinline__ void gather(const U&, int, unsigned (&)[2]) const {}
};
template <bool Y8> struct EpiDown { const int* list; const float* gate; void* y; float sc;
    __device__ __forceinline__ void operator()(const f32x4 (&acc)[8][4], const MoeU& u, int wr, int wc, int fr, int fq) const {
        int slot[8]; float gt[8];
#pragma unroll
        for (int m = 0; m < 8; ++m) { int gr = u.rt * 256 + arow_of<8>(wr, m, fr); gr = gr < u.ne ? gr : u.ne - 1; slot[m] = list[u.e * CAPF + gr]; gt[m] = gate[u.e * CAPF + gr] * sc; }
        { float dep = 0.f;
#pragma unroll
          for (int m = 0; m < 8; ++m) dep += gt[m] + (float)slot[m];
          asm volatile("" :: "v"(dep)); }
#pragma unroll
        for (int m = 0; m < 8; ++m) { const int gr = u.rt * 256 + arow_of<8>(wr, m, fr);
            if (gr < u.ne) { const float g = gt[m];
                const size_t yo = (size_t)slot[m] * 2048 + u.pn * 256 + wc * 32 + 8 * fq;
#pragma unroll
                for (int hf = 0; hf < 2; ++hf) { const f32x4 a = acc[m][2 * hf], b = acc[m][2 * hf + 1];
                    if (Y8) { float o[8] = {g * a[0], g * a[1], g * a[2], g * a[3], g * b[0], g * b[1], g * b[2], g * b[3]};
#pragma unroll
                        for (int e = 0; e < 8; ++e) o[e] = __builtin_amdgcn_fmed3f(o[e], -448.f, 448.f);
                        u32x2 w; w.x = pk4_fp8(o[0], o[1], o[2], o[3]); w.y = pk4_fp8(o[4], o[5], o[6], o[7]); *(u32x2*)((unsigned char*)y + yo + hf * 128) = w; }
                    else { u32x4 w; w.x = cvt_pk_bf16(g * a[0], g * a[1]); w.y = cvt_pk_bf16(g * a[2], g * a[3]); w.z = cvt_pk_bf16(g * b[0], g * b[1]); w.w = cvt_pk_bf16(g * b[2], g * b[3]);
                        *(u32x4*)((bf16_t*)y + yo + hf * 128) = w; } } } }
    }
};
template <bool FP8, bool Y8>
__device__ __forceinline__ void moe_down_phase(LAS unsigned char* lds, const void* hid, const void* Wdn, const int* cnt, const int* list, const float* gate, void* y, int wg, int nwg, int wave_s) {
    const int tid = opaque_tid(wave_s);
    LAS int* tp = (LAS int*)(lds + 143360); LAS int* cn = tp + 40; LAS int* tab = tp + 80;
    moe_prefix(tp, cn, tab, cnt, tid);
    const int rb = FP8 ? 1024 : 2048;
    DownSched S{(const char*)hid, (const char*)Wdn, tp, cn, tab, wg, nwg, __builtin_amdgcn_readfirstlane(tp[32]) * 8, rb}; EpiDown<Y8> E{list, gate, y, (FP8 ? (1.f / 256.f) : 1.f) * (Y8 ? 64.f : 1.f)};
    gemm8_phase<FP8>(lds, rb, S, E, wave_s);
    __syncthreads();
}
template <bool WRITE_X, bool Y8, bool XIN16, bool XOUT16, bool HB8 = false>
__device__ __forceinline__ void moe_combine_phase_gen(const void* xin, void* xout, const void* y, const float* g, bf16_t* hb, float* outf, int wg, int nwg, int wave_s) {
    const int tid = opaque_tid(wave_s), lane = tid & 63, wv = tid >> 6;
    for (int row = wg * 8 + wv; row < T_; row += nwg * 8) {
        const size_t r4 = (size_t)row * (D_ / 4);
        float4 v[8]; float ss = 0.f;
#pragma unroll
        for (int i = 0; i < 4; ++i) { const int e0 = 8 * (lane + 64 * i);
            float4 a = ld_x4<XIN16>(xin, r4 + e0 / 4), b = ld_x4<XIN16>(xin, r4 + e0 / 4 + 1);
            if (Y8) { const u32x2 p = *(const u32x2*)((const unsigned char*)y + (size_t)(2 * row) * D_ + e0), q2 = *(const u32x2*)((const unsigned char*)y + (size_t)(2 * row + 1) * D_ + e0);
                const f32x2 p0 = __builtin_amdgcn_cvt_pk_f32_fp8((int)p.x, false), p1 = __builtin_amdgcn_cvt_pk_f32_fp8((int)p.x, true), p2 = __builtin_amdgcn_cvt_pk_f32_fp8((int)p.y, false), p3 = __builtin_amdgcn_cvt_pk_f32_fp8((int)p.y, true);
                const f32x2 s0 = __builtin_amdgcn_cvt_pk_f32_fp8((int)q2.x, false), s1 = __builtin_amdgcn_cvt_pk_f32_fp8((int)q2.x, true), s2 = __builtin_amdgcn_cvt_pk_f32_fp8((int)q2.y, false), s3 = __builtin_amdgcn_cvt_pk_f32_fp8((int)q2.y, true);
                a.x += (p0[0] + s0[0]) * (1.f / 64.f); a.y += (p0[1] + s0[1]) * (1.f / 64.f); a.z += (p1[0] + s1[0]) * (1.f / 64.f); a.w += (p1[1] + s1[1]) * (1.f / 64.f);
                b.x += (p2[0] + s2[0]) * (1.f / 64.f); b.y += (p2[1] + s2[1]) * (1.f / 64.f); b.z += (p3[0] + s3[0]) * (1.f / 64.f); b.w += (p3[1] + s3[1]) * (1.f / 64.f); }
            else { const u32x4 p = *(const u32x4*)((const bf16_t*)y + (size_t)(2 * row) * D_ + e0), q2 = *(const u32x4*)((const bf16_t*)y + (size_t)(2 * row + 1) * D_ + e0);
                a.x += bflo(p.x) + bflo(q2.x); a.y += bfhi(p.x) + bfhi(q2.x); a.z += bflo(p.y) + bflo(q2.y); a.w += bfhi(p.y) + bfhi(q2.y);
                b.x += bflo(p.z) + bflo(q2.z); b.y += bfhi(p.z) + bfhi(q2.z); b.z += bflo(p.w) + bflo(q2.w); b.w += bfhi(p.w) + bfhi(q2.w); }
            v[2 * i] = a; v[2 * i + 1] = b;
            ss += a.x * a.x + a.y * a.y + a.z * a.z + a.w * a.w + b.x * b.x + b.y * b.y + b.z * b.z + b.w * b.w; }
        ss = wave_sum(ss);
        const float r = rsqrtf(ss * (1.f / D_) + 1e-6f);
#pragma unroll
        for (int i = 0; i < 4; ++i) { const int e0 = 8 * (lane + 64 * i); const float4 ga = *(const float4*)(g + e0), gb = *(const float4*)(g + e0 + 4); const float4 a = v[2 * i], b = v[2 * i + 1];
            if (hb) { if (WRITE_X) { st_x4<XOUT16>(xout, r4 + e0 / 4, a); st_x4<XOUT16>(xout, r4 + e0 / 4 + 1, b); }
                if (HB8) { const float r4s = 4.f * r; u32x2 o; o.x = pk4_fp8(a.x * r4s * ga.x, a.y * r4s * ga.y, a.z * r4s * ga.z, a.w * r4s * ga.w); o.y = pk4_fp8(b.x * r4s * gb.x, b.y * r4s * gb.y, b.z * r4s * gb.z, b.w * r4s * gb.w);
                    *(u32x2*)((unsigned char*)hb + (size_t)row * D_ + e0) = o; }
                else { u32x4 o; o.x = cvt_pk_bf16(a.x * r * ga.x, a.y * r * ga.y); o.y = cvt_pk_bf16(a.z * r * ga.z, a.w * r * ga.w); o.z = cvt_pk_bf16(b.x * r * gb.x, b.y * r * gb.y); o.w = cvt_pk_bf16(b.z * r * gb.z, b.w * r * gb.w);
                *(u32x4*)(hb + (size_t)row * D_ + e0) = o; } }
            else { float4 oa, ob; oa.x = a.x * r * ga.x; oa.y = a.y * r * ga.y; oa.z = a.z * r * ga.z; oa.w = a.w * r * ga.w; ob.x = b.x * r * gb.x; ob.y = b.y * r * gb.y; ob.z = b.z * r * gb.z; ob.w = b.w * r * gb.w;
                *(float4*)(outf + (size_t)row * D_ + e0) = oa; *(float4*)(outf + (size_t)row * D_ + e0 + 4) = ob; } }
    }
}
__device__ __forceinline__ void moe_combine_phase2(const float* x1, const bf16_t* y, const float* g, bf16_t* hb, float* xd, int wg, int nwg, int wave_s) {
    const int tid = opaque_tid(wave_s), lane = tid & 63, wv = tid >> 6;
    for (int row = wg * 8 + wv; row < T_; row += nwg * 8) {
        const float4* xr = (const float4*)(x1 + (size_t)row * D_); float4* xo = (float4*)(xd + (size_t)row * D_);
        const u32x2* y0 = (const u32x2*)(y + (size_t)(2 * row) * D_); const u32x2* y1 = (const u32x2*)(y + (size_t)(2 * row + 1) * D_);
        float4 v[8]; float ss = 0.f;
#pragma unroll
        for (int i = 0; i < 8; ++i) { v[i] = xr[lane + 64 * i]; const u32x2 a = y0[lane + 64 * i], b = y1[lane + 64 * i];
            v[i].x += bflo(a.x) + bflo(b.x); v[i].y += bfhi(a.x) + bfhi(b.x); v[i].z += bflo(a.y) + bflo(b.y); v[i].w += bfhi(a.y) + bfhi(b.y);
            ss += v[i].x * v[i].x + v[i].y * v[i].y + v[i].z * v[i].z + v[i].w * v[i].w; }
        ss = wave_sum(ss);
        const float r = rsqrtf(ss * (1.f / D_) + 1e-6f);
#pragma unroll
        for (int i = 0; i < 8; ++i) { const float4 gg = ((const float4*)g)[lane + 64 * i]; xo[lane + 64 * i] = v[i];
            u32x2 o; o.x = cvt_pk_bf16(v[i].x * r * gg.x, v[i].y * r * gg.y); o.y = cvt_pk_bf16(v[i].z * r * gg.z, v[i].w * r * gg.w);
            *(u32x2*)(hb + (size_t)row * D_ + (lane + 64 * i) * 4) = o; }
    }
}

template <bool WRITE_X, bool HB8, bool XIN16 = false, bool XOUT16 = false>
__device__ __forceinline__ void moe_combine_phase_pipe(const float* xin, float* xout, const unsigned char* y, const float* g, bf16_t* hb, float* outf, int wg, int nwg, int wave_s) {
    const int tid = opaque_tid(wave_s), lane = tid & 63, wv = tid >> 6;
    f32x4 gv[8];
#pragma unroll
    for (int i = 0; i < 4; ++i) { const int e0 = 8 * (lane + 64 * i); gv[2 * i] = *(const f32x4*)(g + e0); gv[2 * i + 1] = *(const f32x4*)(g + e0 + 4); }
    f32x4 xa[8]; u32x4 xh[4]; u32x2 yp[4], yq[4];
#define MC_LOAD(row_) do { const size_t rb_ = (size_t)(row_) * D_; _Pragma("unroll") for (int i = 0; i < 4; ++i) { const int e0 = 8 * (lane + 64 * i); \
        if (XIN16) xh[i] = *(const u32x4*)((const bf16_t*)xin + rb_ + e0); else { xa[2 * i] = *(const f32x4*)(xin + rb_ + e0); xa[2 * i + 1] = *(const f32x4*)(xin + rb_ + e0 + 4); } \
        yp[i] = *(const u32x2*)(y + 2 * rb_ + e0); yq[i] = *(const u32x2*)(y + 2 * rb_ + D_ + e0); } } while (0)
    int row = wg * 8 + wv;
    if (row < T_) MC_LOAD(row);
    for (; row < T_; row += nwg * 8) {
        f32x4 v[8]; float ss = 0.f;
#pragma unroll
        for (int i = 0; i < 4; ++i) { f32x4 a, b; const u32x2 p = yp[i], q2 = yq[i];
            if (XIN16) { const u32x4 w = xh[i]; a = (f32x4){bflo(w.x), bfhi(w.x), bflo(w.y), bfhi(w.y)}; b = (f32x4){bflo(w.z), bfhi(w.z), bflo(w.w), bfhi(w.w)}; } else { a = xa[2 * i]; b = xa[2 * i + 1]; }
            const f32x2 p0 = __builtin_amdgcn_cvt_pk_f32_fp8((int)p.x, false), p1 = __builtin_amdgcn_cvt_pk_f32_fp8((int)p.x, true), p2 = __builtin_amdgcn_cvt_pk_f32_fp8((int)p.y, false), p3 = __builtin_amdgcn_cvt_pk_f32_fp8((int)p.y, true);
            const f32x2 s0 = __builtin_amdgcn_cvt_pk_f32_fp8((int)q2.x, false), s1 = __builtin_amdgcn_cvt_pk_f32_fp8((int)q2.x, true), s2 = __builtin_amdgcn_cvt_pk_f32_fp8((int)q2.y, false), s3 = __builtin_amdgcn_cvt_pk_f32_fp8((int)q2.y, true);
            a[0] += (p0[0] + s0[0]) * (1.f / 64.f); a[1] += (p0[1] + s0[1]) * (1.f / 64.f); a[2] += (p1[0] + s1[0]) * (1.f / 64.f); a[3] += (p1[1] + s1[1]) * (1.f / 64.f);
            b[0] += (p2[0] + s2[0]) * (1.f / 64.f); b[1] += (p2[1] + s2[1]) * (1.f / 64.f); b[2] += (p3[0] + s3[0]) * (1.f / 64.f); b[3] += (p3[1] + s3[1]) * (1.f / 64.f);
            v[2 * i] = a; v[2 * i + 1] = b;
            ss += a[0] * a[0] + a[1] * a[1] + a[2] * a[2] + a[3] * a[3] + b[0] * b[0] + b[1] * b[1] + b[2] * b[2] + b[3] * b[3]; }
        asm volatile("" ::: "memory");
        if (row + nwg * 8 < T_) MC_LOAD(row + nwg * 8);
        asm volatile("" ::: "memory");
        ss = wave_sum(ss);
        const float r = rsqrtf(ss * (1.f / D_) + 1e-6f);
        const size_t rb = (size_t)row * D_;
#pragma unroll
        for (int i = 0; i < 4; ++i) { const int e0 = 8 * (lane + 64 * i); const f32x4 ga = gv[2 * i], gb = gv[2 * i + 1], a = v[2 * i], b = v[2 * i + 1];
            if (hb) { if (WRITE_X) { if (XOUT16) { u32x4 o; o.x = cvt_pk_bf16(a[0], a[1]); o.y = cvt_pk_bf16(a[2], a[3]); o.z = cvt_pk_bf16(b[0], b[1]); o.w = cvt_pk_bf16(b[2], b[3]); *(u32x4*)((bf16_t*)xout + rb + e0) = o; }
                                      else { *(f32x4*)(xout + rb + e0) = a; *(f32x4*)(xout + rb + e0 + 4) = b; } }
                if (HB8) { const float r4s = 4.f * r; u32x2 o; o.x = pk4_fp8(a[0] * r4s * ga[0], a[1] * r4s * ga[1], a[2] * r4s * ga[2], a[3] * r4s * ga[3]); o.y = pk4_fp8(b[0] * r4s * gb[0], b[1] * r4s * gb[1], b[2] * r4s * gb[2], b[3] * r4s * gb[3]);
                    *(u32x2*)((unsigned char*)hb + rb + e0) = o; }
                else { u32x4 o; o.x = cvt_pk_bf16(a[0] * r * ga[0], a[1] * r * ga[1]); o.y = cvt_pk_bf16(a[2] * r * ga[2], a[3] * r * ga[3]); o.z = cvt_pk_bf16(b[0] * r * gb[0], b[1] * r * gb[1]); o.w = cvt_pk_bf16(b[2] * r * gb[2], b[3] * r * gb[3]);
                    *(u32x4*)(hb + rb + e0) = o; } }
            else { f32x4 oa, ob;
#pragma unroll
                for (int e = 0; e < 4; ++e) { oa[e] = a[e] * r * ga[e]; ob[e] = b[e] * r * gb[e]; }
                *(f32x4*)(outf + rb + e0) = oa; *(f32x4*)(outf + rb + e0 + 4) = ob; } }
    }
#undef MC_LOAD
}
template <bool WRITE_X, bool Y8, bool XIN16, bool XOUT16, bool HB8 = false>
__device__ __forceinline__ void moe_combine_phase(const void* xin, void* xout, const void* y, const float* g, bf16_t* hb, float* outf, int wg, int nwg, int wave_s) {
    if constexpr (Y8) moe_combine_phase_pipe<WRITE_X, HB8, XIN16, XOUT16>((const float*)xin, (float*)xout, (const unsigned char*)y, g, hb, outf, wg, nwg, wave_s);
    else moe_combine_phase_gen<WRITE_X, Y8, XIN16, XOUT16, HB8>(xin, xout, y, g, hb, outf, wg, nwg, wave_s);
}
__device__ __forceinline__ void lb_phase(const float* lbp, float* lbv, int wg, int nwg, int wave_s) {
    const int tid = opaque_tid(wave_s);
    for (int i = wg * NTHR + tid; i < 2048; i += nwg * NTHR) lbv[i] = 1.f / (1.f + __expf(lbp[i] - lbp[2048 + i]));
}
template <bool S8> struct EpiInC {
    bf16_t *qs, *vT, *sg, *lf; const float* lbv;
    static constexpr float SC = S8 ? (1.f / 256.f) : 1.f;
    __device__ __forceinline__ bool swapped(int pn) const { return pn >= 16 && pn < 24; }
    __device__ __forceinline__ int brow0(int pn) const { return pn * 256; }
    __device__ __forceinline__ void operator()(const f32x4 (&acc)[8][4], int pm, int pn, int wr, int wc, int fr, int fq) const {
        if (pn < 8 || pn >= 24) {
            bf16_t* dst = (pn < 8 ? qs : sg) + (size_t)((pn & 7) * 2) * T_ * 128;
#pragma unroll
            for (int m = 0; m < 8; ++m) { int row = pm * 256 + arow_of<8>(wr, m, fr); asm volatile("" : "+v"(row));
#pragma unroll
                for (int hf = 0; hf < 2; ++hf) { u32x4 w; const f32x4 a = acc[m][2 * hf], b = acc[m][2 * hf + 1];
                    w.x = cvt_pk_bf16(silu_fast(SC * a[0]), silu_fast(SC * a[1])); w.y = cvt_pk_bf16(silu_fast(SC * a[2]), silu_fast(SC * a[3]));
                    w.z = cvt_pk_bf16(silu_fast(SC * b[0]), silu_fast(SC * b[1])); w.w = cvt_pk_bf16(silu_fast(SC * b[2]), silu_fast(SC * b[3]));
                    *(u32x4*)(dst + ((size_t)hf * T_ + row) * 128 + wc * 32 + 8 * fq) = w; } }
        } else if (pn < 16) {
            const int cb = (pn - 8) * 256; f32x4 lb[4];
#pragma unroll
            for (int n = 0; n < 4; ++n) lb[n] = *(const f32x4*)(lbv + cb + bcol_of<4>(wc, n, fq, 0));
#pragma unroll
            for (int m = 0; m < 8; ++m) { int row = pm * 256 + arow_of<8>(wr, m, fr); asm volatile("" : "+v"(row));
#pragma unroll
                for (int hf = 0; hf < 2; ++hf) { float o[8];
#pragma unroll
                    for (int e = 0; e < 8; ++e) { const float z = acc[m][2 * hf + (e >> 2)][e & 3], l = lb[2 * hf + (e >> 2)][e & 3]; o[e] = 0.6931471805599453f * __builtin_amdgcn_logf(l + (1.f - l) * __builtin_amdgcn_rcpf(1.f + __builtin_amdgcn_exp2f((-1.4426950408889634f * SC) * z))); }
                    u32x4 w; w.x = cvt_pk_bf16(o[0], o[1]); w.y = cvt_pk_bf16(o[2], o[3]); w.z = cvt_pk_bf16(o[4], o[5]); w.w = cvt_pk_bf16(o[6], o[7]);
                    *(u32x4*)(lf + ((size_t)((pn - 8) * 2 + hf) * T_ + row) * 128 + wc * 32 + 8 * fq) = w; } }
        } else {
            bf16_t* dst = vT + ((size_t)((pn - 16) * 2) * 128 + pm * 2) * 16384;
#pragma unroll
            for (int m = 0; m < 8; ++m) { int f = arow_of<8>(wr, m, fr); asm volatile("" : "+v"(f));
#pragma unroll
                for (int hf = 0; hf < 2; ++hf) { u32x4 w; const f32x4 a = acc[m][2 * hf], b = acc[m][2 * hf + 1];
                    w.x = cvt_pk_bf16(SC * a[0], SC * a[1]); w.y = cvt_pk_bf16(SC * a[2], SC * a[3]); w.z = cvt_pk_bf16(SC * b[0], SC * b[1]); w.w = cvt_pk_bf16(SC * b[2], SC * b[3]);
                    *(u32x4*)(dst + ((size_t)(m >> 2) * 128 + hf) * 16384 + (f & 127) * 128 + wc * 32 + 8 * fq) = w; } }
        }
    }
};
__device__ __forceinline__ int bcol_to_slot2(int c) { const int c5 = c & 31; return (c & ~31) + ((c5 >> 2) & 1) * 16 + (c5 >> 3) * 4 + (c5 & 3); }
template <bool BG>
__device__ __forceinline__ void hgrn_kv_phase(LAS unsigned char* lds, const bf16_t* lf, const bf16_t* vT, float* dec, bf16_t* KVT2, const float* bw0, const float* bw1, const float* bw2, unsigned char* bgu, unsigned char* bdn, int tile0, int wg, int nwg, int wave_s) {
    typedef Core<4, 2> C;
    const int tid = opaque_tid(wave_s), wid = __builtin_amdgcn_readfirstlane(tid >> 6), lane = tid & 63, wr = wid >> 2, wc = wid & 3, fr = lane & 15, fq = lane >> 4;
    LAS unsigned char* ldsB = lds + 65536;
    LAS float* tot = (LAS float*)(lds + 131072);
    unsigned aoff[2];
#pragma unroll
    for (int i = 0; i < 2; ++i) { int r, c; C::apiece(tid, i, r, c); aoff[i] = (unsigned)(r * 128 + c) * 2u; }
    const int q4 = lane & 31, s = wid * 2 + (lane >> 5), dk0 = 4 * q4;
    u32x2 lw[8];
    if (wg < 2048) { const size_t t0 = (size_t)(wg >> 4) * 128 + s * 8; const size_t col = (size_t)(wg & 15) * T_ * 128 + dk0;
#pragma unroll
        for (int j = 0; j < 8; ++j) lw[j] = *(const u32x2*)(lf + (t0 + j) * 128 + col); }
    for (int u = wg; u < 2048; u += nwg) {
        const int n = u >> 4, h = u & 15;
        const size_t t0 = (size_t)n * 128 + s * 8; const size_t col = (size_t)h * T_ * 128 + dk0;
        float4 bg[3][8];
        if (BG) {
#pragma unroll
            for (int b3 = 0; b3 < 3; ++b3) bg_issue(bw0, bw1, bw2, tile0 + 3 * u + b3, bg[b3], tid); }
        float l[8][4]; float sm[4] = {0.f, 0.f, 0.f, 0.f};
#pragma unroll
        for (int j = 0; j < 8; ++j) { const u32x2 w = lw[j]; l[j][0] = bflo(w.x); l[j][1] = bfhi(w.x); l[j][2] = bflo(w.y); l[j][3] = bfhi(w.y);
#pragma unroll
            for (int d = 0; d < 4; ++d) sm[d] += l[j][d]; }
        *(LAS f32x4*)(tot + s * 128 + dk0) = (f32x4){sm[0], sm[1], sm[2], sm[3]};
        __syncthreads();
        { const char* Vb = (const char*)(vT + (size_t)(h * 128 + n) * 16384); C::stage_a(lds, Vb, aoff, 0u, wid); C::stage_a(lds + 16384, Vb, aoff, 128u, wid); }
        float pre[4] = {0.f, 0.f, 0.f, 0.f}, tt[4] = {0.f, 0.f, 0.f, 0.f};
#pragma unroll
        for (int q = 0; q < 16; ++q) { const f32x4 v = *(const LAS f32x4*)(tot + q * 128 + dk0);
#pragma unroll
            for (int d = 0; d < 4; ++d) { tt[d] += v[d]; pre[d] += (q < s) ? v[d] : 0.f; } }
        if (s == 0) *(f32x4*)(dec + (size_t)n * 2048 + col) = (f32x4){__expf(tt[0]), __expf(tt[1]), __expf(tt[2]), __expf(tt[3])};
        float kh[4][8];
#pragma unroll
        for (int j = 0; j < 8; ++j)
#pragma unroll
            for (int d = 0; d < 4; ++d) { pre[d] += l[j][d]; kh[d][j] = (1.f - __expf(l[j][d])) * __expf(tt[d] - pre[d]); }
        const int jj = s * 8;
#pragma unroll
        for (int d = 0; d < 4; ++d) { u32x4 w; w.x = cvt_pk_bf16(kh[d][0], kh[d][1]); w.y = cvt_pk_bf16(kh[d][2], kh[d][3]); w.z = cvt_pk_bf16(kh[d][4], kh[d][5]); w.w = cvt_pk_bf16(kh[d][6], kh[d][7]);
            *(LAS u32x4*)(ldsB + (jj >> 6) * 16384 + lds_byte(bcol_to_slot2(dk0 + d), jj & 63)) = w; }
        WAIT_V0(); __syncthreads();
        f32x4 acc[4][2]; C::zero(acc);
        C::compute(lds, ldsB, acc, wr, wc, fr, fq); C::compute(lds + 16384, ldsB + 16384, acc, wr, wc, fr, fq);
        __syncthreads();
        if (u + nwg < 2048) { const int un = u + nwg; const size_t t0n = (size_t)(un >> 4) * 128 + s * 8; const size_t coln = (size_t)(un & 15) * T_ * 128 + dk0;
#pragma unroll
            for (int j = 0; j < 8; ++j) lw[j] = *(const u32x2*)(lf + (t0n + j) * 128 + coln); }
        bf16_t* dst = KVT2 + (size_t)u * 16384;
#pragma unroll
        for (int m = 0; m < 4; ++m) { const f32x4 a = acc[m][0], b = acc[m][1]; u32x4 w;
            w.x = cvt_pk_bf16(a[0], a[1]); w.y = cvt_pk_bf16(a[2], a[3]); w.z = cvt_pk_bf16(b[0], b[1]); w.w = cvt_pk_bf16(b[2], b[3]);
            *(u32x4*)(dst + (wr * 64 + m * 16 + fr) * 128 + wc * 32 + 8 * fq) = w; }
        if (BG) {
#pragma unroll
            for (int b3 = 0; b3 < 3; ++b3) bg_write(lds + b3 * 18432, bg[b3], (tile0 + 3 * u + b3) >= 8192 ? 32.f : 64.f, tid);
            __syncthreads();
#pragma unroll
            for (int b3 = 0; b3 < 3; ++b3) bg_store(lds + b3 * 18432, bgu, bdn, tile0 + 3 * u + b3, tid);
            __syncthreads(); }
    }
}
__device__ __forceinline__ void hgrn_scan_phase(const bf16_t* KVT2, const float* dec, bf16_t* STb2, int wg, int nwg, int wave_s) {
    const int tid = opaque_tid(wave_s);
    for (int e = (wg * NTHR + tid) * 2; e < 262144; e += nwg * NTHR * 2) {
        const int c = (e >> 14) * 128 + (e & 127);
        float s0 = 0.f, s1 = 0.f;
        for (int n0 = 0; n0 < 128; n0 += 8) {
            unsigned kv[8]; float2 d[8];
#pragma unroll
            for (int i = 0; i < 8; ++i) { kv[i] = *(const unsigned*)(KVT2 + (size_t)(n0 + i) * 262144 + e); d[i] = *(const float2*)(dec + (size_t)(n0 + i) * 2048 + c); }
#pragma unroll
            for (int i = 0; i < 8; ++i) { *(unsigned*)(STb2 + (size_t)(n0 + i) * 262144 + e) = cvt_pk_bf16(s0, s1); s0 = d[i].x * s0 + bflo(kv[i]); s1 = d[i].y * s1 + bfhi(kv[i]); }
        }
    }
}
template <bool BG, bool MIX8 = false>
__device__ __forceinline__ void hgrn_out_phase(LAS unsigned char* lds, const bf16_t* qs, const bf16_t* lf, const bf16_t* vT, const bf16_t* STb2, const bf16_t* sg,
                                               const float* gain, bf16_t* mixb, const float* bw0, const float* bw1, const float* bw2, unsigned char* bgu, unsigned char* bdn, int tile0, int wg, int nwg, int wave_s) {
    typedef Core<4, 2> C;
    const int tid = opaque_tid(wave_s), wid = __builtin_amdgcn_readfirstlane(tid >> 6), lane = tid & 63, wr = wid >> 2, wc = wid & 3, fr = lane & 15, fq = lane >> 4;
    LAS unsigned char* lQ = lds; LAS unsigned char* lK = lds + 32768; LAS unsigned char* lS = lds + 65536; LAS unsigned char* lV = lds + 98304;
    LAS float* stat = (LAS float*)(lds + 131072);
    LAS float* tot = (LAS float*)(lds + 133120);
    unsigned soff[2], voff[2];
#pragma unroll
    for (int i = 0; i < 2; ++i) { int r, c; C::bpiece(tid, i, r, c); soff[i] = (unsigned)(r * 128 + c) * 2u; voff[i] = (unsigned)(r * 128 + c) * 2u; }
    const int q4 = lane & 31, s = wid * 2 + (lane >> 5), dk0 = 4 * q4;
    u32x2 lw[8], qw8[8];
    if (wg < 2048) { const size_t t0 = (size_t)(wg >> 4) * 128 + s * 8; const size_t col = (size_t)(wg & 15) * T_ * 128 + dk0;
#pragma unroll
        for (int j = 0; j < 8; ++j) { lw[j] = *(const u32x2*)(lf + (t0 + j) * 128 + col); qw8[j] = *(const u32x2*)(qs + (t0 + j) * 128 + col); } }
    for (int u = wg; u < 2048; u += nwg) {
        const int n = u >> 4, h = u & 15;
        const char* Sb = (const char*)(STb2 + (size_t)u * 16384); const char* Vb = (const char*)(vT + (size_t)(h * 128 + n) * 16384);
        float4 bg[3][8];
        if (BG) {
#pragma unroll
            for (int b3 = 0; b3 < 3; ++b3) bg_issue(bw0, bw1, bw2, tile0 + 3 * u + b3, bg[b3], tid); }
        {
            const size_t t0 = (size_t)n * 128 + s * 8; const int col = h * 128 + dk0;
            float l[8][4]; float sm[4] = {0.f, 0.f, 0.f, 0.f};
#pragma unroll
            for (int j = 0; j < 8; ++j) { const u32x2 w = lw[j]; l[j][0] = bflo(w.x); l[j][1] = bfhi(w.x); l[j][2] = bflo(w.y); l[j][3] = bfhi(w.y);
#pragma unroll
                for (int d = 0; d < 4; ++d) sm[d] += l[j][d]; }
            *(LAS f32x4*)(tot + s * 128 + dk0) = (f32x4){sm[0], sm[1], sm[2], sm[3]};
            __syncthreads();
#pragma unroll
            for (int t = 0; t < 2; ++t) { C::stage_b(lS + t * 16384, Sb, soff, t * 128u, wid); C::stage_b(lV + t * 16384, Vb, voff, t * 128u, wid); }
            float pre[4] = {0.f, 0.f, 0.f, 0.f};
#pragma unroll
            for (int q = 0; q < 16; ++q) { const f32x4 v = *(const LAS f32x4*)(tot + q * 128 + dk0);
#pragma unroll
                for (int d = 0; d < 4; ++d) pre[d] += (q < s) ? v[d] : 0.f; }
#pragma unroll
            for (int j = 0; j < 8; ++j) { const u32x2 qw = qw8[j];
                const float qv[4] = {bflo(qw.x), bfhi(qw.x), bflo(qw.y), bfhi(qw.y)}; float oq[4], ok[4];
#pragma unroll
                for (int d = 0; d < 4; ++d) { pre[d] += l[j][d]; oq[d] = qv[d] * __expf(pre[d]); ok[d] = (1.f - __expf(l[j][d])) * __expf(-pre[d]); }
                const int tk = s * 8 + j;
                u32x2 w; w.x = cvt_pk_bf16(oq[0], oq[1]); w.y = cvt_pk_bf16(oq[2], oq[3]); *(LAS u32x2*)(lQ + (dk0 >> 6) * 16384 + lds_byte(tk, dk0 & 63)) = w;
                w.x = cvt_pk_bf16(ok[0], ok[1]); w.y = cvt_pk_bf16(ok[2], ok[3]); *(LAS u32x2*)(lK + (dk0 >> 6) * 16384 + lds_byte(bcol_to_slot2(tk), dk0 & 63)) = w; }
        }
        WAIT_V0(); __syncthreads();
        if (u + nwg < 2048) { const int un = u + nwg; const size_t t0n = (size_t)(un >> 4) * 128 + s * 8; const size_t coln = (size_t)(un & 15) * T_ * 128 + dk0;
#pragma unroll
            for (int j = 0; j < 8; ++j) { lw[j] = *(const u32x2*)(lf + (t0n + j) * 128 + coln); qw8[j] = *(const u32x2*)(qs + (t0n + j) * 128 + coln); } }
        {
            f32x4 sa[4][2]; C::zero(sa);
            C::compute(lQ, lK, sa, wr, wc, fr, fq); C::compute(lQ + 16384, lK + 16384, sa, wr, wc, fr, fq);
            __syncthreads();
#pragma unroll
            for (int m = 0; m < 4; ++m) { const int i = wr * 64 + m * 16 + fr; const int j0 = wc * 32 + 8 * fq;
                float p[8];
#pragma unroll
                for (int e = 0; e < 8; ++e) { const float sv = e < 4 ? sa[m][0][e] : sa[m][1][e - 4]; p[e] = (j0 + e <= i) ? sv : 0.f; }
                u32x4 w; w.x = cvt_pk_bf16(p[0], p[1]); w.y = cvt_pk_bf16(p[2], p[3]); w.z = cvt_pk_bf16(p[4], p[5]); w.w = cvt_pk_bf16(p[6], p[7]);
                *(LAS u32x4*)(lK + (wc >> 1) * 16384 + lds_byte(i, j0 & 63)) = w; }
            __syncthreads();
        }
        f32x4 acc[4][2]; C::zero(acc);
        C::compute(lQ, lS, acc, wr, wc, fr, fq); C::compute(lQ + 16384, lS + 16384, acc, wr, wc, fr, fq);
        C::compute(lK, lV, acc, wr, wc, fr, fq); C::compute(lK + 16384, lV + 16384, acc, wr, wc, fr, fq);
#pragma unroll
        for (int m = 0; m < 4; ++m) { float ss = 0.f;
#pragma unroll
            for (int nn = 0; nn < 2; ++nn)
#pragma unroll
                for (int e = 0; e < 4; ++e) { const float v = acc[m][nn][e]; ss += v * v; }
            ss += __shfl_xor(ss, 16); ss += __shfl_xor(ss, 32);
            if (fq == 0) stat[(wr * 64 + m * 16 + fr) * 4 + wc] = ss; }
        __syncthreads();
        u32x4 g8v[4]; f32x4 gn0, gn1;
        { const int c0 = h * 128 + wc * 32 + 8 * fq; gn0 = *(const f32x4*)(gain + c0); gn1 = *(const f32x4*)(gain + c0 + 4);
#pragma unroll
          for (int m = 0; m < 4; ++m) g8v[m] = *(const u32x4*)(sg + ((size_t)h * T_ + (size_t)n * 128 + wr * 64 + m * 16 + fr) * 128 + wc * 32 + 8 * fq); }
        asm volatile("" ::: "memory");
#pragma unroll
        for (int m = 0; m < 4; ++m) { const int i = wr * 64 + m * 16 + fr;
            const float ss = stat[i * 4] + stat[i * 4 + 1] + stat[i * 4 + 2] + stat[i * 4 + 3];
            const float rstd = rsqrtf(ss * (1.f / 128.f) + 1e-6f);
            const size_t t = (size_t)n * 128 + i; const int c0 = h * 128 + wc * 32 + 8 * fq;
            const u32x4 g8 = g8v[m];
            const f32x4 g0 = gn0, g1 = gn1;
            const f32x4 a = acc[m][0], b = acc[m][1];
            u32x4 w; w.x = cvt_pk_bf16(a[0] * rstd * g0[0] * bflo(g8.x), a[1] * rstd * g0[1] * bfhi(g8.x)); w.y = cvt_pk_bf16(a[2] * rstd * g0[2] * bflo(g8.y), a[3] * rstd * g0[3] * bfhi(g8.y));
            w.z = cvt_pk_bf16(b[0] * rstd * g1[0] * bflo(g8.z), b[1] * rstd * g1[1] * bfhi(g8.z)); w.w = cvt_pk_bf16(b[2] * rstd * g1[2] * bflo(g8.w), b[3] * rstd * g1[3] * bfhi(g8.w));
            if (MIX8) { float o8[8] = {a[0] * rstd * g0[0] * bflo(g8.x), a[1] * rstd * g0[1] * bfhi(g8.x), a[2] * rstd * g0[2] * bflo(g8.y), a[3] * rstd * g0[3] * bfhi(g8.y),
                                       b[0] * rstd * g1[0] * bflo(g8.z), b[1] * rstd * g1[1] * bfhi(g8.z), b[2] * rstd * g1[2] * bflo(g8.w), b[3] * rstd * g1[3] * bfhi(g8.w)};
#pragma unroll
                for (int e = 0; e < 8; ++e) o8[e] = __builtin_amdgcn_fmed3f(8.f * o8[e], -448.f, 448.f);
                u32x2 w8; w8.x = pk4_fp8(o8[0], o8[1], o8[2], o8[3]); w8.y = pk4_fp8(o8[4], o8[5], o8[6], o8[7]);
                *(u32x2*)((unsigned char*)mixb + t * 2048 + c0) = w8; }
            else *(u32x4*)(mixb + t * 2048 + c0) = w; }
        __syncthreads();
        if (BG) {
#pragma unroll
            for (int b3 = 0; b3 < 3; ++b3) bg_write(lds + b3 * 18432, bg[b3], (tile0 + 3 * u + b3) >= 8192 ? 32.f : 64.f, tid);
            __syncthreads();
#pragma unroll
            for (int b3 = 0; b3 < 3; ++b3) bg_store(lds + b3 * 18432, bgu, bdn, tile0 + 3 * u + b3, tid);
            __syncthreads(); }
    }
}
#define LDS_BYTES 147456
#define MiB(x) ((size_t)(x) << 20)
#define WS_CTL     ((size_t)0)
#define CTL_BYTES  65536
#define CTL_CNT    1024
#define CTL_BAR    4096
#define WS_X1      MiB(1)
#define WS_HB      MiB(129)
#define WS_ROPE    MiB(193)
#define WS_WSM     MiB(225)
#define WS_WR      MiB(226)
#define WS_WINAB   MiB(228)
#define WS_WOUTAB  MiB(252)
#define WS_WINC    MiB(260)
#define WS_WOUTC   MiB(292)
#define WS_WGU     MiB(300)
#define WS_WDN     MiB(812)
#define WS_SCR     MiB(1068)
#define WS_QB      (WS_SCR)
#define WS_KVT     (WS_SCR + MiB(224))
#define WS_STB     (WS_SCR + MiB(352))
#define WS_MIXB    (WS_SCR + MiB(416))
#define WS_VNT     (WS_SCR + MiB(480))
#define WS_HID     (WS_SCR)
#define WS_Y       (WS_SCR + MiB(80))
#define WS_LIST    (WS_SCR + MiB(208))
#define WS_GATE    (WS_SCR + MiB(212))
struct FArgs { const float* in[21]; float* out; unsigned char* ws; int ph_lo, ph_hi; };
#define WS1_QS     (WS_SCR)
#define WS1_VT     (WS_SCR + MiB(64))
#define WS1_SG     (WS_SCR + MiB(128))
#define WS1_LF     (WS_SCR + MiB(192))
#define WS1_QH     (WS_SCR + MiB(320))
#define WS1_KT     (WS_SCR + MiB(480))
#define WS1_KVT    (WS_SCR + MiB(544))
#define WS1_STB    (WS_SCR + MiB(672))
#define WS1_DEC    (WS_SCR + MiB(736))
#define WS_Y0      (WS_SCR + MiB(740))
#define WS_LBV     (WS_WR + MiB(1))
#define N_PHASES 20
#ifndef FP8_L0
#define FP8_L0 1
#endif
#ifndef FP8_L1
#define FP8_L1 1
#endif
#ifndef BGCONV_L1
#define BGCONV_L1 0
#endif
#ifndef F8_INC
#define F8_INC 1
#endif
#ifndef F8_INAB
#define F8_INAB 0
#endif
#ifndef BG_T2
#define BG_T2 18432
#endif
#ifndef NCONV2
#define NCONV2 85
#endif
#ifndef BG_T11
#define BG_T11 6144
#endif
#ifndef NCONV11
#define NCONV11 51
#endif
static_assert(BG_T11 == 0 || BG_T2 >= 12288, "layer-0 tiles must be converted before P8");
static_assert(BG_T2 + BG_T11 <= 24576, "tile ranges");
#ifndef F8_OUTC
#define F8_OUTC 1
#endif
#ifndef XB16
#define XB16 1
#endif
#ifndef Y8_L0
#define Y8_L0 1
#endif
#ifndef Y8_L1
#define Y8_L1 1
#endif
__global__ void __launch_bounds__(NTHR, 2) fwd(FArgs a) {
    extern __shared__ __attribute__((aligned(16))) unsigned char lds_raw[];
    LAS unsigned char* lds = (LAS unsigned char*)lds_raw;
    const int lo = a.ph_lo, hi = a.ph_hi;
    const int wave_s = __builtin_amdgcn_readfirstlane(threadIdx.x >> 6);
    const int wg = blockIdx.x, nwg = gridDim.x;
    if (threadIdx.x == 0) *(LAS u32x4*)(lds + LDS_BYTES - 16) = (u32x4){0u, 0u, 0u, 0u};
    __syncthreads();
    XcdBarrier bar; bar.bar = (unsigned*)(a.ws + WS_CTL + CTL_BAR); bar.x = 0; bar.st = (volatile LAS unsigned*)(lds + LDS_BYTES - 16);
    if (hi - lo > 1) bar = xcd_barrier_post((unsigned*)(a.ws + WS_CTL + CTL_BAR), (volatile LAS unsigned*)(lds + LDS_BYTES - 16));
#define GRID_BAR() xcd_barrier(bar)
#define IN(k) (lo <= (k) && (k) < hi)
#define BOTH(k) (IN(k) && IN((k) + 1))
#ifndef DUP_MASK
#define DUP_MASK 0
#endif
#define DUP(k) ((DUP_MASK >> (k)) & 1)
#define PH(k, ...) if (IN(k)) { __VA_ARGS__ if (DUP(k)) { GRID_BAR(); __VA_ARGS__ } if (BOTH(k)) GRID_BAR(); }
    unsigned char* ws = a.ws;
    float* x1 = (float*)(ws + WS_X1); bf16_t* xb = (bf16_t*)(ws + WS1_QH);     bf16_t* hb = (bf16_t*)(ws + WS_HB);
    bf16_t* WsM = (bf16_t*)(ws + WS_WSM); bf16_t* WrT = (bf16_t*)(ws + WS_WR); float* lbv = (float*)(ws + WS_LBV);
    bf16_t* winab = (bf16_t*)(ws + WS_WINAB); bf16_t* woutab = (bf16_t*)(ws + WS_WOUTAB); bf16_t* winc = (bf16_t*)(ws + WS_WINC); bf16_t* woutc = (bf16_t*)(ws + WS_WOUTC);
    bf16_t* wgu = (bf16_t*)(ws + WS_WGU); bf16_t* wdn = (bf16_t*)(ws + WS_WDN);
    bf16_t* qb = (bf16_t*)(ws + WS_QB); bf16_t* KVT = (bf16_t*)(ws + WS_KVT); bf16_t* STb = (bf16_t*)(ws + WS_STB); bf16_t* mixb = (bf16_t*)(ws + WS_MIXB); bf16_t* vnT = (bf16_t*)(ws + WS_VNT);
    unsigned char* hb8 = ws + WS_ROPE;
    bf16_t* hid = (bf16_t*)(ws + WS_HID); bf16_t* yb = (bf16_t*)(ws + WS_Y); bf16_t* yb0 = (bf16_t*)(ws + WS_Y0); int* list = (int*)(ws + WS_LIST); float* gate = (float*)(ws + WS_GATE);
    int* cnt = (int*)(ws + WS_CTL + CTL_CNT);
    const size_t TS = (size_t)T_ * 1024; const size_t WGU_L = (size_t)32 * 2048 * 2048, WDN_L = (size_t)32 * 2048 * 1024;
    PH(0, {
        { ConvJob J{a.in[4], winab, 2048, 6144, 1, 6144, 6144, 6144, 0, 0}; if (F8_INAB) conv8_phase(lds, J, 64.f, wg, nwg, wave_s); else conv_phase(lds, J, wg, nwg, wave_s); }
        { ConvJob J{a.in[9], woutab, 2048, 2048, 1, 2048, 2048, 2048, 0, 0}; conv_phase(lds, J, wg, nwg, wave_s); }
        { ConvJob J{a.in[10], winc, 2048, 8192, 1, 8192, 8192, 8192, 0, 0}; if (F8_INC) conv8_phase(lds, J, 64.f, wg, nwg, wave_s); else conv_phase(lds, J, wg, nwg, wave_s); }
        { ConvJob J{a.in[13], woutc, 2048, 2048, 1, 2048, 2048, 2048, 0, 0}; if (F8_OUTC) conv8_phase(lds, J, 64.f, wg, nwg, wave_s); else conv_phase(lds, J, wg, nwg, wave_s); }
        if (FP8_L0 && FP8_L1 && !BGCONV_L1) { if (BG_T2 + BG_T11 < 24576) conv_stream(lds, a.in[18], a.in[19], a.in[20], (unsigned char*)wgu, (unsigned char*)wdn, BG_T2 + BG_T11, 24576, wg, nwg, wave_s); }
        else for (int L = 0; L < 2; ++L) {
            const bool f8 = L ? (FP8_L1 != 0) : (FP8_L0 != 0);
            if (L == 1 && BGCONV_L1 && FP8_L1) continue;
            const float* sg_ = a.in[18] + (size_t)L * 32 * 2048 * 1024; const float* su_ = a.in[19] + (size_t)L * 32 * 2048 * 1024; const float* sd_ = a.in[20] + (size_t)L * 32 * 2048 * 1024;
            ConvJob Jg{sg_, wgu + L * WGU_L, 2048, 1024, 32, 2048, 128, 256, 0, 0}, Ju{su_, wgu + L * WGU_L, 2048, 1024, 32, 2048, 128, 256, 128, 0}, Jd{sd_, wdn + L * WDN_L, 1024, 2048, 32, 2048, 2048, 2048, 0, 0};
            if (f8) { conv8_phase(lds, Jg, 64.f, wg, nwg, wave_s); conv8_phase(lds, Ju, 64.f, wg, nwg, wave_s); conv8_phase(lds, Jd, 32.f, wg, nwg, wave_s); }
            else { conv_phase(lds, Jg, wg, nwg, wave_s); conv_phase(lds, Ju, wg, nwg, wave_s); conv_phase(lds, Jd, wg, nwg, wave_s); }
        }
        wr_phase(a.in[14], a.in[16], WrT, wg, nwg, wave_s);
        wr_phase(a.in[14] + 2048 * 4, a.in[16] + 2048 * 32, WrT + 64 * 2048, wg, nwg, wave_s);
        wsm_phase(a.in[7], WsM, wg, nwg, wave_s);
        lb_phase(a.in[11], lbv, wg, nwg, wave_s);
        norm_rows_bf16<F8_INAB != 0>(a.in[0], a.in[1], hb, wg, nwg, wave_s);
    })

    PH(2, { const bool split = FP8_L0 && FP8_L1 && !BGCONV_L1 && BG_T2 > 0 && nwg > 2 * NCONV2; const int ng = split ? nwg - NCONV2 : nwg;
            if (wg < ng) { EpiInAB<F8_INAB != 0> E{qb, qb + TS, qb + 3 * TS, qb + 4 * TS, qb + 5 * TS, qb + 6 * TS};
                if (F8_INAB) gemm_phase_f8(lds, (const unsigned char*)hb, (const unsigned char*)winab, 64, 24, 2048, E, wave_s, wg, ng); else gemm_phase(lds, hb, winab, 64, 24, 2048, E, wave_s, wg, ng); }
            else conv_stream(lds, a.in[18], a.in[19], a.in[20], (unsigned char*)wgu, (unsigned char*)wdn, 0, BG_T2, wg - ng, nwg - ng, wave_s); })
    PH(3, { gmlp_norm_phase(lds, qb + 6 * TS, vnT, a.in[6], wg, nwg, wave_s); ret_kv_phase(lds, qb + 3 * TS, qb + TS, KVT, wg, nwg, wave_s); })
    PH(4, { ret_scan_phase(KVT, STb, wg, nwg, wave_s); })
    PH(5, { ret_out_phase(lds, qb, qb + TS, qb + 3 * TS, STb, qb + 4 * TS, a.in[5], mixb, wg, nwg, wave_s);
                 gmlp_mix_phase(lds, WsM, vnT, qb + 5 * TS, a.in[8], mixb, wg, nwg, wave_s); })
    PH(6, { if (XB16) { EpiResidualT<true> E{a.in[0], (float*)xb}; gemm_phase(lds, mixb, woutab, 64, 8, 2048, E, wave_s); } else { EpiResidual E{a.in[0], x1}; gemm_phase(lds, mixb, woutab, 64, 8, 2048, E, wave_s); } })
    PH(7, { moe_route_phase<XB16 != 0>(lds, XB16 ? (const void*)xb : (const void*)x1, a.in[2], hb, FP8_L0 ? hb8 : nullptr, WrT, a.in[15], a.in[17], cnt, list, gate, wg, nwg, wave_s); })
    PH(8, { moe_gu_phase<FP8_L0 != 0>(lds, FP8_L0 ? (const void*)hb8 : (const void*)hb, wgu, cnt, list, hid, wg, nwg, wave_s); })
    PH(9, { moe_down_phase<FP8_L0 != 0, Y8_L0 != 0>(lds, hid, wdn, cnt, list, gate, yb, wg, nwg, wave_s); })
    PH(10, { moe_combine_phase<true, Y8_L0 != 0, XB16 != 0, XB16 != 0, F8_INC != 0>(XB16 ? (const void*)xb : (const void*)x1, XB16 ? (void*)xb : (void*)x1, yb, a.in[1] + D_, hb, nullptr, wg, nwg, wave_s); })
    bf16_t* qs = (bf16_t*)(ws + WS1_QS); bf16_t* vT1 = (bf16_t*)(ws + WS1_VT); bf16_t* sg1 = (bf16_t*)(ws + WS1_SG); bf16_t* lf = (bf16_t*)(ws + WS1_LF);
    bf16_t* qh = (bf16_t*)(ws + WS1_QH); bf16_t* kt = (bf16_t*)(ws + WS1_KT); bf16_t* KVT2 = (bf16_t*)(ws + WS1_KVT); bf16_t* STb2 = (bf16_t*)(ws + WS1_STB); float* dec = (float*)(ws + WS1_DEC);
    PH(11, { const bool split = FP8_L0 && FP8_L1 && !BGCONV_L1 && BG_T11 > 0 && nwg > 2 * NCONV11; const int ng = split ? nwg - NCONV11 : nwg;
            if (wg < ng) { EpiInC<F8_INC != 0> E{qs, vT1, sg1, lf, lbv};
                if (F8_INC) gemm_phase_f8(lds, (const unsigned char*)hb, (const unsigned char*)winc, 64, 32, 2048, E, wave_s, wg, ng); else gemm_phase(lds, hb, winc, 64, 32, 2048, E, wave_s, wg, ng); }
            else conv_stream(lds, a.in[18], a.in[19], a.in[20], (unsigned char*)wgu, (unsigned char*)wdn, BG_T2, BG_T2 + BG_T11, wg - ng, nwg - ng, wave_s); })
    PH(12, { hgrn_kv_phase<(BGCONV_L1 && FP8_L1)>(lds, lf, vT1, dec, KVT2, a.in[18] + (size_t)32 * 2048 * 1024, a.in[19] + (size_t)32 * 2048 * 1024, a.in[20] + (size_t)32 * 2048 * 1024, (unsigned char*)(wgu + WGU_L), (unsigned char*)(wdn + WDN_L), 0, wg, nwg, wave_s); })
    PH(13, { hgrn_scan_phase(KVT2, dec, STb2, wg, nwg, wave_s); })
    PH(14, { hgrn_out_phase<(BGCONV_L1 && FP8_L1), (F8_OUTC != 0)>(lds, qs, lf, vT1, STb2, sg1, a.in[12], mixb, a.in[18] + (size_t)32 * 2048 * 1024, a.in[19] + (size_t)32 * 2048 * 1024, a.in[20] + (size_t)32 * 2048 * 1024, (unsigned char*)(wgu + WGU_L), (unsigned char*)(wdn + WDN_L), 6144, wg, nwg, wave_s); })
    PH(15, { if (XB16) { EpiResidual16 E{xb, F8_OUTC ? (1.f / 512.f) : 1.f}; if (F8_OUTC) gemm_phase_f8(lds, (const unsigned char*)mixb, (const unsigned char*)woutc, 64, 8, 2048, E, wave_s); else gemm_phase(lds, mixb, woutc, 64, 8, 2048, E, wave_s); } else { EpiResidual E{x1, x1, F8_OUTC ? (1.f / 512.f) : 1.f}; if (F8_OUTC) gemm_phase_f8(lds, (const unsigned char*)mixb, (const unsigned char*)woutc, 64, 8, 2048, E, wave_s); else gemm_phase(lds, mixb, woutc, 64, 8, 2048, E, wave_s); } })
    PH(16, { moe_route_phase<XB16 != 0>(lds, XB16 ? (const void*)xb : (const void*)x1, a.in[2] + D_, hb, FP8_L1 ? hb8 : nullptr, WrT + 64 * 2048, a.in[15] + 4, a.in[17] + 32, cnt + 32, list, gate, wg, nwg, wave_s); })
    PH(17, { moe_gu_phase<FP8_L1 != 0>(lds, FP8_L1 ? (const void*)hb8 : (const void*)hb, wgu + WGU_L, cnt + 32, list, hid, wg, nwg, wave_s); })
    PH(18, { moe_down_phase<FP8_L1 != 0, Y8_L1 != 0>(lds, hid, wdn + WDN_L, cnt + 32, list, gate, yb, wg, nwg, wave_s); })
    PH(19, { moe_combine_phase<true, Y8_L1 != 0, XB16 != 0, false>(XB16 ? (const void*)xb : (const void*)x1, nullptr, yb, a.in[3], nullptr, a.out, wg, nwg, wave_s); })
#undef IN
#undef BOTH
#undef GRID_BAR
}
#ifndef N_LAUNCH_PER_PHASE
#define N_LAUNCH_PER_PHASE 0
#endif
extern "C" void kernel_launch(void* const* d_in, const int* in_sizes, int n_in, void* d_out, int out_size, void* d_ws, size_t ws_size, hipStream_t stream) {
    static int grid = 0;
    if (!grid) {
        int dev = 0, cus = 0, per_cu = 0;
        (void)hipGetDevice(&dev); (void)hipDeviceGetAttribute(&cus, hipDeviceAttributeMultiprocessorCount, dev);
        (void)hipFuncSetAttribute((const void*)fwd, hipFuncAttributeMaxDynamicSharedMemorySize, LDS_BYTES);
        if (hipOccupancyMaxActiveBlocksPerMultiprocessor(&per_cu, (const void*)fwd, NTHR, LDS_BYTES) != hipSuccess || per_cu < 1) per_cu = 1;
        (void)hipGetLastError();
        grid = cus > 0 ? cus : 256;
    }
    FArgs fa{}; for (int i = 0; i < 21; ++i) fa.in[i] = (const float*)d_in[i];
    fa.out = (float*)d_out; fa.ws = (unsigned char*)d_ws;
    (void)hipMemsetAsync((char*)d_ws + WS_CTL, 0, CTL_BYTES, stream);
#if N_LAUNCH_PER_PHASE
    for (int p = 0; p < N_PHASES; ++p) { fa.ph_lo = p; fa.ph_hi = p + 1; hipLaunchKernelGGL(fwd, dim3(grid), dim3(NTHR), LDS_BYTES, stream, fa); }
#else
    fa.ph_lo = 0; fa.ph_hi = N_PHASES; hipLaunchKernelGGL(fwd, dim3(grid), dim3(NTHR), LDS_BYTES, stream, fa);
#endif
}
```
